# Optimizing an MI355X kernel written in HIP

```python
import jax, jax.numpy as jnp
from jax import lax
import numpy as np

D_MODEL = 1024
BATCH = 8
SEQ = 2048
DEPTH = 2

POOL_WINDOWS = (2, 4, 8, 16)
N_POOL_GROUPS = len(POOL_WINDOWS)
POOL_WIDTH = D_MODEL // 2
POOL_GROUP = POOL_WIDTH // N_POOL_GROUPS
POOL_OUT_GROUP = D_MODEL // N_POOL_GROUPS
ATTN_HEADS = 8
HEAD_DIM = 64
ATTN_WIDTH = ATTN_HEADS * HEAD_DIM
MOBA_BLOCK = 256
MOBA_TOPK = 3
Q_CHUNK = 16
N_BRANCHES = 2
IN_WIDTH = POOL_WIDTH + 3 * ATTN_WIDTH + N_BRANCHES * D_MODEL
PEER_HEADS = 8
PEER_NKEYS = 128
PEER_EXPERTS = PEER_NKEYS * PEER_NKEYS
PEER_QDIM = 256
PEER_HALF = PEER_QDIM // 2
PEER_TOPK = 16
TOKEN_CHUNK = 128
EPS = 1e-6

kernel_name = "hybrid_pool_moba_peer_trunk"


def rmsnorm(x, g):
    xf = x.astype(jnp.float32)
    y = xf * lax.rsqrt(jnp.mean(xf * xf, axis=-1, keepdims=True) + EPS)
    return (y * g.astype(jnp.float32)).astype(x.dtype)


def alibi_slopes(n_heads):
    return jnp.asarray([2.0 ** (-8.0 * (h + 1) / n_heads) for h in range(n_heads)], jnp.float32)


def pool_mixer(p, w_pool, pool_scale):
    B_, S_, _ = p.shape
    pf = p.astype(jnp.float32)
    c = jnp.pad(jnp.cumsum(pf, axis=1), ((0, 0), (1, 0), (0, 0)))
    pos = jnp.arange(S_)
    outs = []
    for gi, w in enumerate(POOL_WINDOWS):
        cg = c[..., gi * POOL_GROUP:(gi + 1) * POOL_GROUP]
        start = jnp.maximum(pos + 1 - w, 0)
        cnt = (pos + 1 - start).astype(jnp.float32)
        win_mean = (cg[:, 1:] - jnp.take(cg, start, axis=1)) / cnt[None, :, None]
        outs.append(win_mean - pf[..., gi * POOL_GROUP:(gi + 1) * POOL_GROUP])
    m = jnp.stack(outs, axis=2)
    y = jnp.einsum('bsgc,gco->bsgo', m, w_pool.astype(jnp.float32)).reshape(B_, S_, D_MODEL)
    return (y * pool_scale.astype(jnp.float32)).astype(p.dtype)


def moba_attention(q, k, v):
    B_, H_, S_, dh = q.shape
    n_blk = -(-S_ // MOBA_BLOCK)
    pad = n_blk * MOBA_BLOCK - S_
    kp = jnp.pad(k, ((0, 0), (0, 0), (0, pad), (0, 0)))
    vp = jnp.pad(v, ((0, 0), (0, 0), (0, pad), (0, 0)))
    k_blocks = kp.reshape(B_, H_, n_blk, MOBA_BLOCK, dh)
    v_blocks = vp.reshape(B_, H_, n_blk, MOBA_BLOCK, dh)
    k_mean = jnp.mean(k_blocks.astype(jnp.float32), axis=3)
    top = min(MOBA_TOPK, n_blk)
    slopes = alibi_slopes(H_)
    scale = dh ** -0.5
    b_ix = jnp.arange(B_)[:, None, None, None]
    h_ix = jnp.arange(H_)[None, :, None, None]
    blk_ids = jnp.arange(n_blk)
    offs = jnp.arange(MOBA_BLOCK)

    def chunk(ci):
        t0 = ci * Q_CHUNK
        qc = lax.dynamic_slice_in_dim(q, t0, Q_CHUNK, axis=2).astype(jnp.float32)
        t = t0 + jnp.arange(Q_CHUNK)
        own = t0 // MOBA_BLOCK
        bscore = jnp.einsum('bhcd,bhnd->bhcn', qc, k_mean)
        bscore = jnp.where(blk_ids < own, bscore, -jnp.inf)
        _, sel = lax.top_k(bscore, top)
        sel_ok = sel < own
        kg = k_blocks[b_ix, h_ix, sel].astype(jnp.float32)
        vg = v_blocks[b_ix, h_ix, sel].astype(jnp.float32)
        s_sel = jnp.einsum('bhcd,bhcjkd->bhcjk', qc, kg) * scale
        dist_sel = t[None, None, :, None, None] - (sel[..., None] * MOBA_BLOCK + offs)
        s_sel = s_sel - slopes[None, :, None, None, None] * dist_sel
        s_sel = jnp.where(sel_ok[..., None], s_sel, -jnp.inf)
        k_own = lax.dynamic_slice_in_dim(kp, own * MOBA_BLOCK, MOBA_BLOCK, axis=2).astype(jnp.float32)
        v_own = lax.dynamic_slice_in_dim(vp, own * MOBA_BLOCK, MOBA_BLOCK, axis=2).astype(jnp.float32)
        dist_own = t[:, None] - (own * MOBA_BLOCK + offs)[None, :]
        s_own = jnp.einsum('bhcd,bhkd->bhck', qc, k_own) * scale
        s_own = s_own - slopes[None, :, None, None] * dist_own
        s_own = jnp.where(dist_own >= 0, s_own, -jnp.inf)
        s_all = jnp.concatenate([s_sel.reshape(B_, H_, Q_CHUNK, top * MOBA_BLOCK), s_own], axis=-1)
        pr = jax.nn.softmax(s_all, axis=-1)
        p_sel = pr[..., :top * MOBA_BLOCK].reshape(B_, H_, Q_CHUNK, top, MOBA_BLOCK)
        p_own = pr[..., top * MOBA_BLOCK:]
        o = (jnp.einsum('bhcjk,bhcjkd->bhcd', p_sel, vg)
             + jnp.einsum('bhck,bhkd->bhcd', p_own, v_own))
        return o.astype(q.dtype)

    out = lax.map(chunk, jnp.arange(S_ // Q_CHUNK))
    return out.transpose(1, 2, 0, 3, 4).reshape(B_, H_, S_, dh)


def peer_ffn(x, w_q, sub_keys, u, v):
    B_, S_, D_ = x.shape
    xt = x.reshape((B_ * S_) // TOKEN_CHUNK, TOKEN_CHUNK, D_)

    def chunk(xc):
        q = (xc @ w_q).reshape(TOKEN_CHUNK, PEER_HEADS, 2, PEER_HALF).astype(jnp.float32)
        s = jnp.einsum('thpd,pkd->thpk', q, sub_keys.astype(jnp.float32))
        sv, si = lax.top_k(s, PEER_TOPK)
        cand = sv[:, :, 0, :, None] + sv[:, :, 1, None, :]
        cand_id = si[:, :, 0, :, None] * PEER_NKEYS + si[:, :, 1, None, :]
        cv, ci = lax.top_k(cand.reshape(TOKEN_CHUNK, PEER_HEADS, PEER_TOPK * PEER_TOPK), PEER_TOPK)
        eid = jnp.take_along_axis(cand_id.reshape(TOKEN_CHUNK, PEER_HEADS, PEER_TOPK * PEER_TOPK), ci, axis=-1)
        g = jax.nn.softmax(cv, axis=-1)
        ug = u[eid].astype(jnp.float32)
        vg = v[eid].astype(jnp.float32)
        act = jax.nn.gelu(jnp.einsum('thkd,td->thk', ug, xc.astype(jnp.float32)))
        y = jnp.einsum('thk,thkd->td', g * act, vg)
        return y.astype(x.dtype)

    return lax.map(chunk, xt).reshape(B_, S_, D_)


def hybrid_layer(x, g_mix, w_in, w_pool, pool_scale, w_attn_up, w_out, g_ffn, w_peer_q, peer_keys, peer_u, peer_v):
    B_, S_, _ = x.shape
    h = rmsnorm(x, g_mix)
    z = h @ w_in
    o1 = POOL_WIDTH
    o2 = o1 + ATTN_WIDTH
    o3 = o2 + ATTN_WIDTH
    o4 = o3 + ATTN_WIDTH
    p, q, k, v, gl = z[..., :o1], z[..., o1:o2], z[..., o2:o3], z[..., o3:o4], z[..., o4:]
    branch_a = pool_mixer(p, w_pool, pool_scale)
    to_heads = lambda t: t.reshape(B_, S_, ATTN_HEADS, HEAD_DIM).transpose(0, 2, 1, 3)
    o = moba_attention(to_heads(q), to_heads(k), to_heads(v))
    branch_b = o.transpose(0, 2, 1, 3).reshape(B_, S_, ATTN_WIDTH) @ w_attn_up
    gates = jax.nn.sigmoid(gl.astype(jnp.float32)).astype(x.dtype)
    merged = gates[..., :D_MODEL] * branch_a + gates[..., D_MODEL:] * branch_b
    x = x + merged @ w_out
    x = x + peer_ffn(rmsnorm(x, g_ffn), w_peer_q, peer_keys, peer_u, peer_v)
    return x


def setup_inputs(seed: int = 0) -> dict:
    key = jax.random.key(seed)
    ks = jax.random.split(key, 14)
    f = jnp.float32
    nrm = lambda k_, shape, s: jax.random.normal(k_, shape, f) * s
    return {
        "x": nrm(ks[0], (BATCH, SEQ, D_MODEL), 1.0),
        "mix_norm": 1.0 + nrm(ks[1], (DEPTH, D_MODEL), 0.02),
        "w_in": nrm(ks[2], (DEPTH, D_MODEL, IN_WIDTH), D_MODEL ** -0.5),
        "w_pool": nrm(ks[3], (DEPTH, N_POOL_GROUPS, POOL_GROUP, POOL_OUT_GROUP), POOL_GROUP ** -0.5),
        "pool_scale": 1.0 + nrm(ks[4], (DEPTH, D_MODEL), 0.02),
        "w_attn_up": nrm(ks[5], (DEPTH, ATTN_WIDTH, D_MODEL), ATTN_WIDTH ** -0.5),
        "w_out": nrm(ks[6], (DEPTH, D_MODEL, D_MODEL), D_MODEL ** -0.5),
        "ffn_norm": 1.0 + nrm(ks[7], (DEPTH, D_MODEL), 0.02),
        "peer_wq": nrm(ks[8], (DEPTH, D_MODEL, PEER_HEADS * PEER_QDIM), D_MODEL ** -0.5),
        "peer_keys": nrm(ks[9], (DEPTH, 2, PEER_NKEYS, PEER_HALF), PEER_HALF ** -0.5),
        "peer_u": nrm(ks[10], (DEPTH, PEER_EXPERTS, D_MODEL), D_MODEL ** -0.5),
        "peer_v": nrm(ks[11], (DEPTH, PEER_EXPERTS, D_MODEL), PEER_HEADS ** -0.5),
        "final_norm": 1.0 + nrm(ks[12], (D_MODEL,), 0.02),
    }


def reference(x, mix_norm, w_in, w_pool, pool_scale, w_attn_up, w_out, ffn_norm, peer_wq, peer_keys, peer_u, peer_v, final_norm):
    for l in range(DEPTH):
        x = hybrid_layer(x, mix_norm[l], w_in[l], w_pool[l], pool_scale[l], w_attn_up[l], w_out[l],
                         ffn_norm[l], peer_wq[l], peer_keys[l], peer_u[l], peer_v[l])
    return rmsnorm(x, final_norm)
```

```cpp
#include <hip/hip_runtime.h>
#include <stdint.h>
#include <cstdio>

typedef unsigned short bf16_t;
typedef float f32x4 __attribute__((ext_vector_type(4)));
typedef unsigned u32x4 __attribute__((ext_vector_type(4)));
typedef unsigned u32x2 __attribute__((ext_vector_type(2)));

constexpr int NB = 8, SEQ = 2048, DM = 1024, T = NB * SEQ, NL = 2;
constexpr int INW = 4096, PW = 512, AW = 512, NH = 8, HD = 64, MBLK = 256, NBLK = SEQ / MBLK;
constexpr int PH = 8, NKEY = 128, QD = 256, PK = 16, NEXP = NKEY * NKEY, PQW = PH * QD;
constexpr int NSLOT = PH * PK;
constexpr float EPS = 1e-6f;
constexpr float LOG2E = 1.4426950408889634f;
constexpr float C2 = 0.125f * LOG2E;

constexpr size_t MiB = 1u << 20;
constexpr size_t WS_CTL = 0, WS_KMEAN = 1 * MiB, WS_WPOOL = 2 * MiB, WS_WUP = 3 * MiB, WS_WOUT = 5 * MiB, WS_WPEER = 9 * MiB, WS_WIN = 17 * MiB;
constexpr size_t WS_UB = 33 * MiB, WS_VB = 97 * MiB, WS_H = 161 * MiB, WS_Z = 193 * MiB, WS_SC = 193 * MiB;
constexpr size_t WS_M = 321 * MiB, WS_O = 337 * MiB, WS_MRG = 353 * MiB, WS_GAA = 385 * MiB, WS_EID = 417 * MiB, WS_GW = 425 * MiB, WS_WACT = 433 * MiB, WS_END = 441 * MiB;

__device__ __forceinline__ float bf2f(bf16_t v) { return __uint_as_float(((unsigned)v) << 16); }
__device__ __forceinline__ unsigned f2bf(float f) { unsigned u = __float_as_uint(f); return (u + 0x7fffu + ((u >> 16) & 1u)) >> 16; }
__device__ __forceinline__ unsigned pk2(float lo, float hi) { return f2bf(lo) | (f2bf(hi) << 16); }
__device__ __forceinline__ float lo16(unsigned w) { return __uint_as_float(w << 16); }
__device__ __forceinline__ float hi16(unsigned w) { return __uint_as_float(w & 0xffff0000u); }
__device__ __forceinline__ float wave_sum(float v) {
#pragma unroll
    for (int o = 1; o < 64; o <<= 1) v += __shfl_xor(v, o);
    return v;
}
__device__ __forceinline__ float wave_max(float v) {
#pragma unroll
    for (int o = 1; o < 64; o <<= 1) v = fmaxf(v, __shfl_xor(v, o));
    return v;
}
__device__ __forceinline__ float gelu_tanh(float x) {
    const float u = 0.7978845608028654f * (x + 0.044715f * x * x * x);
    const float e = __expf(2.f * u);
    const float th = 1.f - 2.f / (e + 1.f);
    return 0.5f * x * (1.f + th);
}

__global__ void k_transpose(const float* __restrict__ W, bf16_t* __restrict__ Wt, int K, int N) {
    __shared__ float tile[32][33];
    const int n0 = blockIdx.x * 32, k0 = blockIdx.y * 32, tx = threadIdx.x & 31, ty = threadIdx.x >> 5;
    for (int i = ty; i < 32; i += 8) tile[i][tx] = W[(size_t)(k0 + i) * N + n0 + tx];
    __syncthreads();
    for (int i = ty; i < 32; i += 8) Wt[(size_t)(n0 + i) * K + k0 + tx] = (bf16_t)f2bf(tile[tx][i]);
}
__global__ void k_wpeer(const float* __restrict__ wq, const float* __restrict__ keys, bf16_t* __restrict__ Wp) {
    const int idx = blockIdx.x * 256 + threadIdx.x;
    const int c = idx & 1023, n = idx >> 10, hp = n >> 7, k = n & 127, p = hp & 1;
    const float* a = wq + (size_t)c * PQW + hp * 128; const float* b = keys + ((size_t)p * NKEY + k) * 128;
    float s = 0.f;
    for (int d = 0; d < 128; ++d) s += a[d] * b[d];
    Wp[(size_t)n * DM + c] = (bf16_t)f2bf(s);
}
__global__ void k_cvt(const float* __restrict__ src, bf16_t* __restrict__ dst, size_t n4) {
    for (size_t i = (size_t)blockIdx.x * blockDim.x + threadIdx.x; i < n4; i += (size_t)gridDim.x * blockDim.x) {
        const f32x4 v = ((const f32x4*)src)[i]; u32x2 o; o.x = pk2(v.x, v.y); o.y = pk2(v.z, v.w); ((u32x2*)dst)[i] = o; }
}
__global__ void k_rmsnorm(const float* __restrict__ x, const float* __restrict__ g, bf16_t* __restrict__ out) {
    const int lane = threadIdx.x & 63, row = blockIdx.x * 4 + (threadIdx.x >> 6);
    const f32x4* xr = (const f32x4*)(x + (size_t)row * DM); f32x4 v[4]; float s = 0.f;
#pragma unroll
    for (int j = 0; j < 4; ++j) { v[j] = xr[lane + 64 * j]; s += v[j].x * v[j].x + v[j].y * v[j].y + v[j].z * v[j].z + v[j].w * v[j].w; }
    const float rstd = rsqrtf(wave_sum(s) * (1.f / DM) + EPS);
#pragma unroll
    for (int j = 0; j < 4; ++j) { const f32x4 gg = ((const f32x4*)g)[lane + 64 * j]; u32x2 o; o.x = pk2(v[j].x * rstd * gg.x, v[j].y * rstd * gg.y); o.y = pk2(v[j].z * rstd * gg.z, v[j].w * rstd * gg.w);
        ((u32x2*)(out + (size_t)row * DM))[lane + 64 * j] = o; }
}

struct EpiZ {
    bf16_t* z;
    __device__ __forceinline__ void operator()(int row, int col0, f32x4 v) const {
        if (col0 >= 2048) { v.x = 1.f / (1.f + __expf(-v.x)); v.y = 1.f / (1.f + __expf(-v.y)); v.z = 1.f / (1.f + __expf(-v.z)); v.w = 1.f / (1.f + __expf(-v.w)); }
        else if (col0 >= 512 && col0 < 1024) { v = v * C2; }
        u32x2 o; o.x = pk2(v.x, v.y); o.y = pk2(v.z, v.w); *(u32x2*)(z + (size_t)row * INW + col0) = o;
    }
};
struct EpiPool {
    const bf16_t* z; const float* pscale; bf16_t* gaa;
    __device__ __forceinline__ void operator()(int row, int col0, f32x4 v) const {
        const u32x2 g = *(const u32x2*)(z + (size_t)row * INW + 2048 + col0); const f32x4 ps = *(const f32x4*)(pscale + col0);
        u32x2 o; o.x = pk2(v.x * ps.x * lo16(g.x), v.y * ps.y * hi16(g.x)); o.y = pk2(v.z * ps.z * lo16(g.y), v.w * ps.w * hi16(g.y));
        *(u32x2*)(gaa + (size_t)row * DM + col0) = o;
    }
};
struct EpiUp {
    const bf16_t* z; const bf16_t* gaa; bf16_t* mrg;
    __device__ __forceinline__ void operator()(int row, int col0, f32x4 v) const {
        const u32x2 g = *(const u32x2*)(z + (size_t)row * INW + 3072 + col0); const u32x2 a = *(const u32x2*)(gaa + (size_t)row * DM + col0);
        u32x2 o; o.x = pk2(lo16(a.x) + v.x * lo16(g.x), hi16(a.x) + v.y * hi16(g.x)); o.y = pk2(lo16(a.y) + v.z * lo16(g.y), hi16(a.y) + v.w * hi16(g.y));
        *(u32x2*)(mrg + (size_t)row * DM + col0) = o;
    }
};
struct EpiRes {
    const float* xin; float* xout;
    __device__ __forceinline__ void operator()(int row, int col0, f32x4 v) const {
        const f32x4 b = *(const f32x4*)(xin + (size_t)row * DM + col0); *(f32x4*)(xout + (size_t)row * DM + col0) = b + v;
    }
};
struct EpiF32 {
    float* out; int ldc;
    __device__ __forceinline__ void operator()(int row, int col0, f32x4 v) const { *(f32x4*)(out + (size_t)row * ldc + col0) = v; }
};

template <class Epi> __global__ void k_gemm_naive(const bf16_t* __restrict__ A, int lda, int a_pn_off, const bf16_t* __restrict__ Bt, int ldb, int K, Epi E) {
    const int cg = threadIdx.x & 63, rr = threadIdx.x >> 6;
    const int col0 = blockIdx.x * 256 + cg * 4, row = blockIdx.y * 4 + rr;
    const bf16_t* a = A + (size_t)row * lda + (size_t)blockIdx.x * a_pn_off;
    const bf16_t* b = Bt + (size_t)col0 * ldb;
    float acc[4] = {0.f, 0.f, 0.f, 0.f};
    for (int k = 0; k < K; k += 8) {
        const u32x4 av = *(const u32x4*)(a + k);
#pragma unroll
        for (int i = 0; i < 4; ++i) { const u32x4 bv = *(const u32x4*)(b + (size_t)i * ldb + k);
            acc[i] += lo16(av.x) * lo16(bv.x) + hi16(av.x) * hi16(bv.x) + lo16(av.y) * lo16(bv.y) + hi16(av.y) * hi16(bv.y)
                    + lo16(av.z) * lo16(bv.z) + hi16(av.z) * hi16(bv.z) + lo16(av.w) * lo16(bv.w) + hi16(av.w) * hi16(bv.w); }
    }
    E(row, col0, (f32x4){acc[0], acc[1], acc[2], acc[3]});
}

__global__ void k_kmean(const bf16_t* __restrict__ z, float* __restrict__ kmean) {
    const int b = blockIdx.x / NBLK, blk = blockIdx.x % NBLK, c = threadIdx.x;
    const bf16_t* p = z + ((size_t)b * SEQ + blk * MBLK) * INW + 1024 + c; float s = 0.f;
    for (int r = 0; r < MBLK; ++r) s += bf2f(p[(size_t)r * INW]);
    kmean[((size_t)b * NBLK + blk) * AW + c] = s * (1.f / MBLK);
}
__global__ void k_poolm(const bf16_t* __restrict__ z, bf16_t* __restrict__ m) {
    const int c = threadIdx.x, w = 2 << (c >> 7), t0 = blockIdx.x * 64;
    for (int i = 0; i < 64; ++i) { const int t = t0 + i, pos = t & (SEQ - 1); const int cnt = (pos + 1 < w) ? pos + 1 : w; float s = 0.f;
        for (int j = 0; j < cnt; ++j) s += bf2f(z[(size_t)(t - j) * INW + c]);
        const float pv = bf2f(z[(size_t)t * INW + c]);
        m[(size_t)t * PW + c] = (bf16_t)f2bf(s / (float)cnt - pv); }
}
__global__ void k_attn_naive(const bf16_t* __restrict__ z, const float* __restrict__ kmean, bf16_t* __restrict__ o) {
    __shared__ float sc[4][1024];
    const int w = threadIdx.x >> 6, lane = threadIdx.x & 63; const int idx = blockIdx.x * 4 + w, t = idx >> 3, h = idx & 7;
    const int b = t / SEQ, pos = t % SEQ, own = pos / MBLK;
    float q[64];
    { const u32x4* qp = (const u32x4*)(z + (size_t)t * INW + 512 + h * 64);
#pragma unroll
      for (int i = 0; i < 8; ++i) { const u32x4 v = qp[i]; q[8 * i] = lo16(v.x); q[8 * i + 1] = hi16(v.x); q[8 * i + 2] = lo16(v.y); q[8 * i + 3] = hi16(v.y); q[8 * i + 4] = lo16(v.z); q[8 * i + 5] = hi16(v.z); q[8 * i + 6] = lo16(v.w); q[8 * i + 7] = hi16(v.w); } }
    float bs[7];
#pragma unroll
    for (int j = 0; j < 7; ++j) { float s = -INFINITY; if (j < own) { s = 0.f; const float* km = kmean + ((size_t)b * NBLK + j) * AW + h * 64;
#pragma unroll
        for (int d = 0; d < 64; ++d) s += q[d] * km[d]; } bs[j] = s; }
    int sel[3];
#pragma unroll
    for (int r = 0; r < 3; ++r) { float best = -INFINITY; int bi = -1;
#pragma unroll
        for (int j = 0; j < 7; ++j) if (bs[j] > best) { best = bs[j]; bi = j; }
        sel[r] = bi;
#pragma unroll
        for (int j = 0; j < 7; ++j) if (j == bi) bs[j] = -INFINITY; }
    const float slope2 = exp2f(-(float)(h + 1)) * LOG2E;
    float mx = -INFINITY;
#pragma unroll
    for (int sg = 0; sg < 4; ++sg) {
        const int blk = (sg < 3) ? sel[sg] : own; if (blk < 0) continue;
        const int kb = blk * MBLK, cnt = (sg < 3) ? MBLK : (pos - kb + 1);
        for (int kk = lane; kk < cnt; kk += 64) {
            const u32x4* kp = (const u32x4*)(z + ((size_t)b * SEQ + kb + kk) * INW + 1024 + h * 64); float s = 0.f;
#pragma unroll
            for (int i = 0; i < 8; ++i) { const u32x4 v = kp[i]; s += q[8 * i] * lo16(v.x) + q[8 * i + 1] * hi16(v.x) + q[8 * i + 2] * lo16(v.y) + q[8 * i + 3] * hi16(v.y) + q[8 * i + 4] * lo16(v.z) + q[8 * i + 5] * hi16(v.z) + q[8 * i + 6] * lo16(v.w) + q[8 * i + 7] * hi16(v.w); }
            s -= slope2 * (float)(pos - (kb + kk)); sc[w][sg * 256 + kk] = s; mx = fmaxf(mx, s); }
    }
    mx = wave_max(mx); float sum = 0.f;
#pragma unroll
    for (int sg = 0; sg < 4; ++sg) {
        const int blk = (sg < 3) ? sel[sg] : own; if (blk < 0) continue;
        const int kb = blk * MBLK, cnt = (sg < 3) ? MBLK : (pos - kb + 1);
        for (int kk = lane; kk < cnt; kk += 64) { const float p = exp2f(sc[w][sg * 256 + kk] - mx); sc[w][sg * 256 + kk] = p; sum += p; }
    }
    sum = wave_sum(sum);
    __syncthreads();
    float acc = 0.f;
#pragma unroll
    for (int sg = 0; sg < 4; ++sg) {
        const int blk = (sg < 3) ? sel[sg] : own; if (blk < 0) continue;
        const int kb = blk * MBLK, cnt = (sg < 3) ? MBLK : (pos - kb + 1);
        const bf16_t* vp = z + ((size_t)b * SEQ + kb) * INW + 1536 + h * 64 + lane;
        for (int kk = 0; kk < cnt; ++kk) acc += sc[w][sg * 256 + kk] * bf2f(vp[(size_t)kk * INW]);
    }
    o[(size_t)t * AW + h * 64 + lane] = (bf16_t)f2bf(acc / sum);
}

__global__ void k_topk_naive(const float* __restrict__ scores, int* __restrict__ eid, float* __restrict__ gw) {
    __shared__ float svl[4][2][16]; __shared__ int sil[4][2][16]; __shared__ float cvl[4][16]; __shared__ int cil[4][16];
    const int w = threadIdx.x >> 6, lane = threadIdx.x & 63; const int idx = blockIdx.x * 4 + w, t = idx >> 3, h = idx & 7;
    for (int p = 0; p < 2; ++p) {
        const float* s = scores + (size_t)t * PQW + h * 256 + p * 128;
        float v0 = s[lane], v1 = s[lane + 64];
        for (int r = 0; r < 16; ++r) {
            float bv; int bi; if (v0 >= v1) { bv = v0; bi = lane; } else { bv = v1; bi = lane + 64; }
#pragma unroll
            for (int o = 1; o < 64; o <<= 1) { const float ov = __shfl_xor(bv, o); const int oi = __shfl_xor(bi, o); if (ov > bv || (ov == bv && oi < bi)) { bv = ov; bi = oi; } }
            if (lane == 0) { svl[w][p][r] = bv; sil[w][p][r] = bi; }
            if (bi == lane) v0 = -INFINITY; if (bi == lane + 64) v1 = -INFINITY;
        }
    }
    __syncthreads();
    float cv[4];
#pragma unroll
    for (int m = 0; m < 4; ++m) { const int c = lane + 64 * m; cv[m] = svl[w][0][c >> 4] + svl[w][1][c & 15]; }
    for (int r = 0; r < 16; ++r) {
        float bv = cv[0]; int bi = lane;
#pragma unroll
        for (int m = 1; m < 4; ++m) if (cv[m] > bv) { bv = cv[m]; bi = lane + 64 * m; }
#pragma unroll
        for (int o = 1; o < 64; o <<= 1) { const float ov = __shfl_xor(bv, o); const int oi = __shfl_xor(bi, o); if (ov > bv || (ov == bv && oi < bi)) { bv = ov; bi = oi; } }
        if (lane == 0) { cvl[w][r] = bv; cil[w][r] = bi; }
#pragma unroll
        for (int m = 0; m < 4; ++m) if (bi == lane + 64 * m) cv[m] = -INFINITY;
    }
    __syncthreads();
    if (lane < 16) {
        const float mx = cvl[w][0]; float sum = 0.f;
        for (int r = 0; r < 16; ++r) sum += __expf(cvl[w][r] - mx);
        const int c = cil[w][lane];
        eid[(size_t)t * NSLOT + h * 16 + lane] = sil[w][0][c >> 4] * NKEY + sil[w][1][c & 15];
        gw[(size_t)t * NSLOT + h * 16 + lane] = __expf(cvl[w][lane] - mx) / sum;
    }
}
__global__ void k_peer_u(const bf16_t* __restrict__ hn, const bf16_t* __restrict__ Ub, const int* __restrict__ eid, const float* __restrict__ gw, float* __restrict__ wact) {
    const int lane = threadIdx.x & 63, t = blockIdx.x * 4 + (threadIdx.x >> 6);
    const u32x4 h0 = *(const u32x4*)(hn + (size_t)t * DM + lane * 8), h1 = *(const u32x4*)(hn + (size_t)t * DM + 512 + lane * 8);
    for (int s = 0; s < NSLOT; ++s) {
        const int e = eid[(size_t)t * NSLOT + s]; const bf16_t* row = Ub + (size_t)e * DM;
        const u32x4 a = *(const u32x4*)(row + lane * 8), b = *(const u32x4*)(row + 512 + lane * 8);
        float d = lo16(a.x) * lo16(h0.x) + hi16(a.x) * hi16(h0.x) + lo16(a.y) * lo16(h0.y) + hi16(a.y) * hi16(h0.y) + lo16(a.z) * lo16(h0.z) + hi16(a.z) * hi16(h0.z) + lo16(a.w) * lo16(h0.w) + hi16(a.w) * hi16(h0.w)
                + lo16(b.x) * lo16(h1.x) + hi16(b.x) * hi16(h1.x) + lo16(b.y) * lo16(h1.y) + hi16(b.y) * hi16(h1.y) + lo16(b.z) * lo16(h1.z) + hi16(b.z) * hi16(h1.z) + lo16(b.w) * lo16(h1.w) + hi16(b.w) * hi16(h1.w);
        d = wave_sum(d);
        if (lane == 0) wact[(size_t)t * NSLOT + s] = gw[(size_t)t * NSLOT + s] * gelu_tanh(d);
    }
}
__global__ void k_peer_v(float* __restrict__ xres, const bf16_t* __restrict__ Vb, const int* __restrict__ eid, const float* __restrict__ wact, const float* __restrict__ gn, bf16_t* __restrict__ hout, int last) {
    const int lane = threadIdx.x & 63, t = blockIdx.x * 4 + (threadIdx.x >> 6);
    float acc[16];
#pragma unroll
    for (int i = 0; i < 16; ++i) acc[i] = 0.f;
    for (int s = 0; s < NSLOT; ++s) {
        const int e = eid[(size_t)t * NSLOT + s]; const float w = wact[(size_t)t * NSLOT + s]; const bf16_t* row = Vb + (size_t)e * DM;
        const u32x4 a = *(const u32x4*)(row + lane * 8), b = *(const u32x4*)(row + 512 + lane * 8);
        acc[0] += w * lo16(a.x); acc[1] += w * hi16(a.x); acc[2] += w * lo16(a.y); acc[3] += w * hi16(a.y); acc[4] += w * lo16(a.z); acc[5] += w * hi16(a.z); acc[6] += w * lo16(a.w); acc[7] += w * hi16(a.w);
        acc[8] += w * lo16(b.x); acc[9] += w * hi16(b.x); acc[10] += w * lo16(b.y); acc[11] += w * hi16(b.y); acc[12] += w * lo16(b.z); acc[13] += w * hi16(b.z); acc[14] += w * lo16(b.w); acc[15] += w * hi16(b.w);
    }
    float* xr = xres + (size_t)t * DM; float ss = 0.f;
#pragma unroll
    for (int hf = 0; hf < 2; ++hf)
#pragma unroll
        for (int j = 0; j < 2; ++j) { const f32x4 xv = *(const f32x4*)(xr + hf * 512 + lane * 8 + j * 4);
            acc[hf * 8 + j * 4 + 0] += xv.x; acc[hf * 8 + j * 4 + 1] += xv.y; acc[hf * 8 + j * 4 + 2] += xv.z; acc[hf * 8 + j * 4 + 3] += xv.w; }
#pragma unroll
    for (int i = 0; i < 16; ++i) ss += acc[i] * acc[i];
    const float rstd = rsqrtf(wave_sum(ss) * (1.f / DM) + EPS);
#pragma unroll
    for (int hf = 0; hf < 2; ++hf)
#pragma unroll
        for (int j = 0; j < 2; ++j) { const int c = hf * 512 + lane * 8 + j * 4; const f32x4 g = *(const f32x4*)(gn + c); const int a0 = hf * 8 + j * 4;
            if (last) { *(f32x4*)(xr + c) = (f32x4){acc[a0] * rstd * g.x, acc[a0 + 1] * rstd * g.y, acc[a0 + 2] * rstd * g.z, acc[a0 + 3] * rstd * g.w}; }
            else { *(f32x4*)(xr + c) = (f32x4){acc[a0], acc[a0 + 1], acc[a0 + 2], acc[a0 + 3]};
                u32x2 ob; ob.x = pk2(acc[a0] * rstd * g.x, acc[a0 + 1] * rstd * g.y); ob.y = pk2(acc[a0 + 2] * rstd * g.z, acc[a0 + 3] * rstd * g.w); *(u32x2*)(hout + (size_t)t * DM + c) = ob; } }
}

extern "C" void kernel_launch(void* const* d_in, const int* in_sizes, int n_in, void* d_out, int out_size, void* d_ws, size_t ws_size, hipStream_t stream) {
    if (n_in != 13 || ws_size < WS_END) { fprintf(stderr, "kernel_launch: unexpected inputs / workspace (%d, %zu)\n", n_in, ws_size); return; }
    const float* x = (const float*)d_in[0]; const float* mix_norm = (const float*)d_in[1]; const float* w_in = (const float*)d_in[2]; const float* w_pool = (const float*)d_in[3];
    const float* pool_scale = (const float*)d_in[4]; const float* w_up = (const float*)d_in[5]; const float* w_out = (const float*)d_in[6]; const float* ffn_norm = (const float*)d_in[7];
    const float* peer_wq = (const float*)d_in[8]; const float* peer_keys = (const float*)d_in[9]; const float* peer_u = (const float*)d_in[10]; const float* peer_v = (const float*)d_in[11];
    const float* final_norm = (const float*)d_in[12];
    unsigned char* ws = (unsigned char*)d_ws; float* out = (float*)d_out;
    float* kmean = (float*)(ws + WS_KMEAN); bf16_t* Wpool = (bf16_t*)(ws + WS_WPOOL); bf16_t* Wup = (bf16_t*)(ws + WS_WUP); bf16_t* Wout = (bf16_t*)(ws + WS_WOUT);
    bf16_t* Wpeer = (bf16_t*)(ws + WS_WPEER); bf16_t* Win = (bf16_t*)(ws + WS_WIN); bf16_t* Ub = (bf16_t*)(ws + WS_UB); bf16_t* Vb = (bf16_t*)(ws + WS_VB);
    bf16_t* h = (bf16_t*)(ws + WS_H); bf16_t* z = (bf16_t*)(ws + WS_Z); float* sc = (float*)(ws + WS_SC); bf16_t* m = (bf16_t*)(ws + WS_M); bf16_t* o = (bf16_t*)(ws + WS_O);
    bf16_t* mrg = (bf16_t*)(ws + WS_MRG); bf16_t* gaa = (bf16_t*)(ws + WS_GAA); int* eid = (int*)(ws + WS_EID); float* gw = (float*)(ws + WS_GW); float* wact = (float*)(ws + WS_WACT);
    for (int l = 0; l < NL; ++l) {
        k_transpose<<<dim3(INW / 32, DM / 32), 256, 0, stream>>>(w_in + (size_t)l * DM * INW, Win + (size_t)l * INW * DM, DM, INW);
        for (int g = 0; g < 4; ++g) k_transpose<<<dim3(256 / 32, 128 / 32), 256, 0, stream>>>(w_pool + ((size_t)l * 4 + g) * 128 * 256, Wpool + ((size_t)l * 1024 + g * 256) * 128, 128, 256);
        k_transpose<<<dim3(DM / 32, AW / 32), 256, 0, stream>>>(w_up + (size_t)l * AW * DM, Wup + (size_t)l * DM * AW, AW, DM);
        k_transpose<<<dim3(DM / 32, DM / 32), 256, 0, stream>>>(w_out + (size_t)l * DM * DM, Wout + (size_t)l * DM * DM, DM, DM);
        k_wpeer<<<PQW * DM / 256, 256, 0, stream>>>(peer_wq + (size_t)l * DM * PQW, peer_keys + (size_t)l * 2 * NKEY * 128, Wpeer + (size_t)l * PQW * DM);
    }
    k_cvt<<<4096, 256, 0, stream>>>(peer_u, Ub, (size_t)NL * NEXP * DM / 4);
    k_cvt<<<4096, 256, 0, stream>>>(peer_v, Vb, (size_t)NL * NEXP * DM / 4);
    k_rmsnorm<<<T / 4, 256, 0, stream>>>(x, mix_norm, h);
    for (int l = 0; l < NL; ++l) {
        k_gemm_naive<EpiZ><<<dim3(INW / 256, T / 4), 256, 0, stream>>>(h, DM, 0, Win + (size_t)l * INW * DM, DM, DM, EpiZ{z});
        k_kmean<<<NB * NBLK, 512, 0, stream>>>(z, kmean);
        k_poolm<<<T / 64, 512, 0, stream>>>(z, m);
        k_attn_naive<<<T * NH / 4, 256, 0, stream>>>(z, kmean, o);
        k_gemm_naive<EpiPool><<<dim3(DM / 256, T / 4), 256, 0, stream>>>(m, PW, 128, Wpool + (size_t)l * 1024 * 128, 128, 128, EpiPool{z, pool_scale + l * DM, gaa});
        k_gemm_naive<EpiUp><<<dim3(DM / 256, T / 4), 256, 0, stream>>>(o, AW, 0, Wup + (size_t)l * DM * AW, AW, AW, EpiUp{z, gaa, mrg});
        k_gemm_naive<EpiRes><<<dim3(DM / 256, T / 4), 256, 0, stream>>>(mrg, DM, 0, Wout + (size_t)l * DM * DM, DM, DM, EpiRes{l == 0 ? x : out, out});
        k_rmsnorm<<<T / 4, 256, 0, stream>>>(out, ffn_norm + l * DM, h);
        k_gemm_naive<EpiF32><<<dim3(PQW / 256, T / 4), 256, 0, stream>>>(h, DM, 0, Wpeer + (size_t)l * PQW * DM, DM, DM, EpiF32{sc, PQW});
        k_topk_naive<<<T * PH / 4, 256, 0, stream>>>(sc, eid, gw);
        k_peer_u<<<T / 4, 256, 0, stream>>>(h, Ub + (size_t)l * NEXP * DM, eid, gw, wact);
        k_peer_v<<<T / 4, 256, 0, stream>>>(out, Vb + (size_t)l * NEXP * DM, eid, wact, l == NL - 1 ? final_norm : mix_norm + (l + 1) * DM, h, l == NL - 1 ? 1 : 0);
    }
}
```

```cpp
#include <hip/hip_runtime.h>
#include <hip/hip_cooperative_groups.h>
namespace cg = cooperative_groups;
#include <stdint.h>
#include <cstdio>
#include <type_traits>

typedef unsigned short bf16_t;
typedef float f32x4 __attribute__((ext_vector_type(4)));
typedef unsigned u32x4 __attribute__((ext_vector_type(4)));
typedef unsigned u32x2 __attribute__((ext_vector_type(2)));

constexpr int NB = 8, SEQ = 2048, DM = 1024, T = NB * SEQ, NL = 2;
constexpr int INW = 4096, PW = 512, AW = 512, NH = 8, HD = 64, MBLK = 256, NBLK = SEQ / MBLK;
constexpr int PH = 8, NKEY = 128, QD = 256, PK = 16, NEXP = NKEY * NKEY, PQW = PH * QD;
constexpr int NSLOT = PH * PK;
constexpr float EPS = 1e-6f;
constexpr float LOG2E = 1.4426950408889634f;
constexpr float C2 = 0.125f * LOG2E;

constexpr size_t MiB = 1u << 20;
constexpr size_t WS_CTL = 0, WS_KMEAN = 1 * MiB, WS_WPOOL = 2 * MiB, WS_WUP = 4 * MiB, WS_WOUT = 6 * MiB, WS_WPEER = 10 * MiB, WS_WIN = 18 * MiB;
constexpr size_t WS_UB = 34 * MiB, WS_VB = 98 * MiB, WS_H = 162 * MiB, WS_Z = 194 * MiB, WS_SC = 194 * MiB;
constexpr size_t WS_M = 322 * MiB, WS_O = 338 * MiB, WS_MRG = 354 * MiB, WS_GAA = 386 * MiB, WS_EID = 418 * MiB, WS_GW = 426 * MiB, WS_WACT = 434 * MiB, WS_END = 442 * MiB;

__device__ __forceinline__ float bf2f(bf16_t v) { return __uint_as_float(((unsigned)v) << 16); }
__device__ __forceinline__ unsigned f2bf(float f) { unsigned u = __float_as_uint(f); return (u + 0x7fffu + ((u >> 16) & 1u)) >> 16; }
typedef float f32x2_pk __attribute__((ext_vector_type(2))); typedef __bf16 bf16x2_pk __attribute__((ext_vector_type(2)));
__device__ __forceinline__ unsigned pk2(float lo, float hi) { f32x2_pk v = {lo, hi}; bf16x2_pk b = __builtin_convertvector(v, bf16x2_pk); return __builtin_bit_cast(unsigned, b); }
__device__ __forceinline__ float lo16(unsigned w) { return __uint_as_float(w << 16); }
__device__ __forceinline__ float hi16(unsigned w) { return __uint_as_float(w & 0xffff0000u); }
__device__ __forceinline__ float wave_sum(float v) {
#pragma unroll
    for (int o = 1; o < 64; o <<= 1) v += __shfl_xor(v, o);
    return v;
}
__device__ __forceinline__ float wave_max(float v) {
#pragma unroll
    for (int o = 1; o < 64; o <<= 1) v = fmaxf(v, __shfl_xor(v, o));
    return v;
}
__device__ __forceinline__ int opq_tid() { int t = threadIdx.x; asm volatile("" : "+v"(t)); return t; }
__device__ __forceinline__ int ldcg(const int* p) { return __hip_atomic_load(p, __ATOMIC_RELAXED, __HIP_MEMORY_SCOPE_AGENT); }
__device__ __forceinline__ float ldcg(const float* p) { return __hip_atomic_load(p, __ATOMIC_RELAXED, __HIP_MEMORY_SCOPE_AGENT); }
__device__ __forceinline__ float gelu_tanh(float x) {
    const float u = 0.7978845608028654f * (x + 0.044715f * x * x * x);
    const float e = __expf(2.f * u);
    const float th = 1.f - 2.f / (e + 1.f);
    return 0.5f * x * (1.f + th);
}

struct EpiZ {
    bf16_t* z;
    __device__ __forceinline__ void operator()(int row, int col0, f32x4 v) const {
        if (col0 >= 2048) { v.x = 1.f / (1.f + __expf(-v.x)); v.y = 1.f / (1.f + __expf(-v.y)); v.z = 1.f / (1.f + __expf(-v.z)); v.w = 1.f / (1.f + __expf(-v.w)); }
        else if (col0 >= 512 && col0 < 1024) { v = v * C2; }
        u32x2 o; o.x = pk2(v.x, v.y); o.y = pk2(v.z, v.w); *(u32x2*)(z + (size_t)row * INW + col0) = o;
    }
};
struct EpiPool {
    const bf16_t* z; const float* pscale; bf16_t* gaa;
    __device__ __forceinline__ void operator()(int row, int col0, f32x4 v) const {
        const u32x2 g = *(const u32x2*)(z + (size_t)row * INW + 2048 + col0); const f32x4 ps = *(const f32x4*)(pscale + col0);
        u32x2 o; o.x = pk2(v.x * ps.x * lo16(g.x), v.y * ps.y * hi16(g.x)); o.y = pk2(v.z * ps.z * lo16(g.y), v.w * ps.w * hi16(g.y));
        *(u32x2*)(gaa + (size_t)row * DM + col0) = o;
    }
};
struct EpiUp {
    const bf16_t* z; const bf16_t* gaa; bf16_t* mrg;
    __device__ __forceinline__ void operator()(int row, int col0, f32x4 v) const {
        const u32x2 g = *(const u32x2*)(z + (size_t)row * INW + 3072 + col0); const u32x2 a = *(const u32x2*)(gaa + (size_t)row * DM + col0);
        u32x2 o; o.x = pk2(lo16(a.x) + v.x * lo16(g.x), hi16(a.x) + v.y * hi16(g.x)); o.y = pk2(lo16(a.y) + v.z * lo16(g.y), hi16(a.y) + v.w * hi16(g.y));
        *(u32x2*)(mrg + (size_t)row * DM + col0) = o;
    }
};
struct EpiRes {
    const float* xin; float* xout;
    __device__ __forceinline__ void operator()(int row, int col0, f32x4 v) const {
        const f32x4 b = *(const f32x4*)(xin + (size_t)row * DM + col0); *(f32x4*)(xout + (size_t)row * DM + col0) = b + v;
    }
};
struct EpiF32 {
    float* out; int ldc;
    __device__ __forceinline__ void operator()(int row, int col0, f32x4 v) const { *(f32x4*)(out + (size_t)row * ldc + col0) = v; }
};

__device__ __forceinline__ float sigm(float v) { return __builtin_amdgcn_rcpf(1.f + __expf(-v)); }
struct EpiZ8 {
    bf16_t* z;
    __device__ __forceinline__ void operator()(int row, int col0, f32x4 a, f32x4 b) const {
        if (col0 >= 2048) { a.x = sigm(a.x); a.y = sigm(a.y); a.z = sigm(a.z); a.w = sigm(a.w); b.x = sigm(b.x); b.y = sigm(b.y); b.z = sigm(b.z); b.w = sigm(b.w); }
        else if (col0 >= 512 && col0 < 1024) { a = a * C2; b = b * C2; }
        u32x4 o; o.x = pk2(a.x, a.y); o.y = pk2(a.z, a.w); o.z = pk2(b.x, b.y); o.w = pk2(b.z, b.w); *(u32x4*)(z + (size_t)row * INW + col0) = o;
    }
};
struct EpiPool8 {
    const bf16_t* z; const float* pscale; bf16_t* gaa;
    __device__ __forceinline__ void operator()(int row, int col0, f32x4 a, f32x4 b) const {
        const u32x4 g = *(const u32x4*)(z + (size_t)row * INW + 2048 + col0); const f32x4 p0 = *(const f32x4*)(pscale + col0), p1 = *(const f32x4*)(pscale + col0 + 4);
        u32x4 o; o.x = pk2(a.x * p0.x * lo16(g.x), a.y * p0.y * hi16(g.x)); o.y = pk2(a.z * p0.z * lo16(g.y), a.w * p0.w * hi16(g.y));
        o.z = pk2(b.x * p1.x * lo16(g.z), b.y * p1.y * hi16(g.z)); o.w = pk2(b.z * p1.z * lo16(g.w), b.w * p1.w * hi16(g.w));
        *(u32x4*)(gaa + (size_t)row * DM + col0) = o;
    }
};
struct EpiUp8 {
    const bf16_t* z; const bf16_t* gaa; bf16_t* mrg;
    __device__ __forceinline__ void operator()(int row, int col0, f32x4 a, f32x4 b) const {
        const u32x4 g = *(const u32x4*)(z + (size_t)row * INW + 3072 + col0); const u32x4 q = *(const u32x4*)(gaa + (size_t)row * DM + col0);
        u32x4 o; o.x = pk2(lo16(q.x) + a.x * lo16(g.x), hi16(q.x) + a.y * hi16(g.x)); o.y = pk2(lo16(q.y) + a.z * lo16(g.y), hi16(q.y) + a.w * hi16(g.y));
        o.z = pk2(lo16(q.z) + b.x * lo16(g.z), hi16(q.z) + b.y * hi16(g.z)); o.w = pk2(lo16(q.w) + b.z * lo16(g.w), hi16(q.w) + b.w * hi16(g.w));
        *(u32x4*)(mrg + (size_t)row * DM + col0) = o;
    }
};


namespace pg8 {
#define PG8_LAS __attribute__((address_space(3)))
typedef unsigned short bf16_t;
typedef short bf16x8 __attribute__((ext_vector_type(8)));
typedef float f32x4 __attribute__((ext_vector_type(4)));
typedef unsigned u32x4 __attribute__((ext_vector_type(4)));
constexpr int BM = 256, BK = 64, HALF = 128, HTB = HALF * BK * 2  , STAGE_BYTES = 8 * HTB, NXCD = 8, WGM = 8;

__host__ __device__ __forceinline__ int lds_byte(int r, int c) { const int st = (r >> 4) * 2 + (c >> 5), rr = r & 15, cc = c & 31, ob = rr * 64 + cc * 2; return st * 1024 + (ob ^ (((ob >> 9) & 1) << 5)); }
__host__ __device__ __forceinline__ void stage_rc(int b, int& R, int& C) { const int st = b / 1024, sb = b % 1024, swz = sb ^ (((sb >> 9) & 1) << 5); R = (st >> 1) * 16 + swz / 64; C = (st & 1) * 32 + (swz % 64) / 2; }
__host__ __device__ __forceinline__ int perm32(int rho) { const int n = rho >> 4, i = rho & 15; return 8 * (i >> 2) + 4 * n + (i & 3); }

struct Unit { int pm, pn; };
struct Gemm { const bf16_t* A; const bf16_t* Bt; int M, N, K, lda, ldb, a_pn_off; };

struct StaticOrder {
    int nM, nN, nwg, G, c;
    __host__ __device__ void init(int M, int N, int G_, int c_) { nM = M / BM; nN = N / BM; nwg = nM * nN; G = G_; c = c_; }
    __host__ __device__ bool next(int i, Unit& u) const {
        const long L = (long)i * G + c; if (L >= nwg) return false;
        int wgid = (int)L; { const int q = nwg / NXCD, r = nwg % NXCD, xcd = wgid % NXCD, off = wgid / NXCD; wgid = (xcd < r ? xcd * (q + 1) : r * (q + 1) + (xcd - r) * q) + off; }
        const int nig = WGM * nN, gid = wgid / nig, fm = gid * WGM, gsz = (nM - fm) < WGM ? (nM - fm) : WGM;
        u.pm = fm + ((wgid % nig) % gsz); u.pn = (wgid % nig) / gsz; return true;
    }
    __device__ __forceinline__ void a_ready(const Unit&) const {}
    __device__ __forceinline__ void done(const Unit&) const {}
};
template <class Epi, class Sched, bool ALIGN_EPI = false, bool SP2 = false>
__device__ __forceinline__ void gemm_phase(PG8_LAS unsigned char* lds, const Gemm g, const Sched& S, const Epi& E) {
    const int tid = opq_tid(), wid = __builtin_amdgcn_readfirstlane(tid >> 6), lane = tid & 63, wr = wid >> 2, wc = wid & 3, fr = lane & 15, fq = lane >> 4;
    const int K = g.K, nt = K / BK;
    unsigned voffA[2], voffB[2];
#pragma unroll
    for (int i = 0; i < 2; ++i) { int R, C; stage_rc(tid * 16 + i * 8192, R, C); const int Rb = Epi::PERM ? ((R & ~31) + perm32(R & 31)) : R;
        voffA[i] = (unsigned)(R * g.lda + C) * 2u; voffB[i] = (unsigned)(Rb * g.ldb + C) * 2u; }
    const size_t kstep = (size_t)(BK * 2);
    const size_t hstepA = (size_t)HALF * g.lda * 2, hstepB = (size_t)HALF * g.ldb * 2;
    const size_t tstepA = 2 * hstepA, tstepB = 2 * hstepB; const size_t pnoff = (size_t)g.a_pn_off * 2;
    const unsigned ldsw = (unsigned)wid * 1024u;
    const int aoff = lds_byte(wr * 64 + fr, fq * 8), boff = lds_byte(wc * 32 + fr, fq * 8);
#define PG8_SA(b, h) (((b) * 2 + (h)) * HTB)
#define PG8_SB(b, h) ((4 + (b) * 2 + (h)) * HTB)
#define PG8_STAGE(bufoff, gbase, voff) do { _Pragma("unroll") for (int _i = 0; _i < 2; ++_i) \
        __builtin_amdgcn_global_load_lds((const unsigned*)((const char*)(gbase) + (voff)[_i]), (PG8_LAS unsigned*)(lds + (bufoff) + ldsw + _i * 8192), 16, 0, 0); } while (0)
#define PG8_LDA(dst, b, h) do { _Pragma("unroll") for (int m = 0; m < 4; ++m) _Pragma("unroll") for (int k = 0; k < 2; ++k) dst[m][k] = *(const PG8_LAS bf16x8*)(lds + PG8_SA(b, h) + aoff + m * 2048 + k * 1024); } while (0)
#define PG8_LDB(dst, b, h) do { _Pragma("unroll") for (int n = 0; n < 2; ++n) _Pragma("unroll") for (int k = 0; k < 2; ++k) dst[n][k] = *(const PG8_LAS bf16x8*)(lds + PG8_SB(b, h) + boff + n * 2048 + k * 1024); } while (0)
#define PG8_MMA(ai, bj, At, Bt) do { __builtin_amdgcn_s_setprio(1); _Pragma("unroll") for (int m = 0; m < 4; ++m) _Pragma("unroll") for (int n = 0; n < 2; ++n) _Pragma("unroll") for (int k = 0; k < 2; ++k) \
        acc[ai][bj][m][n] = __builtin_amdgcn_mfma_f32_16x16x32_bf16(Bt[n][k], At[m][k], acc[ai][bj][m][n], 0, 0, 0); __builtin_amdgcn_s_setprio(0); } while (0)
#define PG8_WAIT_V(n) asm volatile("s_waitcnt vmcnt(" #n ")" ::: "memory")
#define PG8_WAIT_L(n) asm volatile("s_waitcnt lgkmcnt(" #n ")" ::: "memory")
#define PG8_BAR __builtin_amdgcn_s_barrier()
#define PG8_SCHED __builtin_amdgcn_sched_barrier(0)
    Unit cur, nxt; int ui = 0;
    if (!S.next(0, cur)) return;
    f32x4 acc[2][2][4][2];
#pragma unroll
    for (int a = 0; a < 2; ++a)
#pragma unroll
        for (int b = 0; b < 2; ++b)
#pragma unroll
            for (int m = 0; m < 4; ++m)
#pragma unroll
                for (int n = 0; n < 2; ++n) acc[a][b][m][n] = (f32x4){0.f, 0.f, 0.f, 0.f};
    bf16x8 At[4][2], B0[2][2], B1[2][2];
    const char* cA = (const char*)g.A + (size_t)cur.pm * tstepA + (size_t)cur.pn * pnoff; const char* cB = (const char*)g.Bt + (size_t)cur.pn * tstepB;
    S.a_ready(cur);
    if constexpr (SP2) {
        PG8_STAGE(PG8_SB(0, 0), cB, voffB); PG8_STAGE(PG8_SB(0, 1), cB + hstepB, voffB); PG8_STAGE(PG8_SA(0, 0), cA, voffA); PG8_STAGE(PG8_SA(0, 1), cA + hstepA, voffA);
        if (wr == 1) PG8_BAR;
        PG8_WAIT_V(2); PG8_BAR;
        PG8_STAGE(PG8_SB(1, 0), cB + kstep, voffB); PG8_STAGE(PG8_SA(1, 0), cA + kstep, voffA); PG8_STAGE(PG8_SB(1, 1), cB + hstepB + kstep, voffB);
        PG8_WAIT_V(6); PG8_BAR;
    } else {
        PG8_STAGE(PG8_SB(0, 0), cB, voffB); PG8_STAGE(PG8_SA(0, 0), cA, voffA); PG8_STAGE(PG8_SB(0, 1), cB + hstepB, voffB); PG8_STAGE(PG8_SA(0, 1), cA + hstepA, voffA);
        if (wr == 1) PG8_BAR;
        PG8_WAIT_V(4); PG8_BAR;
        PG8_STAGE(PG8_SB(1, 0), cB + kstep, voffB); PG8_STAGE(PG8_SA(1, 0), cA + kstep, voffA); PG8_STAGE(PG8_SB(1, 1), cB + hstepB + kstep, voffB);
        PG8_WAIT_V(6); PG8_BAR;
    }
    for (;;) {
        const bool has_next = S.next(ui + 1, nxt);
        const char* nA = has_next ? (const char*)g.A + (size_t)nxt.pm * tstepA + (size_t)nxt.pn * pnoff : cA; const char* nB = has_next ? (const char*)g.Bt + (size_t)nxt.pn * tstepB : cB;
        for (int t = 0; t < nt; t += 2) {
            const bool last = (t == nt - 2);
            const char* a1 = cA + (size_t)(t + 1) * kstep;
            const char* a2 = last ? nA : cA + (size_t)(t + 2) * kstep; const char* b2 = last ? nB : cB + (size_t)(t + 2) * kstep;
            const char* a3 = a2 + kstep; const char* b3 = b2 + kstep;
            if (last && has_next) S.a_ready(nxt);
            if constexpr (SP2) {
            PG8_LDB(B0, 0, 0); PG8_LDB(B1, 0, 1); PG8_SCHED; PG8_LDA(At, 0, 0); PG8_STAGE(PG8_SA(1, 1), a1 + hstepA, voffA);
            PG8_WAIT_V(8); PG8_WAIT_L(0); PG8_BAR; PG8_MMA(0, 0, At, B0); PG8_MMA(0, 1, At, B1); PG8_BAR; PG8_SCHED;
            PG8_LDA(At, 0, 1); PG8_STAGE(PG8_SB(0, 0), b2, voffB); PG8_STAGE(PG8_SB(0, 1), b2 + hstepB, voffB); PG8_STAGE(PG8_SA(0, 0), a2, voffA);
            PG8_WAIT_V(8); PG8_WAIT_L(0); PG8_BAR; PG8_MMA(1, 0, At, B0); PG8_MMA(1, 1, At, B1); PG8_BAR; PG8_SCHED;
            PG8_LDB(B0, 1, 0); PG8_LDB(B1, 1, 1); PG8_SCHED; PG8_LDA(At, 1, 0); PG8_STAGE(PG8_SA(0, 1), a2 + hstepA, voffA);
            PG8_WAIT_V(8); PG8_WAIT_L(0); PG8_BAR; PG8_MMA(0, 0, At, B0); PG8_MMA(0, 1, At, B1); PG8_BAR; PG8_SCHED;
            PG8_LDA(At, 1, 1); PG8_STAGE(PG8_SB(1, 0), b3, voffB); PG8_STAGE(PG8_SB(1, 1), b3 + hstepB, voffB); PG8_STAGE(PG8_SA(1, 0), a3, voffA);
            PG8_WAIT_V(8); PG8_WAIT_L(0); PG8_BAR; PG8_MMA(1, 0, At, B0); PG8_MMA(1, 1, At, B1); PG8_BAR; PG8_SCHED;
            } else {
            PG8_LDB(B0, 0, 0); PG8_SCHED; PG8_LDA(At, 0, 0); PG8_STAGE(PG8_SA(1, 1), a1 + hstepA, voffA);
            PG8_WAIT_L(8); PG8_BAR; PG8_WAIT_L(0); PG8_MMA(0, 0, At, B0); PG8_BAR; PG8_SCHED;
            PG8_LDB(B1, 0, 1); PG8_STAGE(PG8_SB(0, 0), b2, voffB);
            PG8_BAR; PG8_WAIT_L(0); PG8_MMA(0, 1, At, B1); PG8_BAR;
            PG8_LDA(At, 0, 1); PG8_STAGE(PG8_SA(0, 0), a2, voffA);
            PG8_BAR; PG8_WAIT_L(0); PG8_MMA(1, 0, At, B0); PG8_BAR; PG8_SCHED;
            PG8_STAGE(PG8_SB(0, 1), b2 + hstepB, voffB);
            PG8_WAIT_V(6); PG8_BAR; PG8_MMA(1, 1, At, B1); PG8_BAR;
            PG8_LDB(B0, 1, 0); PG8_SCHED; PG8_LDA(At, 1, 0); PG8_STAGE(PG8_SA(0, 1), a2 + hstepA, voffA);
            PG8_WAIT_L(8); PG8_BAR; PG8_WAIT_L(0); PG8_MMA(0, 0, At, B0); PG8_BAR; PG8_SCHED;
            PG8_LDB(B1, 1, 1); PG8_STAGE(PG8_SB(1, 0), b3, voffB);
            PG8_BAR; PG8_WAIT_L(0); PG8_MMA(0, 1, At, B1); PG8_BAR;
            PG8_LDA(At, 1, 1); PG8_STAGE(PG8_SA(1, 0), a3, voffA);
            PG8_BAR; PG8_WAIT_L(0); PG8_MMA(1, 0, At, B0); PG8_BAR; PG8_SCHED;
            PG8_STAGE(PG8_SB(1, 1), b3 + hstepB, voffB);
            PG8_WAIT_V(6); PG8_BAR; PG8_MMA(1, 1, At, B1); PG8_BAR;
            }
        }
        if constexpr (ALIGN_EPI) { if (wr == 0) PG8_BAR; }
        if constexpr (!Epi::AFTER_DRAIN) { E(acc, cur, wr, wc, fr, fq); S.done(cur); }
        if (!has_next) break;
#pragma unroll
        for (int a = 0; a < 2; ++a)
#pragma unroll
            for (int b = 0; b < 2; ++b)
#pragma unroll
                for (int m = 0; m < 4; ++m)
#pragma unroll
                    for (int n = 0; n < 2; ++n) acc[a][b][m][n] = (f32x4){0.f, 0.f, 0.f, 0.f};
        cur = nxt; cA = nA; cB = nB; ++ui;
        if constexpr (ALIGN_EPI) { if (wr == 1) PG8_BAR; }
    }
    PG8_WAIT_V(0);
    if constexpr (!ALIGN_EPI) { if (wr == 0) PG8_BAR; }
    PG8_BAR;
    if constexpr (Epi::AFTER_DRAIN) { E.fused(acc, cur, wr, wc, fr, fq, lds, wid, lane); S.done(cur); }
#undef PG8_SA
#undef PG8_SB
#undef PG8_STAGE
#undef PG8_LDA
#undef PG8_LDB
#undef PG8_MMA
#undef PG8_WAIT_V
#undef PG8_WAIT_L
#undef PG8_BAR
#undef PG8_SCHED
}
}

template <class F> struct EpiAdapt {
    static constexpr bool PERM = false, AFTER_DRAIN = false;
    F f;
    __device__ __forceinline__ void operator()(const pg8::f32x4 (&acc)[2][2][4][2], const pg8::Unit& u, int wr, int wc, int fr, int fq) const {
        const int row0 = u.pm * 256 + wr * 64 + fr, col0 = u.pn * 256 + wc * 32 + 4 * fq;
#pragma unroll
        for (int ai = 0; ai < 2; ++ai)
#pragma unroll
            for (int m = 0; m < 4; ++m)
#pragma unroll
                for (int bj = 0; bj < 2; ++bj)
#pragma unroll
                    for (int n = 0; n < 2; ++n) { f(row0 + ai * 128 + m * 16, col0 + bj * 128 + n * 16, acc[ai][bj][m][n]); asm volatile("" ::: "memory"); }
    }
};
template <class F, bool ALIGN> __device__ __forceinline__ void ph_gemm(unsigned char* lds, const bf16_t* A, int lda, const bf16_t* Bt, int ldb, int N, int K, F f) {
    pg8::Gemm g{A, Bt, T, N, K, lda, ldb, 0}; pg8::StaticOrder S; S.init(T, N, (int)gridDim.x, (int)blockIdx.x);
    pg8::gemm_phase<EpiAdapt<F>, pg8::StaticOrder, ALIGN, true>((PG8_LAS unsigned char*)lds, g, S, EpiAdapt<F>{f});
}

template <class F> struct EpiAdapt8 {
    static constexpr bool PERM = true, AFTER_DRAIN = false;
    F f;
    __device__ __forceinline__ void operator()(const pg8::f32x4 (&acc)[2][2][4][2], const pg8::Unit& u, int wr, int wc, int fr, int fq) const {
        const int row0 = u.pm * 256 + wr * 64 + fr, col0 = u.pn * 256 + wc * 32 + 8 * fq;
#pragma unroll
        for (int ai = 0; ai < 2; ++ai)
#pragma unroll
            for (int m = 0; m < 4; ++m)
#pragma unroll
                for (int bj = 0; bj < 2; ++bj) { f(row0 + ai * 128 + m * 16, col0 + bj * 128, acc[ai][bj][m][0], acc[ai][bj][m][1]); asm volatile("" ::: "memory"); }
    }
};
template <class F, bool ALIGN> __device__ __forceinline__ void ph_gemm8(unsigned char* lds, const bf16_t* A, int lda, const bf16_t* Bt, int ldb, int N, int K, F f) {
    pg8::Gemm g{A, Bt, T, N, K, lda, ldb, 0}; pg8::StaticOrder S; S.init(T, N, (int)gridDim.x, (int)blockIdx.x);
    pg8::gemm_phase<EpiAdapt8<F>, pg8::StaticOrder, ALIGN, true>((PG8_LAS unsigned char*)lds, g, S, EpiAdapt8<F>{f});
}

__device__ __forceinline__ float rstd_of(const float* rowsq, size_t row) {
    const f32x4* p = (const f32x4*)(rowsq + row * 16); const f32x4 a = p[0], b = p[1], c = p[2], d = p[3];
    return rsqrtf((((a.x + a.y) + (a.z + a.w)) + ((b.x + b.y) + (b.z + b.w)) + ((c.x + c.y) + (c.z + c.w)) + ((d.x + d.y) + (d.z + d.w))) * (1.f / DM) + EPS);
}
struct EpiResNorm {
    static constexpr bool PERM = true, AFTER_DRAIN = false;
    const float* xin; const bf16_t* xbin; bf16_t* xb; bf16_t* xg; const float* g; float* rowsq; int use_xb;
    __device__ __forceinline__ void operator()(const pg8::f32x4 (&acc)[2][2][4][2], const pg8::Unit& u, int wr, int wc, int fr, int fq) const {
        const int row0 = u.pm * 256 + wr * 64 + fr, col0 = u.pn * 256 + wc * 32 + 8 * fq;
#pragma unroll
        for (int ai = 0; ai < 2; ++ai)
#pragma unroll
            for (int m = 0; m < 4; ++m) { const int row = row0 + ai * 128 + m * 16; float s = 0.f;
#pragma unroll
                for (int bj = 0; bj < 2; ++bj) { const int col = col0 + bj * 128; f32x4 x0, x1;
                    if (use_xb) { const u32x4 w = *(const u32x4*)(xbin + (size_t)row * DM + col); x0 = (f32x4){lo16(w.x), hi16(w.x), lo16(w.y), hi16(w.y)}; x1 = (f32x4){lo16(w.z), hi16(w.z), lo16(w.w), hi16(w.w)}; }
                    else { x0 = *(const f32x4*)(xin + (size_t)row * DM + col); x1 = *(const f32x4*)(xin + (size_t)row * DM + col + 4); }
                    f32x4 v0 = acc[ai][bj][m][0] + x0, v1 = acc[ai][bj][m][1] + x1;
                    u32x4 ox; ox.x = pk2(v0.x, v0.y); ox.y = pk2(v0.z, v0.w); ox.z = pk2(v1.x, v1.y); ox.w = pk2(v1.z, v1.w); *(u32x4*)(xb + (size_t)row * DM + col) = ox;
                    v0 = (f32x4){lo16(ox.x), hi16(ox.x), lo16(ox.y), hi16(ox.y)}; v1 = (f32x4){lo16(ox.z), hi16(ox.z), lo16(ox.w), hi16(ox.w)};
                    const f32x4 g0 = *(const f32x4*)(g + col), g1 = *(const f32x4*)(g + col + 4);
                    u32x4 o; o.x = pk2(v0.x * g0.x, v0.y * g0.y); o.y = pk2(v0.z * g0.z, v0.w * g0.w); o.z = pk2(v1.x * g1.x, v1.y * g1.y); o.w = pk2(v1.z * g1.z, v1.w * g1.w); *(u32x4*)(xg + (size_t)row * DM + col) = o;
                    s += (v0.x * v0.x + v0.y * v0.y + v0.z * v0.z + v0.w * v0.w) + (v1.x * v1.x + v1.y * v1.y + v1.z * v1.z + v1.w * v1.w); }
                s += __shfl_xor(s, 16); s += __shfl_xor(s, 32);
                if (fq == 0) rowsq[(size_t)row * 16 + u.pn * 4 + wc] = s;
                asm volatile("" ::: "memory"); }
    }
};
struct EpiI16s {
    static constexpr bool PERM = true, AFTER_DRAIN = false;
    short* out; const float* rowsq;
    __device__ __forceinline__ static unsigned q2(float a, float b) { const int ia = (int)__builtin_rintf(fminf(fmaxf(a, -32767.f), 32767.f)), ib = (int)__builtin_rintf(fminf(fmaxf(b, -32767.f), 32767.f)); return ((unsigned)ia & 0xffffu) | ((unsigned)ib << 16); }
    __device__ __forceinline__ void operator()(const pg8::f32x4 (&acc)[2][2][4][2], const pg8::Unit& u, int wr, int wc, int fr, int fq) const {
        const int rloc = wr * 64 + fr, row0 = u.pm * 256 + rloc, col0 = u.pn * 256 + wc * 32 + 8 * fq;
        constexpr int ldc = PQW; const PG8_LAS float* rl = (const PG8_LAS float*)131072u; const PG8_LAS int* tg = (const PG8_LAS int*)133120u;
        const int sel = (u.pm == tg[0]) ? 0 : ((u.pm == tg[1]) ? 256 : -1);
#pragma unroll
        for (int ai = 0; ai < 2; ++ai)
#pragma unroll
            for (int m = 0; m < 4; ++m) { const int row = row0 + ai * 128 + m * 16; const float r = ((sel >= 0) ? rl[sel + rloc + ai * 128 + m * 16] : rstd_of(rowsq, (size_t)row)) * 2048.f;
#pragma unroll
                for (int bj = 0; bj < 2; ++bj) { const f32x4 a = acc[ai][bj][m][0] * r, b = acc[ai][bj][m][1] * r;
                    *(u32x4*)(out + (size_t)row * ldc + col0 + bj * 128) = (u32x4){q2(a.x, a.y), q2(a.z, a.w), q2(b.x, b.y), q2(b.z, b.w)}; } }
    }
};

template <class F, int MB = 4> struct EpiAdapt8L {
    static constexpr bool PERM = true, AFTER_DRAIN = false;
    F f;
    __device__ __forceinline__ void operator()(const pg8::f32x4 (&acc)[2][2][4][2], const pg8::Unit& u, int wr, int wc, int fr, int fq) const {
        const int row0 = u.pm * 256 + wr * 64 + fr, col0 = u.pn * 256 + wc * 32 + 8 * fq;
        typename F::C cc[2];
#pragma unroll
        for (int bj = 0; bj < 2; ++bj) cc[bj] = f.cols(col0 + bj * 128);
#pragma unroll
        for (int ai = 0; ai < 2; ++ai)
#pragma unroll
          for (int mb = 0; mb < 4; mb += MB) {
            typename F::L ld[MB][2];
#pragma unroll
            for (int m = 0; m < MB; ++m)
#pragma unroll
                for (int bj = 0; bj < 2; ++bj) ld[m][bj] = f.load(row0 + ai * 128 + (mb + m) * 16, col0 + bj * 128);
#pragma unroll
            for (int m = 0; m < MB; ++m) { float s = 0.f;
#pragma unroll
                for (int bj = 0; bj < 2; ++bj) s += f.apply(row0 + ai * 128 + (mb + m) * 16, col0 + bj * 128, acc[ai][bj][mb + m][0], acc[ai][bj][mb + m][1], ld[m][bj], cc[bj]);
                f.rowdone(row0 + ai * 128 + (mb + m) * 16, u.pn, wc, fq, s); }
            asm volatile("" ::: "memory");
          }
    }
};
struct EpiPool8L {
    const bf16_t* z; const float* pscale; bf16_t* gaa;
    struct L { u32x4 g; }; struct C { f32x4 p0, p1; };
    __device__ __forceinline__ C cols(int col) const { C c; c.p0 = *(const f32x4*)(pscale + col); c.p1 = *(const f32x4*)(pscale + col + 4); return c; }
    __device__ __forceinline__ L load(int row, int col) const { L l; l.g = *(const u32x4*)(z + (size_t)row * INW + 2048 + col); return l; }
    __device__ __forceinline__ float apply(int row, int col, f32x4 a, f32x4 b, const L& l, const C& c) const {
        u32x4 o; o.x = pk2(a.x * c.p0.x * lo16(l.g.x), a.y * c.p0.y * hi16(l.g.x)); o.y = pk2(a.z * c.p0.z * lo16(l.g.y), a.w * c.p0.w * hi16(l.g.y));
        o.z = pk2(b.x * c.p1.x * lo16(l.g.z), b.y * c.p1.y * hi16(l.g.z)); o.w = pk2(b.z * c.p1.z * lo16(l.g.w), b.w * c.p1.w * hi16(l.g.w));
        *(u32x4*)(gaa + (size_t)row * DM + col) = o; return 0.f; }
    __device__ __forceinline__ void rowdone(int, int, int, int, float) const {}
};
struct EpiUp8L {
    const bf16_t* z; const bf16_t* gaa; bf16_t* mrg;
    struct L { u32x4 g, q; }; struct C { int dummy; };
    __device__ __forceinline__ C cols(int) const { C c; c.dummy = 0; return c; }
    __device__ __forceinline__ L load(int row, int col) const { L l; l.g = *(const u32x4*)(z + (size_t)row * INW + 3072 + col); l.q = *(const u32x4*)(gaa + (size_t)row * DM + col); return l; }
    __device__ __forceinline__ float apply(int row, int col, f32x4 a, f32x4 b, const L& l, const C&) const {
        u32x4 o; o.x = pk2(lo16(l.q.x) + a.x * lo16(l.g.x), hi16(l.q.x) + a.y * hi16(l.g.x)); o.y = pk2(lo16(l.q.y) + a.z * lo16(l.g.y), hi16(l.q.y) + a.w * hi16(l.g.y));
        o.z = pk2(lo16(l.q.z) + b.x * lo16(l.g.z), hi16(l.q.z) + b.y * hi16(l.g.z)); o.w = pk2(lo16(l.q.w) + b.z * lo16(l.g.w), hi16(l.q.w) + b.w * hi16(l.g.w));
        *(u32x4*)(mrg + (size_t)row * DM + col) = o; return 0.f; }
    __device__ __forceinline__ void rowdone(int, int, int, int, float) const {}
};
template <bool XB> struct EpiResNormL {
    const float* xin; const bf16_t* xbin; bf16_t* xb; float* rowsq;
    struct LB { u32x4 w; }; struct LF { f32x4 x0, x1; }; typedef typename std::conditional<XB, LB, LF>::type L; struct C { int dummy; };
    __device__ __forceinline__ C cols(int) const { C c; c.dummy = 0; return c; }
    __device__ __forceinline__ L load(int row, int col) const { L l;
        if constexpr (XB) { l.w = *(const u32x4*)(xbin + (size_t)row * DM + col); } else { l.x0 = *(const f32x4*)(xin + (size_t)row * DM + col); l.x1 = *(const f32x4*)(xin + (size_t)row * DM + col + 4); }
        return l; }
    __device__ __forceinline__ float apply(int row, int col, f32x4 a, f32x4 b, const L& l, const C&) const {
        f32x4 v0, v1;
        if constexpr (XB) { v0 = a + (f32x4){lo16(l.w.x), hi16(l.w.x), lo16(l.w.y), hi16(l.w.y)}; v1 = b + (f32x4){lo16(l.w.z), hi16(l.w.z), lo16(l.w.w), hi16(l.w.w)}; } else { v0 = a + l.x0; v1 = b + l.x1; }
        u32x4 ox; ox.x = pk2(v0.x, v0.y); ox.y = pk2(v0.z, v0.w); ox.z = pk2(v1.x, v1.y); ox.w = pk2(v1.z, v1.w); *(u32x4*)(xb + (size_t)row * DM + col) = ox;
        v0 = (f32x4){lo16(ox.x), hi16(ox.x), lo16(ox.y), hi16(ox.y)}; v1 = (f32x4){lo16(ox.z), hi16(ox.z), lo16(ox.w), hi16(ox.w)};
        return (v0.x * v0.x + v0.y * v0.y + v0.z * v0.z + v0.w * v0.w) + (v1.x * v1.x + v1.y * v1.y + v1.z * v1.z + v1.w * v1.w); }
    __device__ __forceinline__ void rowdone(int row, int pn, int wc, int fq, float s) const { s += __shfl_xor(s, 16); s += __shfl_xor(s, 32); if (fq == 0) rowsq[(size_t)row * 16 + pn * 4 + wc] = s; }
};

struct EpiZk {
    static constexpr bool PERM = true, AFTER_DRAIN = false;
    bf16_t* z; float* kmean;
    __device__ __forceinline__ void operator()(const pg8::f32x4 (&acc)[2][2][4][2], const pg8::Unit& u, int wr, int wc, int fr, int fq) const {
        const int row0 = u.pm * 256 + wr * 64 + fr, col0 = u.pn * 256 + wc * 32 + 8 * fq; const EpiZ8 f{z};
#pragma unroll
        for (int ai = 0; ai < 2; ++ai)
#pragma unroll
            for (int m = 0; m < 4; ++m)
#pragma unroll
                for (int bj = 0; bj < 2; ++bj) { f(row0 + ai * 128 + m * 16, col0 + bj * 128, acc[ai][bj][m][0], acc[ai][bj][m][1]); asm volatile("" ::: "memory"); }
        if (u.pn == 4 || u.pn == 5) {
#pragma unroll
            for (int bj = 0; bj < 2; ++bj) { float cs[8];
#pragma unroll
                for (int e = 0; e < 8; ++e) cs[e] = 0.f;
#pragma unroll
                for (int ai = 0; ai < 2; ++ai)
#pragma unroll
                    for (int m = 0; m < 4; ++m) { const f32x4 a = acc[ai][bj][m][0], b = acc[ai][bj][m][1]; cs[0] += a.x; cs[1] += a.y; cs[2] += a.z; cs[3] += a.w; cs[4] += b.x; cs[5] += b.y; cs[6] += b.z; cs[7] += b.w; }
#pragma unroll
                for (int e = 0; e < 8; ++e) { cs[e] += __shfl_xor(cs[e], 1); cs[e] += __shfl_xor(cs[e], 2); cs[e] += __shfl_xor(cs[e], 4); cs[e] += __shfl_xor(cs[e], 8); }
                if (fr == 0) { float* kb = kmean + (size_t)u.pm * AW + (u.pn - 4) * 256 + bj * 128 + wc * 32 + 8 * fq;
#pragma unroll
                    for (int e = 0; e < 8; ++e) atomicAdd(kb + e, cs[e] * (1.f / MBLK)); } }
        }
    }
};

constexpr int NTHR = 512, NWAVE = 8;
constexpr int LDS_BYTES = 147456;
struct Args {
    const float* x; const float* mix_norm; const float* w_in; const float* w_pool; const float* pool_scale; const float* w_up; const float* w_out; const float* ffn_norm;
    const float* peer_wq; const float* peer_keys; const float* peer_u; const float* peer_v; const float* final_norm; float* out; unsigned char* ws;
};
#define LAS __attribute__((address_space(3)))
#define GAS __attribute__((address_space(1)))

__device__ __forceinline__ void ph_transpose(const float* __restrict__ W, bf16_t* __restrict__ Wt, int K, int N, float* smem) {
    const int tid_ = opq_tid();
    float (*tile)[33] = (float (*)[33])smem;
    const int tx = tid_ & 31, ty = tid_ >> 5, nbx = N / 32, nit = nbx * (K / 32);
    for (int it = blockIdx.x; it < nit; it += gridDim.x) {
        const int n0 = (it % nbx) * 32, k0 = (it / nbx) * 32;
        for (int i = ty; i < 32; i += 16) tile[i][tx] = W[(size_t)(k0 + i) * N + n0 + tx];
        __syncthreads();
        for (int i = ty; i < 32; i += 16) Wt[(size_t)(n0 + i) * K + k0 + tx] = (bf16_t)f2bf(tile[tx][i]);
        __syncthreads();
    }
}

__device__ __forceinline__ void ph_transpose_w(const float* W, bf16_t* Wt, int K, int N, unsigned char* lds_) {
    const int tid_ = opq_tid(); const int lane = tid_ & 63, wv = tid_ >> 6;
    LAS float* scr = (LAS float*)lds_ + wv * (64 * 33 + 32);
    const int nblk = N / 32, nitems = (K / 64) * nblk;
    for (int item = blockIdx.x * NWAVE + wv; item < nitems; item += gridDim.x * NWAVE) {
        const int kb = item / nblk, nb = item % nblk, k0 = 64 * kb, n0 = 32 * nb;
#pragma unroll 8
        for (int i = 0; i < 32; ++i) { const int kk = 2 * i + (lane >> 5); scr[kk * 33 + (lane & 31)] = W[(size_t)(k0 + kk) * N + n0 + (lane & 31)]; }
        const int c = lane & 7;
#pragma unroll
        for (int j = 0; j < 4; ++j) { const int n = (lane >> 3) + 8 * j; const LAS float* s = scr + (8 * c) * 33 + n;
            u32x4 o; o.x = pk2(s[0 * 33], s[1 * 33]); o.y = pk2(s[2 * 33], s[3 * 33]); o.z = pk2(s[4 * 33], s[5 * 33]); o.w = pk2(s[6 * 33], s[7 * 33]);
            *(u32x4*)(Wt + (size_t)(n0 + n) * K + k0 + 8 * c) = o; }
    }
}
__device__ __forceinline__ void ph_wpeer(const float* __restrict__ wq, const float* __restrict__ keys, bf16_t* __restrict__ Wp) {
    const int tid_ = opq_tid();
    for (int it = blockIdx.x; it < PQW * DM / NTHR; it += gridDim.x) {
        const int idx = it * NTHR + tid_; const int c = idx & 1023, n = idx >> 10, hp = n >> 7, k = n & 127, p = hp & 1;
        const float* a = wq + (size_t)c * PQW + hp * 128; const float* b = keys + ((size_t)p * NKEY + k) * 128; float s = 0.f;
        for (int d = 0; d < 128; ++d) s += a[d] * b[d];
        Wp[(size_t)n * DM + c] = (bf16_t)f2bf(s);
    }
}
__device__ __forceinline__ void ph_wpool_bd(const float* __restrict__ wp, bf16_t* __restrict__ Wbd) {
    const int tid_ = opq_tid();
    for (int it = blockIdx.x; it < DM * PW / NTHR; it += gridDim.x) {
        const int idx = it * NTHR + tid_; const int k = idx & 511, n = idx >> 9, g = n >> 8;
        const float v = ((k >> 7) == g) ? wp[((size_t)g * 128 + (k & 127)) * 256 + (n & 255)] : 0.f;
        Wbd[(size_t)n * PW + k] = (bf16_t)f2bf(v);
    }
}
__device__ __forceinline__ void ph_cvt(const float* __restrict__ src, bf16_t* __restrict__ dst, size_t n4) {
    const int tid_ = opq_tid();
    for (size_t i = (size_t)blockIdx.x * NTHR + tid_; i < n4; i += (size_t)gridDim.x * NTHR) {
        const f32x4 v = ((const f32x4*)src)[i]; u32x2 o; o.x = pk2(v.x, v.y); o.y = pk2(v.z, v.w); ((u32x2*)dst)[i] = o; }
}
__device__ __forceinline__ void ph_rmsnorm(const float* __restrict__ x, const float* __restrict__ g, bf16_t* __restrict__ out) {
    const int tid_ = opq_tid();
    const int lane = tid_ & 63, wv = tid_ >> 6;
    for (int it = blockIdx.x; it < T / NWAVE; it += gridDim.x) {
        const int row = it * NWAVE + wv; const f32x4* xr = (const f32x4*)(x + (size_t)row * DM); f32x4 v[4]; float s = 0.f;
#pragma unroll
        for (int j = 0; j < 4; ++j) { v[j] = xr[lane + 64 * j]; s += v[j].x * v[j].x + v[j].y * v[j].y + v[j].z * v[j].z + v[j].w * v[j].w; }
        const float rstd = rsqrtf(wave_sum(s) * (1.f / DM) + EPS);
#pragma unroll
        for (int j = 0; j < 4; ++j) { const f32x4 gg = ((const f32x4*)g)[lane + 64 * j]; u32x2 o; o.x = pk2(v[j].x * rstd * gg.x, v[j].y * rstd * gg.y); o.y = pk2(v[j].z * rstd * gg.z, v[j].w * rstd * gg.w);
            ((u32x2*)(out + (size_t)row * DM))[lane + 64 * j] = o; }
    }
}
template <class Epi> __device__ __forceinline__ void ph_gemm_naive(const bf16_t* __restrict__ A, int lda, int a_pn_off, const bf16_t* __restrict__ Bt, int ldb, int N, int K, Epi E) {
    const int tid_ = opq_tid();
    const int cg_ = tid_ & 63, rr = tid_ >> 6, nbx = N / 256, nit = nbx * (T / 8);
    for (int it = blockIdx.x; it < nit; it += gridDim.x) {
        const int bx = it % nbx, by = it / nbx; const int col0 = bx * 256 + cg_ * 4, row = by * 8 + rr;
        const bf16_t* a = A + (size_t)row * lda + (size_t)bx * a_pn_off; const bf16_t* b = Bt + (size_t)col0 * ldb;
        float acc[4] = {0.f, 0.f, 0.f, 0.f};
        for (int k = 0; k < K; k += 8) {
            const u32x4 av = *(const u32x4*)(a + k);
#pragma unroll
            for (int i = 0; i < 4; ++i) { const u32x4 bv = *(const u32x4*)(b + (size_t)i * ldb + k);
                acc[i] += lo16(av.x) * lo16(bv.x) + hi16(av.x) * hi16(bv.x) + lo16(av.y) * lo16(bv.y) + hi16(av.y) * hi16(bv.y)
                        + lo16(av.z) * lo16(bv.z) + hi16(av.z) * hi16(bv.z) + lo16(av.w) * lo16(bv.w) + hi16(av.w) * hi16(bv.w); }
        }
        E(row, col0, (f32x4){acc[0], acc[1], acc[2], acc[3]});
    }
}
__device__ __forceinline__ void ph_kmean(const bf16_t* __restrict__ z, float* __restrict__ kmean) {
    const int tid_ = opq_tid();
    for (int it = blockIdx.x; it < NB * NBLK; it += gridDim.x) {
        const int b = it / NBLK, blk = it % NBLK, c = tid_;
        const bf16_t* p = z + ((size_t)b * SEQ + blk * MBLK) * INW + 1024 + c; float s = 0.f;
        for (int r = 0; r < MBLK; ++r) s += bf2f(p[(size_t)r * INW]);
        kmean[((size_t)b * NBLK + blk) * AW + c] = s * (1.f / MBLK);
    }
}
__device__ __forceinline__ void ph_poolm(const bf16_t* __restrict__ z, bf16_t* __restrict__ m) {
    const int tid_ = opq_tid();
    const int c = tid_, w = 2 << (c >> 7);
    for (int it = blockIdx.x; it < T / 64; it += gridDim.x) {
        const int t0 = it * 64;
        for (int i = 0; i < 64; ++i) { const int t = t0 + i, pos = t & (SEQ - 1); const int cnt = (pos + 1 < w) ? pos + 1 : w; float s = 0.f;
            for (int j = 0; j < cnt; ++j) s += bf2f(z[(size_t)(t - j) * INW + c]);
            const float pv = bf2f(z[(size_t)t * INW + c]);
            m[(size_t)t * PW + c] = (bf16_t)f2bf(s / (float)cnt - pv); }
    }
}
__device__ __forceinline__ void ph_attn_naive(const bf16_t* __restrict__ z, const float* __restrict__ kmean, bf16_t* __restrict__ o, float* smem) {
    const int tid_ = opq_tid();
    float (*sc)[1024] = (float (*)[1024])smem;
    const int w = tid_ >> 6, lane = tid_ & 63;
    for (int it = blockIdx.x; it < T; it += gridDim.x) {
        const int t = it, h = w; const int b = t / SEQ, pos = t % SEQ, own = pos / MBLK;
        float q[64];
        { const u32x4* qp = (const u32x4*)(z + (size_t)t * INW + 512 + h * 64);
#pragma unroll
          for (int i = 0; i < 8; ++i) { const u32x4 v = qp[i]; q[8 * i] = lo16(v.x); q[8 * i + 1] = hi16(v.x); q[8 * i + 2] = lo16(v.y); q[8 * i + 3] = hi16(v.y); q[8 * i + 4] = lo16(v.z); q[8 * i + 5] = hi16(v.z); q[8 * i + 6] = lo16(v.w); q[8 * i + 7] = hi16(v.w); } }
        float bs[7];
#pragma unroll
        for (int j = 0; j < 7; ++j) { float s = -INFINITY; if (j < own) { s = 0.f; const float* km = kmean + ((size_t)b * NBLK + j) * AW + h * 64;
#pragma unroll
            for (int d = 0; d < 64; ++d) s += q[d] * km[d]; } bs[j] = s; }
        int sel[3];
#pragma unroll
        for (int r = 0; r < 3; ++r) { float best = -INFINITY; int bi = -1;
#pragma unroll
            for (int j = 0; j < 7; ++j) if (bs[j] > best) { best = bs[j]; bi = j; }
            sel[r] = bi;
#pragma unroll
            for (int j = 0; j < 7; ++j) if (j == bi) bs[j] = -INFINITY; }
        const float slope2 = exp2f(-(float)(h + 1)) * LOG2E;
        float mx = -INFINITY;
#pragma unroll
        for (int sg = 0; sg < 4; ++sg) {
            const int blk = (sg < 3) ? sel[sg] : own; if (blk < 0) continue;
            const int kb = blk * MBLK, cnt = (sg < 3) ? MBLK : (pos - kb + 1);
            for (int kk = lane; kk < cnt; kk += 64) {
                const u32x4* kp = (const u32x4*)(z + ((size_t)b * SEQ + kb + kk) * INW + 1024 + h * 64); float s = 0.f;
#pragma unroll
                for (int i = 0; i < 8; ++i) { const u32x4 v = kp[i]; s += q[8 * i] * lo16(v.x) + q[8 * i + 1] * hi16(v.x) + q[8 * i + 2] * lo16(v.y) + q[8 * i + 3] * hi16(v.y) + q[8 * i + 4] * lo16(v.z) + q[8 * i + 5] * hi16(v.z) + q[8 * i + 6] * lo16(v.w) + q[8 * i + 7] * hi16(v.w); }
                s -= slope2 * (float)(pos - (kb + kk)); sc[w][sg * 256 + kk] = s; mx = fmaxf(mx, s); }
        }
        mx = wave_max(mx); float sum = 0.f;
#pragma unroll
        for (int sg = 0; sg < 4; ++sg) {
            const int blk = (sg < 3) ? sel[sg] : own; if (blk < 0) continue;
            const int kb = blk * MBLK, cnt = (sg < 3) ? MBLK : (pos - kb + 1);
            for (int kk = lane; kk < cnt; kk += 64) { const float p = exp2f(sc[w][sg * 256 + kk] - mx); sc[w][sg * 256 + kk] = p; sum += p; }
        }
        sum = wave_sum(sum);
        __syncthreads();
        float acc = 0.f;
#pragma unroll
        for (int sg = 0; sg < 4; ++sg) {
            const int blk = (sg < 3) ? sel[sg] : own; if (blk < 0) continue;
            const int kb = blk * MBLK, cnt = (sg < 3) ? MBLK : (pos - kb + 1);
            const bf16_t* vp = z + ((size_t)b * SEQ + kb) * INW + 1536 + h * 64 + lane;
            for (int kk = 0; kk < cnt; ++kk) acc += sc[w][sg * 256 + kk] * bf2f(vp[(size_t)kk * INW]);
        }
        o[(size_t)t * AW + h * 64 + lane] = (bf16_t)f2bf(acc / sum);
        __syncthreads();
    }
}
__device__ __forceinline__ void ph_topk_naive(const float* __restrict__ scores, int* __restrict__ eid, float* __restrict__ gw, float* smem) {
    const int tid_ = opq_tid();
    float (*svl)[2][16] = (float (*)[2][16])smem; int (*sil)[2][16] = (int (*)[2][16])(smem + 256); float (*cvl)[16] = (float (*)[16])(smem + 512); int (*cil)[16] = (int (*)[16])(smem + 640);
    const int w = tid_ >> 6, lane = tid_ & 63;
    for (int it = blockIdx.x; it < T; it += gridDim.x) {
        const int t = it, h = w;
        for (int p = 0; p < 2; ++p) {
            const float* s = scores + (size_t)t * PQW + h * 256 + p * 128;
            float v0 = s[lane], v1 = s[lane + 64];
            for (int r = 0; r < 16; ++r) {
                float bv; int bi; if (v0 >= v1) { bv = v0; bi = lane; } else { bv = v1; bi = lane + 64; }
#pragma unroll
                for (int o = 1; o < 64; o <<= 1) { const float ov = __shfl_xor(bv, o); const int oi = __shfl_xor(bi, o); if (ov > bv || (ov == bv && oi < bi)) { bv = ov; bi = oi; } }
                if (lane == 0) { svl[w][p][r] = bv; sil[w][p][r] = bi; }
                if (bi == lane) v0 = -INFINITY; if (bi == lane + 64) v1 = -INFINITY;
            }
        }
        __syncthreads();
        float cv[4];
#pragma unroll
        for (int m = 0; m < 4; ++m) { const int c = lane + 64 * m; cv[m] = svl[w][0][c >> 4] + svl[w][1][c & 15]; }
        for (int r = 0; r < 16; ++r) {
            float bv = cv[0]; int bi = lane;
#pragma unroll
            for (int m = 1; m < 4; ++m) if (cv[m] > bv) { bv = cv[m]; bi = lane + 64 * m; }
#pragma unroll
            for (int o = 1; o < 64; o <<= 1) { const float ov = __shfl_xor(bv, o); const int oi = __shfl_xor(bi, o); if (ov > bv || (ov == bv && oi < bi)) { bv = ov; bi = oi; } }
            if (lane == 0) { cvl[w][r] = bv; cil[w][r] = bi; }
#pragma unroll
            for (int m = 0; m < 4; ++m) if (bi == lane + 64 * m) cv[m] = -INFINITY;
        }
        __syncthreads();
        if (lane < 16) {
            const float mx = cvl[w][0]; float sum = 0.f;
            for (int r = 0; r < 16; ++r) sum += __expf(cvl[w][r] - mx);
            const int c = cil[w][lane];
            eid[(size_t)t * NSLOT + h * 16 + lane] = sil[w][0][c >> 4] * NKEY + sil[w][1][c & 15];
            gw[(size_t)t * NSLOT + h * 16 + lane] = __expf(cvl[w][lane] - mx) / sum;
        }
        __syncthreads();
    }
}
__device__ __forceinline__ void ph_peer_u(const bf16_t* __restrict__ hn, const bf16_t* __restrict__ Ub, const int* __restrict__ eid, const float* __restrict__ gw, float* __restrict__ wact) {
    const int tid_ = opq_tid();
    const int lane = tid_ & 63, wv = tid_ >> 6;
    for (int it = blockIdx.x; it < T / NWAVE; it += gridDim.x) {
        const int t = it * NWAVE + wv;
        const u32x4 h0 = *(const u32x4*)(hn + (size_t)t * DM + lane * 8), h1 = *(const u32x4*)(hn + (size_t)t * DM + 512 + lane * 8);
        for (int s = 0; s < NSLOT; ++s) {
            const int e = eid[(size_t)t * NSLOT + s]; const bf16_t* row = Ub + (size_t)e * DM;
            const u32x4 a = *(const u32x4*)(row + lane * 8), b = *(const u32x4*)(row + 512 + lane * 8);
            float d = lo16(a.x) * lo16(h0.x) + hi16(a.x) * hi16(h0.x) + lo16(a.y) * lo16(h0.y) + hi16(a.y) * hi16(h0.y) + lo16(a.z) * lo16(h0.z) + hi16(a.z) * hi16(h0.z) + lo16(a.w) * lo16(h0.w) + hi16(a.w) * hi16(h0.w)
                    + lo16(b.x) * lo16(h1.x) + hi16(b.x) * hi16(h1.x) + lo16(b.y) * lo16(h1.y) + hi16(b.y) * hi16(h1.y) + lo16(b.z) * lo16(h1.z) + hi16(b.z) * hi16(h1.z) + lo16(b.w) * lo16(h1.w) + hi16(b.w) * hi16(h1.w);
            d = wave_sum(d);
            if (lane == 0) wact[(size_t)t * NSLOT + s] = gw[(size_t)t * NSLOT + s] * gelu_tanh(d);
        }
    }
}
__device__ __forceinline__ void ph_peer_v(float* __restrict__ xres, const bf16_t* __restrict__ Vb, const int* __restrict__ eid, const float* __restrict__ wact, const float* __restrict__ gn, bf16_t* __restrict__ hout, int last) {
    const int tid_ = opq_tid();
    const int lane = tid_ & 63, wv = tid_ >> 6;
    for (int it = blockIdx.x; it < T / NWAVE; it += gridDim.x) {
        const int t = it * NWAVE + wv;
        float acc[16];
#pragma unroll
        for (int i = 0; i < 16; ++i) acc[i] = 0.f;
        for (int s = 0; s < NSLOT; ++s) {
            const int e = eid[(size_t)t * NSLOT + s]; const float w = wact[(size_t)t * NSLOT + s]; const bf16_t* row = Vb + (size_t)e * DM;
            const u32x4 a = *(const u32x4*)(row + lane * 8), b = *(const u32x4*)(row + 512 + lane * 8);
            acc[0] += w * lo16(a.x); acc[1] += w * hi16(a.x); acc[2] += w * lo16(a.y); acc[3] += w * hi16(a.y); acc[4] += w * lo16(a.z); acc[5] += w * hi16(a.z); acc[6] += w * lo16(a.w); acc[7] += w * hi16(a.w);
            acc[8] += w * lo16(b.x); acc[9] += w * hi16(b.x); acc[10] += w * lo16(b.y); acc[11] += w * hi16(b.y); acc[12] += w * lo16(b.z); acc[13] += w * hi16(b.z); acc[14] += w * lo16(b.w); acc[15] += w * hi16(b.w);
        }
        float* xr = xres + (size_t)t * DM; float ss = 0.f;
#pragma unroll
        for (int hf = 0; hf < 2; ++hf)
#pragma unroll
            for (int j = 0; j < 2; ++j) { const f32x4 xv = *(const f32x4*)(xr + hf * 512 + lane * 8 + j * 4);
                acc[hf * 8 + j * 4 + 0] += xv.x; acc[hf * 8 + j * 4 + 1] += xv.y; acc[hf * 8 + j * 4 + 2] += xv.z; acc[hf * 8 + j * 4 + 3] += xv.w; }
#pragma unroll
        for (int i = 0; i < 16; ++i) ss += acc[i] * acc[i];
        const float rstd = rsqrtf(wave_sum(ss) * (1.f / DM) + EPS);
#pragma unroll
        for (int hf = 0; hf < 2; ++hf)
#pragma unroll
            for (int j = 0; j < 2; ++j) { const int c = hf * 512 + lane * 8 + j * 4; const f32x4 g = *(const f32x4*)(gn + c); const int a0 = hf * 8 + j * 4;
                if (last) { *(f32x4*)(xr + c) = (f32x4){acc[a0] * rstd * g.x, acc[a0 + 1] * rstd * g.y, acc[a0 + 2] * rstd * g.z, acc[a0 + 3] * rstd * g.w}; }
                else { *(f32x4*)(xr + c) = (f32x4){acc[a0], acc[a0 + 1], acc[a0 + 2], acc[a0 + 3]};
                    u32x2 ob; ob.x = pk2(acc[a0] * rstd * g.x, acc[a0 + 1] * rstd * g.y); ob.y = pk2(acc[a0 + 2] * rstd * g.z, acc[a0 + 3] * rstd * g.w); *(u32x2*)(hout + (size_t)t * DM + c) = ob; } }
    }
}


__device__ __forceinline__ void ph_poolm2(const bf16_t* z, bf16_t* m) {
    const int tid_ = opq_tid(); const int c = tid_, wsel = c >> 7, w = 2 << wsel;
    for (int it = blockIdx.x; it < T / 64; it += gridDim.x) {
        const int t0 = it * 64, pos0 = t0 & (SEQ - 1);
        float x[32];
#pragma unroll
        for (int i = 0; i < 16; ++i) x[i] = (pos0 == 0) ? 0.f : bf2f(z[(size_t)(t0 - 16 + i) * INW + c]);
#pragma unroll 1
        for (int bt = 0; bt < 4; ++bt) {
#pragma unroll
            for (int i = 0; i < 16; ++i) x[16 + i] = bf2f(z[(size_t)(t0 + bt * 16 + i) * INW + c]);
            float s1[32], s2[32], s3[32], s4[32];
#pragma unroll
            for (int i = 1; i < 32; ++i) s1[i] = x[i] + x[i - 1];
#pragma unroll
            for (int i = 3; i < 32; ++i) s2[i] = s1[i] + s1[i - 2];
#pragma unroll
            for (int i = 7; i < 32; ++i) s3[i] = s2[i] + s2[i - 4];
#pragma unroll
            for (int i = 16; i < 32; ++i) s4[i] = s3[i] + s3[i - 8];
#pragma unroll
            for (int i = 16; i < 32; ++i) { const int pos = pos0 + bt * 16 + (i - 16); const int cnt = (pos + 1 < w) ? pos + 1 : w;
                const float s = (wsel == 0) ? s1[i] : (wsel == 1) ? s2[i] : (wsel == 2) ? s3[i] : s4[i];
                m[(size_t)(t0 + bt * 16 + i - 16) * PW + c] = (bf16_t)f2bf(s / (float)cnt - x[i]); }
#pragma unroll
            for (int i = 0; i < 16; ++i) x[i] = x[16 + i];
        }
    }
}
__device__ __forceinline__ void ph_wpeer2(const float* wq, const float* keys, const float* gf, bf16_t* Wp, float* smem) {
    const int tid_ = opq_tid(); const int kq = tid_ & 31, cq = tid_ >> 5;
    float* kl = smem; float* wl = smem + 128 * 129;
    for (int it = blockIdx.x; it < 16 * 16; it += gridDim.x) {
        const int hp = it >> 4, c0 = (it & 15) * 64, p = hp & 1;
        for (int i = tid_; i < 128 * 32; i += NTHR) { const int row = i >> 5, d4 = (i & 31) * 4; const f32x4 v = *(const f32x4*)(keys + ((size_t)p * NKEY + row) * 128 + d4);
            kl[row * 129 + d4] = v.x; kl[row * 129 + d4 + 1] = v.y; kl[row * 129 + d4 + 2] = v.z; kl[row * 129 + d4 + 3] = v.w; }
        for (int i = tid_; i < 64 * 32; i += NTHR) { const int row = i >> 5, d4 = (i & 31) * 4; const f32x4 v = *(const f32x4*)(wq + (size_t)(c0 + row) * PQW + hp * 128 + d4);
            wl[row * 129 + d4] = v.x; wl[row * 129 + d4 + 1] = v.y; wl[row * 129 + d4 + 2] = v.z; wl[row * 129 + d4 + 3] = v.w; }
        __syncthreads();
        float acc[4][4];
#pragma unroll
        for (int i = 0; i < 4; ++i)
#pragma unroll
            for (int j = 0; j < 4; ++j) acc[i][j] = 0.f;
        for (int d = 0; d < 128; ++d) {
            float av[4], bv[4];
#pragma unroll
            for (int i = 0; i < 4; ++i) { av[i] = kl[(kq + 32 * i) * 129 + d]; bv[i] = wl[(cq + 16 * i) * 129 + d]; }
#pragma unroll
            for (int i = 0; i < 4; ++i)
#pragma unroll
                for (int j = 0; j < 4; ++j) acc[i][j] += av[i] * bv[j];
        }
#pragma unroll
        for (int i = 0; i < 4; ++i)
#pragma unroll
            for (int j = 0; j < 4; ++j) Wp[(size_t)(hp * 128 + kq + 32 * i) * DM + c0 + cq + 16 * j] = (bf16_t)f2bf(acc[i][j] * gf[c0 + cq + 16 * j]);
        __syncthreads();
    }
}

typedef short bf16x8_t __attribute__((ext_vector_type(8)));
typedef float f32x16 __attribute__((ext_vector_type(16)));
typedef short v4i16_t __attribute__((ext_vector_type(4)));
typedef float f32x2_t __attribute__((ext_vector_type(2)));
typedef __bf16 bf16x2_t __attribute__((ext_vector_type(2)));
__device__ __forceinline__ unsigned cvtpk(float lo, float hi) { f32x2_t v = {lo, hi}; bf16x2_t b = __builtin_convertvector(v, bf16x2_t); return __builtin_bit_cast(unsigned, b); }
constexpr int AT_ROW = 144, AT_TILE = 64 * AT_ROW;
__device__ __forceinline__ void ph_attn(unsigned char* lds_, const bf16_t* z, const float* kmean, bf16_t* o) {
    LAS unsigned char* lds = (LAS unsigned char*)lds_;
    const int tid = opq_tid(), lane = tid & 63, wv = __builtin_amdgcn_readfirstlane(tid >> 6), r = lane & 31, hi = lane >> 5;
    const int srow = tid >> 3, sch = tid & 7;
    const unsigned st_off = srow * AT_ROW + sch * 16;
    const unsigned k_off = r * AT_ROW + hi * 16;
    const unsigned v_off = (4 * hi + ((lane & 15) >> 2)) * AT_ROW + (16 * ((lane >> 4) & 1) + 4 * (lane & 3)) * 2;
    LAS float* kml = (LAS float*)(lds + 4 * AT_TILE);
    for (int pr = blockIdx.x; pr < 256; pr += gridDim.x) {
#pragma unroll 1
        for (int uu = 0; uu < 2; ++uu) {
            const int bh = pr >> 2, qb = uu == 0 ? (pr & 3) : 7 - (pr & 3);
            const int b = bh >> 3, h = bh & 7, own = qb, q0 = qb * MBLK;
            const size_t rowbase = (size_t)b * SEQ;
            const int qrel = wv * 32 + r;
            bf16x8_t qf[4];
            { const bf16_t* qptr = z + (rowbase + q0 + qrel) * INW + 512 + h * 64 + hi * 8;
#pragma unroll
              for (int ds = 0; ds < 4; ++ds) qf[ds] = *(const bf16x8_t*)(qptr + ds * 16); }
            unsigned selmask = 0;
            if (own > 0) {
                float bs[7];
#pragma unroll
                for (int j = 0; j < 7; ++j) { float s = -INFINITY;
                    if (j < own) { const float* km = kmean + ((size_t)b * NBLK + j) * AW + h * 64 + hi * 8; s = 0.f;
#pragma unroll
                        for (int ds = 0; ds < 4; ++ds) { const f32x4 k0 = *(const f32x4*)(km + ds * 16), k1 = *(const f32x4*)(km + ds * 16 + 4);
                            s += bf2f((bf16_t)qf[ds][0]) * k0.x + bf2f((bf16_t)qf[ds][1]) * k0.y + bf2f((bf16_t)qf[ds][2]) * k0.z + bf2f((bf16_t)qf[ds][3]) * k0.w
                               + bf2f((bf16_t)qf[ds][4]) * k1.x + bf2f((bf16_t)qf[ds][5]) * k1.y + bf2f((bf16_t)qf[ds][6]) * k1.z + bf2f((bf16_t)qf[ds][7]) * k1.w; }
                        s += __shfl_xor(s, 32); }
                    bs[j] = s; }
#pragma unroll
                for (int rr = 0; rr < 3; ++rr) { float best = -INFINITY; int bi = -1;
#pragma unroll
                    for (int j = 0; j < 7; ++j) if (bs[j] > best) { best = bs[j]; bi = j; }
                    if (bi >= 0) selmask |= 1u << bi;
#pragma unroll
                    for (int j = 0; j < 7; ++j) if (j == bi) bs[j] = -INFINITY; }
            }
            const float slope2 = exp2f(-(float)(h + 1)) * LOG2E;
            const float hoff = slope2 * (float)(4 * hi);
            f32x16 o0, o1;
#pragma unroll
            for (int i = 0; i < 16; ++i) { o0[i] = 0.f; o1[i] = 0.f; }
            float mrun = 0.f, lrun = 0.f;
            const int NS = 2 * (own + 1);
            const unsigned kv_voff = (unsigned)(srow * INW + sch * 8) * 2u;
#define AT_KVLOAD(kd, vd, kvabs_) do { const GAS char* kvb_ = (const GAS char*)z + ((size_t)(rowbase + (kvabs_)) * INW + 1024 + h * 64) * 2; asm("" : "+s"(kvb_)); unsigned vo_ = kv_voff; asm("" : "+v"(vo_)); \
                kd[0] = *(const GAS u32x4*)(kvb_ + vo_); vd[0] = *(const GAS u32x4*)(kvb_ + 1024 + vo_); kd[1] = *(const GAS u32x4*)(kvb_ + 64 * INW * 2 + vo_); vd[1] = *(const GAS u32x4*)(kvb_ + 64 * INW * 2 + 1024 + vo_); } while (0)
#define AT_KVABS(s_) (((s_) < 2) ? own * MBLK + (s_) * 128 : ((s_) - 2) * 128)
#define AT_WRITE(buf_, kd, vd) do { *(LAS u32x4*)(lds + ((buf_) * 4 + 0) * AT_TILE + st_off) = kd[0]; *(LAS u32x4*)(lds + ((buf_) * 4 + 1) * AT_TILE + st_off) = kd[1]; \
                *(LAS u32x4*)(lds + ((buf_) * 4 + 2) * AT_TILE + st_off) = vd[0]; *(LAS u32x4*)(lds + ((buf_) * 4 + 3) * AT_TILE + st_off) = vd[1]; } while (0)
            u32x4 kr[2], vr[2];
            { AT_KVLOAD(kr, vr, own * MBLK); AT_WRITE(0, kr, vr); }
            __syncthreads();
            for (int i0 = 0; i0 < NS; i0 += 2) {
#pragma unroll
              for (int u = 0; u < 2; ++u) {
                const int i = i0 + u; const int cur = u;
                { const int i2 = (i + 1 < NS) ? i + 1 : NS - 1; AT_KVLOAD(kr, vr, AT_KVABS(i2)); }
                int mode[2]; float base[2]; int kv0[2];
#pragma unroll
                for (int sb = 0; sb < 2; ++sb) {
                    if (i < 2) { kv0[sb] = i * 128 + sb * 64; mode[sb] = (kv0[sb] > wv * 32 + 31) ? 0 : ((kv0[sb] + 63 <= wv * 32) ? 1 : 2); base[sb] = slope2 * (float)(kv0[sb] - qrel); }
                    else { kv0[sb] = 0; const int blk = (i - 2) >> 1; const bool sel = (selmask >> blk) & 1u; mode[sb] = __any(sel) ? 1 : 0; base[sb] = sel ? slope2 * (float)((i - 2) * 128 + sb * 64 - q0 - qrel) : -INFINITY; } }
                if (mode[0] | mode[1]) {
                    f32x16 p[2][2];
#pragma unroll
                    for (int sb = 0; sb < 2; ++sb) { const float base2 = (mode[sb] ? base[sb] : -INFINITY) + hoff - mrun;
#pragma unroll
                        for (int e = 0; e < 16; ++e) { p[sb][0][e] = fmaf(slope2, (float)((e & 3) + 8 * (e >> 2)), base2); p[sb][1][e] = fmaf(slope2, (float)((e & 3) + 8 * (e >> 2) + 32), base2); }
                        if (mode[sb] == 2) {
#pragma unroll
                            for (int e = 0; e < 16; ++e) { const int kvr = kv0[sb] + (e & 3) + 8 * (e >> 2) + 4 * hi; if (kvr > qrel) p[sb][0][e] = -INFINITY; if (kvr + 32 > qrel) p[sb][1][e] = -INFINITY; } } }
#pragma unroll
                    for (int sb = 0; sb < 2; ++sb) if (mode[sb]) {
                        const LAS unsigned char* kb = lds + (cur * 4 + sb) * AT_TILE + k_off;
#pragma unroll
                        for (int kh = 0; kh < 2; ++kh) { bf16x8_t ka[4];
#pragma unroll
                            for (int ds = 0; ds < 4; ++ds) ka[ds] = *(const LAS bf16x8_t*)(kb + kh * 32 * AT_ROW + ds * 32);
                            asm volatile("s_waitcnt lgkmcnt(0)" : "+v"(ka[0]), "+v"(ka[1]), "+v"(ka[2]), "+v"(ka[3]) :: "memory");
#pragma unroll
                            for (int ds = 0; ds < 4; ++ds) p[sb][kh] = __builtin_amdgcn_mfma_f32_32x32x16_bf16(ka[ds], qf[ds], p[sb][kh], 0, 0, 0); } }
                    float mloc = fmaxf(fmaxf(p[0][0][0], p[0][1][0]), fmaxf(p[1][0][0], p[1][1][0]));
#pragma unroll
                    for (int e = 1; e < 16; ++e) mloc = fmaxf(mloc, fmaxf(fmaxf(p[0][0][e], p[0][1][e]), fmaxf(p[1][0][e], p[1][1][e])));
                    mloc = fmaxf(mloc, __shfl_xor(mloc, 32));
                    const float delta = (i == 0) ? mloc : fmaxf(mloc, 0.f);
                    if (__any(delta != 0.f)) {
#pragma unroll
                        for (int e = 0; e < 16; ++e) { p[0][0][e] -= delta; p[0][1][e] -= delta; p[1][0][e] -= delta; p[1][1][e] -= delta; }
                        mrun += delta;
                        if (i > 0) { const float alpha = __builtin_amdgcn_exp2f(-delta); lrun *= alpha;
#pragma unroll
                            for (int e = 0; e < 16; ++e) { o0[e] *= alpha; o1[e] *= alpha; } }
                    }
#pragma unroll
                    for (int sb = 0; sb < 2; ++sb) if (mode[sb]) {
                        float ls = 0.f;
#pragma unroll
                        for (int e = 0; e < 16; ++e) { p[sb][0][e] = __builtin_amdgcn_exp2f(p[sb][0][e]); p[sb][1][e] = __builtin_amdgcn_exp2f(p[sb][1][e]); ls += p[sb][0][e] + p[sb][1][e]; }
                        lrun += ls;
                        u32x4 pb[2][2];
#pragma unroll
                        for (int s = 0; s < 2; ++s) { pb[0][s] = (u32x4){cvtpk(p[sb][0][8 * s], p[sb][0][8 * s + 1]), cvtpk(p[sb][0][8 * s + 2], p[sb][0][8 * s + 3]), cvtpk(p[sb][0][8 * s + 4], p[sb][0][8 * s + 5]), cvtpk(p[sb][0][8 * s + 6], p[sb][0][8 * s + 7])};
                            pb[1][s] = (u32x4){cvtpk(p[sb][1][8 * s], p[sb][1][8 * s + 1]), cvtpk(p[sb][1][8 * s + 2], p[sb][1][8 * s + 3]), cvtpk(p[sb][1][8 * s + 4], p[sb][1][8 * s + 5]), cvtpk(p[sb][1][8 * s + 6], p[sb][1][8 * s + 7])}; }
                        const LAS unsigned char* vb = lds + (cur * 4 + 2 + sb) * AT_TILE + v_off;
#pragma unroll
                        for (int kh = 0; kh < 2; ++kh) { v4i16_t vlo[4], vhh[4];
#pragma unroll
                            for (int s = 0; s < 2; ++s)
#pragma unroll
                                for (int dh = 0; dh < 2; ++dh) { const LAS unsigned char* va = vb + (32 * kh + 16 * s) * AT_ROW + dh * 64; const int ix = s * 2 + dh;
                                    vlo[ix] = __builtin_amdgcn_ds_read_tr16_b64_v4i16((LAS v4i16_t*)(va)); vhh[ix] = __builtin_amdgcn_ds_read_tr16_b64_v4i16((LAS v4i16_t*)(va + 8 * AT_ROW)); }
                            asm volatile("s_waitcnt lgkmcnt(0)" : "+v"(vlo[0]), "+v"(vlo[1]), "+v"(vlo[2]), "+v"(vlo[3]), "+v"(vhh[0]), "+v"(vhh[1]), "+v"(vhh[2]), "+v"(vhh[3]) :: "memory");
#pragma unroll
                            for (int s = 0; s < 2; ++s) { const bf16x8_t pf = __builtin_bit_cast(bf16x8_t, pb[kh][s]);
#pragma unroll
                                for (int dh = 0; dh < 2; ++dh) { const int ix = s * 2 + dh;
                                    const bf16x8_t vf = (bf16x8_t){vlo[ix][0], vlo[ix][1], vlo[ix][2], vlo[ix][3], vhh[ix][0], vhh[ix][1], vhh[ix][2], vhh[ix][3]};
                                    if (dh == 0) o0 = __builtin_amdgcn_mfma_f32_32x32x16_bf16(vf, pf, o0, 0, 0, 0); else o1 = __builtin_amdgcn_mfma_f32_32x32x16_bf16(vf, pf, o1, 0, 0, 0); } } }
                    }
                }
                AT_WRITE(cur ^ 1, kr, vr);
                __syncthreads();
              }
            }
#undef AT_KVLOAD
#undef AT_KVABS
#undef AT_WRITE
            lrun += __shfl_xor(lrun, 32);
            const float rl = 1.f / lrun;
            bf16_t* op = o + (rowbase + q0 + qrel) * AW + h * 64 + 4 * hi;
#pragma unroll
            for (int g = 0; g < 4; ++g) {
                u32x2 w0, w1; w0.x = cvtpk(o0[4 * g] * rl, o0[4 * g + 1] * rl); w0.y = cvtpk(o0[4 * g + 2] * rl, o0[4 * g + 3] * rl);
                w1.x = cvtpk(o1[4 * g] * rl, o1[4 * g + 1] * rl); w1.y = cvtpk(o1[4 * g + 2] * rl, o1[4 * g + 3] * rl);
                *(u32x2*)(op + 8 * g) = w0; *(u32x2*)(op + 32 + 8 * g) = w1; }
        }
    }
}


__device__ __forceinline__ void ce_desc(float& a, float& b) {
    float mx, mn; asm("v_max_f32 %0, %1, %2" : "=v"(mx) : "v"(a), "v"(b)); asm("v_min_f32 %0, %1, %2" : "=v"(mn) : "v"(a), "v"(b)); a = mx; b = mn;
}
__device__ __forceinline__ float vmaxf(float a, float b) { float mx; asm("v_max_f32 %0, %1, %2" : "=v"(mx) : "v"(a), "v"(b)); return mx; }
template <int N> __device__ __forceinline__ void bitonic_sort_desc(float (&v)[N]) {
#pragma unroll
    for (int k = 2; k <= N; k <<= 1)
#pragma unroll
        for (int j = k >> 1; j > 0; j >>= 1)
#pragma unroll
            for (int i = 0; i < N; ++i) { const int l = i ^ j; if (l > i) { if ((i & k) == 0) ce_desc(v[i], v[l]); else ce_desc(v[l], v[i]); } }
}
template <int N> __device__ __forceinline__ void bitonic_merge_desc(float (&v)[N]) {
#pragma unroll
    for (int j = N >> 1; j > 0; j >>= 1)
#pragma unroll
        for (int i = 0; i < N; ++i) { const int l = i ^ j; if (l > i) ce_desc(v[i], v[l]); }
}
__device__ __forceinline__ void merge_top16(float (&a)[16], const float (&b)[16]) {
#pragma unroll
    for (int i = 0; i < 16; ++i) a[i] = vmaxf(a[i], b[15 - i]);
    bitonic_merge_desc<16>(a);
}
constexpr int TK_ROW = 68;
__device__ __forceinline__ void ph_topk(unsigned char* lds_, const short* scores, int* eid, float* gw, int* offs, const int task) {
    const int tid = opq_tid(), lane = tid & 63, wv = __builtin_amdgcn_readfirstlane(tid >> 6);
    LAS float* stg = (LAS float*)lds_ + wv * (64 * TK_ROW);
    {
        const short* base = scores + (size_t)task * 64 * 256;
        float top[2][16];
        u32x2 pre[16];
#pragma unroll
        for (int i = 0; i < 16; ++i) pre[i] = *(const u32x2*)(base + (size_t)(4 * i + (lane >> 4)) * 256 + (lane & 15) * 4);
#pragma unroll
        for (int p = 0; p < 2; ++p) {
#pragma unroll
            for (int rd = 0; rd < 2; ++rd) {
#pragma unroll
                for (int i = 0; i < 16; ++i) { const int jj = 4 * i + (lane >> 4);
                    const u32x2 w = pre[i];
                    const f32x4 v = (f32x4){(float)(short)(w.x & 0xffffu), (float)((int)w.x >> 16), (float)(short)(w.y & 0xffffu), (float)((int)w.y >> 16)} * (1.f / 2048.f);
                    *(LAS f32x4*)(stg + jj * TK_ROW + (lane & 15) * 4) = v; }
                if (p * 2 + rd < 3) { const int qn = p * 2 + rd + 1;
#pragma unroll
                    for (int i = 0; i < 16; ++i) pre[i] = *(const u32x2*)(base + (size_t)(4 * i + (lane >> 4)) * 256 + (qn >> 1) * 128 + (qn & 1) * 64 + (lane & 15) * 4); }
                float blk[4][16];
#pragma unroll
                for (int g = 0; g < 4; ++g)
#pragma unroll
                    for (int c = 0; c < 4; ++c) { const f32x4 v = *(const LAS f32x4*)(stg + lane * TK_ROW + g * 16 + c * 4);
#pragma unroll
                        for (int e = 0; e < 4; ++e) { const unsigned idx = rd * 64 + g * 16 + c * 4 + e; blk[g][c * 4 + e] = __uint_as_float((__float_as_uint(v[e]) & ~127u) | idx); } }
#pragma unroll
                for (int g = 0; g < 4; ++g) bitonic_sort_desc<16>(blk[g]);
                merge_top16(blk[0], blk[1]); merge_top16(blk[2], blk[3]); merge_top16(blk[0], blk[2]);
                if (rd == 0) {
#pragma unroll
                    for (int e = 0; e < 16; ++e) top[p][e] = blk[0][e];
                } else merge_top16(top[p], blk[0]);
            }
        }
        LAS unsigned* tab = (LAS unsigned*)(stg + lane * TK_ROW);
#pragma unroll
        for (int p = 0; p < 2; ++p)
#pragma unroll
            for (int q = 0; q < 4; ++q) { unsigned w = 0;
#pragma unroll
                for (int e = 0; e < 4; ++e) w |= (__float_as_uint(top[p][4 * q + e]) & 127u) << (8 * e);
                tab[p * 4 + q] = w; }
#define CAND(i, j) __uint_as_float((__float_as_uint(top[0][i] + top[1][j]) & ~255u) | (unsigned)((i) * 16 + (j)))
        float A[16], Bv[16], C[16], Dv[16];
#pragma unroll
        for (int j = 0; j < 16; ++j) A[j] = CAND(0, j);
#pragma unroll
        for (int i = 1; i < 16; ++i) Bv[i - 1] = CAND(i, 0);
        Bv[15] = -INFINITY;
#pragma unroll
        for (int j = 1; j < 8; ++j) Dv[j - 1] = CAND(1, j);
#pragma unroll
        for (int j = 7; j < 16; ++j) Dv[j] = -INFINITY;
        C[0] = CAND(2, 1); C[1] = CAND(2, 2); C[2] = CAND(2, 3); C[3] = CAND(2, 4); C[4] = CAND(3, 1); C[5] = CAND(3, 2); C[6] = CAND(3, 3); C[7] = CAND(4, 1); C[8] = CAND(4, 2);
        C[9] = CAND(5, 1); C[10] = CAND(6, 1); C[11] = CAND(7, 1); C[12] = -INFINITY; C[13] = -INFINITY; C[14] = -INFINITY; C[15] = -INFINITY;
#undef CAND
        bitonic_sort_desc<16>(C);
        merge_top16(A, Bv); merge_top16(C, Dv); merge_top16(A, C);
        float g[16]; int ex[16]; float sum = 0.f; const float mx = __uint_as_float(__float_as_uint(A[0]) & ~255u);
#pragma unroll
        for (int e = 0; e < 16; ++e) { const unsigned bits = __float_as_uint(A[e]); const unsigned id = bits & 255u;
            g[e] = __expf(__uint_as_float(bits & ~255u) - mx); sum += g[e];
            const unsigned i0 = ((const LAS unsigned char*)tab)[id >> 4], i1 = ((const LAS unsigned char*)tab)[16 + (id & 15)];
            ex[e] = (int)(i0 * NKEY + i1); }
        const float rs = 1.f / sum;
        LAS unsigned* si = (LAS unsigned*)stg; LAS float* sf = stg + 1024;
        { const int sb = (lane >> 3) * 128 + (lane & 7) * 16;
#pragma unroll
          for (int q = 0; q < 4; ++q) { *(LAS u32x4*)(si + sb + 4 * q) = (u32x4){(unsigned)ex[4 * q], (unsigned)ex[4 * q + 1], (unsigned)ex[4 * q + 2], (unsigned)ex[4 * q + 3]};
              *(LAS f32x4*)(sf + sb + 4 * q) = (f32x4){g[4 * q] * rs, g[4 * q + 1] * rs, g[4 * q + 2] * rs, g[4 * q + 3] * rs}; } }
#pragma unroll 1
        for (int j = 0; j < 8; ++j) {
            const unsigned e0 = si[j * 128 + lane], e1 = si[j * 128 + 64 + lane]; const float g0 = sf[j * 128 + lane], g1 = sf[j * 128 + 64 + lane];
            const unsigned k0 = e0 >> 11, k1 = e1 >> 11; int pos0 = 0, pos1 = 0, offq = 0, offv = 0;
#pragma unroll
            for (int q = 0; q < 8; ++q) {
                const unsigned long long m0 = __builtin_amdgcn_ballot_w64(k0 == (unsigned)q), m1 = __builtin_amdgcn_ballot_w64(k1 == (unsigned)q);
                const int c0 = __builtin_popcountll(m0), c1 = __builtin_popcountll(m1);
                const int r0 = __builtin_amdgcn_mbcnt_hi((unsigned)(m0 >> 32), __builtin_amdgcn_mbcnt_lo((unsigned)m0, 0)), r1 = __builtin_amdgcn_mbcnt_hi((unsigned)(m1 >> 32), __builtin_amdgcn_mbcnt_lo((unsigned)m1, 0));
                if (k0 == (unsigned)q) pos0 = offq + r0;
                if (k1 == (unsigned)q) pos1 = offq + c0 + r1;
                offq += c0 + c1; if (lane == q + 1) offv = offq;
            }
            const size_t tb = ((size_t)task * 8 + j) * NSLOT;
            eid[tb + pos0] = (int)e0; eid[tb + pos1] = (int)e1; gw[tb + pos0] = g0; gw[tb + pos1] = g1;
            if (lane < 16) offs[((size_t)task * 8 + j) * 16 + lane] = (lane <= 8) ? offv : NSLOT;
        }
    }
}

typedef __bf16 bf16x2v __attribute__((ext_vector_type(2)));
__device__ __forceinline__ float dot2bf(unsigned a, unsigned b, float c) { return __builtin_amdgcn_fdot2_f32_bf16(__builtin_bit_cast(bf16x2v, a), __builtin_bit_cast(bf16x2v, b), c, false); }
__device__ __forceinline__ float dot8(u32x4 a, u32x4 b, float c) { c = dot2bf(a.x, b.x, c); c = dot2bf(a.y, b.y, c); c = dot2bf(a.z, b.z, c); return dot2bf(a.w, b.w, c); }
__device__ __forceinline__ void ph_peer_u2(const bf16_t* hn, const bf16_t* Ub, const int* eid, const float* gw, float* wact) {
    const int tid = opq_tid(), lane = tid & 63, wv = __builtin_amdgcn_readfirstlane(tid >> 6); const unsigned voff = (unsigned)lane * 16u;
    for (int t = blockIdx.x * NWAVE + wv; t < T; t += gridDim.x * NWAVE) {
        const u32x4 h0 = *(const u32x4*)(hn + (size_t)t * DM + lane * 8), h1 = *(const u32x4*)(hn + (size_t)t * DM + 512 + lane * 8);
        const int e_lo = eid[(size_t)t * NSLOT + lane], e_hi = eid[(size_t)t * NSLOT + 64 + lane];
        u32x4 bufA[16], bufB[16];
#define U_ISSUE(buf, st) do { unsigned vo = voff; asm("" : "+v"(vo)); _Pragma("unroll") for (int k = 0; k < 8; ++k) { const int sl = (st) * 8 + k; const int e = __builtin_amdgcn_readlane((sl < 64) ? e_lo : e_hi, sl & 63); \
            const GAS char* row = (const GAS char*)Ub + (size_t)e * (DM * 2); asm("" : "+s"(row)); buf[2 * k] = *(const GAS u32x4*)(row + vo); buf[2 * k + 1] = *(const GAS u32x4*)(row + 1024 + vo); } } while (0)
#define U_DOT(buf, dst, off) do { _Pragma("unroll") for (int k = 0; k < 8; ++k) dst[(off) + k] = dot8(buf[2 * k + 1], h1, dot8(buf[2 * k], h0, 0.f)); } while (0)
#define U_REDUCE(hh_) do { float r8[8], r4[4], r2[2], r1; \
            _Pragma("unroll") for (int k = 0; k < 8; ++k) { const bool up = lane & 32; const float keep = up ? part[k + 8] : part[k], send = up ? part[k] : part[k + 8]; r8[k] = keep + __shfl_xor(send, 32); } \
            _Pragma("unroll") for (int k = 0; k < 4; ++k) { const bool up = lane & 16; const float keep = up ? r8[k + 4] : r8[k], send = up ? r8[k] : r8[k + 4]; r4[k] = keep + __shfl_xor(send, 16); } \
            _Pragma("unroll") for (int k = 0; k < 2; ++k) { const bool up = lane & 8; const float keep = up ? r4[k + 2] : r4[k], send = up ? r4[k] : r4[k + 2]; r2[k] = keep + __shfl_xor(send, 8); } \
            { const bool up = lane & 4; const float keep = up ? r2[1] : r2[0], send = up ? r2[0] : r2[1]; r1 = keep + __shfl_xor(send, 4); } \
            r1 += __shfl_xor(r1, 2); r1 += __shfl_xor(r1, 1); \
            if ((lane & 3) == 0) { const int s = (hh_) * 16 + (lane >> 2); wact[(size_t)t * NSLOT + s] = gw[(size_t)t * NSLOT + s] * gelu_tanh(r1); } } while (0)
        U_ISSUE(bufA, 0); U_ISSUE(bufB, 1);
#pragma unroll 1
        for (int hh = 0; hh < PH - 1; ++hh) {
            float part[16];
            U_DOT(bufA, part, 0); U_ISSUE(bufA, 2 * hh + 2);
            U_DOT(bufB, part, 8); U_ISSUE(bufB, 2 * hh + 3);
            U_REDUCE(hh);
        }
        { float part[16]; U_DOT(bufA, part, 0); U_DOT(bufB, part, 8); U_REDUCE(PH - 1); }
#undef U_REDUCE
#undef U_ISSUE
#undef U_DOT
    }
}
__device__ __forceinline__ void ph_peer_v2(float* xres, const bf16_t* Vb, const int* eid, const float* wact, const float* gn, bf16_t* hout, int last) {
    const int tid = opq_tid(), lane = tid & 63, wv = __builtin_amdgcn_readfirstlane(tid >> 6); const unsigned voff = (unsigned)lane * 16u;
    for (int t = blockIdx.x * NWAVE + wv; t < T; t += gridDim.x * NWAVE) {
        const int e_lo = eid[(size_t)t * NSLOT + lane], e_hi = eid[(size_t)t * NSLOT + 64 + lane];
        const float w_lo = wact[(size_t)t * NSLOT + lane], w_hi = wact[(size_t)t * NSLOT + 64 + lane];
        float acc[16];
#pragma unroll
        for (int i = 0; i < 16; ++i) acc[i] = 0.f;
        u32x4 bufA[16], bufB[16];
#define V_ISSUE(buf, st) do { unsigned vo = voff; asm("" : "+v"(vo)); _Pragma("unroll") for (int k = 0; k < 8; ++k) { const int sl = (st) * 8 + k; const int e = __builtin_amdgcn_readlane((sl < 64) ? e_lo : e_hi, sl & 63); \
            const GAS char* row = (const GAS char*)Vb + (size_t)e * (DM * 2); asm("" : "+s"(row)); buf[2 * k] = *(const GAS u32x4*)(row + vo); buf[2 * k + 1] = *(const GAS u32x4*)(row + 1024 + vo); } } while (0)
#define V_ACC(buf, st) do { _Pragma("unroll") for (int k = 0; k < 8; ++k) { const int sl = (st) * 8 + k; const float w = __builtin_bit_cast(float, __builtin_amdgcn_readlane(__builtin_bit_cast(int, (sl < 64) ? w_lo : w_hi), sl & 63)); \
            const u32x4 a = buf[2 * k], b = buf[2 * k + 1]; \
            acc[0] += w * lo16(a.x); acc[1] += w * hi16(a.x); acc[2] += w * lo16(a.y); acc[3] += w * hi16(a.y); acc[4] += w * lo16(a.z); acc[5] += w * hi16(a.z); acc[6] += w * lo16(a.w); acc[7] += w * hi16(a.w); \
            acc[8] += w * lo16(b.x); acc[9] += w * hi16(b.x); acc[10] += w * lo16(b.y); acc[11] += w * hi16(b.y); acc[12] += w * lo16(b.z); acc[13] += w * hi16(b.z); acc[14] += w * lo16(b.w); acc[15] += w * hi16(b.w); } } while (0)
        V_ISSUE(bufA, 0); V_ISSUE(bufB, 1);
#pragma unroll 1
        for (int st = 0; st < 14; st += 2) {
            V_ACC(bufA, st); V_ISSUE(bufA, st + 2);
            V_ACC(bufB, st + 1); V_ISSUE(bufB, st + 3);
        }
        V_ACC(bufA, 14); V_ACC(bufB, 15);
#undef V_ISSUE
#undef V_ACC
        float* xr = xres + (size_t)t * DM; float ss = 0.f;
#pragma unroll
        for (int hf = 0; hf < 2; ++hf)
#pragma unroll
            for (int j = 0; j < 2; ++j) { const f32x4 xv = *(const f32x4*)(xr + hf * 512 + lane * 8 + j * 4);
                acc[hf * 8 + j * 4 + 0] += xv.x; acc[hf * 8 + j * 4 + 1] += xv.y; acc[hf * 8 + j * 4 + 2] += xv.z; acc[hf * 8 + j * 4 + 3] += xv.w; }
#pragma unroll
        for (int i = 0; i < 16; ++i) ss += acc[i] * acc[i];
        const float rstd = rsqrtf(wave_sum(ss) * (1.f / DM) + EPS);
#pragma unroll
        for (int hf = 0; hf < 2; ++hf)
#pragma unroll
            for (int j = 0; j < 2; ++j) { const int c = hf * 512 + lane * 8 + j * 4; const f32x4 g = *(const f32x4*)(gn + c); const int a0 = hf * 8 + j * 4;
                if (last) { *(f32x4*)(xr + c) = (f32x4){acc[a0] * rstd * g.x, acc[a0 + 1] * rstd * g.y, acc[a0 + 2] * rstd * g.z, acc[a0 + 3] * rstd * g.w}; }
                else { *(f32x4*)(xr + c) = (f32x4){acc[a0], acc[a0 + 1], acc[a0 + 2], acc[a0 + 3]};
                    u32x2 ob; ob.x = pk2(acc[a0] * rstd * g.x, acc[a0 + 1] * rstd * g.y); ob.y = pk2(acc[a0 + 2] * rstd * g.z, acc[a0 + 3] * rstd * g.w); *(u32x2*)(hout + (size_t)t * DM + c) = ob; } }
    }
}


constexpr size_t WS_KM = WS_VB + 40 * MiB;
constexpr size_t WS_XB = WS_VB + 4 * MiB;
constexpr size_t WS_UQ = WS_UB, WS_VQ = WS_UB + 32 * MiB, WS_SU = WS_VB, WS_SV = WS_VB + 1 * MiB, WS_HQ = WS_VB + 2 * MiB, WS_SH = WS_VB + 18 * MiB;
__device__ __forceinline__ float ub0(unsigned x) { float f; asm("v_cvt_f32_ubyte0 %0, %1" : "=v"(f) : "v"(x)); return f; }
__device__ __forceinline__ float ub1(unsigned x) { float f; asm("v_cvt_f32_ubyte1 %0, %1" : "=v"(f) : "v"(x)); return f; }
__device__ __forceinline__ float ub2(unsigned x) { float f; asm("v_cvt_f32_ubyte2 %0, %1" : "=v"(f) : "v"(x)); return f; }
__device__ __forceinline__ float ub3(unsigned x) { float f; asm("v_cvt_f32_ubyte3 %0, %1" : "=v"(f) : "v"(x)); return f; }
__device__ __forceinline__ unsigned q8(float v, float inv, int offs) { return (unsigned)((int)__builtin_rintf(v * inv) + offs) & 255u; }
__device__ __forceinline__ void ph_quant_rows_w(const float* src, unsigned char* dst, float* scale, int nrows, int offs, int widx, int nw) {
    const int tid_ = opq_tid(); const int lane = tid_ & 63;
    for (int row0 = widx * 4; row0 < nrows; row0 += nw * 4) {
        f32x4 v[4][4]; float am[4];
#pragma unroll
        for (int r = 0; r < 4; ++r) { const f32x4* s4 = (const f32x4*)(src + (size_t)(row0 + r) * DM);
#pragma unroll
            for (int j = 0; j < 4; ++j) v[r][j] = s4[lane + 64 * j]; }
#pragma unroll
        for (int r = 0; r < 4; ++r) { float a = 0.f;
#pragma unroll
            for (int j = 0; j < 4; ++j) a = fmaxf(a, fmaxf(fmaxf(fabsf(v[r][j].x), fabsf(v[r][j].y)), fmaxf(fabsf(v[r][j].z), fabsf(v[r][j].w))));
            am[r] = wave_max(a); }
#pragma unroll
        for (int r = 0; r < 4; ++r) { const float inv = am[r] > 0.f ? 127.f / am[r] : 0.f;
#pragma unroll
            for (int j = 0; j < 4; ++j) ((unsigned*)(dst + (size_t)(row0 + r) * DM))[lane + 64 * j] = q8(v[r][j].x, inv, offs) | (q8(v[r][j].y, inv, offs) << 8) | (q8(v[r][j].z, inv, offs) << 16) | (q8(v[r][j].w, inv, offs) << 24);
            if (lane == 0) scale[row0 + r] = am[r] > 0.f ? am[r] * (1.f / 127.f) : 1.f; }
    }
}
__device__ __forceinline__ void ph_quant_rows(const float* src, unsigned char* dst, float* scale, int nrows, int offs) {
    const int wv = __builtin_amdgcn_readfirstlane((int)(threadIdx.x >> 6)); ph_quant_rows_w(src, dst, scale, nrows, offs, blockIdx.x * NWAVE + wv, gridDim.x * NWAVE);
}
__device__ __forceinline__ void ph_rmsnorm_q(const float* x, const float* g, bf16_t* out, unsigned char* hq, float* sh) {
    const int tid_ = opq_tid(); const int lane = tid_ & 63, wv = tid_ >> 6;
    for (int it = blockIdx.x; it < T / NWAVE; it += gridDim.x) {
        const int row = it * NWAVE + wv; const f32x4* xr = (const f32x4*)(x + (size_t)row * DM); f32x4 v[4]; float s = 0.f;
#pragma unroll
        for (int j = 0; j < 4; ++j) { v[j] = xr[lane + 64 * j]; s += v[j].x * v[j].x + v[j].y * v[j].y + v[j].z * v[j].z + v[j].w * v[j].w; }
        const float rstd = rsqrtf(wave_sum(s) * (1.f / DM) + EPS); float am = 0.f;
#pragma unroll
        for (int j = 0; j < 4; ++j) { const f32x4 gg = ((const f32x4*)g)[lane + 64 * j]; v[j] = v[j] * rstd * gg; am = fmaxf(am, fmaxf(fmaxf(fabsf(v[j].x), fabsf(v[j].y)), fmaxf(fabsf(v[j].z), fabsf(v[j].w))));
            u32x2 o; o.x = pk2(v[j].x, v[j].y); o.y = pk2(v[j].z, v[j].w); ((u32x2*)(out + (size_t)row * DM))[lane + 64 * j] = o; }
        am = wave_max(am); const float inv = am > 0.f ? 127.f / am : 0.f;
#pragma unroll
        for (int j = 0; j < 4; ++j) ((unsigned*)(hq + (size_t)row * DM))[lane + 64 * j] = q8(v[j].x, inv, 0) | (q8(v[j].y, inv, 0) << 8) | (q8(v[j].z, inv, 0) << 16) | (q8(v[j].w, inv, 0) << 24);
        if (lane == 0) sh[row] = am > 0.f ? am * (1.f / 127.f) : 1.f;
    }
}
__device__ __forceinline__ int dot16i(u32x4 a, u32x4 b) { int c = __builtin_amdgcn_sdot4((int)a.x, (int)b.x, 0, false); c = __builtin_amdgcn_sdot4((int)a.y, (int)b.y, c, false); c = __builtin_amdgcn_sdot4((int)a.z, (int)b.z, c, false); return __builtin_amdgcn_sdot4((int)a.w, (int)b.w, c, false); }
template <int EMASK> __device__ __forceinline__ void ph_peer_u3(const unsigned char* hq, const float* sh, const unsigned char* Uq, const float* su, const int* eid, const float* gw, float* wact) {
    const int tid = opq_tid(), lane = tid & 63, wv = __builtin_amdgcn_readfirstlane(tid >> 6); const unsigned voff = (unsigned)lane * 16u;
    for (int t = blockIdx.x * NWAVE + wv; t < T; t += gridDim.x * NWAVE) {
        const u32x4 h4 = *(const u32x4*)(hq + (size_t)t * DM + lane * 16);
        const int e_lo = eid[(size_t)t * NSLOT + lane], e_hi = eid[(size_t)t * NSLOT + 64 + lane];
        const float sht = sh[t];
        const float g_lo = gw[(size_t)t * NSLOT + lane], g_hi = gw[(size_t)t * NSLOT + 64 + lane];
        const float sc_lo = su[e_lo] * sht, sc_hi = su[e_hi] * sht;
        u32x4 bufA[16], bufB[16];
#define U_ISSUE(buf, hh_) do { unsigned vo = voff; asm("" : "+v"(vo)); _Pragma("unroll") for (int k = 0; k < 16; ++k) { const int sl = (hh_) * 16 + k; const int e = __builtin_amdgcn_readlane((sl < 64) ? e_lo : e_hi, sl & 63) & EMASK; \
            const GAS char* row = (const GAS char*)Uq + (size_t)e * DM; asm("" : "+s"(row)); buf[k] = *(const GAS u32x4*)(row + vo); } } while (0)
#define U_HEAD(buf, hh_) do { float part[16]; _Pragma("unroll") for (int k = 0; k < 16; ++k) part[k] = (float)dot16i(buf[k], h4); \
            float r8[8], r4[4], r2[2], r1; \
            _Pragma("unroll") for (int k = 0; k < 8; ++k) { const bool up = lane & 32; const float keep = up ? part[k + 8] : part[k], send = up ? part[k] : part[k + 8]; r8[k] = keep + __shfl_xor(send, 32); } \
            _Pragma("unroll") for (int k = 0; k < 4; ++k) { const bool up = lane & 16; const float keep = up ? r8[k + 4] : r8[k], send = up ? r8[k] : r8[k + 4]; r4[k] = keep + __shfl_xor(send, 16); } \
            _Pragma("unroll") for (int k = 0; k < 2; ++k) { const bool up = lane & 8; const float keep = up ? r4[k + 2] : r4[k], send = up ? r4[k] : r4[k + 2]; r2[k] = keep + __shfl_xor(send, 8); } \
            { const bool up = lane & 4; const float keep = up ? r2[1] : r2[0], send = up ? r2[0] : r2[1]; r1 = keep + __shfl_xor(send, 4); } \
            r1 += __shfl_xor(r1, 2); r1 += __shfl_xor(r1, 1); \
            const int sl_ = ((hh_) & 3) * 16 + (lane >> 2); const float scl = __shfl(((hh_) < 4) ? sc_lo : sc_hi, sl_), gg = __shfl(((hh_) < 4) ? g_lo : g_hi, sl_); \
            if ((lane & 3) == 0) wact[(size_t)t * NSLOT + (hh_) * 16 + (lane >> 2)] = gg * gelu_tanh(r1 * scl); } while (0)
        U_ISSUE(bufA, 0); U_ISSUE(bufB, 1);
#pragma unroll 1
        for (int hp = 0; hp < 3; ++hp) {
            U_HEAD(bufA, 2 * hp); U_ISSUE(bufA, 2 * hp + 2);
            U_HEAD(bufB, 2 * hp + 1); U_ISSUE(bufB, 2 * hp + 3);
        }
        U_HEAD(bufA, 6); U_HEAD(bufB, 7);
#undef U_ISSUE
#undef U_HEAD
    }
}
__device__ __forceinline__ void ph_peer_v3(float* xres, const unsigned char* Vq, const float* sv, const int* eid, const float* wact, const float* gn, bf16_t* hout, int last) {
    const int tid = opq_tid(), lane = tid & 63, wv = __builtin_amdgcn_readfirstlane(tid >> 6); const unsigned voff = (unsigned)lane * 16u;
    for (int t = blockIdx.x * NWAVE + wv; t < T; t += gridDim.x * NWAVE) {
        const int e_lo = eid[(size_t)t * NSLOT + lane], e_hi = eid[(size_t)t * NSLOT + 64 + lane];
        const float c_lo = wact[(size_t)t * NSLOT + lane] * sv[e_lo], c_hi = wact[(size_t)t * NSLOT + 64 + lane] * sv[e_hi];
        float acc[16]; float corr = 0.f;
#pragma unroll
        for (int i = 0; i < 16; ++i) acc[i] = 0.f;
        u32x4 bufA[8], bufB[8];
#define V_ISSUE(buf, st_) do { unsigned vo = voff; asm("" : "+v"(vo)); _Pragma("unroll") for (int k = 0; k < 8; ++k) { const int sl = (st_) * 8 + k; const int e = __builtin_amdgcn_readlane((sl < 64) ? e_lo : e_hi, sl & 63); \
            const GAS char* row = (const GAS char*)Vq + (size_t)e * DM; asm("" : "+s"(row)); buf[k] = *(const GAS u32x4*)(row + vo); } } while (0)
#define V_ACC(buf, st_) do { _Pragma("unroll") for (int k = 0; k < 8; ++k) { const int sl = (st_) * 8 + k; const float w = __builtin_bit_cast(float, __builtin_amdgcn_readlane(__builtin_bit_cast(int, (sl < 64) ? c_lo : c_hi), sl & 63)); \
            const u32x4 a = buf[k]; corr += w; \
            acc[0] += w * ub0(a.x); acc[1] += w * ub1(a.x); acc[2] += w * ub2(a.x); acc[3] += w * ub3(a.x); acc[4] += w * ub0(a.y); acc[5] += w * ub1(a.y); acc[6] += w * ub2(a.y); acc[7] += w * ub3(a.y); \
            acc[8] += w * ub0(a.z); acc[9] += w * ub1(a.z); acc[10] += w * ub2(a.z); acc[11] += w * ub3(a.z); acc[12] += w * ub0(a.w); acc[13] += w * ub1(a.w); acc[14] += w * ub2(a.w); acc[15] += w * ub3(a.w); } } while (0)
        V_ISSUE(bufA, 0); V_ISSUE(bufB, 1);
#pragma unroll 1
        for (int st = 0; st < 14; st += 2) {
            V_ACC(bufA, st); V_ISSUE(bufA, st + 2);
            V_ACC(bufB, st + 1); V_ISSUE(bufB, st + 3);
        }
        V_ACC(bufA, 14); V_ACC(bufB, 15);
#undef V_ISSUE
#undef V_ACC
        float* xr = xres + (size_t)t * DM + lane * 16; float ss = 0.f; const float c128 = 128.f * corr;
#pragma unroll
        for (int j = 0; j < 4; ++j) { const f32x4 xv = *(const f32x4*)(xr + j * 4);
            acc[j * 4 + 0] += xv.x - c128; acc[j * 4 + 1] += xv.y - c128; acc[j * 4 + 2] += xv.z - c128; acc[j * 4 + 3] += xv.w - c128; }
#pragma unroll
        for (int i = 0; i < 16; ++i) ss += acc[i] * acc[i];
        const float rstd = rsqrtf(wave_sum(ss) * (1.f / DM) + EPS);
#pragma unroll
        for (int j = 0; j < 4; ++j) { const int c = lane * 16 + j * 4; const f32x4 g = *(const f32x4*)(gn + c); const int a0 = j * 4;
            if (last) { *(f32x4*)(xr + j * 4) = (f32x4){acc[a0] * rstd * g.x, acc[a0 + 1] * rstd * g.y, acc[a0 + 2] * rstd * g.z, acc[a0 + 3] * rstd * g.w}; }
            else { *(f32x4*)(xr + j * 4) = (f32x4){acc[a0], acc[a0 + 1], acc[a0 + 2], acc[a0 + 3]};
                u32x2 ob; ob.x = pk2(acc[a0] * rstd * g.x, acc[a0 + 1] * rstd * g.y); ob.y = pk2(acc[a0 + 2] * rstd * g.z, acc[a0 + 3] * rstd * g.w); *(u32x2*)(hout + (size_t)t * DM + c) = ob; } }
    }
}


__device__ __forceinline__ void ph_peer_v5(float* xres, const unsigned char* Vq, const float* sv, const int* eid, const float* wact, const float* gn, bf16_t* hout, int last) {
    const int tid = opq_tid(), lane = tid & 63, wv = __builtin_amdgcn_readfirstlane(tid >> 6); const unsigned voff = (unsigned)lane * 16u;
    for (int t = blockIdx.x * NWAVE + wv; t < T; t += gridDim.x * NWAVE) {
        const int e_lo = eid[(size_t)t * NSLOT + lane], e_hi = eid[(size_t)t * NSLOT + 64 + lane];
        const float c_lo = wact[(size_t)t * NSLOT + lane] * sv[e_lo], c_hi = wact[(size_t)t * NSLOT + 64 + lane] * sv[e_hi];
        float acc[16]; float corr = 0.f;
#pragma unroll
        for (int i = 0; i < 16; ++i) acc[i] = 0.f;
        u32x4 bufA[16], bufB[16];
#define V_ISSUE(buf, hh_) do { _Pragma("unroll") for (int k = 0; k < 16; ++k) { const int sl = (hh_) * 16 + k; const int e = __builtin_amdgcn_readlane((sl < 64) ? e_lo : e_hi, sl & 63); \
            const GAS char* row = (const GAS char*)Vq + (size_t)e * DM; asm("" : "+s"(row)); unsigned vo = voff; asm("" : "+v"(vo)); buf[k] = *(const GAS u32x4*)(row + vo); } } while (0)
#define V_ACC(buf, hh_) do { _Pragma("unroll") for (int k = 0; k < 16; ++k) { const int sl = (hh_) * 16 + k; const float w = __builtin_bit_cast(float, __builtin_amdgcn_readlane(__builtin_bit_cast(int, (sl < 64) ? c_lo : c_hi), sl & 63)); \
            const u32x4 a = buf[k]; corr += w; \
            acc[0] += w * ub0(a.x); acc[1] += w * ub1(a.x); acc[2] += w * ub2(a.x); acc[3] += w * ub3(a.x); acc[4] += w * ub0(a.y); acc[5] += w * ub1(a.y); acc[6] += w * ub2(a.y); acc[7] += w * ub3(a.y); \
            acc[8] += w * ub0(a.z); acc[9] += w * ub1(a.z); acc[10] += w * ub2(a.z); acc[11] += w * ub3(a.z); acc[12] += w * ub0(a.w); acc[13] += w * ub1(a.w); acc[14] += w * ub2(a.w); acc[15] += w * ub3(a.w); \
            __builtin_amdgcn_sched_barrier(0); } } while (0)
        V_ISSUE(bufA, 0); V_ISSUE(bufB, 1);
#pragma unroll 1
        for (int hp = 0; hp < 3; ++hp) {
            V_ACC(bufA, 2 * hp); V_ISSUE(bufA, 2 * hp + 2);
            V_ACC(bufB, 2 * hp + 1); V_ISSUE(bufB, 2 * hp + 3);
        }
        V_ACC(bufA, 6); V_ACC(bufB, 7);
#undef V_ISSUE
#undef V_ACC
        float* xr = xres + (size_t)t * DM + lane * 16; float ss = 0.f; const float c128 = 128.f * corr;
#pragma unroll
        for (int j = 0; j < 4; ++j) { const f32x4 xv = *(const f32x4*)(xr + j * 4);
            acc[j * 4 + 0] += xv.x - c128; acc[j * 4 + 1] += xv.y - c128; acc[j * 4 + 2] += xv.z - c128; acc[j * 4 + 3] += xv.w - c128; }
#pragma unroll
        for (int i = 0; i < 16; ++i) ss += acc[i] * acc[i];
        const float rstd = rsqrtf(wave_sum(ss) * (1.f / DM) + EPS);
#pragma unroll
        for (int j = 0; j < 4; ++j) { const int c = lane * 16 + j * 4; const f32x4 g = *(const f32x4*)(gn + c); const int a0 = j * 4;
            if (last) { *(f32x4*)(xr + j * 4) = (f32x4){acc[a0] * rstd * g.x, acc[a0 + 1] * rstd * g.y, acc[a0 + 2] * rstd * g.z, acc[a0 + 3] * rstd * g.w}; }
            else { *(f32x4*)(xr + j * 4) = (f32x4){acc[a0], acc[a0 + 1], acc[a0 + 2], acc[a0 + 3]};
                u32x2 ob; ob.x = pk2(acc[a0] * rstd * g.x, acc[a0 + 1] * rstd * g.y); ob.y = pk2(acc[a0 + 2] * rstd * g.z, acc[a0 + 3] * rstd * g.w); *(u32x2*)(hout + (size_t)t * DM + c) = ob; } }
    }
}


__device__ __forceinline__ void fma_ub4(float& a0, float& a1, float& a2, float& a3, unsigned a, float w) {
    float t0, t1;
    asm("v_cvt_f32_ubyte0 %4, %6\n\tv_cvt_f32_ubyte1 %5, %6\n\tv_fmac_f32 %0, %7, %4\n\tv_fmac_f32 %1, %7, %5\n\tv_cvt_f32_ubyte2 %4, %6\n\tv_cvt_f32_ubyte3 %5, %6\n\tv_fmac_f32 %2, %7, %4\n\tv_fmac_f32 %3, %7, %5"
        : "+v"(a0), "+v"(a1), "+v"(a2), "+v"(a3), "=&v"(t0), "=&v"(t1) : "v"(a), "s"(w));
}
__device__ __forceinline__ void ph_peer_v4(float* xres, const unsigned char* Vq, const float* sv, const int* eid, const float* wact, const float* gw, const float* su, const float* sh, const float* gn, bf16_t* hout, int last) {
    const int tid = opq_tid(), lane = tid & 63, wv = __builtin_amdgcn_readfirstlane(tid >> 6); const unsigned voff = (unsigned)lane * 16u;
    const int tstride = gridDim.x * NWAVE;
    int t = blockIdx.x * NWAVE + wv;
    const int ntok = (T - t + tstride - 1) / tstride;
    int tn = (t + tstride < T) ? t + tstride : t;
    int e_lo = eid[(size_t)t * NSLOT + lane], e_hi = eid[(size_t)t * NSLOT + 64 + lane];
    float c_lo, c_hi;
    { const float sht = sh[t]; c_lo = gw[(size_t)t * NSLOT + lane] * gelu_tanh(wact[(size_t)t * NSLOT + lane] * su[e_lo] * sht) * sv[e_lo];
      c_hi = gw[(size_t)t * NSLOT + 64 + lane] * gelu_tanh(wact[(size_t)t * NSLOT + 64 + lane] * su[e_hi] * sht) * sv[e_hi]; }
    u32x4 ring[32];
#define V_LOAD(slot, esrc, ln) do { const int e = __builtin_amdgcn_readlane(esrc, ln); const GAS char* row = (const GAS char*)Vq + (size_t)e * DM; asm("" : "+s"(row)); \
        unsigned vo = voff; asm("" : "+v"(vo)); ring[slot] = *(const GAS u32x4*)(row + vo); } while (0)
#pragma unroll
    for (int k = 0; k < 32; ++k) V_LOAD(k, e_lo, k);
    f32x4 xv[4];
#pragma unroll
    for (int j = 0; j < 4; ++j) xv[j] = *(const f32x4*)(xres + (size_t)t * DM + lane * 16 + j * 4);
    int ne_lo = eid[(size_t)tn * NSLOT + lane], ne_hi = eid[(size_t)tn * NSLOT + 64 + lane];
    float nw_lo = wact[(size_t)tn * NSLOT + lane], nw_hi = wact[(size_t)tn * NSLOT + 64 + lane], ng_lo = gw[(size_t)tn * NSLOT + lane], ng_hi = gw[(size_t)tn * NSLOT + 64 + lane], nsh = sh[tn];
    float nc_lo = 0.f, nc_hi = 0.f;
    float acc[16]; float corr = 0.f;
#pragma unroll
    for (int i = 0; i < 16; ++i) acc[i] = 0.f;
#pragma unroll 1
    for (int q = 0; q < 4 * ntok; ++q) {
        const int rr = q & 3;
        const int csrc = __builtin_bit_cast(int, (rr < 2) ? c_lo : c_hi), cbase = (rr & 1) * 32;
        const int esrc = (rr == 0) ? e_lo : ((rr < 3) ? e_hi : ne_lo), ebase = (rr & 1) ? 0 : 32;
        if (rr == 2) { nc_lo = ng_lo * gelu_tanh(nw_lo * su[ne_lo] * nsh) * sv[ne_lo]; nc_hi = ng_hi * gelu_tanh(nw_hi * su[ne_hi] * nsh) * sv[ne_hi]; }
#pragma unroll
        for (int k = 0; k < 32; ++k) {
            const float w = __builtin_bit_cast(float, __builtin_amdgcn_readlane(csrc, cbase + k));
            const u32x4 a = ring[k]; corr += w;
            fma_ub4(acc[0], acc[1], acc[2], acc[3], a.x, w); fma_ub4(acc[4], acc[5], acc[6], acc[7], a.y, w); fma_ub4(acc[8], acc[9], acc[10], acc[11], a.z, w); fma_ub4(acc[12], acc[13], acc[14], acc[15], a.w, w);
            V_LOAD(k, esrc, ebase + k);
        }
        if (rr == 3) {
            float* xr = xres + (size_t)t * DM + lane * 16;
            float ss = 0.f; const float c128 = 128.f * corr;
#pragma unroll
            for (int j = 0; j < 4; ++j) { acc[j * 4 + 0] += xv[j].x - c128; acc[j * 4 + 1] += xv[j].y - c128; acc[j * 4 + 2] += xv[j].z - c128; acc[j * 4 + 3] += xv[j].w - c128; }
#pragma unroll
            for (int i = 0; i < 16; ++i) ss += acc[i] * acc[i];
            const float rstd = rsqrtf(wave_sum(ss) * (1.f / DM) + EPS);
#pragma unroll
            for (int j = 0; j < 4; ++j) { const int c = lane * 16 + j * 4; const f32x4 g = *(const f32x4*)(gn + c); const int a0 = j * 4;
                if (last) { *(f32x4*)(xr + j * 4) = (f32x4){acc[a0] * rstd * g.x, acc[a0 + 1] * rstd * g.y, acc[a0 + 2] * rstd * g.z, acc[a0 + 3] * rstd * g.w}; }
                else { *(f32x4*)(xr + j * 4) = (f32x4){acc[a0], acc[a0 + 1], acc[a0 + 2], acc[a0 + 3]};
                    u32x2 ob; ob.x = pk2(acc[a0] * rstd * g.x, acc[a0 + 1] * rstd * g.y); ob.y = pk2(acc[a0 + 2] * rstd * g.z, acc[a0 + 3] * rstd * g.w); *(u32x2*)(hout + (size_t)t * DM + c) = ob; } }
            t = tn; tn = (t + tstride < T) ? t + tstride : t;
            e_lo = ne_lo; e_hi = ne_hi; c_lo = nc_lo; c_hi = nc_hi; corr = 0.f;
#pragma unroll
            for (int i = 0; i < 16; ++i) acc[i] = 0.f;
#pragma unroll
            for (int j = 0; j < 4; ++j) xv[j] = *(const f32x4*)(xres + (size_t)t * DM + lane * 16 + j * 4);
            ne_lo = eid[(size_t)tn * NSLOT + lane]; ne_hi = eid[(size_t)tn * NSLOT + 64 + lane];
            nw_lo = wact[(size_t)tn * NSLOT + lane]; nw_hi = wact[(size_t)tn * NSLOT + 64 + lane]; ng_lo = gw[(size_t)tn * NSLOT + lane]; ng_hi = gw[(size_t)tn * NSLOT + 64 + lane]; nsh = sh[tn];
        }
    }
#undef V_LOAD
}


__device__ __forceinline__ void ph_peer_u5(const unsigned char* hq, const float* sh, const unsigned char* Uq, const float* su, const int* eid, const float* gw, const int* offs, float* wact) {
    const int tid = opq_tid(), lane = tid & 63, wv = __builtin_amdgcn_readfirstlane(tid >> 6); const unsigned voff = (unsigned)lane * 16u;
    for (int task = blockIdx.x * NWAVE + wv; task < T / 8; task += gridDim.x * NWAVE) {
        int es_lo[8], es_hi[8], offv[8]; float g_lo[8], g_hi[8], sc_lo[8], sc_hi[8]; u32x4 h4[8];
#pragma unroll
        for (int j = 0; j < 8; ++j) { const size_t t = (size_t)task * 8 + j;
            es_lo[j] = eid[t * NSLOT + lane]; es_hi[j] = eid[t * NSLOT + 64 + lane]; g_lo[j] = gw[t * NSLOT + lane]; g_hi[j] = gw[t * NSLOT + 64 + lane];
            h4[j] = *(const u32x4*)(hq + t * DM + lane * 16); offv[j] = offs[t * 16 + (lane & 15)]; }
#pragma unroll
        for (int j = 0; j < 8; ++j) { const float sht = sh[(size_t)task * 8 + j]; sc_lo[j] = su[es_lo[j]] * sht; sc_hi[j] = su[es_hi[j]] * sht; }
#pragma unroll 1
        for (int r = 0; r < 8; ++r) {
#pragma unroll
            for (int j = 0; j < 8; ++j) {
                const int p0 = __builtin_amdgcn_readlane(offv[j], r), p1 = __builtin_amdgcn_readlane(offv[j], r + 1);
#pragma unroll 1
                for (int base = p0; base < p1; base += 16) {
                    u32x4 buf[16];
#pragma unroll
                    for (int k = 0; k < 16; ++k) { const int p = base + k; buf[k] = (u32x4){0u, 0u, 0u, 0u};
                        if (p < p1) { const int e = __builtin_amdgcn_readlane((p < 64) ? es_lo[j] : es_hi[j], p & 63); const GAS char* row = (const GAS char*)Uq + (size_t)e * DM; asm("" : "+s"(row));
                            unsigned vo = voff; asm("" : "+v"(vo)); buf[k] = *(const GAS u32x4*)(row + vo); } }
                    float part[16];
#pragma unroll
                    for (int k = 0; k < 16; ++k) part[k] = (float)dot16i(buf[k], h4[j]);
                    float r8[8], r4[4], r2[2], r1;
#pragma unroll
                    for (int k = 0; k < 8; ++k) { const bool up = lane & 32; const float keep = up ? part[k + 8] : part[k], send = up ? part[k] : part[k + 8]; r8[k] = keep + __shfl_xor(send, 32); }
#pragma unroll
                    for (int k = 0; k < 4; ++k) { const bool up = lane & 16; const float keep = up ? r8[k + 4] : r8[k], send = up ? r8[k] : r8[k + 4]; r4[k] = keep + __shfl_xor(send, 16); }
#pragma unroll
                    for (int k = 0; k < 2; ++k) { const bool up = lane & 8; const float keep = up ? r4[k + 2] : r4[k], send = up ? r4[k] : r4[k + 2]; r2[k] = keep + __shfl_xor(send, 8); }
                    { const bool up = lane & 4; const float keep = up ? r2[1] : r2[0], send = up ? r2[0] : r2[1]; r1 = keep + __shfl_xor(send, 4); }
                    r1 += __shfl_xor(r1, 2); r1 += __shfl_xor(r1, 1);
                    const int pp = base + (lane >> 2);
                    const float s0 = __shfl(sc_lo[j], pp & 63), s1 = __shfl(sc_hi[j], pp & 63), q0 = __shfl(g_lo[j], pp & 63), q1 = __shfl(g_hi[j], pp & 63);
                    const float scl = (pp < 64) ? s0 : s1, gg = (pp < 64) ? q0 : q1;
                    if ((lane & 3) == 0 && pp < p1) wact[((size_t)task * 8 + j) * NSLOT + pp] = gg * gelu_tanh(r1 * scl);
                }
            }
        }
    }
}
__device__ __forceinline__ void ph_peer_v6(float* xres, const unsigned char* Vq, const float* sv, const int* eid, const float* wact, const int* offs, const float* gn, bf16_t* hout, int last) {
    const int tid = opq_tid(), lane = tid & 63, wv = __builtin_amdgcn_readfirstlane(tid >> 6); const unsigned voff = (unsigned)lane * 16u;
    for (int task = blockIdx.x * NWAVE + wv; task < T / 4; task += gridDim.x * NWAVE) {
        int es_lo[4], es_hi[4], offv[4]; float c_lo[4], c_hi[4];
#pragma unroll
        for (int j = 0; j < 4; ++j) { const size_t t = (size_t)task * 4 + j;
            es_lo[j] = eid[t * NSLOT + lane]; es_hi[j] = eid[t * NSLOT + 64 + lane]; c_lo[j] = wact[t * NSLOT + lane]; c_hi[j] = wact[t * NSLOT + 64 + lane]; offv[j] = offs[t * 16 + (lane & 15)]; }
#pragma unroll
        for (int j = 0; j < 4; ++j) { c_lo[j] *= sv[es_lo[j]]; c_hi[j] *= sv[es_hi[j]]; }
        float acc[4][16], corr[4];
#pragma unroll
        for (int j = 0; j < 4; ++j) { corr[j] = 0.f;
#pragma unroll
            for (int i = 0; i < 16; ++i) acc[j][i] = 0.f; }
#pragma unroll 1
        for (int r = 0; r < 8; ++r) {
#pragma unroll
            for (int j = 0; j < 4; ++j) {
                const int p0 = __builtin_amdgcn_readlane(offv[j], r), p1 = __builtin_amdgcn_readlane(offv[j], r + 1);
#pragma unroll 1
                for (int base = p0; base < p1; base += 16) {
                    u32x4 buf[16];
#pragma unroll
                    for (int k = 0; k < 16; ++k) { const int p = base + k; buf[k] = (u32x4){0u, 0u, 0u, 0u};
                        if (p < p1) { const int e = __builtin_amdgcn_readlane((p < 64) ? es_lo[j] : es_hi[j], p & 63); const GAS char* row = (const GAS char*)Vq + (size_t)e * DM; asm("" : "+s"(row));
                            unsigned vo = voff; asm("" : "+v"(vo)); buf[k] = *(const GAS u32x4*)(row + vo); } }
#pragma unroll
                    for (int k = 0; k < 16; ++k) { const int p = base + k; const int pc = (p < NSLOT) ? p : NSLOT - 1;
                        float w = __builtin_bit_cast(float, __builtin_amdgcn_readlane(__builtin_bit_cast(int, (pc < 64) ? c_lo[j] : c_hi[j]), pc & 63)); w = (p < p1) ? w : 0.f;
                        corr[j] += w; const u32x4 a = buf[k];
                        fma_ub4(acc[j][0], acc[j][1], acc[j][2], acc[j][3], a.x, w); fma_ub4(acc[j][4], acc[j][5], acc[j][6], acc[j][7], a.y, w);
                        fma_ub4(acc[j][8], acc[j][9], acc[j][10], acc[j][11], a.z, w); fma_ub4(acc[j][12], acc[j][13], acc[j][14], acc[j][15], a.w, w); }
                }
            }
        }
#pragma unroll
        for (int j = 0; j < 4; ++j) {
            const size_t t = (size_t)task * 4 + j; float* xr = xres + t * DM + lane * 16; float ss = 0.f; const float c128 = 128.f * corr[j];
#pragma unroll
            for (int q = 0; q < 4; ++q) { const f32x4 xv = *(const f32x4*)(xr + q * 4);
                acc[j][q * 4 + 0] += xv.x - c128; acc[j][q * 4 + 1] += xv.y - c128; acc[j][q * 4 + 2] += xv.z - c128; acc[j][q * 4 + 3] += xv.w - c128; }
#pragma unroll
            for (int i = 0; i < 16; ++i) ss += acc[j][i] * acc[j][i];
            const float rstd = rsqrtf(wave_sum(ss) * (1.f / DM) + EPS);
#pragma unroll
            for (int q = 0; q < 4; ++q) { const int c = lane * 16 + q * 4; const f32x4 g = *(const f32x4*)(gn + c); const int a0 = q * 4;
                if (last) { *(f32x4*)(xr + q * 4) = (f32x4){acc[j][a0] * rstd * g.x, acc[j][a0 + 1] * rstd * g.y, acc[j][a0 + 2] * rstd * g.z, acc[j][a0 + 3] * rstd * g.w}; }
                else { *(f32x4*)(xr + q * 4) = (f32x4){acc[j][a0], acc[j][a0 + 1], acc[j][a0 + 2], acc[j][a0 + 3]};
                    u32x2 ob; ob.x = pk2(acc[j][a0] * rstd * g.x, acc[j][a0 + 1] * rstd * g.y); ob.y = pk2(acc[j][a0 + 2] * rstd * g.z, acc[j][a0 + 3] * rstd * g.w); *(u32x2*)(hout + t * DM + c) = ob; } }
        }
    }
}


constexpr int US_LDS = 12288;
__device__ __forceinline__ void ph_peer_u6(unsigned char* lds_, const bf16_t* xg, const float* gf, const float* rowsq, const unsigned char* Uq, const int* eid, const int* offs, float* dots, const int task) {
    const int tid = opq_tid(), lane = tid & 63, wv = __builtin_amdgcn_readfirstlane(tid >> 6); const unsigned voff = (unsigned)lane * 16u;
    LAS unsigned char* hqL = (LAS unsigned char*)lds_ + wv * (64 * TK_ROW * 4); LAS unsigned* sched = (LAS unsigned*)(hqL + 8192); LAS float* shL = (LAS float*)(hqL + 12288);
    {
        int es_lo[8], es_hi[8], offv[8]; float gv[16];
#pragma unroll
        for (int i = 0; i < 4; ++i) { const f32x4 g4 = *(const f32x4*)(gf + lane * 16 + i * 4); gv[i * 4] = g4.x; gv[i * 4 + 1] = g4.y; gv[i * 4 + 2] = g4.z; gv[i * 4 + 3] = g4.w; }
#pragma unroll
        for (int j = 0; j < 8; ++j) { const size_t t = (size_t)task * 8 + j;
            es_lo[j] = ldcg(eid + t * NSLOT + lane); es_hi[j] = ldcg(eid + t * NSLOT + 64 + lane); offv[j] = ldcg(offs + t * 16 + (lane & 15));
            const u32x4 xa = *(const u32x4*)(xg + t * DM + lane * 16), xb = *(const u32x4*)(xg + t * DM + lane * 16 + 8); const float rstd = rstd_of(rowsq, t);
            float hv[16] = {lo16(xa.x), hi16(xa.x), lo16(xa.y), hi16(xa.y), lo16(xa.z), hi16(xa.z), lo16(xa.w), hi16(xa.w), lo16(xb.x), hi16(xb.x), lo16(xb.y), hi16(xb.y), lo16(xb.z), hi16(xb.z), lo16(xb.w), hi16(xb.w)};
            float am = 0.f;
#pragma unroll
            for (int i = 0; i < 16; ++i) { hv[i] *= rstd * gv[i]; am = fmaxf(am, fabsf(hv[i])); }
            am = wave_max(am); const float inv = am > 0.f ? 127.f / am : 0.f;
            u32x4 hq4;
            hq4.x = q8(hv[0], inv, 0) | (q8(hv[1], inv, 0) << 8) | (q8(hv[2], inv, 0) << 16) | (q8(hv[3], inv, 0) << 24); hq4.y = q8(hv[4], inv, 0) | (q8(hv[5], inv, 0) << 8) | (q8(hv[6], inv, 0) << 16) | (q8(hv[7], inv, 0) << 24);
            hq4.z = q8(hv[8], inv, 0) | (q8(hv[9], inv, 0) << 8) | (q8(hv[10], inv, 0) << 16) | (q8(hv[11], inv, 0) << 24); hq4.w = q8(hv[12], inv, 0) | (q8(hv[13], inv, 0) << 8) | (q8(hv[14], inv, 0) << 16) | (q8(hv[15], inv, 0) << 24);
            *(LAS u32x4*)(hqL + j * 1024 + lane * 16) = hq4; if (lane == 0) shL[j] = am * (1.f / 127.f); }
        int ncell = 0;
#pragma unroll
        for (int j = 0; j < 8; ++j) { const int v = __shfl(offv[j], (lane >> 3) + 1) - __shfl(offv[j], lane >> 3); if ((lane & 7) == j) ncell = v; }
        int scan = ncell;
#pragma unroll
        for (int o = 1; o < 64; o <<= 1) { const int u = __shfl_up(scan, o); if (lane >= o) scan += u; }
        const int sexc = scan - ncell;
#pragma unroll
        for (int j = 0; j < 8; ++j) {
            const int r0 = es_lo[j] >> 11, r1 = es_hi[j] >> 11;
            const int i0 = __shfl(sexc, r0 * 8 + j) + lane - __shfl(offv[j], r0), i1 = __shfl(sexc, r1 * 8 + j) + 64 + lane - __shfl(offv[j], r1);
            sched[i0] = (unsigned)es_lo[j] | ((unsigned)j << 14) | ((unsigned)lane << 17); sched[i1] = (unsigned)es_hi[j] | ((unsigned)j << 14) | ((unsigned)(64 + lane) << 17);
        }
        u32x4 bufA[16], bufB[16]; unsigned entA, entB;
#define US_ISSUE(buf, ent, s_) do { ent = sched[(s_) * 16 + (lane & 15)]; unsigned vo = voff; asm("" : "+v"(vo)); _Pragma("unroll") for (int k = 0; k < 16; ++k) { \
            const unsigned e = (unsigned)__builtin_amdgcn_readlane((int)ent, k) & 16383u; const GAS char* row = (const GAS char*)Uq + (size_t)e * DM; asm("" : "+s"(row)); buf[k] = *(const GAS u32x4*)(row + vo); } } while (0)
#define US_CONS(buf, ent) do { float part[16]; _Pragma("unroll") for (int k = 0; k < 16; ++k) { const unsigned jj = ((unsigned)__builtin_amdgcn_readlane((int)ent, k) >> 14) & 7u; \
                const u32x4 hrow = *(const LAS u32x4*)(hqL + jj * 1024 + lane * 16); part[k] = (float)dot16i(buf[k], hrow); } \
            float r8[8], r4[4], r2[2], r1; \
            _Pragma("unroll") for (int k = 0; k < 8; ++k) { const bool up = lane & 32; const float keep = up ? part[k + 8] : part[k], send = up ? part[k] : part[k + 8]; r8[k] = keep + __shfl_xor(send, 32); } \
            _Pragma("unroll") for (int k = 0; k < 4; ++k) { const bool up = lane & 16; const float keep = up ? r8[k + 4] : r8[k], send = up ? r8[k] : r8[k + 4]; r4[k] = keep + __shfl_xor(send, 16); } \
            _Pragma("unroll") for (int k = 0; k < 2; ++k) { const bool up = lane & 8; const float keep = up ? r4[k + 2] : r4[k], send = up ? r4[k] : r4[k + 2]; r2[k] = keep + __shfl_xor(send, 8); } \
            { const bool up = lane & 4; const float keep = up ? r2[1] : r2[0], send = up ? r2[0] : r2[1]; r1 = keep + __shfl_xor(send, 4); } \
            r1 += __shfl_xor(r1, 2); r1 += __shfl_xor(r1, 1); \
            const unsigned me = (unsigned)__shfl((int)ent, lane >> 2); \
            if ((lane & 3) == 0) dots[(((size_t)task * 8 + ((me >> 14) & 7u)) << 7) + (me >> 17)] = r1 * shL[(me >> 14) & 7u]; } while (0)
        US_ISSUE(bufA, entA, 0); US_ISSUE(bufB, entB, 1);
#pragma unroll 1
        for (int s = 0; s < 62; s += 2) {
            US_CONS(bufA, entA); US_ISSUE(bufA, entA, s + 2);
            US_CONS(bufB, entB); US_ISSUE(bufB, entB, s + 3);
        }
        US_CONS(bufA, entA); US_CONS(bufB, entB);
#undef US_ISSUE
#undef US_CONS
    }
}


__device__ __forceinline__ void fma_ub4v(float& a0, float& a1, float& a2, float& a3, unsigned a, float w) {
    float t0, t1;
    asm("v_cvt_f32_ubyte0 %4, %6\n\tv_cvt_f32_ubyte1 %5, %6\n\tv_fmac_f32 %0, %7, %4\n\tv_fmac_f32 %1, %7, %5\n\tv_cvt_f32_ubyte2 %4, %6\n\tv_cvt_f32_ubyte3 %5, %6\n\tv_fmac_f32 %2, %7, %4\n\tv_fmac_f32 %3, %7, %5"
        : "+v"(a0), "+v"(a1), "+v"(a2), "+v"(a3), "=&v"(t0), "=&v"(t1) : "v"(a), "v"(w));
}
constexpr int VS_LDS = 16384 + 256;
template <int MODE> __device__ __forceinline__ void ph_peer_v7(unsigned char* lds_, float* xres, const unsigned char* Vq, const float* sv, const int* eid, const float* dots, const float* gw, const float* su, const float* sh,
                                           const int* offs, const float* gn, bf16_t* hout, int last) {
    const int tid = opq_tid(), lane = tid & 63, wv = __builtin_amdgcn_readfirstlane(tid >> 6); const int j = lane >> 4, li = lane & 15;
    LAS int* slotE = (LAS int*)((LAS unsigned char*)lds_ + wv * VS_LDS); LAS float* slotC = (LAS float*)(slotE + 2048);
    for (int task = blockIdx.x * NWAVE + wv; task < T / 4; task += gridDim.x * NWAVE) {
        int nmax = 0, sexc;
        int offq[4];
#pragma unroll
        for (int q = 0; q < 4; ++q) { offq[q] = offs[((size_t)task * 4 + q) * 16 + (lane & 15)]; const int n = __shfl(offq[q], (lane & 15) + 1) - offq[q]; nmax = (n > nmax) ? n : nmax; }
        nmax = (lane < 8) ? nmax : 0;
        { int sc = nmax;
#pragma unroll
          for (int o = 1; o < 8; o <<= 1) { const int u = __shfl_up(sc, o); if (lane >= o) sc += u; }
          sexc = sc - nmax; }
        const int total = __builtin_amdgcn_readlane(sexc, 7) + __builtin_amdgcn_readlane(nmax, 7);
        for (int i = lane; i < total * 4; i += 64) { slotE[i] = -1; slotC[i] = 0.f; }
#pragma unroll
        for (int q = 0; q < 4; ++q) { const size_t t = (size_t)task * 4 + q; const float sht = sh[t];
#pragma unroll
            for (int hf = 0; hf < 2; ++hf) { const int p = hf * 64 + lane; const int e = eid[t * NSLOT + p]; const float c = gw[t * NSLOT + p] * gelu_tanh(dots[t * NSLOT + p] * su[e] * sht) * sv[e];
                const int r = e >> 11; const int s = __shfl(sexc, r) + p - __shfl(offq[q], r); slotE[s * 4 + q] = e; slotC[s * 4 + q] = c; } }
        float acc[64]; float corr = 0.f;
#pragma unroll
        for (int i = 0; i < 64; ++i) acc[i] = 0.f;
        constexpr int RING = 6; u32x4 ring[RING][4]; float cR[RING];
#define VS_ISSUE(u_, s_) do { const int s__ = (s_); int e = -1; float c = 0.f; if (s__ < total) { e = slotE[s__ * 4 + j]; c = slotC[s__ * 4 + j]; } cR[u_] = c; \
            if (e >= 0) { const u32x4* rp = (const u32x4*)(Vq + (size_t)(MODE == 2 ? (e & 2047) : e) * DM) + li; ring[u_][0] = rp[0]; ring[u_][1] = rp[16]; ring[u_][2] = rp[32]; ring[u_][3] = rp[48]; } } while (0)
#define VS_CONS(u_) do { const float w = cR[u_]; corr += w; if (MODE >= 1) { acc[0] += w * __uint_as_float((ring[u_][0].x ^ ring[u_][1].y ^ ring[u_][2].z ^ ring[u_][3].w) & 0x3f800000u); } else _Pragma("unroll") for (int m = 0; m < 4; ++m) { const u32x4 a = ring[u_][m]; \
            fma_ub4v(acc[m * 16 + 0], acc[m * 16 + 1], acc[m * 16 + 2], acc[m * 16 + 3], a.x, w); fma_ub4v(acc[m * 16 + 4], acc[m * 16 + 5], acc[m * 16 + 6], acc[m * 16 + 7], a.y, w); \
            fma_ub4v(acc[m * 16 + 8], acc[m * 16 + 9], acc[m * 16 + 10], acc[m * 16 + 11], a.z, w); fma_ub4v(acc[m * 16 + 12], acc[m * 16 + 13], acc[m * 16 + 14], acc[m * 16 + 15], a.w, w); } } while (0)
#pragma unroll
        for (int u = 0; u < RING; ++u) {
#pragma unroll
            for (int m = 0; m < 4; ++m) ring[u][m] = (u32x4){0u, 0u, 0u, 0u};
            VS_ISSUE(u, u); }
#pragma unroll 1
        for (int base = 0; base < total; base += RING) {
#pragma unroll
            for (int u = 0; u < RING; ++u) { VS_CONS(u); VS_ISSUE(u, base + RING + u); }
        }
#undef VS_ISSUE
#undef VS_CONS
        const size_t t = (size_t)task * 4 + j; float* xr = xres + t * DM + li * 16; float ss = 0.f; const float c128 = 128.f * corr;
#pragma unroll
        for (int m = 0; m < 4; ++m)
#pragma unroll
            for (int q = 0; q < 4; ++q) { const f32x4 xv = *(const f32x4*)(xr + m * 256 + q * 4); const int a0 = m * 16 + q * 4;
                acc[a0] += xv.x - c128; acc[a0 + 1] += xv.y - c128; acc[a0 + 2] += xv.z - c128; acc[a0 + 3] += xv.w - c128; }
#pragma unroll
        for (int i = 0; i < 64; ++i) ss += acc[i] * acc[i];
        ss += __shfl_xor(ss, 1); ss += __shfl_xor(ss, 2); ss += __shfl_xor(ss, 4); ss += __shfl_xor(ss, 8);
        const float rstd = rsqrtf(ss * (1.f / DM) + EPS);
#pragma unroll
        for (int m = 0; m < 4; ++m)
#pragma unroll
            for (int q = 0; q < 4; ++q) { const int c = m * 256 + li * 16 + q * 4; const f32x4 g = *(const f32x4*)(gn + c); const int a0 = m * 16 + q * 4;
                if (last) { *(f32x4*)(xres + t * DM + c) = (f32x4){acc[a0] * rstd * g.x, acc[a0 + 1] * rstd * g.y, acc[a0 + 2] * rstd * g.z, acc[a0 + 3] * rstd * g.w}; }
                else { *(f32x4*)(xres + t * DM + c) = (f32x4){acc[a0], acc[a0 + 1], acc[a0 + 2], acc[a0 + 3]};
                    u32x2 ob; ob.x = pk2(acc[a0] * rstd * g.x, acc[a0 + 1] * rstd * g.y); ob.y = pk2(acc[a0 + 2] * rstd * g.z, acc[a0 + 3] * rstd * g.w); *(u32x2*)(hout + t * DM + c) = ob; } }
    }
}


constexpr int VS8_LDS = 4096;
template <int MODE> __device__ __forceinline__ void ph_peer_v8(unsigned char* lds_, float* xres, const unsigned char* Vq, const float* sv, const int* eid, const float* dots, const float* gw, const float* su, const float* sh,
                                           const int* offs, const float* gn, bf16_t* hout, int last) {
    const int tid = opq_tid(), lane = tid & 63, wv = __builtin_amdgcn_readfirstlane(tid >> 6); const unsigned voff = (unsigned)lane * 16u;
    LAS unsigned* sched = (LAS unsigned*)((LAS unsigned char*)lds_ + wv * VS8_LDS); LAS unsigned char* schedW = (LAS unsigned char*)(sched + 640);
    for (int task = blockIdx.x * NWAVE + wv; task < T / 4; task += gridDim.x * NWAVE) {
        int offq[4]; int npad = 0;
#pragma unroll
        for (int q = 0; q < 4; ++q) { offq[q] = offs[((size_t)task * 4 + q) * 16 + (lane & 15)]; const int n = __shfl(offq[q], (lane >> 2) + 1) - __shfl(offq[q], lane >> 2); if ((lane & 3) == q) npad = (n + 3) & ~3; }
        npad = (lane < 32) ? npad : 0;
        int sc_ = npad;
#pragma unroll
        for (int o = 1; o < 32; o <<= 1) { const int u = __shfl_up(sc_, o); if (lane >= o) sc_ += u; }
        const int sexc = sc_ - npad;
        const int slen = __builtin_amdgcn_readlane(sc_, 31), nst = (slen + 15) >> 4;
        for (int i = lane; i < 160; i += 64) { ((LAS u32x4*)sched)[i] = (u32x4){0u, 0u, 0u, 0u}; }
        for (int i = lane; i < 40; i += 64) { ((LAS u32x4*)schedW)[i] = (u32x4){0u, 0u, 0u, 0u}; }
        float tsc[4];
#pragma unroll
        for (int q = 0; q < 4; ++q) { const size_t t = (size_t)task * 4 + q; const float sht = sh[t];
            const int e0 = eid[t * NSLOT + lane], e1 = eid[t * NSLOT + 64 + lane];
            const float c0 = gw[t * NSLOT + lane] * gelu_tanh(dots[t * NSLOT + lane] * su[e0] * sht) * sv[e0], c1 = gw[t * NSLOT + 64 + lane] * gelu_tanh(dots[t * NSLOT + 64 + lane] * su[e1] * sht) * sv[e1];
            const float am = wave_max(fmaxf(fabsf(c0), fabsf(c1))); const float inv = am > 0.f ? 127.f / am : 0.f; tsc[q] = am * (1.f / 127.f);
            const int r0 = e0 >> 11, r1 = e1 >> 11;
            const int i0 = __shfl(sexc, r0 * 4 + q) + lane - __shfl(offq[q], r0), i1 = __shfl(sexc, r1 * 4 + q) + 64 + lane - __shfl(offq[q], r1);
            sched[i0] = (unsigned)e0 | ((unsigned)q << 14); sched[i1] = (unsigned)e1 | ((unsigned)q << 14);
            schedW[i0] = (unsigned char)((int)__builtin_rintf(c0 * inv) & 255); schedW[i1] = (unsigned char)((int)__builtin_rintf(c1 * inv) & 255); }
        int acc[4][16];
#pragma unroll
        for (int q = 0; q < 4; ++q)
#pragma unroll
            for (int i = 0; i < 16; ++i) acc[q][i] = 0;
        u32x4 bufA[8], bufB[8], bufC[8]; unsigned entA, entB, entC, wqA, wqB, wqC;
#define V8_ISSUE(buf, ent, wq, s_) do { ent = sched[(s_) * 8 + (lane & 7)]; wq = ((LAS unsigned*)schedW)[(s_) * 2 + (lane & 1)]; unsigned vo = voff; asm("" : "+v"(vo)); _Pragma("unroll") for (int k = 0; k < 8; ++k) { \
            const unsigned e = (unsigned)__builtin_amdgcn_readlane((int)ent, k) & 16383u; const GAS char* row = (const GAS char*)Vq + (size_t)e * DM; asm("" : "+s"(row)); buf[k] = *(const GAS u32x4*)(row + vo); } } while (0)
#define V8_CONS(buf, ent, wq) do { if (MODE == 1) { _Pragma("unroll") for (int k = 0; k < 8; ++k) acc[0][k] ^= (int)(buf[k].x ^ buf[k].y ^ buf[k].z ^ buf[k].w) & (int)wq; } else _Pragma("unroll") for (int g = 0; g < 2; ++g) { \
            const unsigned jg = ((unsigned)__builtin_amdgcn_readlane((int)ent, 4 * g) >> 14) & 3u; const int wg = __builtin_amdgcn_readlane((int)wq, g); \
            const int w0 = (jg == 0u) ? wg : 0, w1 = (jg == 1u) ? wg : 0, w2 = (jg == 2u) ? wg : 0, w3 = (jg == 3u) ? wg : 0;        \
            _Pragma("unroll") for (int xi = 0; xi < 4; ++xi) { const unsigned ra = buf[4 * g][xi], rb = buf[4 * g + 1][xi], rc = buf[4 * g + 2][xi], rd = buf[4 * g + 3][xi]; \
                const unsigned t0 = __builtin_amdgcn_perm(rb, ra, 0x05010400u), t1 = __builtin_amdgcn_perm(rb, ra, 0x07030602u), t2 = __builtin_amdgcn_perm(rd, rc, 0x05010400u), t3 = __builtin_amdgcn_perm(rd, rc, 0x07030602u); \
                const int o0 = (int)__builtin_amdgcn_perm(t2, t0, 0x05040100u), o1 = (int)__builtin_amdgcn_perm(t2, t0, 0x07060302u), o2 = (int)__builtin_amdgcn_perm(t3, t1, 0x05040100u), o3 = (int)__builtin_amdgcn_perm(t3, t1, 0x07060302u); \
                acc[0][4 * xi] = __builtin_amdgcn_sdot4(o0, w0, acc[0][4 * xi], false); acc[0][4 * xi + 1] = __builtin_amdgcn_sdot4(o1, w0, acc[0][4 * xi + 1], false); acc[0][4 * xi + 2] = __builtin_amdgcn_sdot4(o2, w0, acc[0][4 * xi + 2], false); acc[0][4 * xi + 3] = __builtin_amdgcn_sdot4(o3, w0, acc[0][4 * xi + 3], false); \
                acc[1][4 * xi] = __builtin_amdgcn_sdot4(o0, w1, acc[1][4 * xi], false); acc[1][4 * xi + 1] = __builtin_amdgcn_sdot4(o1, w1, acc[1][4 * xi + 1], false); acc[1][4 * xi + 2] = __builtin_amdgcn_sdot4(o2, w1, acc[1][4 * xi + 2], false); acc[1][4 * xi + 3] = __builtin_amdgcn_sdot4(o3, w1, acc[1][4 * xi + 3], false); \
                acc[2][4 * xi] = __builtin_amdgcn_sdot4(o0, w2, acc[2][4 * xi], false); acc[2][4 * xi + 1] = __builtin_amdgcn_sdot4(o1, w2, acc[2][4 * xi + 1], false); acc[2][4 * xi + 2] = __builtin_amdgcn_sdot4(o2, w2, acc[2][4 * xi + 2], false); acc[2][4 * xi + 3] = __builtin_amdgcn_sdot4(o3, w2, acc[2][4 * xi + 3], false); \
                acc[3][4 * xi] = __builtin_amdgcn_sdot4(o0, w3, acc[3][4 * xi], false); acc[3][4 * xi + 1] = __builtin_amdgcn_sdot4(o1, w3, acc[3][4 * xi + 1], false); acc[3][4 * xi + 2] = __builtin_amdgcn_sdot4(o2, w3, acc[3][4 * xi + 2], false); acc[3][4 * xi + 3] = __builtin_amdgcn_sdot4(o3, w3, acc[3][4 * xi + 3], false); } } } while (0)
        const int nst8 = (slen + 7) >> 3;
        V8_ISSUE(bufA, entA, wqA, 0); V8_ISSUE(bufB, entB, wqB, 1); V8_ISSUE(bufC, entC, wqC, 2);
#pragma unroll 1
        for (int s = 0; s < ((MODE == 2) ? 3 : nst8); s += 3) {
            V8_CONS(bufA, entA, wqA); V8_ISSUE(bufA, entA, wqA, (s + 3 < 80) ? s + 3 : 79);
            V8_CONS(bufB, entB, wqB); V8_ISSUE(bufB, entB, wqB, (s + 4 < 80) ? s + 4 : 79);
            V8_CONS(bufC, entC, wqC); V8_ISSUE(bufC, entC, wqC, (s + 5 < 80) ? s + 5 : 79);
        }
#undef V8_ISSUE
#undef V8_CONS
        int task2 = task; asm volatile("" : "+s"(task2)); int lane2 = lane; asm volatile("" : "+v"(lane2));
#pragma unroll
        for (int q = 0; q < 4; ++q) {
            const size_t t = (size_t)task2 * 4 + q; float* xr = xres + t * DM + lane2 * 16; float ss = 0.f; float y[16];
#pragma unroll
            for (int c4 = 0; c4 < 4; ++c4) { const f32x4 xv = *(const f32x4*)(xr + c4 * 4);
                y[c4 * 4 + 0] = xv.x + tsc[q] * (float)acc[q][c4 * 4 + 0]; y[c4 * 4 + 1] = xv.y + tsc[q] * (float)acc[q][c4 * 4 + 1]; y[c4 * 4 + 2] = xv.z + tsc[q] * (float)acc[q][c4 * 4 + 2]; y[c4 * 4 + 3] = xv.w + tsc[q] * (float)acc[q][c4 * 4 + 3]; }
#pragma unroll
            for (int i = 0; i < 16; ++i) ss += y[i] * y[i];
            const float rstd = rsqrtf(wave_sum(ss) * (1.f / DM) + EPS);
#pragma unroll
            for (int c4 = 0; c4 < 4; ++c4) { const int c = lane2 * 16 + c4 * 4; const f32x4 g = *(const f32x4*)(gn + c); const int a0 = c4 * 4;
                if (last) { *(f32x4*)(xr + c4 * 4) = (f32x4){y[a0] * rstd * g.x, y[a0 + 1] * rstd * g.y, y[a0 + 2] * rstd * g.z, y[a0 + 3] * rstd * g.w}; }
                else { *(f32x4*)(xr + c4 * 4) = (f32x4){y[a0], y[a0 + 1], y[a0 + 2], y[a0 + 3]};
                    u32x2 ob; ob.x = pk2(y[a0] * rstd * g.x, y[a0 + 1] * rstd * g.y); ob.y = pk2(y[a0 + 2] * rstd * g.z, y[a0 + 3] * rstd * g.w); *(u32x2*)(hout + t * DM + c) = ob; } }
        }
    }
}


template <int MODE> __device__ __forceinline__ void ph_peer_v9(float* xout, bf16_t* xb, const unsigned char* Vq, const float* sv, const int* eid, const float* dots, const float* gw, const float* su,
                                                              const float* gn, bf16_t* hout, int last, const int task) {
    const int tid = opq_tid(), lane = tid & 63, wv = __builtin_amdgcn_readfirstlane(tid >> 6); const unsigned voff = (unsigned)lane * 16u;
    {
        int e_lo[4], e_hi[4]; unsigned cw[4]; float tsc[4]; float c0[4], c1[4];
#pragma unroll
        for (int q = 0; q < 4; ++q) { const size_t t = (size_t)task * 4 + q; e_lo[q] = ldcg(eid + t * NSLOT + lane); e_hi[q] = ldcg(eid + t * NSLOT + 64 + lane); c0[q] = ldcg(gw + t * NSLOT + lane); c1[q] = ldcg(gw + t * NSLOT + 64 + lane); }
#pragma unroll
        for (int q = 0; q < 4; ++q) { const size_t t = (size_t)task * 4 + q;
            c0[q] *= gelu_tanh(ldcg(dots + t * NSLOT + lane) * su[e_lo[q]]) * sv[e_lo[q]]; c1[q] *= gelu_tanh(ldcg(dots + t * NSLOT + 64 + lane) * su[e_hi[q]]) * sv[e_hi[q]]; }
#pragma unroll
        for (int q = 0; q < 4; ++q) {
            const float am = wave_max(fmaxf(fabsf(c0[q]), fabsf(c1[q]))); const float inv = am > 0.f ? 127.f / am : 0.f; tsc[q] = am * (1.f / 127.f);
            const unsigned b0 = (unsigned)((int)__builtin_rintf(c0[q] * inv) & 255), b1 = (unsigned)((int)__builtin_rintf(c1[q] * inv) & 255);
            const unsigned p0 = b0 | (__shfl_down(b0, 1) << 8) | (__shfl_down(b0, 2) << 16) | (__shfl_down(b0, 3) << 24), p1 = b1 | (__shfl_down(b1, 1) << 8) | (__shfl_down(b1, 2) << 16) | (__shfl_down(b1, 3) << 24);
            const unsigned g0 = __shfl(p0, (lane & 15) * 4), g1 = __shfl(p1, (lane & 15) * 4); cw[q] = (lane < 16) ? g0 : g1; }
        int acc[4][16];
#pragma unroll
        for (int q = 0; q < 4; ++q)
#pragma unroll
            for (int i = 0; i < 16; ++i) acc[q][i] = 0;
        u32x4 bufA[16], bufB[16];
#define V9_ISSUE(buf, s_) do { const int s__ = (s_); unsigned vo = voff; asm("" : "+v"(vo)); _Pragma("unroll") for (int q = 0; q < 4; ++q) { const int esrc = (s__ < 16) ? e_lo[q] : e_hi[q]; _Pragma("unroll") for (int k = 0; k < 4; ++k) { \
            const int e = __builtin_amdgcn_readlane(esrc, (4 * s__ + k) & 63); const GAS char* row = (const GAS char*)Vq + (size_t)e * DM; asm("" : "+s"(row)); buf[4 * q + k] = *(const GAS u32x4*)(row + vo); } } } while (0)
#define V9_CONS(buf, s_) do { if (MODE == 1) { _Pragma("unroll") for (int k = 0; k < 16; ++k) acc[0][k] ^= (int)(buf[k].x ^ buf[k].y ^ buf[k].z ^ buf[k].w); } else { _Pragma("unroll") for (int q = 0; q < 4; ++q) { const int wg = __builtin_amdgcn_readlane((int)cw[q], (s_)); \
            _Pragma("unroll") for (int xi = 0; xi < 4; ++xi) { const unsigned ra = buf[4 * q][xi], rb = buf[4 * q + 1][xi], rc = buf[4 * q + 2][xi], rd = buf[4 * q + 3][xi]; \
                const unsigned t0 = __builtin_amdgcn_perm(rb, ra, 0x05010400u), t1 = __builtin_amdgcn_perm(rb, ra, 0x07030602u), t2 = __builtin_amdgcn_perm(rd, rc, 0x05010400u), t3 = __builtin_amdgcn_perm(rd, rc, 0x07030602u); \
                acc[q][4 * xi] = __builtin_amdgcn_sdot4((int)__builtin_amdgcn_perm(t2, t0, 0x05040100u), wg, acc[q][4 * xi], false); acc[q][4 * xi + 1] = __builtin_amdgcn_sdot4((int)__builtin_amdgcn_perm(t2, t0, 0x07060302u), wg, acc[q][4 * xi + 1], false); \
                acc[q][4 * xi + 2] = __builtin_amdgcn_sdot4((int)__builtin_amdgcn_perm(t3, t1, 0x05040100u), wg, acc[q][4 * xi + 2], false); acc[q][4 * xi + 3] = __builtin_amdgcn_sdot4((int)__builtin_amdgcn_perm(t3, t1, 0x07060302u), wg, acc[q][4 * xi + 3], false); } } } } while (0)
        V9_ISSUE(bufA, 0); V9_ISSUE(bufB, 1);
#pragma unroll 1
        for (int s = 0; s < ((MODE == 2) ? 2 : 30); s += 2) {
            V9_CONS(bufA, s); V9_ISSUE(bufA, s + 2);
            V9_CONS(bufB, s + 1); V9_ISSUE(bufB, s + 3);
        }
        V9_CONS(bufA, 30); V9_CONS(bufB, 31);
#undef V9_ISSUE
#undef V9_CONS
        int task2 = task; asm volatile("" : "+s"(task2)); int lane2 = lane; asm volatile("" : "+v"(lane2));
        f32x4 xv[4][4];
#pragma unroll
        for (int q = 0; q < 4; ++q)
#pragma unroll
            for (int c4 = 0; c4 < 4; ++c4) { const u32x2 w = *(const u32x2*)(xb + ((size_t)task2 * 4 + q) * DM + lane2 * 16 + c4 * 4); xv[q][c4] = (f32x4){lo16(w.x), hi16(w.x), lo16(w.y), hi16(w.y)}; }
        float rstd[4];
#pragma unroll
        for (int q = 0; q < 4; ++q) { float ss = 0.f;
#pragma unroll
            for (int c4 = 0; c4 < 4; ++c4) { xv[q][c4].x += tsc[q] * (float)acc[q][c4 * 4 + 0]; xv[q][c4].y += tsc[q] * (float)acc[q][c4 * 4 + 1]; xv[q][c4].z += tsc[q] * (float)acc[q][c4 * 4 + 2]; xv[q][c4].w += tsc[q] * (float)acc[q][c4 * 4 + 3];
                ss += xv[q][c4].x * xv[q][c4].x + xv[q][c4].y * xv[q][c4].y + xv[q][c4].z * xv[q][c4].z + xv[q][c4].w * xv[q][c4].w; }
            rstd[q] = rsqrtf(wave_sum(ss) * (1.f / DM) + EPS); }
#pragma unroll
        for (int q = 0; q < 4; ++q) { const size_t t = (size_t)task2 * 4 + q;
#pragma unroll
            for (int c4 = 0; c4 < 4; ++c4) { const int c = lane2 * 16 + c4 * 4; const f32x4 g = *(const f32x4*)(gn + c); const f32x4 y = xv[q][c4];
                if (last) { *(f32x4*)(xout + t * DM + c) = (f32x4){y.x * rstd[q] * g.x, y.y * rstd[q] * g.y, y.z * rstd[q] * g.z, y.w * rstd[q] * g.w}; }
                else { u32x2 ox; ox.x = pk2(y.x, y.y); ox.y = pk2(y.z, y.w); *(u32x2*)(xb + t * DM + c) = ox;
                    u32x2 ob; ob.x = pk2(y.x * rstd[q] * g.x, y.y * rstd[q] * g.y); ob.y = pk2(y.z * rstd[q] * g.z, y.w * rstd[q] * g.w); *(u32x2*)(hout + t * DM + c) = ob; } } }
    }
}


__device__ __forceinline__ void ph_peer_all(unsigned char* lds_, const short* scores, int* eid, float* gw, int* offs, float* dots, const bf16_t* xg, const float* gf, const float* rowsq, const unsigned char* Uq, const float* su,
                                            const unsigned char* Vq, const float* sv, float* xres, bf16_t* xb, const float* gn, bf16_t* hout, int last, const float* qsrc_u, const float* qsrc_v, unsigned char* qdst, float* qsc) {
    const int wv0 = __builtin_amdgcn_readfirstlane((int)(threadIdx.x >> 6));
    for (int task = blockIdx.x * NWAVE + wv0; task < T / 8; task += gridDim.x * NWAVE) {
        if (qsrc_u && wv0 >= 4) {
            const int widx = blockIdx.x * 4 + (wv0 - 4), nw = gridDim.x * 4;
            ph_quant_rows_w(qsrc_u + (size_t)NEXP * DM, qdst + (size_t)NEXP * DM, qsc, (NL - 1) * NEXP, 0, widx, nw);
            ph_quant_rows_w(qsrc_v + (size_t)NEXP * DM, qdst + (size_t)32 * MiB + (size_t)NEXP * DM, qsc + (1 * MiB / 4), (NL - 1) * NEXP, 0, widx, nw); }
        if (wv0 < 4) __builtin_amdgcn_s_setprio(3);
        ph_topk(lds_, scores, eid, gw, offs, task);
        __builtin_amdgcn_s_setprio(0);
        asm volatile("s_waitcnt vmcnt(0)" ::: "memory");
        ph_peer_u6(lds_, xg, gf, rowsq, Uq, eid, offs, dots, task);
        asm volatile("s_waitcnt vmcnt(0)" ::: "memory");
        ph_peer_v9<0>(xres, xb, Vq, sv, eid, dots, gw, su, gn, hout, last, 2 * task);
        ph_peer_v9<0>(xres, xb, Vq, sv, eid, dots, gw, su, gn, hout, last, 2 * task + 1);
    }
}

typedef GAS unsigned gu32;
#define XB_TMO      128
#define XB_XCNT(j)  (256  + 64 * (j))
#define XB_XSUB(j)  (1280 + 64 * (j))
#define XB_XGEN(j)  (2304 + 64 * (j))
#define XB_TOP      3328
#define XB_TOPGEN   3392
#define XCD_BAR_WORDS 3456
#define XB_SPIN_CAP (1u << 18)

__device__ __forceinline__ unsigned xb_ld(unsigned* p)              { return __hip_atomic_load(p, __ATOMIC_RELAXED, __HIP_MEMORY_SCOPE_AGENT); }
__device__ __forceinline__ unsigned xb_add(unsigned* p, unsigned v) { return __hip_atomic_fetch_add(p, v, __ATOMIC_RELAXED, __HIP_MEMORY_SCOPE_AGENT); }
__device__ __forceinline__ unsigned xb_xcc_id() { return (unsigned)__builtin_amdgcn_s_getreg((3 << 11) | 20) & 0xFu; }
#define XB_SPIN(cond, bar) do { unsigned _sp = 0; while (cond) { __builtin_amdgcn_s_sleep(1); \
    if ((++_sp & 255u) == 0u) { if (xb_ld(&(bar)[XB_TMO])) break; if (_sp > XB_SPIN_CAP) { atomicAdd(&(bar)[XB_TMO], 1u); break; } } } } while (0)

struct XcdBarrier {
    unsigned* bar; unsigned x;
    volatile LAS unsigned* st;
};

__device__ __forceinline__ XcdBarrier xcd_barrier_post(unsigned* bar, volatile LAS unsigned* st) {
    XcdBarrier b; b.bar = bar; b.x = xb_xcc_id(); b.st = st;
    if (threadIdx.x == 0) (void)xb_add(&bar[XB_XCNT(b.x)], 1u);
    return b;
}
__device__ __forceinline__ void xcd_barrier_complete(unsigned* bar, unsigned x, unsigned& nloc, unsigned& nx) {
    const unsigned G = gridDim.x * gridDim.y * gridDim.z;
    unsigned sum, cnt, mine, sp = 0u;
    for (;;) {
        sum = 0u; cnt = 0u; mine = 0u;
#pragma unroll
        for (unsigned j = 0; j < 16; ++j) { const unsigned c = xb_ld(&bar[XB_XCNT(j)]); sum += c; cnt += (c > 0u) ? 1u : 0u; mine = (j == x) ? c : mine; }
        if (sum == G) break;
        __builtin_amdgcn_s_sleep(1);
        if ((++sp & 255u) == 0u) { if (xb_ld(&bar[XB_TMO])) break; if (sp > XB_SPIN_CAP) { atomicAdd(&bar[XB_TMO], 1u); break; } }
    }
    nloc = mine > 0u ? mine : 1u; nx = cnt > 0u ? cnt : 1u;
}

__device__ __forceinline__ void xcd_barrier(const XcdBarrier& b) {
    asm volatile("s_waitcnt vmcnt(0)" ::: "memory");
    __syncthreads();
    if (threadIdx.x == 0) {
        unsigned* bar = b.bar;
        __builtin_amdgcn_s_waitcnt(0);
        unsigned nloc = b.st[0], nx = b.st[1];
        if (nloc == 0u) { xcd_barrier_complete(bar, b.x, nloc, nx); b.st[0] = nloc; b.st[1] = nx; }
        const unsigned old = xb_add(&bar[XB_XSUB(b.x)], 1u);
        const unsigned gen = old / nloc;
        if (old + 1u == (gen + 1u) * nloc) {
            __builtin_amdgcn_fence(__ATOMIC_RELEASE, "agent");
            asm volatile("s_waitcnt vmcnt(0)" ::: "memory");
            const unsigned og = xb_add(&bar[XB_TOP], 1u);
            const unsigned tg = og / nx;
            if (og + 1u == (tg + 1u) * nx) xb_add(&bar[XB_TOPGEN], 1u);
            else XB_SPIN(xb_ld(&bar[XB_TOPGEN]) == tg, bar);
            __builtin_amdgcn_fence(__ATOMIC_ACQUIRE, "agent");
            xb_add(&bar[XB_XGEN(b.x)], 1u);
            asm volatile("s_waitcnt vmcnt(0)" ::: "memory");
        } else {
            XB_SPIN(xb_ld(&bar[XB_XGEN(b.x)]) == gen, bar);
            __builtin_amdgcn_fence(__ATOMIC_ACQUIRE, "agent");
            asm volatile("s_waitcnt vmcnt(0)" ::: "memory");
        }
    }
    __syncthreads();
}

#define OPQ(p) do { size_t z_ = 0; asm volatile("" : "+s"(z_)); p = (decltype(p))((unsigned char*)(p) + z_); } while (0)
#define WSP(type, name, off) type* name = (type*)(ws + (off))
__global__ void __launch_bounds__(NTHR, 2) mk_fwd(Args a) {
    extern __shared__ __attribute__((aligned(16))) unsigned char lds[];
    float* smem = (float*)lds;
    volatile LAS unsigned* bst = (volatile LAS unsigned*)((LAS unsigned char*)lds + (LDS_BYTES - 64));
    if (threadIdx.x < 2) bst[threadIdx.x] = 0u;
    __syncthreads();
    (void)xcd_barrier_post((unsigned*)(a.ws + WS_CTL), bst);
#ifndef PROBE_I
#define PROBE_I -1
#endif
#define GRID_BAR() do { XcdBarrier b_; b_.bar = (unsigned*)(a.ws + WS_CTL); b_.x = xb_xcc_id(); b_.st = (volatile LAS unsigned*)((LAS unsigned char*)lds + (LDS_BYTES - 64)); xcd_barrier(b_); } while (0)
#define REP(idx) for (int rep_ = 0; rep_ < ((PROBE_I == (idx) && l == 0) ? 2 : 1); ++rep_)
    for (int rep_ = 0; rep_ < (PROBE_I == 0 ? 2 : 1); ++rep_) {
        unsigned char* ws = a.ws; OPQ(ws);
        WSP(bf16_t, Wpool, WS_WPOOL); WSP(bf16_t, Wup, WS_WUP); WSP(bf16_t, Wout, WS_WOUT); WSP(bf16_t, Wpeer, WS_WPEER); WSP(bf16_t, Win, WS_WIN); WSP(bf16_t, Ub, WS_UB); WSP(bf16_t, Vb, WS_VB); WSP(bf16_t, h, WS_H);
#define PRO_WEIGHTS() do { for (int l = 0; l < NL; ++l) { \
            ph_transpose_w(a.w_in + (size_t)l * DM * INW, Win + (size_t)l * INW * DM, DM, INW, lds); \
            ph_wpool_bd(a.w_pool + (size_t)l * 4 * 128 * 256, Wpool + (size_t)l * DM * PW); \
            ph_transpose_w(a.w_up + (size_t)l * AW * DM, Wup + (size_t)l * DM * AW, AW, DM, lds); \
            ph_transpose_w(a.w_out + (size_t)l * DM * DM, Wout + (size_t)l * DM * DM, DM, DM, lds); \
            __syncthreads(); \
            ph_wpeer2(a.peer_wq + (size_t)l * DM * PQW, a.peer_keys + (size_t)l * 2 * NKEY * 128, a.ffn_norm + l * DM, Wpeer + (size_t)l * PQW * DM, smem); } } while (0)
#define PRO_STREAM() do { ph_quant_rows(a.peer_u, ws + WS_UQ, (float*)(ws + WS_SU), NEXP, 0); ph_quant_rows(a.peer_v, ws + WS_VQ, (float*)(ws + WS_SV), NEXP, 0);        ph_rmsnorm(a.x, a.mix_norm, h); } while (0)
        if (blockIdx.x & 8) { PRO_STREAM(); PRO_WEIGHTS(); } else { PRO_WEIGHTS(); PRO_STREAM(); }
#undef PRO_WEIGHTS
#undef PRO_STREAM
        { float* km = (float*)(ws + WS_KM); for (int i = blockIdx.x * NTHR + opq_tid(); i < NB * NBLK * AW; i += gridDim.x * NTHR) km[i] = 0.f; }
    }
    GRID_BAR();
    for (int l = 0; l < NL; ++l) {
        REP(1)
        { unsigned char* ws = a.ws; OPQ(ws); WSP(bf16_t, h, WS_H); WSP(bf16_t, z, WS_Z); WSP(bf16_t, Win, WS_WIN);
          pg8::Gemm g{h, Win + (size_t)l * INW * DM, T, INW, DM, DM, DM, 0}; pg8::StaticOrder S; S.init(T, INW, (int)gridDim.x, (int)blockIdx.x);
          pg8::gemm_phase<EpiZk, pg8::StaticOrder, true, true>((PG8_LAS unsigned char*)lds, g, S, EpiZk{z, (float*)(ws + WS_KM)}); }
        GRID_BAR();
        REP(2)
        { unsigned char* ws = a.ws; OPQ(ws); WSP(bf16_t, z, WS_Z); WSP(bf16_t, m, WS_M);
          ph_poolm2(z, m); }
        REP(3)
        { unsigned char* ws = a.ws; OPQ(ws); WSP(bf16_t, z, WS_Z); WSP(bf16_t, o, WS_O);
          ph_attn(lds, z, (const float*)(ws + WS_KM), o); }
        GRID_BAR();
        { float* km = (float*)(a.ws + WS_KM); for (int i = blockIdx.x * NTHR + opq_tid(); i < NB * NBLK * AW; i += gridDim.x * NTHR) km[i] = 0.f; }
        REP(11)
        { unsigned char* ws = a.ws; OPQ(ws); WSP(bf16_t, z, WS_Z); WSP(bf16_t, m, WS_M); WSP(bf16_t, gaa, WS_GAA); WSP(bf16_t, Wpool, WS_WPOOL);
          { pg8::Gemm g{m, Wpool + (size_t)l * DM * PW, T, DM, PW, PW, PW, 0}; pg8::StaticOrder S; S.init(T, DM, (int)gridDim.x, (int)blockIdx.x);
            pg8::gemm_phase<EpiAdapt8L<EpiPool8L>, pg8::StaticOrder, true, true>((PG8_LAS unsigned char*)lds, g, S, EpiAdapt8L<EpiPool8L>{EpiPool8L{z, a.pool_scale + l * DM, gaa}}); } }
        REP(4)
        { unsigned char* ws = a.ws; OPQ(ws); WSP(bf16_t, z, WS_Z); WSP(bf16_t, o, WS_O); WSP(bf16_t, gaa, WS_GAA); WSP(bf16_t, mrg, WS_MRG); WSP(bf16_t, Wup, WS_WUP);
          { pg8::Gemm g{o, Wup + (size_t)l * DM * AW, T, DM, AW, AW, AW, 0}; pg8::StaticOrder S; S.init(T, DM, (int)gridDim.x, (int)blockIdx.x);
            pg8::gemm_phase<EpiAdapt8L<EpiUp8L>, pg8::StaticOrder, true, true>((PG8_LAS unsigned char*)lds, g, S, EpiAdapt8L<EpiUp8L>{EpiUp8L{z, gaa, mrg}}); } }
        GRID_BAR();
        REP(5)
        { unsigned char* ws = a.ws; OPQ(ws); WSP(bf16_t, mrg, WS_MRG); WSP(bf16_t, Wout, WS_WOUT); WSP(bf16_t, h, WS_H); float* out = a.out; OPQ(out);
          pg8::Gemm g{mrg, Wout + (size_t)l * DM * DM, T, DM, DM, DM, DM, 0}; pg8::StaticOrder S; S.init(T, DM, (int)gridDim.x, (int)blockIdx.x);
          if (l == 0) pg8::gemm_phase<EpiAdapt8L<EpiResNormL<false>, 2>, pg8::StaticOrder, true, true>((PG8_LAS unsigned char*)lds, g, S, EpiAdapt8L<EpiResNormL<false>, 2>{EpiResNormL<false>{a.x, (const bf16_t*)(ws + WS_XB), (bf16_t*)(ws + WS_XB), (float*)(ws + WS_GAA)}});
          else pg8::gemm_phase<EpiAdapt8L<EpiResNormL<true>, 4>, pg8::StaticOrder, true, true>((PG8_LAS unsigned char*)lds, g, S, EpiAdapt8L<EpiResNormL<true>, 4>{EpiResNormL<true>{a.x, (const bf16_t*)(ws + WS_XB), (bf16_t*)(ws + WS_XB), (float*)(ws + WS_GAA)}}); }
        GRID_BAR();
        REP(7)
        { unsigned char* ws = a.ws; OPQ(ws); WSP(bf16_t, h, WS_H); WSP(float, sc, WS_SC); WSP(bf16_t, Wpeer, WS_WPEER);
          pg8::Gemm g{(const bf16_t*)(ws + WS_XB), Wpeer + (size_t)l * PQW * DM, T, PQW, DM, DM, DM, 0}; pg8::StaticOrder S; S.init(T, PQW, (int)gridDim.x, (int)blockIdx.x);
          pg8::Unit u0, u1; u0.pm = 0; u0.pn = 0; u1.pm = 0; u1.pn = 0; const bool h0 = S.next(0, u0), h1 = S.next(1, u1);
          LAS float* rl = (LAS float*)((LAS unsigned char*)lds + 131072);
          { const int t_ = opq_tid(); const int pmx = (t_ < 256) ? u0.pm : u1.pm; if ((t_ < 256) ? h0 : h1) rl[t_] = rstd_of((const float*)(ws + WS_GAA), (size_t)pmx * 256 + (t_ & 255)); }
          { const int t2_ = opq_tid(); if (t2_ < 2) ((LAS int*)((LAS unsigned char*)lds + 133120))[t2_] = (t2_ == 0) ? (h0 ? u0.pm : -1) : (h1 ? u1.pm : -1); }
          __syncthreads();
          pg8::gemm_phase<EpiI16s, pg8::StaticOrder, true, true>((PG8_LAS unsigned char*)lds, g, S, EpiI16s{(short*)sc, (const float*)(ws + WS_GAA)}); }
        GRID_BAR();
        { unsigned char* ws = a.ws; OPQ(ws); WSP(float, sc, WS_SC); WSP(int, eid, WS_EID); WSP(float, gw, WS_GW); WSP(float, wact, WS_WACT); WSP(bf16_t, h, WS_H); float* out = a.out; OPQ(out);
          ph_peer_all(lds, (const short*)sc, eid, gw, (int*)(ws + WS_KMEAN), wact, (const bf16_t*)(ws + WS_XB), a.ffn_norm + l * DM, (const float*)(ws + WS_GAA), ws + WS_UQ + (size_t)l * NEXP * DM, (const float*)(ws + WS_SU) + (size_t)l * NEXP,
                      ws + WS_VQ + (size_t)l * NEXP * DM, (const float*)(ws + WS_SV) + (size_t)l * NEXP, out, (bf16_t*)(ws + WS_XB), l == NL - 1 ? a.final_norm : a.mix_norm + (l + 1) * DM, h, l == NL - 1 ? 1 : 0, l == 0 ? a.peer_u : nullptr, a.peer_v, ws + WS_UQ, (float*)(ws + WS_SU) + NEXP); }
        if (l + 1 < NL) GRID_BAR();
    }
}

extern "C" void kernel_launch(void* const* d_in, const int* in_sizes, int n_in, void* d_out, int out_size, void* d_ws, size_t ws_size, hipStream_t stream) {
    static int grid = 0;
    if (grid == 0) {
        if (n_in != 13 || ws_size < WS_END) { fprintf(stderr, "kernel_launch: unexpected inputs / workspace (%d, %zu)\n", n_in, ws_size); grid = -1; return; }
        int dev = 0, cus = 0, per_cu = 0;
        hipGetDevice(&dev); hipDeviceGetAttribute(&cus, hipDeviceAttributeMultiprocessorCount, dev);
        if (hipFuncSetAttribute((const void*)mk_fwd, hipFuncAttributeMaxDynamicSharedMemorySize, LDS_BYTES) != hipSuccess) { fprintf(stderr, "kernel_launch: hipFuncSetAttribute failed\n"); grid = -1; return; }
        if (hipOccupancyMaxActiveBlocksPerMultiprocessor(&per_cu, (const void*)mk_fwd, NTHR, LDS_BYTES) != hipSuccess || per_cu < 1) { fprintf(stderr, "kernel_launch: occupancy query says %d\n", per_cu); grid = -1; return; }
        grid = cus;
    }
    if (grid < 0) return;
    Args a{};
    a.x = (const float*)d_in[0]; a.mix_norm = (const float*)d_in[1]; a.w_in = (const float*)d_in[2]; a.w_pool = (const float*)d_in[3]; a.pool_scale = (const float*)d_in[4];
    a.w_up = (const float*)d_in[5]; a.w_out = (const float*)d_in[6]; a.ffn_norm = (const float*)d_in[7]; a.peer_wq = (const float*)d_in[8]; a.peer_keys = (const float*)d_in[9];
    a.peer_u = (const float*)d_in[10]; a.peer_v = (const float*)d_in[11]; a.final_norm = (const float*)d_in[12]; a.out = (float*)d_out; a.ws = (unsigned char*)d_ws;
    if (hipMemsetAsync((char*)d_ws + WS_CTL, 0, 65536, stream) != hipSuccess) { fprintf(stderr, "kernel_launch: memset failed\n"); return; }
    void* args[] = {&a};
    hipError_t e = hipLaunchCooperativeKernel((const void*)mk_fwd, dim3(grid), dim3(NTHR), args, LDS_BYTES, stream);
    if (e != hipSuccess) fprintf(stderr, "kernel_launch: cooperative launch failed: %s (grid %d)\n", hipGetErrorString(e), grid);
}
```

```cpp
#include <hip/hip_runtime.h>
#include <hip/hip_cooperative_groups.h>
namespace cg = cooperative_groups;
#include <stdint.h>
#include <cstdio>
#include <type_traits>

typedef unsigned short bf16_t;
typedef float f32x4 __attribute__((ext_vector_type(4)));
typedef unsigned u32x4 __attribute__((ext_vector_type(4)));
typedef unsigned u32x2 __attribute__((ext_vector_type(2)));

constexpr int NB = 8, SEQ = 2048, DM = 1024, T = NB * SEQ, NL = 2;
constexpr int INW = 4096, PW = 512, AW = 512, NH = 8, HD = 64, MBLK = 256, NBLK = SEQ / MBLK;
constexpr int PH = 8, NKEY = 128, QD = 256, PK = 16, NEXP = NKEY * NKEY, PQW = PH * QD;
constexpr int NSLOT = PH * PK;
constexpr float EPS = 1e-6f;
constexpr float LOG2E = 1.4426950408889634f;
constexpr float C2 = 0.125f * LOG2E;

constexpr size_t MiB = 1u << 20;
constexpr size_t WS_CTL = 0, WS_KMEAN = 1 * MiB, WS_WPOOL = 2 * MiB, WS_WUP = 4 * MiB, WS_WOUT = 6 * MiB, WS_WPEER = 10 * MiB, WS_WIN = 18 * MiB;
constexpr size_t WS_UB = 34 * MiB, WS_VB = 98 * MiB, WS_H = 162 * MiB, WS_Z = 194 * MiB, WS_SC = 194 * MiB;
constexpr size_t WS_M = 322 * MiB, WS_O = 338 * MiB, WS_MRG = 354 * MiB, WS_GAA = 386 * MiB, WS_EID = 418 * MiB, WS_GW = 426 * MiB, WS_WACT = 434 * MiB, WS_END = 442 * MiB;

__device__ __forceinline__ float bf2f(bf16_t v) { return __uint_as_float(((unsigned)v) << 16); }
__device__ __forceinline__ unsigned f2bf(float f) { unsigned u = __float_as_uint(f); return (u + 0x7fffu + ((u >> 16) & 1u)) >> 16; }
typedef float f32x2_pk __attribute__((ext_vector_type(2))); typedef __bf16 bf16x2_pk __attribute__((ext_vector_type(2)));
__device__ __forceinline__ unsigned pk2(float lo, float hi) { f32x2_pk v = {lo, hi}; bf16x2_pk b = __builtin_convertvector(v, bf16x2_pk); return __builtin_bit_cast(unsigned, b); }
__device__ __forceinline__ float lo16(unsigned w) { return __uint_as_float(w << 16); }
__device__ __forceinline__ float hi16(unsigned w) { return __uint_as_float(w & 0xffff0000u); }
__device__ __forceinline__ float wave_sum(float v) {
#pragma unroll
    for (int o = 1; o < 64; o <<= 1) v += __shfl_xor(v, o);
    return v;
}
__device__ __forceinline__ float wave_max(float v) {
#pragma unroll
    for (int o = 1; o < 64; o <<= 1) v = fmaxf(v, __shfl_xor(v, o));
    return v;
}
__device__ __forceinline__ int opq_tid() { int t = threadIdx.x; asm volatile("" : "+v"(t)); return t; }
__device__ __forceinline__ int ldcg(const int* p) { return __hip_atomic_load(p, __ATOMIC_RELAXED, __HIP_MEMORY_SCOPE_AGENT); }
__device__ __forceinline__ float ldcg(const float* p) { return __hip_atomic_load(p, __ATOMIC_RELAXED, __HIP_MEMORY_SCOPE_AGENT); }
__device__ __forceinline__ float gelu_tanh(float x) {
    const float u = 0.7978845608028654f * (x + 0.044715f * x * x * x);
    const float e = __expf(2.f * u);
    const float th = 1.f - 2.f / (e + 1.f);
    return 0.5f * x * (1.f + th);
}

struct EpiZ {
    bf16_t* z;
    __device__ __forceinline__ void operator()(int row, int col0, f32x4 v) const {
        if (col0 >= 2048) { v.x = 1.f / (1.f + __expf(-v.x)); v.y = 1.f / (1.f + __expf(-v.y)); v.z = 1.f / (1.f + __expf(-v.z)); v.w = 1.f / (1.f + __expf(-v.w)); }
        else if (col0 >= 512 && col0 < 1024) { v = v * C2; }
        u32x2 o; o.x = pk2(v.x, v.y); o.y = pk2(v.z, v.w); *(u32x2*)(z + (size_t)row * INW + col0) = o;
    }
};
struct EpiPool {
    const bf16_t* z; const float* pscale; bf16_t* gaa;
    __device__ __forceinline__ void operator()(int row, int col0, f32x4 v) const {
        const u32x2 g = *(const u32x2*)(z + (size_t)row * INW + 2048 + col0); const f32x4 ps = *(const f32x4*)(pscale + col0);
        u32x2 o; o.x = pk2(v.x * ps.x * lo16(g.x), v.y * ps.y * hi16(g.x)); o.y = pk2(v.z * ps.z * lo16(g.y), v.w * ps.w * hi16(g.y));
        *(u32x2*)(gaa + (size_t)row * DM + col0) = o;
    }
};
struct EpiUp {
    const bf16_t* z; const bf16_t* gaa; bf16_t* mrg;
    __device__ __forceinline__ void operator()(int row, int col0, f32x4 v) const {
        const u32x2 g = *(const u32x2*)(z + (size_t)row * INW + 3072 + col0); const u32x2 a = *(const u32x2*)(gaa + (size_t)row * DM + col0);
        u32x2 o; o.x = pk2(lo16(a.x) + v.x * lo16(g.x), hi16(a.x) + v.y * hi16(g.x)); o.y = pk2(lo16(a.y) + v.z * lo16(g.y), hi16(a.y) + v.w * hi16(g.y));
        *(u32x2*)(mrg + (size_t)row * DM + col0) = o;
    }
};
struct EpiRes {
    const float* xin; float* xout;
    __device__ __forceinline__ void operator()(int row, int col0, f32x4 v) const {
        const f32x4 b = *(const f32x4*)(xin + (size_t)row * DM + col0); *(f32x4*)(xout + (size_t)row * DM + col0) = b + v;
    }
};
struct EpiF32 {
    float* out; int ldc;
    __device__ __forceinline__ void operator()(int row, int col0, f32x4 v) const { *(f32x4*)(out + (size_t)row * ldc + col0) = v; }
};

__device__ __forceinline__ float sigm(float v) { return __builtin_amdgcn_rcpf(1.f + __expf(-v)); }
struct EpiZ8 {
    bf16_t* z;
    __device__ __forceinline__ void operator()(int row, int col0, f32x4 a, f32x4 b) const {
        if (col0 >= 2048) { a.x = sigm(a.x); a.y = sigm(a.y); a.z = sigm(a.z); a.w = sigm(a.w); b.x = sigm(b.x); b.y = sigm(b.y); b.z = sigm(b.z); b.w = sigm(b.w); }
        else if (col0 >= 512 && col0 < 1024) { a = a * C2; b = b * C2; }
        u32x4 o; o.x = pk2(a.x, a.y); o.y = pk2(a.z, a.w); o.z = pk2(b.x, b.y); o.w = pk2(b.z, b.w); *(u32x4*)(z + (size_t)row * INW + col0) = o;
    }
};
struct EpiPool8 {
    const bf16_t* z; const float* pscale; bf16_t* gaa;
    __device__ __forceinline__ void operator()(int row, int col0, f32x4 a, f32x4 b) const {
        const u32x4 g = *(const u32x4*)(z + (size_t)row * INW + 2048 + col0); const f32x4 p0 = *(const f32x4*)(pscale + col0), p1 = *(const f32x4*)(pscale + col0 + 4);
        u32x4 o; o.x = pk2(a.x * p0.x * lo16(g.x), a.y * p0.y * hi16(g.x)); o.y = pk2(a.z * p0.z * lo16(g.y), a.w * p0.w * hi16(g.y));
        o.z = pk2(b.x * p1.x * lo16(g.z), b.y * p1.y * hi16(g.z)); o.w = pk2(b.z * p1.z * lo16(g.w), b.w * p1.w * hi16(g.w));
        *(u32x4*)(gaa + (size_t)row * DM + col0) = o;
    }
};
struct EpiUp8 {
    const bf16_t* z; const bf16_t* gaa; bf16_t* mrg;
    __device__ __forceinline__ void operator()(int row, int col0, f32x4 a, f32x4 b) const {
        const u32x4 g = *(const u32x4*)(z + (size_t)row * INW + 3072 + col0); const u32x4 q = *(const u32x4*)(gaa + (size_t)row * DM + col0);
        u32x4 o; o.x = pk2(lo16(q.x) + a.x * lo16(g.x), hi16(q.x) + a.y * hi16(g.x)); o.y = pk2(lo16(q.y) + a.z * lo16(g.y), hi16(q.y) + a.w * hi16(g.y));
        o.z = pk2(lo16(q.z) + b.x * lo16(g.z), hi16(q.z) + b.y * hi16(g.z)); o.w = pk2(lo16(q.w) + b.z * lo16(g.w), hi16(q.w) + b.w * hi16(g.w));
        *(u32x4*)(mrg + (size_t)row * DM + col0) = o;
    }
};


namespace pg8 {
#define PG8_LAS __attribute__((address_space(3)))
typedef unsigned short bf16_t;
typedef short bf16x8 __attribute__((ext_vector_type(8)));
typedef float f32x4 __attribute__((ext_vector_type(4)));
typedef unsigned u32x4 __attribute__((ext_vector_type(4)));
constexpr int BM = 256, BK = 64, HALF = 128, HTB = HALF * BK * 2  , STAGE_BYTES = 8 * HTB, NXCD = 8, WGM = 4;

__host__ __device__ __forceinline__ int lds_byte(int r, int c) { const int st = (r >> 4) * 2 + (c >> 5), rr = r & 15, cc = c & 31, ob = rr * 64 + cc * 2; return st * 1024 + (ob ^ (((ob >> 9) & 1) << 5)); }
__host__ __device__ __forceinline__ void stage_rc(int b, int& R, int& C) { const int st = b / 1024, sb = b % 1024, swz = sb ^ (((sb >> 9) & 1) << 5); R = (st >> 1) * 16 + swz / 64; C = (st & 1) * 32 + (swz % 64) / 2; }
__host__ __device__ __forceinline__ int perm32(int rho) { const int n = rho >> 4, i = rho & 15; return 8 * (i >> 2) + 4 * n + (i & 3); }

struct Unit { int pm, pn; };
struct Gemm { const bf16_t* A; const bf16_t* Bt; int M, N, K, lda, ldb, a_pn_off; };

struct StaticOrder {
    int nM, nN, nwg, G, c;
    __host__ __device__ void init(int M, int N, int G_, int c_) { nM = M / BM; nN = N / BM; nwg = nM * nN; G = G_; c = c_; }
    __host__ __device__ bool next(int i, Unit& u) const {
        const long L = (long)i * G + c; if (L >= nwg) return false;
        int wgid = (int)L; { const int q = nwg / NXCD, r = nwg % NXCD, xcd = wgid % NXCD, off = wgid / NXCD; wgid = (xcd < r ? xcd * (q + 1) : r * (q + 1) + (xcd - r) * q) + off; }
        const int nig = WGM * nN, gid = wgid / nig, fm = gid * WGM, gsz = (nM - fm) < WGM ? (nM - fm) : WGM;
        u.pm = fm + ((wgid % nig) % gsz); u.pn = (wgid % nig) / gsz; return true;
    }
    __device__ __forceinline__ void a_ready(const Unit&) const {}
    __device__ __forceinline__ void done(const Unit&) const {}
};
template <class Epi, class Sched, bool ALIGN_EPI = false, bool SP2 = false>
__device__ __forceinline__ void gemm_phase(PG8_LAS unsigned char* lds, const Gemm g, const Sched& S, const Epi& E) {
    const int tid = opq_tid(), wid = __builtin_amdgcn_readfirstlane(tid >> 6), lane = tid & 63, wr = wid >> 2, wc = wid & 3, fr = lane & 15, fq = lane >> 4;
    const int K = g.K, nt = K / BK;
    unsigned voffA[2], voffB[2];
#pragma unroll
    for (int i = 0; i < 2; ++i) { int R, C; stage_rc(tid * 16 + i * 8192, R, C); const int Rb = Epi::PERM ? ((R & ~31) + perm32(R & 31)) : R;
        voffA[i] = (unsigned)(R * g.lda + C) * 2u; voffB[i] = (unsigned)(Rb * g.ldb + C) * 2u; }
    const size_t kstep = (size_t)(BK * 2);
    const size_t hstepA = (size_t)HALF * g.lda * 2, hstepB = (size_t)HALF * g.ldb * 2;
    const size_t tstepA = 2 * hstepA, tstepB = 2 * hstepB; const size_t pnoff = (size_t)g.a_pn_off * 2;
    const unsigned ldsw = (unsigned)wid * 1024u;
    const int aoff = lds_byte(wr * 64 + fr, fq * 8), boff = lds_byte(wc * 32 + fr, fq * 8);
#define PG8_SA(b, h) (((b) * 2 + (h)) * HTB)
#define PG8_SB(b, h) ((4 + (b) * 2 + (h)) * HTB)
#define PG8_STAGE(bufoff, gbase, voff) do { _Pragma("unroll") for (int _i = 0; _i < 2; ++_i) \
        __builtin_amdgcn_global_load_lds((const unsigned*)((const char*)(gbase) + (voff)[_i]), (PG8_LAS unsigned*)(lds + (bufoff) + ldsw + _i * 8192), 16, 0, 0); } while (0)
#define PG8_LDA(dst, b, h) do { _Pragma("unroll") for (int m = 0; m < 4; ++m) _Pragma("unroll") for (int k = 0; k < 2; ++k) dst[m][k] = *(const PG8_LAS bf16x8*)(lds + PG8_SA(b, h) + aoff + m * 2048 + k * 1024); } while (0)
#define PG8_LDB(dst, b, h) do { _Pragma("unroll") for (int n = 0; n < 2; ++n) _Pragma("unroll") for (int k = 0; k < 2; ++k) dst[n][k] = *(const PG8_LAS bf16x8*)(lds + PG8_SB(b, h) + boff + n * 2048 + k * 1024); } while (0)
#define PG8_MMA(ai, bj, At, Bt) do { __builtin_amdgcn_s_setprio(1); _Pragma("unroll") for (int m = 0; m < 4; ++m) _Pragma("unroll") for (int n = 0; n < 2; ++n) _Pragma("unroll") for (int k = 0; k < 2; ++k) \
        acc[ai][bj][m][n] = __builtin_amdgcn_mfma_f32_16x16x32_bf16(Bt[n][k], At[m][k], acc[ai][bj][m][n], 0, 0, 0); __builtin_amdgcn_s_setprio(0); } while (0)
#define PG8_WAIT_V(n) asm volatile("s_waitcnt vmcnt(" #n ")" ::: "memory")
#define PG8_WAIT_L(n) asm volatile("s_waitcnt lgkmcnt(" #n ")" ::: "memory")
#define PG8_BAR __builtin_amdgcn_s_barrier()
#define PG8_SCHED __builtin_amdgcn_sched_barrier(0)
    Unit cur, nxt; int ui = 0;
    if (!S.next(0, cur)) return;
    f32x4 acc[2][2][4][2];
#pragma unroll
    for (int a = 0; a < 2; ++a)
#pragma unroll
        for (int b = 0; b < 2; ++b)
#pragma unroll
            for (int m = 0; m < 4; ++m)
#pragma unroll
                for (int n = 0; n < 2; ++n) acc[a][b][m][n] = (f32x4){0.f, 0.f, 0.f, 0.f};
    bf16x8 At[4][2], B0[2][2], B1[2][2];
    const char* cA = (const char*)g.A + (size_t)cur.pm * tstepA + (size_t)cur.pn * pnoff; const char* cB = (const char*)g.Bt + (size_t)cur.pn * tstepB;
    S.a_ready(cur);
    if constexpr (SP2) {
        PG8_STAGE(PG8_SB(0, 0), cB, voffB); PG8_STAGE(PG8_SB(0, 1), cB + hstepB, voffB); PG8_STAGE(PG8_SA(0, 0), cA, voffA); PG8_STAGE(PG8_SA(0, 1), cA + hstepA, voffA);
        if (wr == 1) PG8_BAR;
        PG8_WAIT_V(2); PG8_BAR;
        PG8_STAGE(PG8_SB(1, 0), cB + kstep, voffB); PG8_STAGE(PG8_SA(1, 0), cA + kstep, voffA); PG8_STAGE(PG8_SB(1, 1), cB + hstepB + kstep, voffB);
        PG8_WAIT_V(6); PG8_BAR;
    } else {
        PG8_STAGE(PG8_SB(0, 0), cB, voffB); PG8_STAGE(PG8_SA(0, 0), cA, voffA); PG8_STAGE(PG8_SB(0, 1), cB + hstepB, voffB); PG8_STAGE(PG8_SA(0, 1), cA + hstepA, voffA);
        if (wr == 1) PG8_BAR;
        PG8_WAIT_V(4); PG8_BAR;
        PG8_STAGE(PG8_SB(1, 0), cB + kstep, voffB); PG8_STAGE(PG8_SA(1, 0), cA + kstep, voffA); PG8_STAGE(PG8_SB(1, 1), cB + hstepB + kstep, voffB);
        PG8_WAIT_V(6); PG8_BAR;
    }
    for (;;) {
        const bool has_next = S.next(ui + 1, nxt);
        const char* nA = has_next ? (const char*)g.A + (size_t)nxt.pm * tstepA + (size_t)nxt.pn * pnoff : cA; const char* nB = has_next ? (const char*)g.Bt + (size_t)nxt.pn * tstepB : cB;
        for (int t = 0; t < nt; t += 2) {
            const bool last = (t == nt - 2);
            const char* a1 = cA + (size_t)(t + 1) * kstep;
            const char* a2 = last ? nA : cA + (size_t)(t + 2) * kstep; const char* b2 = last ? nB : cB + (size_t)(t + 2) * kstep;
            const char* a3 = a2 + kstep; const char* b3 = b2 + kstep;
            if (last && has_next) S.a_ready(nxt);
            if constexpr (SP2) {
            PG8_LDB(B0, 0, 0); PG8_LDB(B1, 0, 1); PG8_SCHED; PG8_LDA(At, 0, 0); PG8_STAGE(PG8_SA(1, 1), a1 + hstepA, voffA);
            PG8_WAIT_V(8); PG8_WAIT_L(0); PG8_BAR; PG8_MMA(0, 0, At, B0); PG8_MMA(0, 1, At, B1); PG8_BAR; PG8_SCHED;
            PG8_LDA(At, 0, 1); PG8_STAGE(PG8_SB(0, 0), b2, voffB); PG8_STAGE(PG8_SB(0, 1), b2 + hstepB, voffB); PG8_STAGE(PG8_SA(0, 0), a2, voffA);
            PG8_WAIT_V(8); PG8_WAIT_L(0); PG8_BAR; PG8_MMA(1, 0, At, B0); PG8_MMA(1, 1, At, B1); PG8_BAR; PG8_SCHED;
            PG8_LDB(B0, 1, 0); PG8_LDB(B1, 1, 1); PG8_SCHED; PG8_LDA(At, 1, 0); PG8_STAGE(PG8_SA(0, 1), a2 + hstepA, voffA);
            PG8_WAIT_V(8); PG8_WAIT_L(0); PG8_BAR; PG8_MMA(0, 0, At, B0); PG8_MMA(0, 1, At, B1); PG8_BAR; PG8_SCHED;
            PG8_LDA(At, 1, 1); PG8_STAGE(PG8_SB(1, 0), b3, voffB); PG8_STAGE(PG8_SB(1, 1), b3 + hstepB, voffB); PG8_STAGE(PG8_SA(1, 0), a3, voffA);
            PG8_WAIT_V(8); PG8_WAIT_L(0); PG8_BAR; PG8_MMA(1, 0, At, B0); PG8_MMA(1, 1, At, B1); PG8_BAR; PG8_SCHED;
            } else {
            PG8_LDB(B0, 0, 0); PG8_SCHED; PG8_LDA(At, 0, 0); PG8_STAGE(PG8_SA(1, 1), a1 + hstepA, voffA);
            PG8_WAIT_L(8); PG8_BAR; PG8_WAIT_L(0); PG8_MMA(0, 0, At, B0); PG8_BAR; PG8_SCHED;
            PG8_LDB(B1, 0, 1); PG8_STAGE(PG8_SB(0, 0), b2, voffB);
            PG8_BAR; PG8_WAIT_L(0); PG8_MMA(0, 1, At, B1); PG8_BAR;
            PG8_LDA(At, 0, 1); PG8_STAGE(PG8_SA(0, 0), a2, voffA);
            PG8_BAR; PG8_WAIT_L(0); PG8_MMA(1, 0, At, B0); PG8_BAR; PG8_SCHED;
            PG8_STAGE(PG8_SB(0, 1), b2 + hstepB, voffB);
            PG8_WAIT_V(6); PG8_BAR; PG8_MMA(1, 1, At, B1); PG8_BAR;
            PG8_LDB(B0, 1, 0); PG8_SCHED; PG8_LDA(At, 1, 0); PG8_STAGE(PG8_SA(0, 1), a2 + hstepA, voffA);
            PG8_WAIT_L(8); PG8_BAR; PG8_WAIT_L(0); PG8_MMA(0, 0, At, B0); PG8_BAR; PG8_SCHED;
            PG8_LDB(B1, 1, 1); PG8_STAGE(PG8_SB(1, 0), b3, voffB);
            PG8_BAR; PG8_WAIT_L(0); PG8_MMA(0, 1, At, B1); PG8_BAR;
            PG8_LDA(At, 1, 1); PG8_STAGE(PG8_SA(1, 0), a3, voffA);
            PG8_BAR; PG8_WAIT_L(0); PG8_MMA(1, 0, At, B0); PG8_BAR; PG8_SCHED;
            PG8_STAGE(PG8_SB(1, 1), b3 + hstepB, voffB);
            PG8_WAIT_V(6); PG8_BAR; PG8_MMA(1, 1, At, B1); PG8_BAR;
            }
        }
        if constexpr (ALIGN_EPI) { if (wr == 0) PG8_BAR; }
        if constexpr (!Epi::AFTER_DRAIN) { E(acc, cur, wr, wc, fr, fq); S.done(cur); }
        if (!has_next) break;
#pragma unroll
        for (int a = 0; a < 2; ++a)
#pragma unroll
            for (int b = 0; b < 2; ++b)
#pragma unroll
                for (int m = 0; m < 4; ++m)
#pragma unroll
                    for (int n = 0; n < 2; ++n) acc[a][b][m][n] = (f32x4){0.f, 0.f, 0.f, 0.f};
        cur = nxt; cA = nA; cB = nB; ++ui;
        if constexpr (ALIGN_EPI) { if (wr == 1) PG8_BAR; }
    }
    PG8_WAIT_V(0);
    if constexpr (!ALIGN_EPI) { if (wr == 0) PG8_BAR; }
    PG8_BAR;
    if constexpr (Epi::AFTER_DRAIN) { E.fused(acc, cur, wr, wc, fr, fq, lds, wid, lane); S.done(cur); }
#undef PG8_SA
#undef PG8_SB
#undef PG8_STAGE
#undef PG8_LDA
#undef PG8_LDB
#undef PG8_MMA
#undef PG8_WAIT_V
#undef PG8_WAIT_L
#undef PG8_BAR
#undef PG8_SCHED
}
}

template <class F> struct EpiAdapt {
    static constexpr bool PERM = false, AFTER_DRAIN = false;
    F f;
    __device__ __forceinline__ void operator()(const pg8::f32x4 (&acc)[2][2][4][2], const pg8::Unit& u, int wr, int wc, int fr, int fq) const {
        const int row0 = u.pm * 256 + wr * 64 + fr, col0 = u.pn * 256 + wc * 32 + 4 * fq;
#pragma unroll
        for (int ai = 0; ai < 2; ++ai)
#pragma unroll
            for (int m = 0; m < 4; ++m)
#pragma unroll
                for (int bj = 0; bj < 2; ++bj)
#pragma unroll
                    for (int n = 0; n < 2; ++n) { f(row0 + ai * 128 + m * 16, col0 + bj * 128 + n * 16, acc[ai][bj][m][n]); asm volatile("" ::: "memory"); }
    }
};
template <class F, bool ALIGN> __device__ __forceinline__ void ph_gemm(unsigned char* lds, const bf16_t* A, int lda, const bf16_t* Bt, int ldb, int N, int K, F f) {
    pg8::Gemm g{A, Bt, T, N, K, lda, ldb, 0}; pg8::StaticOrder S; S.init(T, N, (int)gridDim.x, (int)blockIdx.x);
    pg8::gemm_phase<EpiAdapt<F>, pg8::StaticOrder, ALIGN, true>((PG8_LAS unsigned char*)lds, g, S, EpiAdapt<F>{f});
}

template <class F> struct EpiAdapt8 {
    static constexpr bool PERM = true, AFTER_DRAIN = false;
    F f;
    __device__ __forceinline__ void operator()(const pg8::f32x4 (&acc)[2][2][4][2], const pg8::Unit& u, int wr, int wc, int fr, int fq) const {
        const int row0 = u.pm * 256 + wr * 64 + fr, col0 = u.pn * 256 + wc * 32 + 8 * fq;
#pragma unroll
        for (int ai = 0; ai < 2; ++ai)
#pragma unroll
            for (int m = 0; m < 4; ++m)
#pragma unroll
                for (int bj = 0; bj < 2; ++bj) { f(row0 + ai * 128 + m * 16, col0 + bj * 128, acc[ai][bj][m][0], acc[ai][bj][m][1]); asm volatile("" ::: "memory"); }
    }
};
template <class F, bool ALIGN> __device__ __forceinline__ void ph_gemm8(unsigned char* lds, const bf16_t* A, int lda, const bf16_t* Bt, int ldb, int N, int K, F f) {
    pg8::Gemm g{A, Bt, T, N, K, lda, ldb, 0}; pg8::StaticOrder S; S.init(T, N, (int)gridDim.x, (int)blockIdx.x);
    pg8::gemm_phase<EpiAdapt8<F>, pg8::StaticOrder, ALIGN, true>((PG8_LAS unsigned char*)lds, g, S, EpiAdapt8<F>{f});
}

__device__ __forceinline__ float rstd_of(const float* rowsq, size_t row) {
    const f32x4* p = (const f32x4*)(rowsq + row * 16); const f32x4 a = p[0], b = p[1], c = p[2], d = p[3];
    return rsqrtf((((a.x + a.y) + (a.z + a.w)) + ((b.x + b.y) + (b.z + b.w)) + ((c.x + c.y) + (c.z + c.w)) + ((d.x + d.y) + (d.z + d.w))) * (1.f / DM) + EPS);
}
struct EpiResNorm {
    static constexpr bool PERM = true, AFTER_DRAIN = false;
    const float* xin; const bf16_t* xbin; bf16_t* xb; bf16_t* xg; const float* g; float* rowsq; int use_xb;
    __device__ __forceinline__ void operator()(const pg8::f32x4 (&acc)[2][2][4][2], const pg8::Unit& u, int wr, int wc, int fr, int fq) const {
        const int row0 = u.pm * 256 + wr * 64 + fr, col0 = u.pn * 256 + wc * 32 + 8 * fq;
#pragma unroll
        for (int ai = 0; ai < 2; ++ai)
#pragma unroll
            for (int m = 0; m < 4; ++m) { const int row = row0 + ai * 128 + m * 16; float s = 0.f;
#pragma unroll
                for (int bj = 0; bj < 2; ++bj) { const int col = col0 + bj * 128; f32x4 x0, x1;
                    if (use_xb) { const u32x4 w = *(const u32x4*)(xbin + (size_t)row * DM + col); x0 = (f32x4){lo16(w.x), hi16(w.x), lo16(w.y), hi16(w.y)}; x1 = (f32x4){lo16(w.z), hi16(w.z), lo16(w.w), hi16(w.w)}; }
                    else { x0 = *(const f32x4*)(xin + (size_t)row * DM + col); x1 = *(const f32x4*)(xin + (size_t)row * DM + col + 4); }
                    f32x4 v0 = acc[ai][bj][m][0] + x0, v1 = acc[ai][bj][m][1] + x1;
                    u32x4 ox; ox.x = pk2(v0.x, v0.y); ox.y = pk2(v0.z, v0.w); ox.z = pk2(v1.x, v1.y); ox.w = pk2(v1.z, v1.w); *(u32x4*)(xb + (size_t)row * DM + col) = ox;
                    v0 = (f32x4){lo16(ox.x), hi16(ox.x), lo16(ox.y), hi16(ox.y)}; v1 = (f32x4){lo16(ox.z), hi16(ox.z), lo16(ox.w), hi16(ox.w)};
                    const f32x4 g0 = *(const f32x4*)(g + col), g1 = *(const f32x4*)(g + col + 4);
                    u32x4 o; o.x = pk2(v0.x * g0.x, v0.y * g0.y); o.y = pk2(v0.z * g0.z, v0.w * g0.w); o.z = pk2(v1.x * g1.x, v1.y * g1.y); o.w = pk2(v1.z * g1.z, v1.w * g1.w); *(u32x4*)(xg + (size_t)row * DM + col) = o;
                    s += (v0.x * v0.x + v0.y * v0.y + v0.z * v0.z + v0.w * v0.w) + (v1.x * v1.x + v1.y * v1.y + v1.z * v1.z + v1.w * v1.w); }
                s += __shfl_xor(s, 16); s += __shfl_xor(s, 32);
                if (fq == 0) rowsq[(size_t)row * 16 + u.pn * 4 + wc] = s;
                asm volatile("" ::: "memory"); }
    }
};
struct EpiI16s {
    static constexpr bool PERM = true, AFTER_DRAIN = false;
    short* out; const float* rowsq;
    __device__ __forceinline__ static unsigned q2(float a, float b) { const int ia = (int)__builtin_rintf(fminf(fmaxf(a, -32767.f), 32767.f)), ib = (int)__builtin_rintf(fminf(fmaxf(b, -32767.f), 32767.f)); return ((unsigned)ia & 0xffffu) | ((unsigned)ib << 16); }
    __device__ __forceinline__ void operator()(const pg8::f32x4 (&acc)[2][2][4][2], const pg8::Unit& u, int wr, int wc, int fr, int fq) const {
        const int rloc = wr * 64 + fr, row0 = u.pm * 256 + rloc, col0 = u.pn * 256 + wc * 32 + 8 * fq;
        constexpr int ldc = PQW; const PG8_LAS float* rl = (const PG8_LAS float*)131072u; const PG8_LAS int* tg = (const PG8_LAS int*)133120u;
        const int sel = (u.pm == tg[0]) ? 0 : ((u.pm == tg[1]) ? 256 : -1);
#pragma unroll
        for (int ai = 0; ai < 2; ++ai)
#pragma unroll
            for (int m = 0; m < 4; ++m) { const int row = row0 + ai * 128 + m * 16; const float r = ((sel >= 0) ? rl[sel + rloc + ai * 128 + m * 16] : rstd_of(rowsq, (size_t)row)) * 2048.f;
#pragma unroll
                for (int bj = 0; bj < 2; ++bj) { const f32x4 a = acc[ai][bj][m][0] * r, b = acc[ai][bj][m][1] * r;
                    *(u32x4*)(out + (size_t)row * ldc + col0 + bj * 128) = (u32x4){q2(a.x, a.y), q2(a.z, a.w), q2(b.x, b.y), q2(b.z, b.w)}; } }
    }
};

template <class F, int MB = 4> struct EpiAdapt8L {
    static constexpr bool PERM = true, AFTER_DRAIN = false;
    F f;
    __device__ __forceinline__ void operator()(const pg8::f32x4 (&acc)[2][2][4][2], const pg8::Unit& u, int wr, int wc, int fr, int fq) const {
        const int row0 = u.pm * 256 + wr * 64 + fr, col0 = u.pn * 256 + wc * 32 + 8 * fq;
        typename F::C cc[2];
#pragma unroll
        for (int bj = 0; bj < 2; ++bj) cc[bj] = f.cols(col0 + bj * 128);
#pragma unroll
        for (int ai = 0; ai < 2; ++ai)
#pragma unroll
          for (int mb = 0; mb < 4; mb += MB) {
            typename F::L ld[MB][2];
#pragma unroll
            for (int m = 0; m < MB; ++m)
#pragma unroll
                for (int bj = 0; bj < 2; ++bj) ld[m][bj] = f.load(row0 + ai * 128 + (mb + m) * 16, col0 + bj * 128);
#pragma unroll
            for (int m = 0; m < MB; ++m) { float s = 0.f;
#pragma unroll
                for (int bj = 0; bj < 2; ++bj) s += f.apply(row0 + ai * 128 + (mb + m) * 16, col0 + bj * 128, acc[ai][bj][mb + m][0], acc[ai][bj][mb + m][1], ld[m][bj], cc[bj]);
                f.rowdone(row0 + ai * 128 + (mb + m) * 16, u.pn, wc, fq, s); }
            asm volatile("" ::: "memory");
          }
    }
};
struct EpiPool8L {
    const bf16_t* z; const float* pscale; bf16_t* gaa;
    struct L { u32x4 g; }; struct C { f32x4 p0, p1; };
    __device__ __forceinline__ C cols(int col) const { C c; c.p0 = *(const f32x4*)(pscale + col); c.p1 = *(const f32x4*)(pscale + col + 4); return c; }
    __device__ __forceinline__ L load(int row, int col) const { L l; l.g = *(const u32x4*)(z + (size_t)row * INW + 2048 + col); return l; }
    __device__ __forceinline__ float apply(int row, int col, f32x4 a, f32x4 b, const L& l, const C& c) const {
        u32x4 o; o.x = pk2(a.x * c.p0.x * lo16(l.g.x), a.y * c.p0.y * hi16(l.g.x)); o.y = pk2(a.z * c.p0.z * lo16(l.g.y), a.w * c.p0.w * hi16(l.g.y));
        o.z = pk2(b.x * c.p1.x * lo16(l.g.z), b.y * c.p1.y * hi16(l.g.z)); o.w = pk2(b.z * c.p1.z * lo16(l.g.w), b.w * c.p1.w * hi16(l.g.w));
        *(u32x4*)(gaa + (size_t)row * DM + col) = o; return 0.f; }
    __device__ __forceinline__ void rowdone(int, int, int, int, float) const {}
};
struct EpiUp8L {
    const bf16_t* z; const bf16_t* gaa; bf16_t* mrg;
    struct L { u32x4 g, q; }; struct C { int dummy; };
    __device__ __forceinline__ C cols(int) const { C c; c.dummy = 0; return c; }
    __device__ __forceinline__ L load(int row, int col) const { L l; l.g = *(const u32x4*)(z + (size_t)row * INW + 3072 + col); l.q = *(const u32x4*)(gaa + (size_t)row * DM + col); return l; }
    __device__ __forceinline__ float apply(int row, int col, f32x4 a, f32x4 b, const L& l, const C&) const {
        u32x4 o; o.x = pk2(lo16(l.q.x) + a.x * lo16(l.g.x), hi16(l.q.x) + a.y * hi16(l.g.x)); o.y = pk2(lo16(l.q.y) + a.z * lo16(l.g.y), hi16(l.q.y) + a.w * hi16(l.g.y));
        o.z = pk2(lo16(l.q.z) + b.x * lo16(l.g.z), hi16(l.q.z) + b.y * hi16(l.g.z)); o.w = pk2(lo16(l.q.w) + b.z * lo16(l.g.w), hi16(l.q.w) + b.w * hi16(l.g.w));
        *(u32x4*)(mrg + (size_t)row * DM + col) = o; return 0.f; }
    __device__ __forceinline__ void rowdone(int, int, int, int, float) const {}
};
template <bool XB> struct EpiResNormL {
    const float* xin; const bf16_t* xbin; bf16_t* xb; float* rowsq;
    struct LB { u32x4 w; }; struct LF { f32x4 x0, x1; }; typedef typename std::conditional<XB, LB, LF>::type L; struct C { int dummy; };
    __device__ __forceinline__ C cols(int) const { C c; c.dummy = 0; return c; }
    __device__ __forceinline__ L load(int row, int col) const { L l;
        if constexpr (XB) { l.w = *(const u32x4*)(xbin + (size_t)row * DM + col); } else { l.x0 = *(const f32x4*)(xin + (size_t)row * DM + col); l.x1 = *(const f32x4*)(xin + (size_t)row * DM + col + 4); }
        return l; }
    __device__ __forceinline__ float apply(int row, int col, f32x4 a, f32x4 b, const L& l, const C&) const {
        f32x4 v0, v1;
        if constexpr (XB) { v0 = a + (f32x4){lo16(l.w.x), hi16(l.w.x), lo16(l.w.y), hi16(l.w.y)}; v1 = b + (f32x4){lo16(l.w.z), hi16(l.w.z), lo16(l.w.w), hi16(l.w.w)}; } else { v0 = a + l.x0; v1 = b + l.x1; }
        u32x4 ox; ox.x = pk2(v0.x, v0.y); ox.y = pk2(v0.z, v0.w); ox.z = pk2(v1.x, v1.y); ox.w = pk2(v1.z, v1.w); *(u32x4*)(xb + (size_t)row * DM + col) = ox;
        v0 = (f32x4){lo16(ox.x), hi16(ox.x), lo16(ox.y), hi16(ox.y)}; v1 = (f32x4){lo16(ox.z), hi16(ox.z), lo16(ox.w), hi16(ox.w)};
        return (v0.x * v0.x + v0.y * v0.y + v0.z * v0.z + v0.w * v0.w) + (v1.x * v1.x + v1.y * v1.y + v1.z * v1.z + v1.w * v1.w); }
    __device__ __forceinline__ void rowdone(int row, int pn, int wc, int fq, float s) const { s += __shfl_xor(s, 16); s += __shfl_xor(s, 32); if (fq == 0) rowsq[(size_t)row * 16 + pn * 4 + wc] = s; }
};

struct EpiZk {
    static constexpr bool PERM = true, AFTER_DRAIN = false;
    bf16_t* z; float* kmean;
    __device__ __forceinline__ void operator()(const pg8::f32x4 (&acc)[2][2][4][2], const pg8::Unit& u, int wr, int wc, int fr, int fq) const {
        const int row0 = u.pm * 256 + wr * 64 + fr, col0 = u.pn * 256 + wc * 32 + 8 * fq; const EpiZ8 f{z};
#pragma unroll
        for (int ai = 0; ai < 2; ++ai)
#pragma unroll
            for (int m = 0; m < 4; ++m)
#pragma unroll
                for (int bj = 0; bj < 2; ++bj) { f(row0 + ai * 128 + m * 16, col0 + bj * 128, acc[ai][bj][m][0], acc[ai][bj][m][1]); asm volatile("" ::: "memory"); }
        if (u.pn == 4 || u.pn == 5) {
#pragma unroll
            for (int bj = 0; bj < 2; ++bj) { float cs[8];
#pragma unroll
                for (int e = 0; e < 8; ++e) cs[e] = 0.f;
#pragma unroll
                for (int ai = 0; ai < 2; ++ai)
#pragma unroll
                    for (int m = 0; m < 4; ++m) { const f32x4 a = acc[ai][bj][m][0], b = acc[ai][bj][m][1]; cs[0] += a.x; cs[1] += a.y; cs[2] += a.z; cs[3] += a.w; cs[4] += b.x; cs[5] += b.y; cs[6] += b.z; cs[7] += b.w; }
#pragma unroll
                for (int e = 0; e < 8; ++e) { cs[e] += __shfl_xor(cs[e], 1); cs[e] += __shfl_xor(cs[e], 2); cs[e] += __shfl_xor(cs[e], 4); cs[e] += __shfl_xor(cs[e], 8); }
                if (fr == 0) { float* kb = kmean + (size_t)u.pm * AW + (u.pn - 4) * 256 + bj * 128 + wc * 32 + 8 * fq;
#pragma unroll
                    for (int e = 0; e < 8; ++e) atomicAdd(kb + e, cs[e] * (1.f / MBLK)); } }
        }
    }
};

constexpr int NTHR = 512, NWAVE = 8;
constexpr int LDS_BYTES = 147456;
struct Args {
    const float* x; const float* mix_norm; const float* w_in; const float* w_pool; const float* pool_scale; const float* w_up; const float* w_out; const float* ffn_norm;
    const float* peer_wq; const float* peer_keys; const float* peer_u; const float* peer_v; const float* final_norm; float* out; unsigned char* ws;
};
#define LAS __attribute__((address_space(3)))
#define GAS __attribute__((address_space(1)))

__device__ __forceinline__ void ph_transpose(const float* __restrict__ W, bf16_t* __restrict__ Wt, int K, int N, float* smem) {
    const int tid_ = opq_tid();
    float (*tile)[33] = (float (*)[33])smem;
    const int tx = tid_ & 31, ty = tid_ >> 5, nbx = N / 32, nit = nbx * (K / 32);
    for (int it = blockIdx.x; it < nit; it += gridDim.x) {
        const int n0 = (it % nbx) * 32, k0 = (it / nbx) * 32;
        for (int i = ty; i < 32; i += 16) tile[i][tx] = W[(size_t)(k0 + i) * N + n0 + tx];
        __syncthreads();
        for (int i = ty; i < 32; i += 16) Wt[(size_t)(n0 + i) * K + k0 + tx] = (bf16_t)f2bf(tile[tx][i]);
        __syncthreads();
    }
}

__device__ __forceinline__ void ph_transpose_w(const float* W, bf16_t* Wt, int K, int N, unsigned char* lds_) {
    const int tid_ = opq_tid(); const int lane = tid_ & 63, wv = tid_ >> 6;
    LAS float* scr = (LAS float*)lds_ + wv * (64 * 33 + 32);
    const int nblk = N / 32, nitems = (K / 64) * nblk;
    for (int item = blockIdx.x * NWAVE + wv; item < nitems; item += gridDim.x * NWAVE) {
        const int kb = item / nblk, nb = item % nblk, k0 = 64 * kb, n0 = 32 * nb;
#pragma unroll 8
        for (int i = 0; i < 32; ++i) { const int kk = 2 * i + (lane >> 5); scr[kk * 33 + (lane & 31)] = W[(size_t)(k0 + kk) * N + n0 + (lane & 31)]; }
        const int c = lane & 7;
#pragma unroll
        for (int j = 0; j < 4; ++j) { const int n = (lane >> 3) + 8 * j; const LAS float* s = scr + (8 * c) * 33 + n;
            u32x4 o; o.x = pk2(s[0 * 33], s[1 * 33]); o.y = pk2(s[2 * 33], s[3 * 33]); o.z = pk2(s[4 * 33], s[5 * 33]); o.w = pk2(s[6 * 33], s[7 * 33]);
            *(u32x4*)(Wt + (size_t)(n0 + n) * K + k0 + 8 * c) = o; }
    }
}
__device__ __forceinline__ void ph_wpeer(const float* __restrict__ wq, const float* __restrict__ keys, bf16_t* __restrict__ Wp) {
    const int tid_ = opq_tid();
    for (int it = blockIdx.x; it < PQW * DM / NTHR; it += gridDim.x) {
        const int idx = it * NTHR + tid_; const int c = idx & 1023, n = idx >> 10, hp = n >> 7, k = n & 127, p = hp & 1;
        const float* a = wq + (size_t)c * PQW + hp * 128; const float* b = keys + ((size_t)p * NKEY + k) * 128; float s = 0.f;
        for (int d = 0; d < 128; ++d) s += a[d] * b[d];
        Wp[(size_t)n * DM + c] = (bf16_t)f2bf(s);
    }
}
__device__ __forceinline__ void ph_wpool_bd(const float* __restrict__ wp, bf16_t* __restrict__ Wbd) {
    const int tid_ = opq_tid();
    for (int it = blockIdx.x; it < DM * PW / NTHR; it += gridDim.x) {
        const int idx = it * NTHR + tid_; const int k = idx & 511, n = idx >> 9, g = n >> 8;
        const float v = ((k >> 7) == g) ? wp[((size_t)g * 128 + (k & 127)) * 256 + (n & 255)] : 0.f;
        Wbd[(size_t)n * PW + k] = (bf16_t)f2bf(v);
    }
}
__device__ __forceinline__ void ph_cvt(const float* __restrict__ src, bf16_t* __restrict__ dst, size_t n4) {
    const int tid_ = opq_tid();
    for (size_t i = (size_t)blockIdx.x * NTHR + tid_; i < n4; i += (size_t)gridDim.x * NTHR) {
        const f32x4 v = ((const f32x4*)src)[i]; u32x2 o; o.x = pk2(v.x, v.y); o.y = pk2(v.z, v.w); ((u32x2*)dst)[i] = o; }
}
__device__ __forceinline__ void ph_rmsnorm(const float* __restrict__ x, const float* __restrict__ g, bf16_t* __restrict__ out) {
    const int tid_ = opq_tid();
    const int lane = tid_ & 63, wv = tid_ >> 6;
    for (int it = blockIdx.x; it < T / NWAVE; it += gridDim.x) {
        const int row = it * NWAVE + wv; const f32x4* xr = (const f32x4*)(x + (size_t)row * DM); f32x4 v[4]; float s = 0.f;
#pragma unroll
        for (int j = 0; j < 4; ++j) { v[j] = xr[lane + 64 * j]; s += v[j].x * v[j].x + v[j].y * v[j].y + v[j].z * v[j].z + v[j].w * v[j].w; }
        const float rstd = rsqrtf(wave_sum(s) * (1.f / DM) + EPS);
#pragma unroll
        for (int j = 0; j < 4; ++j) { const f32x4 gg = ((const f32x4*)g)[lane + 64 * j]; u32x2 o; o.x = pk2(v[j].x * rstd * gg.x, v[j].y * rstd * gg.y); o.y = pk2(v[j].z * rstd * gg.z, v[j].w * rstd * gg.w);
            ((u32x2*)(out + (size_t)row * DM))[lane + 64 * j] = o; }
    }
}
template <class Epi> __device__ __forceinline__ void ph_gemm_naive(const bf16_t* __restrict__ A, int lda, int a_pn_off, const bf16_t* __restrict__ Bt, int ldb, int N, int K, Epi E) {
    const int tid_ = opq_tid();
    const int cg_ = tid_ & 63, rr = tid_ >> 6, nbx = N / 256, nit = nbx * (T / 8);
    for (int it = blockIdx.x; it < nit; it += gridDim.x) {
        const int bx = it % nbx, by = it / nbx; const int col0 = bx * 256 + cg_ * 4, row = by * 8 + rr;
        const bf16_t* a = A + (size_t)row * lda + (size_t)bx * a_pn_off; const bf16_t* b = Bt + (size_t)col0 * ldb;
        float acc[4] = {0.f, 0.f, 0.f, 0.f};
        for (int k = 0; k < K; k += 8) {
            const u32x4 av = *(const u32x4*)(a + k);
#pragma unroll
            for (int i = 0; i < 4; ++i) { const u32x4 bv = *(const u32x4*)(b + (size_t)i * ldb + k);
                acc[i] += lo16(av.x) * lo16(bv.x) + hi16(av.x) * hi16(bv.x) + lo16(av.y) * lo16(bv.y) + hi16(av.y) * hi16(bv.y)
                        + lo16(av.z) * lo16(bv.z) + hi16(av.z) * hi16(bv.z) + lo16(av.w) * lo16(bv.w) + hi16(av.w) * hi16(bv.w); }
        }
        E(row, col0, (f32x4){acc[0], acc[1], acc[2], acc[3]});
    }
}
__device__ __forceinline__ void ph_kmean(const bf16_t* __restrict__ z, float* __restrict__ kmean) {
    const int tid_ = opq_tid();
    for (int it = blockIdx.x; it < NB * NBLK; it += gridDim.x) {
        const int b = it / NBLK, blk = it % NBLK, c = tid_;
        const bf16_t* p = z + ((size_t)b * SEQ + blk * MBLK) * INW + 1024 + c; float s = 0.f;
        for (int r = 0; r < MBLK; ++r) s += bf2f(p[(size_t)r * INW]);
        kmean[((size_t)b * NBLK + blk) * AW + c] = s * (1.f / MBLK);
    }
}
__device__ __forceinline__ void ph_poolm(const bf16_t* __restrict__ z, bf16_t* __restrict__ m) {
    const int tid_ = opq_tid();
    const int c = tid_, w = 2 << (c >> 7);
    for (int it = blockIdx.x; it < T / 64; it += gridDim.x) {
        const int t0 = it * 64;
        for (int i = 0; i < 64; ++i) { const int t = t0 + i, pos = t & (SEQ - 1); const int cnt = (pos + 1 < w) ? pos + 1 : w; float s = 0.f;
            for (int j = 0; j < cnt; ++j) s += bf2f(z[(size_t)(t - j) * INW + c]);
            const float pv = bf2f(z[(size_t)t * INW + c]);
            m[(size_t)t * PW + c] = (bf16_t)f2bf(s / (float)cnt - pv); }
    }
}
__device__ __forceinline__ void ph_attn_naive(const bf16_t* __restrict__ z, const float* __restrict__ kmean, bf16_t* __restrict__ o, float* smem) {
    const int tid_ = opq_tid();
    float (*sc)[1024] = (float (*)[1024])smem;
    const int w = tid_ >> 6, lane = tid_ & 63;
    for (int it = blockIdx.x; it < T; it += gridDim.x) {
        const int t = it, h = w; const int b = t / SEQ, pos = t % SEQ, own = pos / MBLK;
        float q[64];
        { const u32x4* qp = (const u32x4*)(z + (size_t)t * INW + 512 + h * 64);
#pragma unroll
          for (int i = 0; i < 8; ++i) { const u32x4 v = qp[i]; q[8 * i] = lo16(v.x); q[8 * i + 1] = hi16(v.x); q[8 * i + 2] = lo16(v.y); q[8 * i + 3] = hi16(v.y); q[8 * i + 4] = lo16(v.z); q[8 * i + 5] = hi16(v.z); q[8 * i + 6] = lo16(v.w); q[8 * i + 7] = hi16(v.w); } }
        float bs[7];
#pragma unroll
        for (int j = 0; j < 7; ++j) { float s = -INFINITY; if (j < own) { s = 0.f; const float* km = kmean + ((size_t)b * NBLK + j) * AW + h * 64;
#pragma unroll
            for (int d = 0; d < 64; ++d) s += q[d] * km[d]; } bs[j] = s; }
        int sel[3];
#pragma unroll
        for (int r = 0; r < 3; ++r) { float best = -INFINITY; int bi = -1;
#pragma unroll
            for (int j = 0; j < 7; ++j) if (bs[j] > best) { best = bs[j]; bi = j; }
            sel[r] = bi;
#pragma unroll
            for (int j = 0; j < 7; ++j) if (j == bi) bs[j] = -INFINITY; }
        const float slope2 = exp2f(-(float)(h + 1)) * LOG2E;
        float mx = -INFINITY;
#pragma unroll
        for (int sg = 0; sg < 4; ++sg) {
            const int blk = (sg < 3) ? sel[sg] : own; if (blk < 0) continue;
            const int kb = blk * MBLK, cnt = (sg < 3) ? MBLK : (pos - kb + 1);
            for (int kk = lane; kk < cnt; kk += 64) {
                const u32x4* kp = (const u32x4*)(z + ((size_t)b * SEQ + kb + kk) * INW + 1024 + h * 64); float s = 0.f;
#pragma unroll
                for (int i = 0; i < 8; ++i) { const u32x4 v = kp[i]; s += q[8 * i] * lo16(v.x) + q[8 * i + 1] * hi16(v.x) + q[8 * i + 2] * lo16(v.y) + q[8 * i + 3] * hi16(v.y) + q[8 * i + 4] * lo16(v.z) + q[8 * i + 5] * hi16(v.z) + q[8 * i + 6] * lo16(v.w) + q[8 * i + 7] * hi16(v.w); }
                s -= slope2 * (float)(pos - (kb + kk)); sc[w][sg * 256 + kk] = s; mx = fmaxf(mx, s); }
        }
        mx = wave_max(mx); float sum = 0.f;
#pragma unroll
        for (int sg = 0; sg < 4; ++sg) {
            const int blk = (sg < 3) ? sel[sg] : own; if (blk < 0) continue;
            const int kb = blk * MBLK, cnt = (sg < 3) ? MBLK : (pos - kb + 1);
            for (int kk = lane; kk < cnt; kk += 64) { const float p = exp2f(sc[w][sg * 256 + kk] - mx); sc[w][sg * 256 + kk] = p; sum += p; }
        }
        sum = wave_sum(sum);
        __syncthreads();
        float acc = 0.f;
#pragma unroll
        for (int sg = 0; sg < 4; ++sg) {
            const int blk = (sg < 3) ? sel[sg] : own; if (blk < 0) continue;
            const int kb = blk * MBLK, cnt = (sg < 3) ? MBLK : (pos - kb + 1);
            const bf16_t* vp = z + ((size_t)b * SEQ + kb) * INW + 1536 + h * 64 + lane;
            for (int kk = 0; kk < cnt; ++kk) acc += sc[w][sg * 256 + kk] * bf2f(vp[(size_t)kk * INW]);
        }
        o[(size_t)t * AW + h * 64 + lane] = (bf16_t)f2bf(acc / sum);
        __syncthreads();
    }
}
__device__ __forceinline__ void ph_topk_naive(const float* __restrict__ scores, int* __restrict__ eid, float* __restrict__ gw, float* smem) {
    const int tid_ = opq_tid();
    float (*svl)[2][16] = (float (*)[2][16])smem; int (*sil)[2][16] = (int (*)[2][16])(smem + 256); float (*cvl)[16] = (float (*)[16])(smem + 512); int (*cil)[16] = (int (*)[16])(smem + 640);
    const int w = tid_ >> 6, lane = tid_ & 63;
    for (int it = blockIdx.x; it < T; it += gridDim.x) {
        const int t = it, h = w;
        for (int p = 0; p < 2; ++p) {
            const float* s = scores + (size_t)t * PQW + h * 256 + p * 128;
            float v0 = s[lane], v1 = s[lane + 64];
            for (int r = 0; r < 16; ++r) {
                float bv; int bi; if (v0 >= v1) { bv = v0; bi = lane; } else { bv = v1; bi = lane + 64; }
#pragma unroll
                for (int o = 1; o < 64; o <<= 1) { const float ov = __shfl_xor(bv, o); const int oi = __shfl_xor(bi, o); if (ov > bv || (ov == bv && oi < bi)) { bv = ov; bi = oi; } }
                if (lane == 0) { svl[w][p][r] = bv; sil[w][p][r] = bi; }
                if (bi == lane) v0 = -INFINITY; if (bi == lane + 64) v1 = -INFINITY;
            }
        }
        __syncthreads();
        float cv[4];
#pragma unroll
        for (int m = 0; m < 4; ++m) { const int c = lane + 64 * m; cv[m] = svl[w][0][c >> 4] + svl[w][1][c & 15]; }
        for (int r = 0; r < 16; ++r) {
            float bv = cv[0]; int bi = lane;
#pragma unroll
            for (int m = 1; m < 4; ++m) if (cv[m] > bv) { bv = cv[m]; bi = lane + 64 * m; }
#pragma unroll
            for (int o = 1; o < 64; o <<= 1) { const float ov = __shfl_xor(bv, o); const int oi = __shfl_xor(bi, o); if (ov > bv || (ov == bv && oi < bi)) { bv = ov; bi = oi; } }
            if (lane == 0) { cvl[w][r] = bv; cil[w][r] = bi; }
#pragma unroll
            for (int m = 0; m < 4; ++m) if (bi == lane + 64 * m) cv[m] = -INFINITY;
        }
        __syncthreads();
        if (lane < 16) {
            const float mx = cvl[w][0]; float sum = 0.f;
            for (int r = 0; r < 16; ++r) sum += __expf(cvl[w][r] - mx);
            const int c = cil[w][lane];
            eid[(size_t)t * NSLOT + h * 16 + lane] = sil[w][0][c >> 4] * NKEY + sil[w][1][c & 15];
            gw[(size_t)t * NSLOT + h * 16 + lane] = __expf(cvl[w][lane] - mx) / sum;
        }
        __syncthreads();
    }
}
__device__ __forceinline__ void ph_peer_u(const bf16_t* __restrict__ hn, const bf16_t* __restrict__ Ub, const int* __restrict__ eid, const float* __restrict__ gw, float* __restrict__ wact) {
    const int tid_ = opq_tid();
    const int lane = tid_ & 63, wv = tid_ >> 6;
    for (int it = blockIdx.x; it < T / NWAVE; it += gridDim.x) {
        const int t = it * NWAVE + wv;
        const u32x4 h0 = *(const u32x4*)(hn + (size_t)t * DM + lane * 8), h1 = *(const u32x4*)(hn + (size_t)t * DM + 512 + lane * 8);
        for (int s = 0; s < NSLOT; ++s) {
            const int e = eid[(size_t)t * NSLOT + s]; const bf16_t* row = Ub + (size_t)e * DM;
            const u32x4 a = *(const u32x4*)(row + lane * 8), b = *(const u32x4*)(row + 512 + lane * 8);
            float d = lo16(a.x) * lo16(h0.x) + hi16(a.x) * hi16(h0.x) + lo16(a.y) * lo16(h0.y) + hi16(a.y) * hi16(h0.y) + lo16(a.z) * lo16(h0.z) + hi16(a.z) * hi16(h0.z) + lo16(a.w) * lo16(h0.w) + hi16(a.w) * hi16(h0.w)
                    + lo16(b.x) * lo16(h1.x) + hi16(b.x) * hi16(h1.x) + lo16(b.y) * lo16(h1.y) + hi16(b.y) * hi16(h1.y) + lo16(b.z) * lo16(h1.z) + hi16(b.z) * hi16(h1.z) + lo16(b.w) * lo16(h1.w) + hi16(b.w) * hi16(h1.w);
            d = wave_sum(d);
            if (lane == 0) wact[(size_t)t * NSLOT + s] = gw[(size_t)t * NSLOT + s] * gelu_tanh(d);
        }
    }
}
__device__ __forceinline__ void ph_peer_v(float* __restrict__ xres, const bf16_t* __restrict__ Vb, const int* __restrict__ eid, const float* __restrict__ wact, const float* __restrict__ gn, bf16_t* __restrict__ hout, int last) {
    const int tid_ = opq_tid();
    const int lane = tid_ & 63, wv = tid_ >> 6;
    for (int it = blockIdx.x; it < T / NWAVE; it += gridDim.x) {
        const int t = it * NWAVE + wv;
        float acc[16];
#pragma unroll
        for (int i = 0; i < 16; ++i) acc[i] = 0.f;
        for (int s = 0; s < NSLOT; ++s) {
            const int e = eid[(size_t)t * NSLOT + s]; const float w = wact[(size_t)t * NSLOT + s]; const bf16_t* row = Vb + (size_t)e * DM;
            const u32x4 a = *(const u32x4*)(row + lane * 8), b = *(const u32x4*)(row + 512 + lane * 8);
            acc[0] += w * lo16(a.x); acc[1] += w * hi16(a.x); acc[2] += w * lo16(a.y); acc[3] += w * hi16(a.y); acc[4] += w * lo16(a.z); acc[5] += w * hi16(a.z); acc[6] += w * lo16(a.w); acc[7] += w * hi16(a.w);
            acc[8] += w * lo16(b.x); acc[9] += w * hi16(b.x); acc[10] += w * lo16(b.y); acc[11] += w * hi16(b.y); acc[12] += w * lo16(b.z); acc[13] += w * hi16(b.z); acc[14] += w * lo16(b.w); acc[15] += w * hi16(b.w);
        }
        float* xr = xres + (size_t)t * DM; float ss = 0.f;
#pragma unroll
        for (int hf = 0; hf < 2; ++hf)
#pragma unroll
            for (int j = 0; j < 2; ++j) { const f32x4 xv = *(const f32x4*)(xr + hf * 512 + lane * 8 + j * 4);
                acc[hf * 8 + j * 4 + 0] += xv.x; acc[hf * 8 + j * 4 + 1] += xv.y; acc[hf * 8 + j * 4 + 2] += xv.z; acc[hf * 8 + j * 4 + 3] += xv.w; }
#pragma unroll
        for (int i = 0; i < 16; ++i) ss += acc[i] * acc[i];
        const float rstd = rsqrtf(wave_sum(ss) * (1.f / DM) + EPS);
#pragma unroll
        for (int hf = 0; hf < 2; ++hf)
#pragma unroll
            for (int j = 0; j < 2; ++j) { const int c = hf * 512 + lane * 8 + j * 4; const f32x4 g = *(const f32x4*)(gn + c); const int a0 = hf * 8 + j * 4;
                if (last) { *(f32x4*)(xr + c) = (f32x4){acc[a0] * rstd * g.x, acc[a0 + 1] * rstd * g.y, acc[a0 + 2] * rstd * g.z, acc[a0 + 3] * rstd * g.w}; }
                else { *(f32x4*)(xr + c) = (f32x4){acc[a0], acc[a0 + 1], acc[a0 + 2], acc[a0 + 3]};
                    u32x2 ob; ob.x = pk2(acc[a0] * rstd * g.x, acc[a0 + 1] * rstd * g.y); ob.y = pk2(acc[a0 + 2] * rstd * g.z, acc[a0 + 3] * rstd * g.w); *(u32x2*)(hout + (size_t)t * DM + c) = ob; } }
    }
}


__device__ __forceinline__ void ph_poolm2(const bf16_t* z, bf16_t* m) {
    const int tid_ = opq_tid(); const int c = tid_, wsel = c >> 7, w = 2 << wsel;
    for (int it = blockIdx.x; it < T / 64; it += gridDim.x) {
        const int t0 = it * 64, pos0 = t0 & (SEQ - 1);
        float x[32];
#pragma unroll
        for (int i = 0; i < 16; ++i) x[i] = (pos0 == 0) ? 0.f : bf2f(z[(size_t)(t0 - 16 + i) * INW + c]);
#pragma unroll 1
        for (int bt = 0; bt < 4; ++bt) {
#pragma unroll
            for (int i = 0; i < 16; ++i) x[16 + i] = bf2f(z[(size_t)(t0 + bt * 16 + i) * INW + c]);
            float s1[32], s2[32], s3[32], s4[32];
#pragma unroll
            for (int i = 1; i < 32; ++i) s1[i] = x[i] + x[i - 1];
#pragma unroll
            for (int i = 3; i < 32; ++i) s2[i] = s1[i] + s1[i - 2];
#pragma unroll
            for (int i = 7; i < 32; ++i) s3[i] = s2[i] + s2[i - 4];
#pragma unroll
            for (int i = 16; i < 32; ++i) s4[i] = s3[i] + s3[i - 8];
#pragma unroll
            for (int i = 16; i < 32; ++i) { const int pos = pos0 + bt * 16 + (i - 16); const int cnt = (pos + 1 < w) ? pos + 1 : w;
                const float s = (wsel == 0) ? s1[i] : (wsel == 1) ? s2[i] : (wsel == 2) ? s3[i] : s4[i];
                m[(size_t)(t0 + bt * 16 + i - 16) * PW + c] = (bf16_t)f2bf(s / (float)cnt - x[i]); }
#pragma unroll
            for (int i = 0; i < 16; ++i) x[i] = x[16 + i];
        }
    }
}
__device__ __forceinline__ void ph_wpeer2(const float* wq, const float* keys, const float* gf, bf16_t* Wp, float* smem) {
    const int tid_ = opq_tid(); const int kq = tid_ & 31, cq = tid_ >> 5;
    float* kl = smem; float* wl = smem + 128 * 129;
    for (int it = blockIdx.x; it < 16 * 16; it += gridDim.x) {
        const int hp = it >> 4, c0 = (it & 15) * 64, p = hp & 1;
        for (int i = tid_; i < 128 * 32; i += NTHR) { const int row = i >> 5, d4 = (i & 31) * 4; const f32x4 v = *(const f32x4*)(keys + ((size_t)p * NKEY + row) * 128 + d4);
            kl[row * 129 + d4] = v.x; kl[row * 129 + d4 + 1] = v.y; kl[row * 129 + d4 + 2] = v.z; kl[row * 129 + d4 + 3] = v.w; }
        for (int i = tid_; i < 64 * 32; i += NTHR) { const int row = i >> 5, d4 = (i & 31) * 4; const f32x4 v = *(const f32x4*)(wq + (size_t)(c0 + row) * PQW + hp * 128 + d4);
            wl[row * 129 + d4] = v.x; wl[row * 129 + d4 + 1] = v.y; wl[row * 129 + d4 + 2] = v.z; wl[row * 129 + d4 + 3] = v.w; }
        __syncthreads();
        float acc[4][4];
#pragma unroll
        for (int i = 0; i < 4; ++i)
#pragma unroll
            for (int j = 0; j < 4; ++j) acc[i][j] = 0.f;
        for (int d = 0; d < 128; ++d) {
            float av[4], bv[4];
#pragma unroll
            for (int i = 0; i < 4; ++i) { av[i] = kl[(kq + 32 * i) * 129 + d]; bv[i] = wl[(cq + 16 * i) * 129 + d]; }
#pragma unroll
            for (int i = 0; i < 4; ++i)
#pragma unroll
                for (int j = 0; j < 4; ++j) acc[i][j] += av[i] * bv[j];
        }
#pragma unroll
        for (int i = 0; i < 4; ++i)
#pragma unroll
            for (int j = 0; j < 4; ++j) Wp[(size_t)(hp * 128 + kq + 32 * i) * DM + c0 + cq + 16 * j] = (bf16_t)f2bf(acc[i][j] * gf[c0 + cq + 16 * j]);
        __syncthreads();
    }
}

typedef short bf16x8_t __attribute__((ext_vector_type(8)));
typedef float f32x16 __attribute__((ext_vector_type(16)));
typedef short v4i16_t __attribute__((ext_vector_type(4)));
typedef float f32x2_t __attribute__((ext_vector_type(2)));
typedef __bf16 bf16x2_t __attribute__((ext_vector_type(2)));
__device__ __forceinline__ unsigned cvtpk(float lo, float hi) { f32x2_t v = {lo, hi}; bf16x2_t b = __builtin_convertvector(v, bf16x2_t); return __builtin_bit_cast(unsigned, b); }
constexpr int AT_ROW = 144, AT_TILE = 64 * AT_ROW;
__device__ __forceinline__ void ph_attn(unsigned char* lds_, const bf16_t* z, const float* kmean, bf16_t* o) {
    LAS unsigned char* lds = (LAS unsigned char*)lds_;
    const int tid = opq_tid(), lane = tid & 63, wv = __builtin_amdgcn_readfirstlane(tid >> 6), r = lane & 31, hi = lane >> 5;
    const int srow = tid >> 3, sch = tid & 7;
    const unsigned st_off = srow * AT_ROW + sch * 16;
    const unsigned k_off = r * AT_ROW + hi * 16;
    const unsigned v_off = (4 * hi + ((lane & 15) >> 2)) * AT_ROW + (16 * ((lane >> 4) & 1) + 4 * (lane & 3)) * 2;
    LAS float* kml = (LAS float*)(lds + 4 * AT_TILE);
    for (int pr = blockIdx.x; pr < 256; pr += gridDim.x) {
#pragma unroll 1
        for (int uu = 0; uu < 2; ++uu) {
            const int bh = pr >> 2, qb = uu == 0 ? (pr & 3) : 7 - (pr & 3);
            const int b = bh >> 3, h = bh & 7, own = qb, q0 = qb * MBLK;
            const size_t rowbase = (size_t)b * SEQ;
            const int qrel = wv * 32 + r;
            bf16x8_t qf[4];
            { const bf16_t* qptr = z + (rowbase + q0 + qrel) * INW + 512 + h * 64 + hi * 8;
#pragma unroll
              for (int ds = 0; ds < 4; ++ds) qf[ds] = *(const bf16x8_t*)(qptr + ds * 16); }
            unsigned selmask = 0;
            if (own > 0) {
                float bs[7];
#pragma unroll
                for (int j = 0; j < 7; ++j) { float s = -INFINITY;
                    if (j < own) { const float* km = kmean + ((size_t)b * NBLK + j) * AW + h * 64 + hi * 8; s = 0.f;
#pragma unroll
                        for (int ds = 0; ds < 4; ++ds) { const f32x4 k0 = *(const f32x4*)(km + ds * 16), k1 = *(const f32x4*)(km + ds * 16 + 4);
                            s += bf2f((bf16_t)qf[ds][0]) * k0.x + bf2f((bf16_t)qf[ds][1]) * k0.y + bf2f((bf16_t)qf[ds][2]) * k0.z + bf2f((bf16_t)qf[ds][3]) * k0.w
                               + bf2f((bf16_t)qf[ds][4]) * k1.x + bf2f((bf16_t)qf[ds][5]) * k1.y + bf2f((bf16_t)qf[ds][6]) * k1.z + bf2f((bf16_t)qf[ds][7]) * k1.w; }
                        s += __shfl_xor(s, 32); }
                    bs[j] = s; }
#pragma unroll
                for (int rr = 0; rr < 3; ++rr) { float best = -INFINITY; int bi = -1;
#pragma unroll
                    for (int j = 0; j < 7; ++j) if (bs[j] > best) { best = bs[j]; bi = j; }
                    if (bi >= 0) selmask |= 1u << bi;
#pragma unroll
                    for (int j = 0; j < 7; ++j) if (j == bi) bs[j] = -INFINITY; }
            }
            const float slope2 = exp2f(-(float)(h + 1)) * LOG2E;
            const float hoff = slope2 * (float)(4 * hi);
            f32x16 o0, o1;
#pragma unroll
            for (int i = 0; i < 16; ++i) { o0[i] = 0.f; o1[i] = 0.f; }
            float mrun = 0.f, lrun = 0.f;
            const int NS = 2 * (own + 1);
            const unsigned kv_voff = (unsigned)(srow * INW + sch * 8) * 2u;
#define AT_KVLOAD(kd, vd, kvabs_) do { const GAS char* kvb_ = (const GAS char*)z + ((size_t)(rowbase + (kvabs_)) * INW + 1024 + h * 64) * 2; asm("" : "+s"(kvb_)); unsigned vo_ = kv_voff; asm("" : "+v"(vo_)); \
                kd[0] = *(const GAS u32x4*)(kvb_ + vo_); vd[0] = *(const GAS u32x4*)(kvb_ + 1024 + vo_); kd[1] = *(const GAS u32x4*)(kvb_ + 64 * INW * 2 + vo_); vd[1] = *(const GAS u32x4*)(kvb_ + 64 * INW * 2 + 1024 + vo_); } while (0)
#define AT_KVABS(s_) (((s_) < 2) ? own * MBLK + (s_) * 128 : ((s_) - 2) * 128)
#define AT_WRITE(buf_, kd, vd) do { *(LAS u32x4*)(lds + ((buf_) * 4 + 0) * AT_TILE + st_off) = kd[0]; *(LAS u32x4*)(lds + ((buf_) * 4 + 1) * AT_TILE + st_off) = kd[1]; \
                *(LAS u32x4*)(lds + ((buf_) * 4 + 2) * AT_TILE + st_off) = vd[0]; *(LAS u32x4*)(lds + ((buf_) * 4 + 3) * AT_TILE + st_off) = vd[1]; } while (0)
            u32x4 kr[2], vr[2];
            { AT_KVLOAD(kr, vr, own * MBLK); AT_WRITE(0, kr, vr); }
            __syncthreads();
            for (int i0 = 0; i0 < NS; i0 += 2) {
#pragma unroll
              for (int u = 0; u < 2; ++u) {
                const int i = i0 + u; const int cur = u;
                { const int i2 = (i + 1 < NS) ? i + 1 : NS - 1; AT_KVLOAD(kr, vr, AT_KVABS(i2)); }
                int mode[2]; float base[2]; int kv0[2];
#pragma unroll
                for (int sb = 0; sb < 2; ++sb) {
                    if (i < 2) { kv0[sb] = i * 128 + sb * 64; mode[sb] = (kv0[sb] > wv * 32 + 31) ? 0 : ((kv0[sb] + 63 <= wv * 32) ? 1 : 2); base[sb] = slope2 * (float)(kv0[sb] - qrel); }
                    else { kv0[sb] = 0; const int blk = (i - 2) >> 1; const bool sel = (selmask >> blk) & 1u; mode[sb] = __any(sel) ? 1 : 0; base[sb] = sel ? slope2 * (float)((i - 2) * 128 + sb * 64 - q0 - qrel) : -INFINITY; } }
                if (mode[0] | mode[1]) {
                    f32x16 p[2][2];
#pragma unroll
                    for (int sb = 0; sb < 2; ++sb) { const float base2 = (mode[sb] ? base[sb] : -INFINITY) + hoff - mrun;
#pragma unroll
                        for (int e = 0; e < 16; ++e) { p[sb][0][e] = fmaf(slope2, (float)((e & 3) + 8 * (e >> 2)), base2); p[sb][1][e] = fmaf(slope2, (float)((e & 3) + 8 * (e >> 2) + 32), base2); }
                        if (mode[sb] == 2) {
#pragma unroll
                            for (int e = 0; e < 16; ++e) { const int kvr = kv0[sb] + (e & 3) + 8 * (e >> 2) + 4 * hi; if (kvr > qrel) p[sb][0][e] = -INFINITY; if (kvr + 32 > qrel) p[sb][1][e] = -INFINITY; } } }
#pragma unroll
                    for (int sb = 0; sb < 2; ++sb) if (mode[sb]) {
                        const LAS unsigned char* kb = lds + (cur * 4 + sb) * AT_TILE + k_off;
#pragma unroll
                        for (int kh = 0; kh < 2; ++kh) { bf16x8_t ka[4];
#pragma unroll
                            for (int ds = 0; ds < 4; ++ds) ka[ds] = *(const LAS bf16x8_t*)(kb + kh * 32 * AT_ROW + ds * 32);
                            asm volatile("s_waitcnt lgkmcnt(0)" : "+v"(ka[0]), "+v"(ka[1]), "+v"(ka[2]), "+v"(ka[3]) :: "memory");
#pragma unroll
                            for (int ds = 0; ds < 4; ++ds) p[sb][kh] = __builtin_amdgcn_mfma_f32_32x32x16_bf16(ka[ds], qf[ds], p[sb][kh], 0, 0, 0); } }
                    float mloc = fmaxf(fmaxf(p[0][0][0], p[0][1][0]), fmaxf(p[1][0][0], p[1][1][0]));
#pragma unroll
                    for (int e = 1; e < 16; ++e) mloc = fmaxf(mloc, fmaxf(fmaxf(p[0][0][e], p[0][1][e]), fmaxf(p[1][0][e], p[1][1][e])));
                    mloc = fmaxf(mloc, __shfl_xor(mloc, 32));
                    const float delta = (i == 0) ? mloc : fmaxf(mloc, 0.f);
                    if (__any(delta != 0.f)) {
#pragma unroll
                        for (int e = 0; e < 16; ++e) { p[0][0][e] -= delta; p[0][1][e] -= delta; p[1][0][e] -= delta; p[1][1][e] -= delta; }
                        mrun += delta;
                        if (i > 0) { const float alpha = __builtin_amdgcn_exp2f(-delta); lrun *= alpha;
#pragma unroll
                            for (int e = 0; e < 16; ++e) { o0[e] *= alpha; o1[e] *= alpha; } }
                    }
#pragma unroll
                    for (int sb = 0; sb < 2; ++sb) if (mode[sb]) {
                        float ls = 0.f;
#pragma unroll
                        for (int e = 0; e < 16; ++e) { p[sb][0][e] = __builtin_amdgcn_exp2f(p[sb][0][e]); p[sb][1][e] = __builtin_amdgcn_exp2f(p[sb][1][e]); ls += p[sb][0][e] + p[sb][1][e]; }
                        lrun += ls;
                        u32x4 pb[2][2];
#pragma unroll
                        for (int s = 0; s < 2; ++s) { pb[0][s] = (u32x4){cvtpk(p[sb][0][8 * s], p[sb][0][8 * s + 1]), cvtpk(p[sb][0][8 * s + 2], p[sb][0][8 * s + 3]), cvtpk(p[sb][0][8 * s + 4], p[sb][0][8 * s + 5]), cvtpk(p[sb][0][8 * s + 6], p[sb][0][8 * s + 7])};
                            pb[1][s] = (u32x4){cvtpk(p[sb][1][8 * s], p[sb][1][8 * s + 1]), cvtpk(p[sb][1][8 * s + 2], p[sb][1][8 * s + 3]), cvtpk(p[sb][1][8 * s + 4], p[sb][1][8 * s + 5]), cvtpk(p[sb][1][8 * s + 6], p[sb][1][8 * s + 7])}; }
                        const LAS unsigned char* vb = lds + (cur * 4 + 2 + sb) * AT_TILE + v_off;
#pragma unroll
                        for (int kh = 0; kh < 2; ++kh) { v4i16_t vlo[4], vhh[4];
#pragma unroll
                            for (int s = 0; s < 2; ++s)
#pragma unroll
                                for (int dh = 0; dh < 2; ++dh) { const LAS unsigned char* va = vb + (32 * kh + 16 * s) * AT_ROW + dh * 64; const int ix = s * 2 + dh;
                                    vlo[ix] = __builtin_amdgcn_ds_read_tr16_b64_v4i16((LAS v4i16_t*)(va)); vhh[ix] = __builtin_amdgcn_ds_read_tr16_b64_v4i16((LAS v4i16_t*)(va + 8 * AT_ROW)); }
                            asm volatile("s_waitcnt lgkmcnt(0)" : "+v"(vlo[0]), "+v"(vlo[1]), "+v"(vlo[2]), "+v"(vlo[3]), "+v"(vhh[0]), "+v"(vhh[1]), "+v"(vhh[2]), "+v"(vhh[3]) :: "memory");
#pragma unroll
                            for (int s = 0; s < 2; ++s) { const bf16x8_t pf = __builtin_bit_cast(bf16x8_t, pb[kh][s]);
#pragma unroll
                                for (int dh = 0; dh < 2; ++dh) { const int ix = s * 2 + dh;
                                    const bf16x8_t vf = (bf16x8_t){vlo[ix][0], vlo[ix][1], vlo[ix][2], vlo[ix][3], vhh[ix][0], vhh[ix][1], vhh[ix][2], vhh[ix][3]};
                                    if (dh == 0) o0 = __builtin_amdgcn_mfma_f32_32x32x16_bf16(vf, pf, o0, 0, 0, 0); else o1 = __builtin_amdgcn_mfma_f32_32x32x16_bf16(vf, pf, o1, 0, 0, 0); } } }
                    }
                }
                AT_WRITE(cur ^ 1, kr, vr);
                __syncthreads();
              }
            }
#undef AT_KVLOAD
#undef AT_KVABS
#undef AT_WRITE
            lrun += __shfl_xor(lrun, 32);
            const float rl = 1.f / lrun;
            bf16_t* op = o + (rowbase + q0 + qrel) * AW + h * 64 + 4 * hi;
#pragma unroll
            for (int g = 0; g < 4; ++g) {
                u32x2 w0, w1; w0.x = cvtpk(o0[4 * g] * rl, o0[4 * g + 1] * rl); w0.y = cvtpk(o0[4 * g + 2] * rl, o0[4 * g + 3] * rl);
                w1.x = cvtpk(o1[4 * g] * rl, o1[4 * g + 1] * rl); w1.y = cvtpk(o1[4 * g + 2] * rl, o1[4 * g + 3] * rl);
                *(u32x2*)(op + 8 * g) = w0; *(u32x2*)(op + 32 + 8 * g) = w1; }
        }
    }
}


__device__ __forceinline__ void ce_desc(float& a, float& b) {
    float mx, mn; asm("v_max_f32 %0, %1, %2" : "=v"(mx) : "v"(a), "v"(b)); asm("v_min_f32 %0, %1, %2" : "=v"(mn) : "v"(a), "v"(b)); a = mx; b = mn;
}
__device__ __forceinline__ float vmaxf(float a, float b) { float mx; asm("v_max_f32 %0, %1, %2" : "=v"(mx) : "v"(a), "v"(b)); return mx; }
template <int N> __device__ __forceinline__ void bitonic_sort_desc(float (&v)[N]) {
#pragma unroll
    for (int k = 2; k <= N; k <<= 1)
#pragma unroll
        for (int j = k >> 1; j > 0; j >>= 1)
#pragma unroll
            for (int i = 0; i < N; ++i) { const int l = i ^ j; if (l > i) { if ((i & k) == 0) ce_desc(v[i], v[l]); else ce_desc(v[l], v[i]); } }
}
template <int N> __device__ __forceinline__ void bitonic_merge_desc(float (&v)[N]) {
#pragma unroll
    for (int j = N >> 1; j > 0; j >>= 1)
#pragma unroll
        for (int i = 0; i < N; ++i) { const int l = i ^ j; if (l > i) ce_desc(v[i], v[l]); }
}
__device__ __forceinline__ void merge_top16(float (&a)[16], const float (&b)[16]) {
#pragma unroll
    for (int i = 0; i < 16; ++i) a[i] = vmaxf(a[i], b[15 - i]);
    bitonic_merge_desc<16>(a);
}
constexpr int TK_ROW = 68;
__device__ __forceinline__ void ph_topk(unsigned char* lds_, const short* scores, int* eid, float* gw, int* offs, const int task) {
    const int tid = opq_tid(), lane = tid & 63, wv = __builtin_amdgcn_readfirstlane(tid >> 6);
    LAS float* stg = (LAS float*)lds_ + wv * (64 * TK_ROW);
    {
        const short* base = scores + (size_t)task * 64 * 256;
        float top[2][16];
        u32x2 pre[16];
#pragma unroll
        for (int i = 0; i < 16; ++i) pre[i] = *(const u32x2*)(base + (size_t)(4 * i + (lane >> 4)) * 256 + (lane & 15) * 4);
#pragma unroll
        for (int p = 0; p < 2; ++p) {
#pragma unroll
            for (int rd = 0; rd < 2; ++rd) {
#pragma unroll
                for (int i = 0; i < 16; ++i) { const int jj = 4 * i + (lane >> 4);
                    const u32x2 w = pre[i];
                    const f32x4 v = (f32x4){(float)(short)(w.x & 0xffffu), (float)((int)w.x >> 16), (float)(short)(w.y & 0xffffu), (float)((int)w.y >> 16)} * (1.f / 2048.f);
                    *(LAS f32x4*)(stg + jj * TK_ROW + (lane & 15) * 4) = v; }
                if (p * 2 + rd < 3) { const int qn = p * 2 + rd + 1;
#pragma unroll
                    for (int i = 0; i < 16; ++i) pre[i] = *(const u32x2*)(base + (size_t)(4 * i + (lane >> 4)) * 256 + (qn >> 1) * 128 + (qn & 1) * 64 + (lane & 15) * 4); }
                float blk[4][16];
#pragma unroll
                for (int g = 0; g < 4; ++g)
#pragma unroll
                    for (int c = 0; c < 4; ++c) { const f32x4 v = *(const LAS f32x4*)(stg + lane * TK_ROW + g * 16 + c * 4);
#pragma unroll
                        for (int e = 0; e < 4; ++e) { const unsigned idx = rd * 64 + g * 16 + c * 4 + e; blk[g][c * 4 + e] = __uint_as_float((__float_as_uint(v[e]) & ~127u) | idx); } }
#pragma unroll
                for (int g = 0; g < 4; ++g) bitonic_sort_desc<16>(blk[g]);
                merge_top16(blk[0], blk[1]); merge_top16(blk[2], blk[3]); merge_top16(blk[0], blk[2]);
                if (rd == 0) {
#pragma unroll
                    for (int e = 0; e < 16; ++e) top[p][e] = blk[0][e];
                } else merge_top16(top[p], blk[0]);
            }
        }
        LAS unsigned* tab = (LAS unsigned*)(stg + lane * TK_ROW);
#pragma unroll
        for (int p = 0; p < 2; ++p)
#pragma unroll
            for (int q = 0; q < 4; ++q) { unsigned w = 0;
#pragma unroll
                for (int e = 0; e < 4; ++e) w |= (__float_as_uint(top[p][4 * q + e]) & 127u) << (8 * e);
                tab[p * 4 + q] = w; }
#define CAND(i, j) __uint_as_float((__float_as_uint(top[0][i] + top[1][j]) & ~255u) | (unsigned)((i) * 16 + (j)))
        float A[16], Bv[16], C[16], Dv[16];
#pragma unroll
        for (int j = 0; j < 16; ++j) A[j] = CAND(0, j);
#pragma unroll
        for (int i = 1; i < 16; ++i) Bv[i - 1] = CAND(i, 0);
        Bv[15] = -INFINITY;
#pragma unroll
        for (int j = 1; j < 8; ++j) Dv[j - 1] = CAND(1, j);
#pragma unroll
        for (int j = 7; j < 16; ++j) Dv[j] = -INFINITY;
        C[0] = CAND(2, 1); C[1] = CAND(2, 2); C[2] = CAND(2, 3); C[3] = CAND(2, 4); C[4] = CAND(3, 1); C[5] = CAND(3, 2); C[6] = CAND(3, 3); C[7] = CAND(4, 1); C[8] = CAND(4, 2);
        C[9] = CAND(5, 1); C[10] = CAND(6, 1); C[11] = CAND(7, 1); C[12] = -INFINITY; C[13] = -INFINITY; C[14] = -INFINITY; C[15] = -INFINITY;
#undef CAND
        bitonic_sort_desc<16>(C);
        merge_top16(A, Bv); merge_top16(C, Dv); merge_top16(A, C);
        float g[16]; int ex[16]; float sum = 0.f; const float mx = __uint_as_float(__float_as_uint(A[0]) & ~255u);
#pragma unroll
        for (int e = 0; e < 16; ++e) { const unsigned bits = __float_as_uint(A[e]); const unsigned id = bits & 255u;
            g[e] = __expf(__uint_as_float(bits & ~255u) - mx); sum += g[e];
            const unsigned i0 = ((const LAS unsigned char*)tab)[id >> 4], i1 = ((const LAS unsigned char*)tab)[16 + (id & 15)];
            ex[e] = (int)(i0 * NKEY + i1); }
        const float rs = 1.f / sum;
        LAS unsigned* si = (LAS unsigned*)stg; LAS float* sf = stg + 1024;
        { const int sb = (lane >> 3) * 128 + (lane & 7) * 16;
#pragma unroll
          for (int q = 0; q < 4; ++q) { *(LAS u32x4*)(si + sb + 4 * q) = (u32x4){(unsigned)ex[4 * q], (unsigned)ex[4 * q + 1], (unsigned)ex[4 * q + 2], (unsigned)ex[4 * q + 3]};
              *(LAS f32x4*)(sf + sb + 4 * q) = (f32x4){g[4 * q] * rs, g[4 * q + 1] * rs, g[4 * q + 2] * rs, g[4 * q + 3] * rs}; } }
#pragma unroll 1
        for (int j = 0; j < 8; ++j) {
            const unsigned e0 = si[j * 128 + lane], e1 = si[j * 128 + 64 + lane]; const float g0 = sf[j * 128 + lane], g1 = sf[j * 128 + 64 + lane];
            const unsigned k0 = e0 >> 11, k1 = e1 >> 11; int pos0 = 0, pos1 = 0, offq = 0, offv = 0;
#pragma unroll
            for (int q = 0; q < 8; ++q) {
                const unsigned long long m0 = __builtin_amdgcn_ballot_w64(k0 == (unsigned)q), m1 = __builtin_amdgcn_ballot_w64(k1 == (unsigned)q);
                const int c0 = __builtin_popcountll(m0), c1 = __builtin_popcountll(m1);
                const int r0 = __builtin_amdgcn_mbcnt_hi((unsigned)(m0 >> 32), __builtin_amdgcn_mbcnt_lo((unsigned)m0, 0)), r1 = __builtin_amdgcn_mbcnt_hi((unsigned)(m1 >> 32), __builtin_amdgcn_mbcnt_lo((unsigned)m1, 0));
                if (k0 == (unsigned)q) pos0 = offq + r0;
                if (k1 == (unsigned)q) pos1 = offq + c0 + r1;
                offq += c0 + c1; if (lane == q + 1) offv = offq;
            }
            const size_t tb = ((size_t)task * 8 + j) * NSLOT;
            eid[tb + pos0] = (int)e0; eid[tb + pos1] = (int)e1; gw[tb + pos0] = g0; gw[tb + pos1] = g1;
            if (lane < 16) offs[((size_t)task * 8 + j) * 16 + lane] = (lane <= 8) ? offv : NSLOT;
        }
    }
}

typedef __bf16 bf16x2v __attribute__((ext_vector_type(2)));
__device__ __forceinline__ float dot2bf(unsigned a, unsigned b, float c) { return __builtin_amdgcn_fdot2_f32_bf16(__builtin_bit_cast(bf16x2v, a), __builtin_bit_cast(bf16x2v, b), c, false); }
__device__ __forceinline__ float dot8(u32x4 a, u32x4 b, float c) { c = dot2bf(a.x, b.x, c); c = dot2bf(a.y, b.y, c); c = dot2bf(a.z, b.z, c); return dot2bf(a.w, b.w, c); }
__device__ __forceinline__ void ph_peer_u2(const bf16_t* hn, const bf16_t* Ub, const int* eid, const float* gw, float* wact) {
    const int tid = opq_tid(), lane = tid & 63, wv = __builtin_amdgcn_readfirstlane(tid >> 6); const unsigned voff = (unsigned)lane * 16u;
    for (int t = blockIdx.x * NWAVE + wv; t < T; t += gridDim.x * NWAVE) {
        const u32x4 h0 = *(const u32x4*)(hn + (size_t)t * DM + lane * 8), h1 = *(const u32x4*)(hn + (size_t)t * DM + 512 + lane * 8);
        const int e_lo = eid[(size_t)t * NSLOT + lane], e_hi = eid[(size_t)t * NSLOT + 64 + lane];
        u32x4 bufA[16], bufB[16];
#define U_ISSUE(buf, st) do { unsigned vo = voff; asm("" : "+v"(vo)); _Pragma("unroll") for (int k = 0; k < 8; ++k) { const int sl = (st) * 8 + k; const int e = __builtin_amdgcn_readlane((sl < 64) ? e_lo : e_hi, sl & 63); \
            const GAS char* row = (const GAS char*)Ub + (size_t)e * (DM * 2); asm("" : "+s"(row)); buf[2 * k] = *(const GAS u32x4*)(row + vo); buf[2 * k + 1] = *(const GAS u32x4*)(row + 1024 + vo); } } while (0)
#define U_DOT(buf, dst, off) do { _Pragma("unroll") for (int k = 0; k < 8; ++k) dst[(off) + k] = dot8(buf[2 * k + 1], h1, dot8(buf[2 * k], h0, 0.f)); } while (0)
#define U_REDUCE(hh_) do { float r8[8], r4[4], r2[2], r1; \
            _Pragma("unroll") for (int k = 0; k < 8; ++k) { const bool up = lane & 32; const float keep = up ? part[k + 8] : part[k], send = up ? part[k] : part[k + 8]; r8[k] = keep + __shfl_xor(send, 32); } \
            _Pragma("unroll") for (int k = 0; k < 4; ++k) { const bool up = lane & 16; const float keep = up ? r8[k + 4] : r8[k], send = up ? r8[k] : r8[k + 4]; r4[k] = keep + __shfl_xor(send, 16); } \
            _Pragma("unroll") for (int k = 0; k < 2; ++k) { const bool up = lane & 8; const float keep = up ? r4[k + 2] : r4[k], send = up ? r4[k] : r4[k + 2]; r2[k] = keep + __shfl_xor(send, 8); } \
            { const bool up = lane & 4; const float keep = up ? r2[1] : r2[0], send = up ? r2[0] : r2[1]; r1 = keep + __shfl_xor(send, 4); } \
            r1 += __shfl_xor(r1, 2); r1 += __shfl_xor(r1, 1); \
            if ((lane & 3) == 0) { const int s = (hh_) * 16 + (lane >> 2); wact[(size_t)t * NSLOT + s] = gw[(size_t)t * NSLOT + s] * gelu_tanh(r1); } } while (0)
        U_ISSUE(bufA, 0); U_ISSUE(bufB, 1);
#pragma unroll 1
        for (int hh = 0; hh < PH - 1; ++hh) {
            float part[16];
            U_DOT(bufA, part, 0); U_ISSUE(bufA, 2 * hh + 2);
            U_DOT(bufB, part, 8); U_ISSUE(bufB, 2 * hh + 3);
            U_REDUCE(hh);
        }
        { float part[16]; U_DOT(bufA, part, 0); U_DOT(bufB, part, 8); U_REDUCE(PH - 1); }
#undef U_REDUCE
#undef U_ISSUE
#undef U_DOT
    }
}
__device__ __forceinline__ void ph_peer_v2(float* xres, const bf16_t* Vb, const int* eid, const float* wact, const float* gn, bf16_t* hout, int last) {
    const int tid = opq_tid(), lane = tid & 63, wv = __builtin_amdgcn_readfirstlane(tid >> 6); const unsigned voff = (unsigned)lane * 16u;
    for (int t = blockIdx.x * NWAVE + wv; t < T; t += gridDim.x * NWAVE) {
        const int e_lo = eid[(size_t)t * NSLOT + lane], e_hi = eid[(size_t)t * NSLOT + 64 + lane];
        const float w_lo = wact[(size_t)t * NSLOT + lane], w_hi = wact[(size_t)t * NSLOT + 64 + lane];
        float acc[16];
#pragma unroll
        for (int i = 0; i < 16; ++i) acc[i] = 0.f;
        u32x4 bufA[16], bufB[16];
#define V_ISSUE(buf, st) do { unsigned vo = voff; asm("" : "+v"(vo)); _Pragma("unroll") for (int k = 0; k < 8; ++k) { const int sl = (st) * 8 + k; const int e = __builtin_amdgcn_readlane((sl < 64) ? e_lo : e_hi, sl & 63); \
            const GAS char* row = (const GAS char*)Vb + (size_t)e * (DM * 2); asm("" : "+s"(row)); buf[2 * k] = *(const GAS u32x4*)(row + vo); buf[2 * k + 1] = *(const GAS u32x4*)(row + 1024 + vo); } } while (0)
#define V_ACC(buf, st) do { _Pragma("unroll") for (int k = 0; k < 8; ++k) { const int sl = (st) * 8 + k; const float w = __builtin_bit_cast(float, __builtin_amdgcn_readlane(__builtin_bit_cast(int, (sl < 64) ? w_lo : w_hi), sl & 63)); \
            const u32x4 a = buf[2 * k], b = buf[2 * k + 1]; \
            acc[0] += w * lo16(a.x); acc[1] += w * hi16(a.x); acc[2] += w * lo16(a.y); acc[3] += w * hi16(a.y); acc[4] += w * lo16(a.z); acc[5] += w * hi16(a.z); acc[6] += w * lo16(a.w); acc[7] += w * hi16(a.w); \
            acc[8] += w * lo16(b.x); acc[9] += w * hi16(b.x); acc[10] += w * lo16(b.y); acc[11] += w * hi16(b.y); acc[12] += w * lo16(b.z); acc[13] += w * hi16(b.z); acc[14] += w * lo16(b.w); acc[15] += w * hi16(b.w); } } while (0)
        V_ISSUE(bufA, 0); V_ISSUE(bufB, 1);
#pragma unroll 1
        for (int st = 0; st < 14; st += 2) {
            V_ACC(bufA, st); V_ISSUE(bufA, st + 2);
            V_ACC(bufB, st + 1); V_ISSUE(bufB, st + 3);
        }
        V_ACC(bufA, 14); V_ACC(bufB, 15);
#undef V_ISSUE
#undef V_ACC
        float* xr = xres + (size_t)t * DM; float ss = 0.f;
#pragma unroll
        for (int hf = 0; hf < 2; ++hf)
#pragma unroll
            for (int j = 0; j < 2; ++j) { const f32x4 xv = *(const f32x4*)(xr + hf * 512 + lane * 8 + j * 4);
                acc[hf * 8 + j * 4 + 0] += xv.x; acc[hf * 8 + j * 4 + 1] += xv.y; acc[hf * 8 + j * 4 + 2] += xv.z; acc[hf * 8 + j * 4 + 3] += xv.w; }
#pragma unroll
        for (int i = 0; i < 16; ++i) ss += acc[i] * acc[i];
        const float rstd = rsqrtf(wave_sum(ss) * (1.f / DM) + EPS);
#pragma unroll
        for (int hf = 0; hf < 2; ++hf)
#pragma unroll
            for (int j = 0; j < 2; ++j) { const int c = hf * 512 + lane * 8 + j * 4; const f32x4 g = *(const f32x4*)(gn + c); const int a0 = hf * 8 + j * 4;
                if (last) { *(f32x4*)(xr + c) = (f32x4){acc[a0] * rstd * g.x, acc[a0 + 1] * rstd * g.y, acc[a0 + 2] * rstd * g.z, acc[a0 + 3] * rstd * g.w}; }
                else { *(f32x4*)(xr + c) = (f32x4){acc[a0], acc[a0 + 1], acc[a0 + 2], acc[a0 + 3]};
                    u32x2 ob; ob.x = pk2(acc[a0] * rstd * g.x, acc[a0 + 1] * rstd * g.y); ob.y = pk2(acc[a0 + 2] * rstd * g.z, acc[a0 + 3] * rstd * g.w); *(u32x2*)(hout + (size_t)t * DM + c) = ob; } }
    }
}


constexpr size_t WS_KM = WS_VB + 40 * MiB;
constexpr size_t WS_XB = WS_VB + 4 * MiB;
constexpr size_t WS_UQ = WS_UB, WS_VQ = WS_UB + 32 * MiB, WS_SU = WS_VB, WS_SV = WS_VB + 1 * MiB, WS_HQ = WS_VB + 2 * MiB, WS_SH = WS_VB + 18 * MiB;
__device__ __forceinline__ float ub0(unsigned x) { float f; asm("v_cvt_f32_ubyte0 %0, %1" : "=v"(f) : "v"(x)); return f; }
__device__ __forceinline__ float ub1(unsigned x) { float f; asm("v_cvt_f32_ubyte1 %0, %1" : "=v"(f) : "v"(x)); return f; }
__device__ __forceinline__ float ub2(unsigned x) { float f; asm("v_cvt_f32_ubyte2 %0, %1" : "=v"(f) : "v"(x)); return f; }
__device__ __forceinline__ float ub3(unsigned x) { float f; asm("v_cvt_f32_ubyte3 %0, %1" : "=v"(f) : "v"(x)); return f; }
__device__ __forceinline__ unsigned q8(float v, float inv, int offs) { return (unsigned)((int)__builtin_rintf(v * inv) + offs) & 255u; }
__device__ __forceinline__ void ph_quant_rows_w(const float* src, unsigned char* dst, float* scale, int nrows, int offs, int widx, int nw) {
    const int tid_ = opq_tid(); const int lane = tid_ & 63;
    for (int row0 = widx * 4; row0 < nrows; row0 += nw * 4) {
        f32x4 v[4][4]; float am[4];
#pragma unroll
        for (int r = 0; r < 4; ++r) { const f32x4* s4 = (const f32x4*)(src + (size_t)(row0 + r) * DM);
#pragma unroll
            for (int j = 0; j < 4; ++j) v[r][j] = s4[lane + 64 * j]; }
#pragma unroll
        for (int r = 0; r < 4; ++r) { float a = 0.f;
#pragma unroll
            for (int j = 0; j < 4; ++j) a = fmaxf(a, fmaxf(fmaxf(fabsf(v[r][j].x), fabsf(v[r][j].y)), fmaxf(fabsf(v[r][j].z), fabsf(v[r][j].w))));
            am[r] = wave_max(a); }
#pragma unroll
        for (int r = 0; r < 4; ++r) { const float inv = am[r] > 0.f ? 127.f / am[r] : 0.f;
#pragma unroll
            for (int j = 0; j < 4; ++j) ((unsigned*)(dst + (size_t)(row0 + r) * DM))[lane + 64 * j] = q8(v[r][j].x, inv, offs) | (q8(v[r][j].y, inv, offs) << 8) | (q8(v[r][j].z, inv, offs) << 16) | (q8(v[r][j].w, inv, offs) << 24);
            if (lane == 0) scale[row0 + r] = am[r] > 0.f ? am[r] * (1.f / 127.f) : 1.f; }
    }
}
__device__ __forceinline__ void ph_quant_rows(const float* src, unsigned char* dst, float* scale, int nrows, int offs) {
    const int wv = __builtin_amdgcn_readfirstlane((int)(threadIdx.x >> 6)); ph_quant_rows_w(src, dst, scale, nrows, offs, blockIdx.x * NWAVE + wv, gridDim.x * NWAVE);
}
__device__ __forceinline__ void ph_rmsnorm_q(const float* x, const float* g, bf16_t* out, unsigned char* hq, float* sh) {
    const int tid_ = opq_tid(); const int lane = tid_ & 63, wv = tid_ >> 6;
    for (int it = blockIdx.x; it < T / NWAVE; it += gridDim.x) {
        const int row = it * NWAVE + wv; const f32x4* xr = (const f32x4*)(x + (size_t)row * DM); f32x4 v[4]; float s = 0.f;
#pragma unroll
        for (int j = 0; j < 4; ++j) { v[j] = xr[lane + 64 * j]; s += v[j].x * v[j].x + v[j].y * v[j].y + v[j].z * v[j].z + v[j].w * v[j].w; }
        const float rstd = rsqrtf(wave_sum(s) * (1.f / DM) + EPS); float am = 0.f;
#pragma unroll
        for (int j = 0; j < 4; ++j) { const f32x4 gg = ((const f32x4*)g)[lane + 64 * j]; v[j] = v[j] * rstd * gg; am = fmaxf(am, fmaxf(fmaxf(fabsf(v[j].x), fabsf(v[j].y)), fmaxf(fabsf(v[j].z), fabsf(v[j].w))));
            u32x2 o; o.x = pk2(v[j].x, v[j].y); o.y = pk2(v[j].z, v[j].w); ((u32x2*)(out + (size_t)row * DM))[lane + 64 * j] = o; }
        am = wave_max(am); const float inv = am > 0.f ? 127.f / am : 0.f;
#pragma unroll
        for (int j = 0; j < 4; ++j) ((unsigned*)(hq + (size_t)row * DM))[lane + 64 * j] = q8(v[j].x, inv, 0) | (q8(v[j].y, inv, 0) << 8) | (q8(v[j].z, inv, 0) << 16) | (q8(v[j].w, inv, 0) << 24);
        if (lane == 0) sh[row] = am > 0.f ? am * (1.f / 127.f) : 1.f;
    }
}
__device__ __forceinline__ int dot16i(u32x4 a, u32x4 b) { int c = __builtin_amdgcn_sdot4((int)a.x, (int)b.x, 0, false); c = __builtin_amdgcn_sdot4((int)a.y, (int)b.y, c, false); c = __builtin_amdgcn_sdot4((int)a.z, (int)b.z, c, false); return __builtin_amdgcn_sdot4((int)a.w, (int)b.w, c, false); }
template <int EMASK> __device__ __forceinline__ void ph_peer_u3(const unsigned char* hq, const float* sh, const unsigned char* Uq, const float* su, const int* eid, const float* gw, float* wact) {
    const int tid = opq_tid(), lane = tid & 63, wv = __builtin_amdgcn_readfirstlane(tid >> 6); const unsigned voff = (unsigned)lane * 16u;
    for (int t = blockIdx.x * NWAVE + wv; t < T; t += gridDim.x * NWAVE) {
        const u32x4 h4 = *(const u32x4*)(hq + (size_t)t * DM + lane * 16);
        const int e_lo = eid[(size_t)t * NSLOT + lane], e_hi = eid[(size_t)t * NSLOT + 64 + lane];
        const float sht = sh[t];
        const float g_lo = gw[(size_t)t * NSLOT + lane], g_hi = gw[(size_t)t * NSLOT + 64 + lane];
        const float sc_lo = su[e_lo] * sht, sc_hi = su[e_hi] * sht;
        u32x4 bufA[16], bufB[16];
#define U_ISSUE(buf, hh_) do { unsigned vo = voff; asm("" : "+v"(vo)); _Pragma("unroll") for (int k = 0; k < 16; ++k) { const int sl = (hh_) * 16 + k; const int e = __builtin_amdgcn_readlane((sl < 64) ? e_lo : e_hi, sl & 63) & EMASK; \
            const GAS char* row = (const GAS char*)Uq + (size_t)e * DM; asm("" : "+s"(row)); buf[k] = *(const GAS u32x4*)(row + vo); } } while (0)
#define U_HEAD(buf, hh_) do { float part[16]; _Pragma("unroll") for (int k = 0; k < 16; ++k) part[k] = (float)dot16i(buf[k], h4); \
            float r8[8], r4[4], r2[2], r1; \
            _Pragma("unroll") for (int k = 0; k < 8; ++k) { const bool up = lane & 32; const float keep = up ? part[k + 8] : part[k], send = up ? part[k] : part[k + 8]; r8[k] = keep + __shfl_xor(send, 32); } \
            _Pragma("unroll") for (int k = 0; k < 4; ++k) { const bool up = lane & 16; const float keep = up ? r8[k + 4] : r8[k], send = up ? r8[k] : r8[k + 4]; r4[k] = keep + __shfl_xor(send, 16); } \
            _Pragma("unroll") for (int k = 0; k < 2; ++k) { const bool up = lane & 8; const float keep = up ? r4[k + 2] : r4[k], send = up ? r4[k] : r4[k + 2]; r2[k] = keep + __shfl_xor(send, 8); } \
            { const bool up = lane & 4; const float keep = up ? r2[1] : r2[0], send = up ? r2[0] : r2[1]; r1 = keep + __shfl_xor(send, 4); } \
            r1 += __shfl_xor(r1, 2); r1 += __shfl_xor(r1, 1); \
            const int sl_ = ((hh_) & 3) * 16 + (lane >> 2); const float scl = __shfl(((hh_) < 4) ? sc_lo : sc_hi, sl_), gg = __shfl(((hh_) < 4) ? g_lo : g_hi, sl_); \
            if ((lane & 3) == 0) wact[(size_t)t * NSLOT + (hh_) * 16 + (lane >> 2)] = gg * gelu_tanh(r1 * scl); } while (0)
        U_ISSUE(bufA, 0); U_ISSUE(bufB, 1);
#pragma unroll 1
        for (int hp = 0; hp < 3; ++hp) {
            U_HEAD(bufA, 2 * hp); U_ISSUE(bufA, 2 * hp + 2);
            U_HEAD(bufB, 2 * hp + 1); U_ISSUE(bufB, 2 * hp + 3);
        }
        U_HEAD(bufA, 6); U_HEAD(bufB, 7);
#undef U_ISSUE
#undef U_HEAD
    }
}
__device__ __forceinline__ void ph_peer_v3(float* xres, const unsigned char* Vq, const float* sv, const int* eid, const float* wact, const float* gn, bf16_t* hout, int last) {
    const int tid = opq_tid(), lane = tid & 63, wv = __builtin_amdgcn_readfirstlane(tid >> 6); const unsigned voff = (unsigned)lane * 16u;
    for (int t = blockIdx.x * NWAVE + wv; t < T; t += gridDim.x * NWAVE) {
        const int e_lo = eid[(size_t)t * NSLOT + lane], e_hi = eid[(size_t)t * NSLOT + 64 + lane];
        const float c_lo = wact[(size_t)t * NSLOT + lane] * sv[e_lo], c_hi = wact[(size_t)t * NSLOT + 64 + lane] * sv[e_hi];
        float acc[16]; float corr = 0.f;
#pragma unroll
        for (int i = 0; i < 16; ++i) acc[i] = 0.f;
        u32x4 bufA[8], bufB[8];
#define V_ISSUE(buf, st_) do { unsigned vo = voff; asm("" : "+v"(vo)); _Pragma("unroll") for (int k = 0; k < 8; ++k) { const int sl = (st_) * 8 + k; const int e = __builtin_amdgcn_readlane((sl < 64) ? e_lo : e_hi, sl & 63); \
            const GAS char* row = (const GAS char*)Vq + (size_t)e * DM; asm("" : "+s"(row)); buf[k] = *(const GAS u32x4*)(row + vo); } } while (0)
#define V_ACC(buf, st_) do { _Pragma("unroll") for (int k = 0; k < 8; ++k) { const int sl = (st_) * 8 + k; const float w = __builtin_bit_cast(float, __builtin_amdgcn_readlane(__builtin_bit_cast(int, (sl < 64) ? c_lo : c_hi), sl & 63)); \
            const u32x4 a = buf[k]; corr += w; \
            acc[0] += w * ub0(a.x); acc[1] += w * ub1(a.x); acc[2] += w * ub2(a.x); acc[3] += w * ub3(a.x); acc[4] += w * ub0(a.y); acc[5] += w * ub1(a.y); acc[6] += w * ub2(a.y); acc[7] += w * ub3(a.y); \
            acc[8] += w * ub0(a.z); acc[9] += w * ub1(a.z); acc[10] += w * ub2(a.z); acc[11] += w * ub3(a.z); acc[12] += w * ub0(a.w); acc[13] += w * ub1(a.w); acc[14] += w * ub2(a.w); acc[15] += w * ub3(a.w); } } while (0)
        V_ISSUE(bufA, 0); V_ISSUE(bufB, 1);
#pragma unroll 1
        for (int st = 0; st < 14; st += 2) {
            V_ACC(bufA, st); V_ISSUE(bufA, st + 2);
            V_ACC(bufB, st + 1); V_ISSUE(bufB, st + 3);
        }
        V_ACC(bufA, 14); V_ACC(bufB, 15);
#undef V_ISSUE
#undef V_ACC
        float* xr = xres + (size_t)t * DM + lane * 16; float ss = 0.f; const float c128 = 128.f * corr;
#pragma unroll
        for (int j = 0; j < 4; ++j) { const f32x4 xv = *(const f32x4*)(xr + j * 4);
            acc[j * 4 + 0] += xv.x - c128; acc[j * 4 + 1] += xv.y - c128; acc[j * 4 + 2] += xv.z - c128; acc[j * 4 + 3] += xv.w - c128; }
#pragma unroll
        for (int i = 0; i < 16; ++i) ss += acc[i] * acc[i];
        const float rstd = rsqrtf(wave_sum(ss) * (1.f / DM) + EPS);
#pragma unroll
        for (int j = 0; j < 4; ++j) { const int c = lane * 16 + j * 4; const f32x4 g = *(const f32x4*)(gn + c); const int a0 = j * 4;
            if (last) { *(f32x4*)(xr + j * 4) = (f32x4){acc[a0] * rstd * g.x, acc[a0 + 1] * rstd * g.y, acc[a0 + 2] * rstd * g.z, acc[a0 + 3] * rstd * g.w}; }
            else { *(f32x4*)(xr + j * 4) = (f32x4){acc[a0], acc[a0 + 1], acc[a0 + 2], acc[a0 + 3]};
                u32x2 ob; ob.x = pk2(acc[a0] * rstd * g.x, acc[a0 + 1] * rstd * g.y); ob.y = pk2(acc[a0 + 2] * rstd * g.z, acc[a0 + 3] * rstd * g.w); *(u32x2*)(hout + (size_t)t * DM + c) = ob; } }
    }
}


__device__ __forceinline__ void ph_peer_v5(float* xres, const unsigned char* Vq, const float* sv, const int* eid, const float* wact, const float* gn, bf16_t* hout, int last) {
    const int tid = opq_tid(), lane = tid & 63, wv = __builtin_amdgcn_readfirstlane(tid >> 6); const unsigned voff = (unsigned)lane * 16u;
    for (int t = blockIdx.x * NWAVE + wv; t < T; t += gridDim.x * NWAVE) {
        const int e_lo = eid[(size_t)t * NSLOT + lane], e_hi = eid[(size_t)t * NSLOT + 64 + lane];
        const float c_lo = wact[(size_t)t * NSLOT + lane] * sv[e_lo], c_hi = wact[(size_t)t * NSLOT + 64 + lane] * sv[e_hi];
        float acc[16]; float corr = 0.f;
#pragma unroll
        for (int i = 0; i < 16; ++i) acc[i] = 0.f;
        u32x4 bufA[16], bufB[16];
#define V_ISSUE(buf, hh_) do { _Pragma("unroll") for (int k = 0; k < 16; ++k) { const int sl = (hh_) * 16 + k; const int e = __builtin_amdgcn_readlane((sl < 64) ? e_lo : e_hi, sl & 63); \
            const GAS char* row = (const GAS char*)Vq + (size_t)e * DM; asm("" : "+s"(row)); unsigned vo = voff; asm("" : "+v"(vo)); buf[k] = *(const GAS u32x4*)(row + vo); } } while (0)
#define V_ACC(buf, hh_) do { _Pragma("unroll") for (int k = 0; k < 16; ++k) { const int sl = (hh_) * 16 + k; const float w = __builtin_bit_cast(float, __builtin_amdgcn_readlane(__builtin_bit_cast(int, (sl < 64) ? c_lo : c_hi), sl & 63)); \
            const u32x4 a = buf[k]; corr += w; \
            acc[0] += w * ub0(a.x); acc[1] += w * ub1(a.x); acc[2] += w * ub2(a.x); acc[3] += w * ub3(a.x); acc[4] += w * ub0(a.y); acc[5] += w * ub1(a.y); acc[6] += w * ub2(a.y); acc[7] += w * ub3(a.y); \
            acc[8] += w * ub0(a.z); acc[9] += w * ub1(a.z); acc[10] += w * ub2(a.z); acc[11] += w * ub3(a.z); acc[12] += w * ub0(a.w); acc[13] += w * ub1(a.w); acc[14] += w * ub2(a.w); acc[15] += w * ub3(a.w); \
            __builtin_amdgcn_sched_barrier(0); } } while (0)
        V_ISSUE(bufA, 0); V_ISSUE(bufB, 1);
#pragma unroll 1
        for (int hp = 0; hp < 3; ++hp) {
            V_ACC(bufA, 2 * hp); V_ISSUE(bufA, 2 * hp + 2);
            V_ACC(bufB, 2 * hp + 1); V_ISSUE(bufB, 2 * hp + 3);
        }
        V_ACC(bufA, 6); V_ACC(bufB, 7);
#undef V_ISSUE
#undef V_ACC
        float* xr = xres + (size_t)t * DM + lane * 16; float ss = 0.f; const float c128 = 128.f * corr;
#pragma unroll
        for (int j = 0; j < 4; ++j) { const f32x4 xv = *(const f32x4*)(xr + j * 4);
            acc[j * 4 + 0] += xv.x - c128; acc[j * 4 + 1] += xv.y - c128; acc[j * 4 + 2] += xv.z - c128; acc[j * 4 + 3] += xv.w - c128; }
#pragma unroll
        for (int i = 0; i < 16; ++i) ss += acc[i] * acc[i];
        const float rstd = rsqrtf(wave_sum(ss) * (1.f / DM) + EPS);
#pragma unroll
        for (int j = 0; j < 4; ++j) { const int c = lane * 16 + j * 4; const f32x4 g = *(const f32x4*)(gn + c); const int a0 = j * 4;
            if (last) { *(f32x4*)(xr + j * 4) = (f32x4){acc[a0] * rstd * g.x, acc[a0 + 1] * rstd * g.y, acc[a0 + 2] * rstd * g.z, acc[a0 + 3] * rstd * g.w}; }
            else { *(f32x4*)(xr + j * 4) = (f32x4){acc[a0], acc[a0 + 1], acc[a0 + 2], acc[a0 + 3]};
                u32x2 ob; ob.x = pk2(acc[a0] * rstd * g.x, acc[a0 + 1] * rstd * g.y); ob.y = pk2(acc[a0 + 2] * rstd * g.z, acc[a0 + 3] * rstd * g.w); *(u32x2*)(hout + (size_t)t * DM + c) = ob; } }
    }
}


__device__ __forceinline__ void fma_ub4(float& a0, float& a1, float& a2, float& a3, unsigned a, float w) {
    float t0, t1;
    asm("v_cvt_f32_ubyte0 %4, %6\n\tv_cvt_f32_ubyte1 %5, %6\n\tv_fmac_f32 %0, %7, %4\n\tv_fmac_f32 %1, %7, %5\n\tv_cvt_f32_ubyte2 %4, %6\n\tv_cvt_f32_ubyte3 %5, %6\n\tv_fmac_f32 %2, %7, %4\n\tv_fmac_f32 %3, %7, %5"
        : "+v"(a0), "+v"(a1), "+v"(a2), "+v"(a3), "=&v"(t0), "=&v"(t1) : "v"(a), "s"(w));
}
__device__ __forceinline__ void ph_peer_v4(float* xres, const unsigned char* Vq, const float* sv, const int* eid, const float* wact, const float* gw, const float* su, const float* sh, const float* gn, bf16_t* hout, int last) {
    const int tid = opq_tid(), lane = tid & 63, wv = __builtin_amdgcn_readfirstlane(tid >> 6); const unsigned voff = (unsigned)lane * 16u;
    const int tstride = gridDim.x * NWAVE;
    int t = blockIdx.x * NWAVE + wv;
    const int ntok = (T - t + tstride - 1) / tstride;
    int tn = (t + tstride < T) ? t + tstride : t;
    int e_lo = eid[(size_t)t * NSLOT + lane], e_hi = eid[(size_t)t * NSLOT + 64 + lane];
    float c_lo, c_hi;
    { const float sht = sh[t]; c_lo = gw[(size_t)t * NSLOT + lane] * gelu_tanh(wact[(size_t)t * NSLOT + lane] * su[e_lo] * sht) * sv[e_lo];
      c_hi = gw[(size_t)t * NSLOT + 64 + lane] * gelu_tanh(wact[(size_t)t * NSLOT + 64 + lane] * su[e_hi] * sht) * sv[e_hi]; }
    u32x4 ring[32];
#define V_LOAD(slot, esrc, ln) do { const int e = __builtin_amdgcn_readlane(esrc, ln); const GAS char* row = (const GAS char*)Vq + (size_t)e * DM; asm("" : "+s"(row)); \
        unsigned vo = voff; asm("" : "+v"(vo)); ring[slot] = *(const GAS u32x4*)(row + vo); } while (0)
#pragma unroll
    for (int k = 0; k < 32; ++k) V_LOAD(k, e_lo, k);
    f32x4 xv[4];
#pragma unroll
    for (int j = 0; j < 4; ++j) xv[j] = *(const f32x4*)(xres + (size_t)t * DM + lane * 16 + j * 4);
    int ne_lo = eid[(size_t)tn * NSLOT + lane], ne_hi = eid[(size_t)tn * NSLOT + 64 + lane];
    float nw_lo = wact[(size_t)tn * NSLOT + lane], nw_hi = wact[(size_t)tn * NSLOT + 64 + lane], ng_lo = gw[(size_t)tn * NSLOT + lane], ng_hi = gw[(size_t)tn * NSLOT + 64 + lane], nsh = sh[tn];
    float nc_lo = 0.f, nc_hi = 0.f;
    float acc[16]; float corr = 0.f;
#pragma unroll
    for (int i = 0; i < 16; ++i) acc[i] = 0.f;
#pragma unroll 1
    for (int q = 0; q < 4 * ntok; ++q) {
        const int rr = q & 3;
        const int csrc = __builtin_bit_cast(int, (rr < 2) ? c_lo : c_hi), cbase = (rr & 1) * 32;
        const int esrc = (rr == 0) ? e_lo : ((rr < 3) ? e_hi : ne_lo), ebase = (rr & 1) ? 0 : 32;
        if (rr == 2) { nc_lo = ng_lo * gelu_tanh(nw_lo * su[ne_lo] * nsh) * sv[ne_lo]; nc_hi = ng_hi * gelu_tanh(nw_hi * su[ne_hi] * nsh) * sv[ne_hi]; }
#pragma unroll
        for (int k = 0; k < 32; ++k) {
            const float w = __builtin_bit_cast(float, __builtin_amdgcn_readlane(csrc, cbase + k));
            const u32x4 a = ring[k]; corr += w;
            fma_ub4(acc[0], acc[1], acc[2], acc[3], a.x, w); fma_ub4(acc[4], acc[5], acc[6], acc[7], a.y, w); fma_ub4(acc[8], acc[9], acc[10], acc[11], a.z, w); fma_ub4(acc[12], acc[13], acc[14], acc[15], a.w, w);
            V_LOAD(k, esrc, ebase + k);
        }
        if (rr == 3) {
            float* xr = xres + (size_t)t * DM + lane * 16;
            float ss = 0.f; const float c128 = 128.f * corr;
#pragma unroll
            for (int j = 0; j < 4; ++j) { acc[j * 4 + 0] += xv[j].x - c128; acc[j * 4 + 1] += xv[j].y - c128; acc[j * 4 + 2] += xv[j].z - c128; acc[j * 4 + 3] += xv[j].w - c128; }
#pragma unroll
            for (int i = 0; i < 16; ++i) ss += acc[i] * acc[i];
            const float rstd = rsqrtf(wave_sum(ss) * (1.f / DM) + EPS);
#pragma unroll
            for (int j = 0; j < 4; ++j) { const int c = lane * 16 + j * 4; const f32x4 g = *(const f32x4*)(gn + c); const int a0 = j * 4;
                if (last) { *(f32x4*)(xr + j * 4) = (f32x4){acc[a0] * rstd * g.x, acc[a0 + 1] * rstd * g.y, acc[a0 + 2] * rstd * g.z, acc[a0 + 3] * rstd * g.w}; }
                else { *(f32x4*)(xr + j * 4) = (f32x4){acc[a0], acc[a0 + 1], acc[a0 + 2], acc[a0 + 3]};
                    u32x2 ob; ob.x = pk2(acc[a0] * rstd * g.x, acc[a0 + 1] * rstd * g.y); ob.y = pk2(acc[a0 + 2] * rstd * g.z, acc[a0 + 3] * rstd * g.w); *(u32x2*)(hout + (size_t)t * DM + c) = ob; } }
            t = tn; tn = (t + tstride < T) ? t + tstride : t;
            e_lo = ne_lo; e_hi = ne_hi; c_lo = nc_lo; c_hi = nc_hi; corr = 0.f;
#pragma unroll
            for (int i = 0; i < 16; ++i) acc[i] = 0.f;
#pragma unroll
            for (int j = 0; j < 4; ++j) xv[j] = *(const f32x4*)(xres + (size_t)t * DM + lane * 16 + j * 4);
            ne_lo = eid[(size_t)tn * NSLOT + lane]; ne_hi = eid[(size_t)tn * NSLOT + 64 + lane];
            nw_lo = wact[(size_t)tn * NSLOT + lane]; nw_hi = wact[(size_t)tn * NSLOT + 64 + lane]; ng_lo = gw[(size_t)tn * NSLOT + lane]; ng_hi = gw[(size_t)tn * NSLOT + 64 + lane]; nsh = sh[tn];
        }
    }
#undef V_LOAD
}


__device__ __forceinline__ void ph_peer_u5(const unsigned char* hq, const float* sh, const unsigned char* Uq, const float* su, const int* eid, const float* gw, const int* offs, float* wact) {
    const int tid = opq_tid(), lane = tid & 63, wv = __builtin_amdgcn_readfirstlane(tid >> 6); const unsigned voff = (unsigned)lane * 16u;
    for (int task = blockIdx.x * NWAVE + wv; task < T / 8; task += gridDim.x * NWAVE) {
        int es_lo[8], es_hi[8], offv[8]; float g_lo[8], g_hi[8], sc_lo[8], sc_hi[8]; u32x4 h4[8];
#pragma unroll
        for (int j = 0; j < 8; ++j) { const size_t t = (size_t)task * 8 + j;
            es_lo[j] = eid[t * NSLOT + lane]; es_hi[j] = eid[t * NSLOT + 64 + lane]; g_lo[j] = gw[t * NSLOT + lane]; g_hi[j] = gw[t * NSLOT + 64 + lane];
            h4[j] = *(const u32x4*)(hq + t * DM + lane * 16); offv[j] = offs[t * 16 + (lane & 15)]; }
#pragma unroll
        for (int j = 0; j < 8; ++j) { const float sht = sh[(size_t)task * 8 + j]; sc_lo[j] = su[es_lo[j]] * sht; sc_hi[j] = su[es_hi[j]] * sht; }
#pragma unroll 1
        for (int r = 0; r < 8; ++r) {
#pragma unroll
            for (int j = 0; j < 8; ++j) {
                const int p0 = __builtin_amdgcn_readlane(offv[j], r), p1 = __builtin_amdgcn_readlane(offv[j], r + 1);
#pragma unroll 1
                for (int base = p0; base < p1; base += 16) {
                    u32x4 buf[16];
#pragma unroll
                    for (int k = 0; k < 16; ++k) { const int p = base + k; buf[k] = (u32x4){0u, 0u, 0u, 0u};
                        if (p < p1) { const int e = __builtin_amdgcn_readlane((p < 64) ? es_lo[j] : es_hi[j], p & 63); const GAS char* row = (const GAS char*)Uq + (size_t)e * DM; asm("" : "+s"(row));
                            unsigned vo = voff; asm("" : "+v"(vo)); buf[k] = *(const GAS u32x4*)(row + vo); } }
                    float part[16];
#pragma unroll
                    for (int k = 0; k < 16; ++k) part[k] = (float)dot16i(buf[k], h4[j]);
                    float r8[8], r4[4], r2[2], r1;
#pragma unroll
                    for (int k = 0; k < 8; ++k) { const bool up = lane & 32; const float keep = up ? part[k + 8] : part[k], send = up ? part[k] : part[k + 8]; r8[k] = keep + __shfl_xor(send, 32); }
#pragma unroll
                    for (int k = 0; k < 4; ++k) { const bool up = lane & 16; const float keep = up ? r8[k + 4] : r8[k], send = up ? r8[k] : r8[k + 4]; r4[k] = keep + __shfl_xor(send, 16); }
#pragma unroll
                    for (int k = 0; k < 2; ++k) { const bool up = lane & 8; const float keep = up ? r4[k + 2] : r4[k], send = up ? r4[k] : r4[k + 2]; r2[k] = keep + __shfl_xor(send, 8); }
                    { const bool up = lane & 4; const float keep = up ? r2[1] : r2[0], send = up ? r2[0] : r2[1]; r1 = keep + __shfl_xor(send, 4); }
                    r1 += __shfl_xor(r1, 2); r1 += __shfl_xor(r1, 1);
                    const int pp = base + (lane >> 2);
                    const float s0 = __shfl(sc_lo[j], pp & 63), s1 = __shfl(sc_hi[j], pp & 63), q0 = __shfl(g_lo[j], pp & 63), q1 = __shfl(g_hi[j], pp & 63);
                    const float scl = (pp < 64) ? s0 : s1, gg = (pp < 64) ? q0 : q1;
                    if ((lane & 3) == 0 && pp < p1) wact[((size_t)task * 8 + j) * NSLOT + pp] = gg * gelu_tanh(r1 * scl);
                }
            }
        }
    }
}
__device__ __forceinline__ void ph_peer_v6(float* xres, const unsigned char* Vq, const float* sv, const int* eid, const float* wact, const int* offs, const float* gn, bf16_t* hout, int last) {
    const int tid = opq_tid(), lane = tid & 63, wv = __builtin_amdgcn_readfirstlane(tid >> 6); const unsigned voff = (unsigned)lane * 16u;
    for (int task = blockIdx.x * NWAVE + wv; task < T / 4; task += gridDim.x * NWAVE) {
        int es_lo[4], es_hi[4], offv[4]; float c_lo[4], c_hi[4];
#pragma unroll
        for (int j = 0; j < 4; ++j) { const size_t t = (size_t)task * 4 + j;
            es_lo[j] = eid[t * NSLOT + lane]; es_hi[j] = eid[t * NSLOT + 64 + lane]; c_lo[j] = wact[t * NSLOT + lane]; c_hi[j] = wact[t * NSLOT + 64 + lane]; offv[j] = offs[t * 16 + (lane & 15)]; }
#pragma unroll
        for (int j = 0; j < 4; ++j) { c_lo[j] *= sv[es_lo[j]]; c_hi[j] *= sv[es_hi[j]]; }
        float acc[4][16], corr[4];
#pragma unroll
        for (int j = 0; j < 4; ++j) { corr[j] = 0.f;
#pragma unroll
            for (int i = 0; i < 16; ++i) acc[j][i] = 0.f; }
#pragma unroll 1
        for (int r = 0; r < 8; ++r) {
#pragma unroll
            for (int j = 0; j < 4; ++j) {
                const int p0 = __builtin_amdgcn_readlane(offv[j], r), p1 = __builtin_amdgcn_readlane(offv[j], r + 1);
#pragma unroll 1
                for (int base = p0; base < p1; base += 16) {
                    u32x4 buf[16];
#pragma unroll
                    for (int k = 0; k < 16; ++k) { const int p = base + k; buf[k] = (u32x4){0u, 0u, 0u, 0u};
                        if (p < p1) { const int e = __builtin_amdgcn_readlane((p < 64) ? es_lo[j] : es_hi[j], p & 63); const GAS char* row = (const GAS char*)Vq + (size_t)e * DM; asm("" : "+s"(row));
                            unsigned vo = voff; asm("" : "+v"(vo)); buf[k] = *(const GAS u32x4*)(row + vo); } }
#pragma unroll
                    for (int k = 0; k < 16; ++k) { const int p = base + k; const int pc = (p < NSLOT) ? p : NSLOT - 1;
                        float w = __builtin_bit_cast(float, __builtin_amdgcn_readlane(__builtin_bit_cast(int, (pc < 64) ? c_lo[j] : c_hi[j]), pc & 63)); w = (p < p1) ? w : 0.f;
                        corr[j] += w; const u32x4 a = buf[k];
                        fma_ub4(acc[j][0], acc[j][1], acc[j][2], acc[j][3], a.x, w); fma_ub4(acc[j][4], acc[j][5], acc[j][6], acc[j][7], a.y, w);
                        fma_ub4(acc[j][8], acc[j][9], acc[j][10], acc[j][11], a.z, w); fma_ub4(acc[j][12], acc[j][13], acc[j][14], acc[j][15], a.w, w); }
                }
            }
        }
#pragma unroll
        for (int j = 0; j < 4; ++j) {
            const size_t t = (size_t)task * 4 + j; float* xr = xres + t * DM + lane * 16; float ss = 0.f; const float c128 = 128.f * corr[j];
#pragma unroll
            for (int q = 0; q < 4; ++q) { const f32x4 xv = *(const f32x4*)(xr + q * 4);
                acc[j][q * 4 + 0] += xv.x - c128; acc[j][q * 4 + 1] += xv.y - c128; acc[j][q * 4 + 2] += xv.z - c128; acc[j][q * 4 + 3] += xv.w - c128; }
#pragma unroll
            for (int i = 0; i < 16; ++i) ss += acc[j][i] * acc[j][i];
            const float rstd = rsqrtf(wave_sum(ss) * (1.f / DM) + EPS);
#pragma unroll
            for (int q = 0; q < 4; ++q) { const int c = lane * 16 + q * 4; const f32x4 g = *(const f32x4*)(gn + c); const int a0 = q * 4;
                if (last) { *(f32x4*)(xr + q * 4) = (f32x4){acc[j][a0] * rstd * g.x, acc[j][a0 + 1] * rstd * g.y, acc[j][a0 + 2] * rstd * g.z, acc[j][a0 + 3] * rstd * g.w}; }
                else { *(f32x4*)(xr + q * 4) = (f32x4){acc[j][a0], acc[j][a0 + 1], acc[j][a0 + 2], acc[j][a0 + 3]};
                    u32x2 ob; ob.x = pk2(acc[j][a0] * rstd * g.x, acc[j][a0 + 1] * rstd * g.y); ob.y = pk2(acc[j][a0 + 2] * rstd * g.z, acc[j][a0 + 3] * rstd * g.w); *(u32x2*)(hout + t * DM + c) = ob; } }
        }
    }
}


constexpr int US_LDS = 12288;
__device__ __forceinline__ void ph_peer_u6(unsigned char* lds_, const bf16_t* xg, const float* gf, const float* rowsq, const unsigned char* Uq, const int* eid, const int* offs, float* dots, const int task) {
    const int tid = opq_tid(), lane = tid & 63, wv = __builtin_amdgcn_readfirstlane(tid >> 6); const unsigned voff = (unsigned)lane * 16u;
    LAS unsigned char* hqL = (LAS unsigned char*)lds_ + wv * (64 * TK_ROW * 4); LAS unsigned* sched = (LAS unsigned*)(hqL + 8192); LAS float* shL = (LAS float*)(hqL + 12288);
    {
        int es_lo[8], es_hi[8], offv[8]; float gv[16];
#pragma unroll
        for (int i = 0; i < 4; ++i) { const f32x4 g4 = *(const f32x4*)(gf + lane * 16 + i * 4); gv[i * 4] = g4.x; gv[i * 4 + 1] = g4.y; gv[i * 4 + 2] = g4.z; gv[i * 4 + 3] = g4.w; }
#pragma unroll
        for (int j = 0; j < 8; ++j) { const size_t t = (size_t)task * 8 + j;
            es_lo[j] = ldcg(eid + t * NSLOT + lane); es_hi[j] = ldcg(eid + t * NSLOT + 64 + lane); offv[j] = ldcg(offs + t * 16 + (lane & 15));
            const u32x4 xa = *(const u32x4*)(xg + t * DM + lane * 16), xb = *(const u32x4*)(xg + t * DM + lane * 16 + 8); const float rstd = rstd_of(rowsq, t);
            float hv[16] = {lo16(xa.x), hi16(xa.x), lo16(xa.y), hi16(xa.y), lo16(xa.z), hi16(xa.z), lo16(xa.w), hi16(xa.w), lo16(xb.x), hi16(xb.x), lo16(xb.y), hi16(xb.y), lo16(xb.z), hi16(xb.z), lo16(xb.w), hi16(xb.w)};
            float am = 0.f;
#pragma unroll
            for (int i = 0; i < 16; ++i) { hv[i] *= rstd * gv[i]; am = fmaxf(am, fabsf(hv[i])); }
            am = wave_max(am); const float inv = am > 0.f ? 127.f / am : 0.f;
            u32x4 hq4;
            hq4.x = q8(hv[0], inv, 0) | (q8(hv[1], inv, 0) << 8) | (q8(hv[2], inv, 0) << 16) | (q8(hv[3], inv, 0) << 24); hq4.y = q8(hv[4], inv, 0) | (q8(hv[5], inv, 0) << 8) | (q8(hv[6], inv, 0) << 16) | (q8(hv[7], inv, 0) << 24);
            hq4.z = q8(hv[8], inv, 0) | (q8(hv[9], inv, 0) << 8) | (q8(hv[10], inv, 0) << 16) | (q8(hv[11], inv, 0) << 24); hq4.w = q8(hv[12], inv, 0) | (q8(hv[13], inv, 0) << 8) | (q8(hv[14], inv, 0) << 16) | (q8(hv[15], inv, 0) << 24);
            *(LAS u32x4*)(hqL + j * 1024 + lane * 16) = hq4; if (lane == 0) shL[j] = am * (1.f / 127.f); }
        int ncell = 0;
#pragma unroll
        for (int j = 0; j < 8; ++j) { const int v = __shfl(offv[j], (lane >> 3) + 1) - __shfl(offv[j], lane >> 3); if ((lane & 7) == j) ncell = v; }
        int scan = ncell;
#pragma unroll
        for (int o = 1; o < 64; o <<= 1) { const int u = __shfl_up(scan, o); if (lane >= o) scan += u; }
        const int sexc = scan - ncell;
#pragma unroll
        for (int j = 0; j < 8; ++j) {
            const int r0 = es_lo[j] >> 11, r1 = es_hi[j] >> 11;
            const int i0 = __shfl(sexc, r0 * 8 + j) + lane - __shfl(offv[j], r0), i1 = __shfl(sexc, r1 * 8 + j) + 64 + lane - __shfl(offv[j], r1);
            sched[i0] = (unsigned)es_lo[j] | ((unsigned)j << 14) | ((unsigned)lane << 17); sched[i1] = (unsigned)es_hi[j] | ((unsigned)j << 14) | ((unsigned)(64 + lane) << 17);
        }
        u32x4 bufA[16], bufB[16]; unsigned entA, entB;
#define US_ISSUE(buf, ent, s_) do { ent = sched[(s_) * 16 + (lane & 15)]; unsigned vo = voff; asm("" : "+v"(vo)); _Pragma("unroll") for (int k = 0; k < 16; ++k) { \
            const unsigned e = (unsigned)__builtin_amdgcn_readlane((int)ent, k) & 16383u; const GAS char* row = (const GAS char*)Uq + (size_t)e * DM; asm("" : "+s"(row)); buf[k] = *(const GAS u32x4*)(row + vo); } } while (0)
#define US_CONS(buf, ent) do { float part[16]; _Pragma("unroll") for (int k = 0; k < 16; ++k) { const unsigned jj = ((unsigned)__builtin_amdgcn_readlane((int)ent, k) >> 14) & 7u; \
                const u32x4 hrow = *(const LAS u32x4*)(hqL + jj * 1024 + lane * 16); part[k] = (float)dot16i(buf[k], hrow); } \
            float r8[8], r4[4], r2[2], r1; \
            _Pragma("unroll") for (int k = 0; k < 8; ++k) { const bool up = lane & 32; const float keep = up ? part[k + 8] : part[k], send = up ? part[k] : part[k + 8]; r8[k] = keep + __shfl_xor(send, 32); } \
            _Pragma("unroll") for (int k = 0; k < 4; ++k) { const bool up = lane & 16; const float keep = up ? r8[k + 4] : r8[k], send = up ? r8[k] : r8[k + 4]; r4[k] = keep + __shfl_xor(send, 16); } \
            _Pragma("unroll") for (int k = 0; k < 2; ++k) { const bool up = lane & 8; const float keep = up ? r4[k + 2] : r4[k], send = up ? r4[k] : r4[k + 2]; r2[k] = keep + __shfl_xor(send, 8); } \
            { const bool up = lane & 4; const float keep = up ? r2[1] : r2[0], send = up ? r2[0] : r2[1]; r1 = keep + __shfl_xor(send, 4); } \
            r1 += __shfl_xor(r1, 2); r1 += __shfl_xor(r1, 1); \
            const unsigned me = (unsigned)__shfl((int)ent, lane >> 2); \
            if ((lane & 3) == 0) dots[(((size_t)task * 8 + ((me >> 14) & 7u)) << 7) + (me >> 17)] = r1 * shL[(me >> 14) & 7u]; } while (0)
        US_ISSUE(bufA, entA, 0); US_ISSUE(bufB, entB, 1);
#pragma unroll 1
        for (int s = 0; s < 62; s += 2) {
            US_CONS(bufA, entA); US_ISSUE(bufA, entA, s + 2);
            US_CONS(bufB, entB); US_ISSUE(bufB, entB, s + 3);
        }
        US_CONS(bufA, entA); US_CONS(bufB, entB);
#undef US_ISSUE
#undef US_CONS
    }
}


__device__ __forceinline__ void fma_ub4v(float& a0, float& a1, float& a2, float& a3, unsigned a, float w) {
    float t0, t1;
    asm("v_cvt_f32_ubyte0 %4, %6\n\tv_cvt_f32_ubyte1 %5, %6\n\tv_fmac_f32 %0, %7, %4\n\tv_fmac_f32 %1, %7, %5\n\tv_cvt_f32_ubyte2 %4, %6\n\tv_cvt_f32_ubyte3 %5, %6\n\tv_fmac_f32 %2, %7, %4\n\tv_fmac_f32 %3, %7, %5"
        : "+v"(a0), "+v"(a1), "+v"(a2), "+v"(a3), "=&v"(t0), "=&v"(t1) : "v"(a), "v"(w));
}
constexpr int VS_LDS = 16384 + 256;
template <int MODE> __device__ __forceinline__ void ph_peer_v7(unsigned char* lds_, float* xres, const unsigned char* Vq, const float* sv, const int* eid, const float* dots, const float* gw, const float* su, const float* sh,
                                           const int* offs, const float* gn, bf16_t* hout, int last) {
    const int tid = opq_tid(), lane = tid & 63, wv = __builtin_amdgcn_readfirstlane(tid >> 6); const int j = lane >> 4, li = lane & 15;
    LAS int* slotE = (LAS int*)((LAS unsigned char*)lds_ + wv * VS_LDS); LAS float* slotC = (LAS float*)(slotE + 2048);
    for (int task = blockIdx.x * NWAVE + wv; task < T / 4; task += gridDim.x * NWAVE) {
        int nmax = 0, sexc;
        int offq[4];
#pragma unroll
        for (int q = 0; q < 4; ++q) { offq[q] = offs[((size_t)task * 4 + q) * 16 + (lane & 15)]; const int n = __shfl(offq[q], (lane & 15) + 1) - offq[q]; nmax = (n > nmax) ? n : nmax; }
        nmax = (lane < 8) ? nmax : 0;
        { int sc = nmax;
#pragma unroll
          for (int o = 1; o < 8; o <<= 1) { const int u = __shfl_up(sc, o); if (lane >= o) sc += u; }
          sexc = sc - nmax; }
        const int total = __builtin_amdgcn_readlane(sexc, 7) + __builtin_amdgcn_readlane(nmax, 7);
        for (int i = lane; i < total * 4; i += 64) { slotE[i] = -1; slotC[i] = 0.f; }
#pragma unroll
        for (int q = 0; q < 4; ++q) { const size_t t = (size_t)task * 4 + q; const float sht = sh[t];
#pragma unroll
            for (int hf = 0; hf < 2; ++hf) { const int p = hf * 64 + lane; const int e = eid[t * NSLOT + p]; const float c = gw[t * NSLOT + p] * gelu_tanh(dots[t * NSLOT + p] * su[e] * sht) * sv[e];
                const int r = e >> 11; const int s = __shfl(sexc, r) + p - __shfl(offq[q], r); slotE[s * 4 + q] = e; slotC[s * 4 + q] = c; } }
        float acc[64]; float corr = 0.f;
#pragma unroll
        for (int i = 0; i < 64; ++i) acc[i] = 0.f;
        constexpr int RING = 6; u32x4 ring[RING][4]; float cR[RING];
#define VS_ISSUE(u_, s_) do { const int s__ = (s_); int e = -1; float c = 0.f; if (s__ < total) { e = slotE[s__ * 4 + j]; c = slotC[s__ * 4 + j]; } cR[u_] = c; \
            if (e >= 0) { const u32x4* rp = (const u32x4*)(Vq + (size_t)(MODE == 2 ? (e & 2047) : e) * DM) + li; ring[u_][0] = rp[0]; ring[u_][1] = rp[16]; ring[u_][2] = rp[32]; ring[u_][3] = rp[48]; } } while (0)
#define VS_CONS(u_) do { const float w = cR[u_]; corr += w; if (MODE >= 1) { acc[0] += w * __uint_as_float((ring[u_][0].x ^ ring[u_][1].y ^ ring[u_][2].z ^ ring[u_][3].w) & 0x3f800000u); } else _Pragma("unroll") for (int m = 0; m < 4; ++m) { const u32x4 a = ring[u_][m]; \
            fma_ub4v(acc[m * 16 + 0], acc[m * 16 + 1], acc[m * 16 + 2], acc[m * 16 + 3], a.x, w); fma_ub4v(acc[m * 16 + 4], acc[m * 16 + 5], acc[m * 16 + 6], acc[m * 16 + 7], a.y, w); \
            fma_ub4v(acc[m * 16 + 8], acc[m * 16 + 9], acc[m * 16 + 10], acc[m * 16 + 11], a.z, w); fma_ub4v(acc[m * 16 + 12], acc[m * 16 + 13], acc[m * 16 + 14], acc[m * 16 + 15], a.w, w); } } while (0)
#pragma unroll
        for (int u = 0; u < RING; ++u) {
#pragma unroll
            for (int m = 0; m < 4; ++m) ring[u][m] = (u32x4){0u, 0u, 0u, 0u};
            VS_ISSUE(u, u); }
#pragma unroll 1
        for (int base = 0; base < total; base += RING) {
#pragma unroll
            for (int u = 0; u < RING; ++u) { VS_CONS(u); VS_ISSUE(u, base + RING + u); }
        }
#undef VS_ISSUE
#undef VS_CONS
        const size_t t = (size_t)task * 4 + j; float* xr = xres + t * DM + li * 16; float ss = 0.f; const float c128 = 128.f * corr;
#pragma unroll
        for (int m = 0; m < 4; ++m)
#pragma unroll
            for (int q = 0; q < 4; ++q) { const f32x4 xv = *(const f32x4*)(xr + m * 256 + q * 4); const int a0 = m * 16 + q * 4;
                acc[a0] += xv.x - c128; acc[a0 + 1] += xv.y - c128; acc[a0 + 2] += xv.z - c128; acc[a0 + 3] += xv.w - c128; }
#pragma unroll
        for (int i = 0; i < 64; ++i) ss += acc[i] * acc[i];
        ss += __shfl_xor(ss, 1); ss += __shfl_xor(ss, 2); ss += __shfl_xor(ss, 4); ss += __shfl_xor(ss, 8);
        const float rstd = rsqrtf(ss * (1.f / DM) + EPS);
#pragma unroll
        for (int m = 0; m < 4; ++m)
#pragma unroll
            for (int q = 0; q < 4; ++q) { const int c = m * 256 + li * 16 + q * 4; const f32x4 g = *(const f32x4*)(gn + c); const int a0 = m * 16 + q * 4;
                if (last) { *(f32x4*)(xres + t * DM + c) = (f32x4){acc[a0] * rstd * g.x, acc[a0 + 1] * rstd * g.y, acc[a0 + 2] * rstd * g.z, acc[a0 + 3] * rstd * g.w}; }
                else { *(f32x4*)(xres + t * DM + c) = (f32x4){acc[a0], acc[a0 + 1], acc[a0 + 2], acc[a0 + 3]};
                    u32x2 ob; ob.x = pk2(acc[a0] * rstd * g.x, acc[a0 + 1] * rstd * g.y); ob.y = pk2(acc[a0 + 2] * rstd * g.z, acc[a0 + 3] * rstd * g.w); *(u32x2*)(hout + t * DM + c) = ob; } }
    }
}


constexpr int VS8_LDS = 4096;
template <int MODE> __device__ __forceinline__ void ph_peer_v8(unsigned char* lds_, float* xres, const unsigned char* Vq, const float* sv, const int* eid, const float* dots, const float* gw, const float* su, const float* sh,
                                           const int* offs, const float* gn, bf16_t* hout, int last) {
    const int tid = opq_tid(), lane = tid & 63, wv = __builtin_amdgcn_readfirstlane(tid >> 6); const unsigned voff = (unsigned)lane * 16u;
    LAS unsigned* sched = (LAS unsigned*)((LAS unsigned char*)lds_ + wv * VS8_LDS); LAS unsigned char* schedW = (LAS unsigned char*)(sched + 640);
    for (int task = blockIdx.x * NWAVE + wv; task < T / 4; task += gridDim.x * NWAVE) {
        int offq[4]; int npad = 0;
#pragma unroll
        for (int q = 0; q < 4; ++q) { offq[q] = offs[((size_t)task * 4 + q) * 16 + (lane & 15)]; const int n = __shfl(offq[q], (lane >> 2) + 1) - __shfl(offq[q], lane >> 2); if ((lane & 3) == q) npad = (n + 3) & ~3; }
        npad = (lane < 32) ? npad : 0;
        int sc_ = npad;
#pragma unroll
        for (int o = 1; o < 32; o <<= 1) { const int u = __shfl_up(sc_, o); if (lane >= o) sc_ += u; }
        const int sexc = sc_ - npad;
        const int slen = __builtin_amdgcn_readlane(sc_, 31), nst = (slen + 15) >> 4;
        for (int i = lane; i < 160; i += 64) { ((LAS u32x4*)sched)[i] = (u32x4){0u, 0u, 0u, 0u}; }
        for (int i = lane; i < 40; i += 64) { ((LAS u32x4*)schedW)[i] = (u32x4){0u, 0u, 0u, 0u}; }
        float tsc[4];
#pragma unroll
        for (int q = 0; q < 4; ++q) { const size_t t = (size_t)task * 4 + q; const float sht = sh[t];
            const int e0 = eid[t * NSLOT + lane], e1 = eid[t * NSLOT + 64 + lane];
            const float c0 = gw[t * NSLOT + lane] * gelu_tanh(dots[t * NSLOT + lane] * su[e0] * sht) * sv[e0], c1 = gw[t * NSLOT + 64 + lane] * gelu_tanh(dots[t * NSLOT + 64 + lane] * su[e1] * sht) * sv[e1];
            const float am = wave_max(fmaxf(fabsf(c0), fabsf(c1))); const float inv = am > 0.f ? 127.f / am : 0.f; tsc[q] = am * (1.f / 127.f);
            const int r0 = e0 >> 11, r1 = e1 >> 11;
            const int i0 = __shfl(sexc, r0 * 4 + q) + lane - __shfl(offq[q], r0), i1 = __shfl(sexc, r1 * 4 + q) + 64 + lane - __shfl(offq[q], r1);
            sched[i0] = (unsigned)e0 | ((unsigned)q << 14); sched[i1] = (unsigned)e1 | ((unsigned)q << 14);
            schedW[i0] = (unsigned char)((int)__builtin_rintf(c0 * inv) & 255); schedW[i1] = (unsigned char)((int)__builtin_rintf(c1 * inv) & 255); }
        int acc[4][16];
#pragma unroll
        for (int q = 0; q < 4; ++q)
#pragma unroll
            for (int i = 0; i < 16; ++i) acc[q][i] = 0;
        u32x4 bufA[8], bufB[8], bufC[8]; unsigned entA, entB, entC, wqA, wqB, wqC;
#define V8_ISSUE(buf, ent, wq, s_) do { ent = sched[(s_) * 8 + (lane & 7)]; wq = ((LAS unsigned*)schedW)[(s_) * 2 + (lane & 1)]; unsigned vo = voff; asm("" : "+v"(vo)); _Pragma("unroll") for (int k = 0; k < 8; ++k) { \
            const unsigned e = (unsigned)__builtin_amdgcn_readlane((int)ent, k) & 16383u; const GAS char* row = (const GAS char*)Vq + (size_t)e * DM; asm("" : "+s"(row)); buf[k] = *(const GAS u32x4*)(row + vo); } } while (0)
#define V8_CONS(buf, ent, wq) do { if (MODE == 1) { _Pragma("unroll") for (int k = 0; k < 8; ++k) acc[0][k] ^= (int)(buf[k].x ^ buf[k].y ^ buf[k].z ^ buf[k].w) & (int)wq; } else _Pragma("unroll") for (int g = 0; g < 2; ++g) { \
            const unsigned jg = ((unsigned)__builtin_amdgcn_readlane((int)ent, 4 * g) >> 14) & 3u; const int wg = __builtin_amdgcn_readlane((int)wq, g); \
            const int w0 = (jg == 0u) ? wg : 0, w1 = (jg == 1u) ? wg : 0, w2 = (jg == 2u) ? wg : 0, w3 = (jg == 3u) ? wg : 0;        \
            _Pragma("unroll") for (int xi = 0; xi < 4; ++xi) { const unsigned ra = buf[4 * g][xi], rb = buf[4 * g + 1][xi], rc = buf[4 * g + 2][xi], rd = buf[4 * g + 3][xi]; \
                const unsigned t0 = __builtin_amdgcn_perm(rb, ra, 0x05010400u), t1 = __builtin_amdgcn_perm(rb, ra, 0x07030602u), t2 = __builtin_amdgcn_perm(rd, rc, 0x05010400u), t3 = __builtin_amdgcn_perm(rd, rc, 0x07030602u); \
                const int o0 = (int)__builtin_amdgcn_perm(t2, t0, 0x05040100u), o1 = (int)__builtin_amdgcn_perm(t2, t0, 0x07060302u), o2 = (int)__builtin_amdgcn_perm(t3, t1, 0x05040100u), o3 = (int)__builtin_amdgcn_perm(t3, t1, 0x07060302u); \
                acc[0][4 * xi] = __builtin_amdgcn_sdot4(o0, w0, acc[0][4 * xi], false); acc[0][4 * xi + 1] = __builtin_amdgcn_sdot4(o1, w0, acc[0][4 * xi + 1], false); acc[0][4 * xi + 2] = __builtin_amdgcn_sdot4(o2, w0, acc[0][4 * xi + 2], false); acc[0][4 * xi + 3] = __builtin_amdgcn_sdot4(o3, w0, acc[0][4 * xi + 3], false); \
                acc[1][4 * xi] = __builtin_amdgcn_sdot4(o0, w1, acc[1][4 * xi], false); acc[1][4 * xi + 1] = __builtin_amdgcn_sdot4(o1, w1, acc[1][4 * xi + 1], false); acc[1][4 * xi + 2] = __builtin_amdgcn_sdot4(o2, w1, acc[1][4 * xi + 2], false); acc[1][4 * xi + 3] = __builtin_amdgcn_sdot4(o3, w1, acc[1][4 * xi + 3], false); \
                acc[2][4 * xi] = __builtin_amdgcn_sdot4(o0, w2, acc[2][4 * xi], false); acc[2][4 * xi + 1] = __builtin_amdgcn_sdot4(o1, w2, acc[2][4 * xi + 1], false); acc[2][4 * xi + 2] = __builtin_amdgcn_sdot4(o2, w2, acc[2][4 * xi + 2], false); acc[2][4 * xi + 3] = __builtin_amdgcn_sdot4(o3, w2, acc[2][4 * xi + 3], false); \
                acc[3][4 * xi] = __builtin_amdgcn_sdot4(o0, w3, acc[3][4 * xi], false); acc[3][4 * xi + 1] = __builtin_amdgcn_sdot4(o1, w3, acc[3][4 * xi + 1], false); acc[3][4 * xi + 2] = __builtin_amdgcn_sdot4(o2, w3, acc[3][4 * xi + 2], false); acc[3][4 * xi + 3] = __builtin_amdgcn_sdot4(o3, w3, acc[3][4 * xi + 3], false); } } } while (0)
        const int nst8 = (slen + 7) >> 3;
        V8_ISSUE(bufA, entA, wqA, 0); V8_ISSUE(bufB, entB, wqB, 1); V8_ISSUE(bufC, entC, wqC, 2);
#pragma unroll 1
        for (int s = 0; s < ((MODE == 2) ? 3 : nst8); s += 3) {
            V8_CONS(bufA, entA, wqA); V8_ISSUE(bufA, entA, wqA, (s + 3 < 80) ? s + 3 : 79);
            V8_CONS(bufB, entB, wqB); V8_ISSUE(bufB, entB, wqB, (s + 4 < 80) ? s + 4 : 79);
            V8_CONS(bufC, entC, wqC); V8_ISSUE(bufC, entC, wqC, (s + 5 < 80) ? s + 5 : 79);
        }
#undef V8_ISSUE
#undef V8_CONS
        int task2 = task; asm volatile("" : "+s"(task2)); int lane2 = lane; asm volatile("" : "+v"(lane2));
#pragma unroll
        for (int q = 0; q < 4; ++q) {
            const size_t t = (size_t)task2 * 4 + q; float* xr = xres + t * DM + lane2 * 16; float ss = 0.f; float y[16];
#pragma unroll
            for (int c4 = 0; c4 < 4; ++c4) { const f32x4 xv = *(const f32x4*)(xr + c4 * 4);
                y[c4 * 4 + 0] = xv.x + tsc[q] * (float)acc[q][c4 * 4 + 0]; y[c4 * 4 + 1] = xv.y + tsc[q] * (float)acc[q][c4 * 4 + 1]; y[c4 * 4 + 2] = xv.z + tsc[q] * (float)acc[q][c4 * 4 + 2]; y[c4 * 4 + 3] = xv.w + tsc[q] * (float)acc[q][c4 * 4 + 3]; }
#pragma unroll
            for (int i = 0; i < 16; ++i) ss += y[i] * y[i];
            const float rstd = rsqrtf(wave_sum(ss) * (1.f / DM) + EPS);
#pragma unroll
            for (int c4 = 0; c4 < 4; ++c4) { const int c = lane2 * 16 + c4 * 4; const f32x4 g = *(const f32x4*)(gn + c); const int a0 = c4 * 4;
                if (last) { *(f32x4*)(xr + c4 * 4) = (f32x4){y[a0] * rstd * g.x, y[a0 + 1] * rstd * g.y, y[a0 + 2] * rstd * g.z, y[a0 + 3] * rstd * g.w}; }
                else { *(f32x4*)(xr + c4 * 4) = (f32x4){y[a0], y[a0 + 1], y[a0 + 2], y[a0 + 3]};
                    u32x2 ob; ob.x = pk2(y[a0] * rstd * g.x, y[a0 + 1] * rstd * g.y); ob.y = pk2(y[a0 + 2] * rstd * g.z, y[a0 + 3] * rstd * g.w); *(u32x2*)(hout + t * DM + c) = ob; } }
        }
    }
}


template <int MODE> __device__ __forceinline__ void ph_peer_v9(float* xout, bf16_t* xb, const unsigned char* Vq, const float* sv, const int* eid, const float* dots, const float* gw, const float* su,
                                                              const float* gn, bf16_t* hout, int last, const int task) {
    const int tid = opq_tid(), lane = tid & 63, wv = __builtin_amdgcn_readfirstlane(tid >> 6); const unsigned voff = (unsigned)lane * 16u;
    {
        int e_lo[4], e_hi[4]; unsigned cw[4]; float tsc[4]; float c0[4], c1[4];
#pragma unroll
        for (int q = 0; q < 4; ++q) { const size_t t = (size_t)task * 4 + q; e_lo[q] = ldcg(eid + t * NSLOT + lane); e_hi[q] = ldcg(eid + t * NSLOT + 64 + lane); c0[q] = ldcg(gw + t * NSLOT + lane); c1[q] = ldcg(gw + t * NSLOT + 64 + lane); }
#pragma unroll
        for (int q = 0; q < 4; ++q) { const size_t t = (size_t)task * 4 + q;
            c0[q] *= gelu_tanh(ldcg(dots + t * NSLOT + lane) * su[e_lo[q]]) * sv[e_lo[q]]; c1[q] *= gelu_tanh(ldcg(dots + t * NSLOT + 64 + lane) * su[e_hi[q]]) * sv[e_hi[q]]; }
#pragma unroll
        for (int q = 0; q < 4; ++q) {
            const float am = wave_max(fmaxf(fabsf(c0[q]), fabsf(c1[q]))); const float inv = am > 0.f ? 127.f / am : 0.f; tsc[q] = am * (1.f / 127.f);
            const unsigned b0 = (unsigned)((int)__builtin_rintf(c0[q] * inv) & 255), b1 = (unsigned)((int)__builtin_rintf(c1[q] * inv) & 255);
            const unsigned p0 = b0 | (__shfl_down(b0, 1) << 8) | (__shfl_down(b0, 2) << 16) | (__shfl_down(b0, 3) << 24), p1 = b1 | (__shfl_down(b1, 1) << 8) | (__shfl_down(b1, 2) << 16) | (__shfl_down(b1, 3) << 24);
            const unsigned g0 = __shfl(p0, (lane & 15) * 4), g1 = __shfl(p1, (lane & 15) * 4); cw[q] = (lane < 16) ? g0 : g1; }
        int acc[4][16];
#pragma unroll
        for (int q = 0; q < 4; ++q)
#pragma unroll
            for (int i = 0; i < 16; ++i) acc[q][i] = 0;
        u32x4 bufA[16], bufB[16];
#define V9_ISSUE(buf, s_) do { const int s__ = (s_); unsigned vo = voff; asm("" : "+v"(vo)); _Pragma("unroll") for (int q = 0; q < 4; ++q) { const int esrc = (s__ < 16) ? e_lo[q] : e_hi[q]; _Pragma("unroll") for (int k = 0; k < 4; ++k) { \
            const int e = __builtin_amdgcn_readlane(esrc, (4 * s__ + k) & 63); const GAS char* row = (const GAS char*)Vq + (size_t)e * DM; asm("" : "+s"(row)); buf[4 * q + k] = *(const GAS u32x4*)(row + vo); } } } while (0)
#define V9_CONS(buf, s_) do { if (MODE == 1) { _Pragma("unroll") for (int k = 0; k < 16; ++k) acc[0][k] ^= (int)(buf[k].x ^ buf[k].y ^ buf[k].z ^ buf[k].w); } else { _Pragma("unroll") for (int q = 0; q < 4; ++q) { const int wg = __builtin_amdgcn_readlane((int)cw[q], (s_)); \
            _Pragma("unroll") for (int xi = 0; xi < 4; ++xi) { const unsigned ra = buf[4 * q][xi], rb = buf[4 * q + 1][xi], rc = buf[4 * q + 2][xi], rd = buf[4 * q + 3][xi]; \
                const unsigned t0 = __builtin_amdgcn_perm(rb, ra, 0x05010400u), t1 = __builtin_amdgcn_perm(rb, ra, 0x07030602u), t2 = __builtin_amdgcn_perm(rd, rc, 0x05010400u), t3 = __builtin_amdgcn_perm(rd, rc, 0x07030602u); \
                acc[q][4 * xi] = __builtin_amdgcn_sdot4((int)__builtin_amdgcn_perm(t2, t0, 0x05040100u), wg, acc[q][4 * xi], false); acc[q][4 * xi + 1] = __builtin_amdgcn_sdot4((int)__builtin_amdgcn_perm(t2, t0, 0x07060302u), wg, acc[q][4 * xi + 1], false); \
                acc[q][4 * xi + 2] = __builtin_amdgcn_sdot4((int)__builtin_amdgcn_perm(t3, t1, 0x05040100u), wg, acc[q][4 * xi + 2], false); acc[q][4 * xi + 3] = __builtin_amdgcn_sdot4((int)__builtin_amdgcn_perm(t3, t1, 0x07060302u), wg, acc[q][4 * xi + 3], false); } } } } while (0)
        V9_ISSUE(bufA, 0); V9_ISSUE(bufB, 1);
#pragma unroll 1
        for (int s = 0; s < ((MODE == 2) ? 2 : 30); s += 2) {
            V9_CONS(bufA, s); V9_ISSUE(bufA, s + 2);
            V9_CONS(bufB, s + 1); V9_ISSUE(bufB, s + 3);
        }
        V9_CONS(bufA, 30); V9_CONS(bufB, 31);
#undef V9_ISSUE
#undef V9_CONS
        int task2 = task; asm volatile("" : "+s"(task2)); int lane2 = lane; asm volatile("" : "+v"(lane2));
        f32x4 xv[4][4];
#pragma unroll
        for (int q = 0; q < 4; ++q)
#pragma unroll
            for (int c4 = 0; c4 < 4; ++c4) { const u32x2 w = *(const u32x2*)(xb + ((size_t)task2 * 4 + q) * DM + lane2 * 16 + c4 * 4); xv[q][c4] = (f32x4){lo16(w.x), hi16(w.x), lo16(w.y), hi16(w.y)}; }
        float rstd[4];
#pragma unroll
        for (int q = 0; q < 4; ++q) { float ss = 0.f;
#pragma unroll
            for (int c4 = 0; c4 < 4; ++c4) { xv[q][c4].x += tsc[q] * (float)acc[q][c4 * 4 + 0]; xv[q][c4].y += tsc[q] * (float)acc[q][c4 * 4 + 1]; xv[q][c4].z += tsc[q] * (float)acc[q][c4 * 4 + 2]; xv[q][c4].w += tsc[q] * (float)acc[q][c4 * 4 + 3];
                ss += xv[q][c4].x * xv[q][c4].x + xv[q][c4].y * xv[q][c4].y + xv[q][c4].z * xv[q][c4].z + xv[q][c4].w * xv[q][c4].w; }
            rstd[q] = rsqrtf(wave_sum(ss) * (1.f / DM) + EPS); }
#pragma unroll
        for (int q = 0; q < 4; ++q) { const size_t t = (size_t)task2 * 4 + q;
#pragma unroll
            for (int c4 = 0; c4 < 4; ++c4) { const int c = lane2 * 16 + c4 * 4; const f32x4 g = *(const f32x4*)(gn + c); const f32x4 y = xv[q][c4];
                if (last) { *(f32x4*)(xout + t * DM + c) = (f32x4){y.x * rstd[q] * g.x, y.y * rstd[q] * g.y, y.z * rstd[q] * g.z, y.w * rstd[q] * g.w}; }
                else { u32x2 ox; ox.x = pk2(y.x, y.y); ox.y = pk2(y.z, y.w); *(u32x2*)(xb + t * DM + c) = ox;
                    u32x2 ob; ob.x = pk2(y.x * rstd[q] * g.x, y.y * rstd[q] * g.y); ob.y = pk2(y.z * rstd[q] * g.z, y.w * rstd[q] * g.w); *(u32x2*)(hout + t * DM + c) = ob; } } }
    }
}


__device__ __forceinline__ void ph_peer_all(unsigned char* lds_, const short* scores, int* eid, float* gw, int* offs, float* dots, const bf16_t* xg, const float* gf, const float* rowsq, const unsigned char* Uq, const float* su,
                                            const unsigned char* Vq, const float* sv, float* xres, bf16_t* xb, const float* gn, bf16_t* hout, int last, const float* qsrc_u, const float* qsrc_v, unsigned char* qdst, float* qsc) {
    const int wv0 = __builtin_amdgcn_readfirstlane((int)(threadIdx.x >> 6));
    for (int task = blockIdx.x * NWAVE + wv0; task < T / 8; task += gridDim.x * NWAVE) {
        if (qsrc_u && wv0 >= 4) {
            const int widx = blockIdx.x * 4 + (wv0 - 4), nw = gridDim.x * 4;
            ph_quant_rows_w(qsrc_u + (size_t)NEXP * DM, qdst + (size_t)NEXP * DM, qsc, (NL - 1) * NEXP, 0, widx, nw);
            ph_quant_rows_w(qsrc_v + (size_t)NEXP * DM, qdst + (size_t)32 * MiB + (size_t)NEXP * DM, qsc + (1 * MiB / 4), (NL - 1) * NEXP, 0, widx, nw); }
        if (wv0 < 4) __builtin_amdgcn_s_setprio(3);
        ph_topk(lds_, scores, eid, gw, offs, task);
        __builtin_amdgcn_s_setprio(0);
        asm volatile("s_waitcnt vmcnt(0)" ::: "memory");
        ph_peer_u6(lds_, xg, gf, rowsq, Uq, eid, offs, dots, task);
        asm volatile("s_waitcnt vmcnt(0)" ::: "memory");
        ph_peer_v9<0>(xres, xb, Vq, sv, eid, dots, gw, su, gn, hout, last, 2 * task);
        ph_peer_v9<0>(xres, xb, Vq, sv, eid, dots, gw, su, gn, hout, last, 2 * task + 1);
    }
}

typedef GAS unsigned gu32;
#define XB_TMO      128
#define XB_XCNT(j)  (256  + 64 * (j))
#define XB_XSUB(j)  (1280 + 64 * (j))
#define XB_XGEN(j)  (2304 + 64 * (j))
#define XB_TOP      3328
#define XB_TOPGEN   3392
#define XCD_BAR_WORDS 3456
#define XB_SPIN_CAP (1u << 18)

__device__ __forceinline__ unsigned xb_ld(unsigned* p)              { return __hip_atomic_load(p, __ATOMIC_RELAXED, __HIP_MEMORY_SCOPE_AGENT); }
__device__ __forceinline__ unsigned xb_add(unsigned* p, unsigned v) { return __hip_atomic_fetch_add(p, v, __ATOMIC_RELAXED, __HIP_MEMORY_SCOPE_AGENT); }
__device__ __forceinline__ unsigned xb_xcc_id() { return (unsigned)__builtin_amdgcn_s_getreg((3 << 11) | 20) & 0xFu; }
#define XB_SPIN(cond, bar) do { unsigned _sp = 0; while (cond) { __builtin_amdgcn_s_sleep(1); \
    if ((++_sp & 255u) == 0u) { if (xb_ld(&(bar)[XB_TMO])) break; if (_sp > XB_SPIN_CAP) { atomicAdd(&(bar)[XB_TMO], 1u); break; } } } } while (0)

struct XcdBarrier {
    unsigned* bar; unsigned x;
    volatile LAS unsigned* st;
};

__device__ __forceinline__ XcdBarrier xcd_barrier_post(unsigned* bar, volatile LAS unsigned* st) {
    XcdBarrier b; b.bar = bar; b.x = xb_xcc_id(); b.st = st;
    if (threadIdx.x == 0) (void)xb_add(&bar[XB_XCNT(b.x)], 1u);
    return b;
}
__device__ __forceinline__ void xcd_barrier_complete(unsigned* bar, unsigned x, unsigned& nloc, unsigned& nx) {
    const unsigned G = gridDim.x * gridDim.y * gridDim.z;
    unsigned sum, cnt, mine, sp = 0u;
    for (;;) {
        sum = 0u; cnt = 0u; mine = 0u;
#pragma unroll
        for (unsigned j = 0; j < 16; ++j) { const unsigned c = xb_ld(&bar[XB_XCNT(j)]); sum += c; cnt += (c > 0u) ? 1u : 0u; mine = (j == x) ? c : mine; }
        if (sum == G) break;
        __builtin_amdgcn_s_sleep(1);
        if ((++sp & 255u) == 0u) { if (xb_ld(&bar[XB_TMO])) break; if (sp > XB_SPIN_CAP) { atomicAdd(&bar[XB_TMO], 1u); break; } }
    }
    nloc = mine > 0u ? mine : 1u; nx = cnt > 0u ? cnt : 1u;
}

__device__ __forceinline__ void xcd_barrier(const XcdBarrier& b) {
    asm volatile("s_waitcnt vmcnt(0)" ::: "memory");
    __syncthreads();
    if (threadIdx.x == 0) {
        unsigned* bar = b.bar;
        __builtin_amdgcn_s_waitcnt(0);
        unsigned nloc = b.st[0], nx = b.st[1];
        if (nloc == 0u) { xcd_barrier_complete(bar, b.x, nloc, nx); b.st[0] = nloc; b.st[1] = nx; }
        const unsigned old = xb_add(&bar[XB_XSUB(b.x)], 1u);
        const unsigned gen = old / nloc;
        if (old + 1u == (gen + 1u) * nloc) {
            __builtin_amdgcn_fence(__ATOMIC_RELEASE, "agent");
            asm volatile("s_waitcnt vmcnt(0)" ::: "memory");
            const unsigned og = xb_add(&bar[XB_TOP], 1u);
            const unsigned tg = og / nx;
            if (og + 1u == (tg + 1u) * nx) xb_add(&bar[XB_TOPGEN], 1u);
            else XB_SPIN(xb_ld(&bar[XB_TOPGEN]) == tg, bar);
            __builtin_amdgcn_fence(__ATOMIC_ACQUIRE, "agent");
            xb_add(&bar[XB_XGEN(b.x)], 1u);
            asm volatile("s_waitcnt vmcnt(0)" ::: "memory");
        } else {
            XB_SPIN(xb_ld(&bar[XB_XGEN(b.x)]) == gen, bar);
            __builtin_amdgcn_fence(__ATOMIC_ACQUIRE, "agent");
            asm volatile("s_waitcnt vmcnt(0)" ::: "memory");
        }
    }
    __syncthreads();
}

#define OPQ(p) do { size_t z_ = 0; asm volatile("" : "+s"(z_)); p = (decltype(p))((unsigned char*)(p) + z_); } while (0)
#define WSP(type, name, off) type* name = (type*)(ws + (off))
__global__ void __launch_bounds__(NTHR, 2) mk_fwd(Args a) {
    extern __shared__ __attribute__((aligned(16))) unsigned char lds[];
    float* smem = (float*)lds;
    volatile LAS unsigned* bst = (volatile LAS unsigned*)((LAS unsigned char*)lds + (LDS_BYTES - 64));
    if (threadIdx.x < 2) bst[threadIdx.x] = 0u;
    __syncthreads();
    (void)xcd_barrier_post((unsigned*)(a.ws + WS_CTL), bst);
#ifndef PROBE_I
#define PROBE_I -1
#endif
#define GRID_BAR() do { XcdBarrier b_; b_.bar = (unsigned*)(a.ws + WS_CTL); b_.x = xb_xcc_id(); b_.st = (volatile LAS unsigned*)((LAS unsigned char*)lds + (LDS_BYTES - 64)); xcd_barrier(b_); } while (0)
#define REP(idx) for (int rep_ = 0; rep_ < ((PROBE_I == (idx) && l == 0) ? 2 : 1); ++rep_)
    for (int rep_ = 0; rep_ < (PROBE_I == 0 ? 2 : 1); ++rep_) {
        unsigned char* ws = a.ws; OPQ(ws);
        WSP(bf16_t, Wpool, WS_WPOOL); WSP(bf16_t, Wup, WS_WUP); WSP(bf16_t, Wout, WS_WOUT); WSP(bf16_t, Wpeer, WS_WPEER); WSP(bf16_t, Win, WS_WIN); WSP(bf16_t, Ub, WS_UB); WSP(bf16_t, Vb, WS_VB); WSP(bf16_t, h, WS_H);
#define PRO_WEIGHTS() do { for (int l = 0; l < NL; ++l) { \
            ph_transpose_w(a.w_in + (size_t)l * DM * INW, Win + (size_t)l * INW * DM, DM, INW, lds); \
            ph_wpool_bd(a.w_pool + (size_t)l * 4 * 128 * 256, Wpool + (size_t)l * DM * PW); \
            ph_transpose_w(a.w_up + (size_t)l * AW * DM, Wup + (size_t)l * DM * AW, AW, DM, lds); \
            ph_transpose_w(a.w_out + (size_t)l * DM * DM, Wout + (size_t)l * DM * DM, DM, DM, lds); \
            __syncthreads(); \
            ph_wpeer2(a.peer_wq + (size_t)l * DM * PQW, a.peer_keys + (size_t)l * 2 * NKEY * 128, a.ffn_norm + l * DM, Wpeer + (size_t)l * PQW * DM, smem); } } while (0)
#define PRO_STREAM() do { ph_quant_rows(a.peer_u, ws + WS_UQ, (float*)(ws + WS_SU), NEXP, 0); ph_quant_rows(a.peer_v, ws + WS_VQ, (float*)(ws + WS_SV), NEXP, 0);        ph_rmsnorm(a.x, a.mix_norm, h); } while (0)
        if (blockIdx.x & 8) { PRO_STREAM(); PRO_WEIGHTS(); } else { PRO_WEIGHTS(); PRO_STREAM(); }
#undef PRO_WEIGHTS
#undef PRO_STREAM
        { float* km = (float*)(ws + WS_KM); for (int i = blockIdx.x * NTHR + opq_tid(); i < NB * NBLK * AW; i += gridDim.x * NTHR) km[i] = 0.f; }
    }
    GRID_BAR();
    for (int l = 0; l < NL; ++l) {
        REP(1)
        { unsigned char* ws = a.ws; OPQ(ws); WSP(bf16_t, h, WS_H); WSP(bf16_t, z, WS_Z); WSP(bf16_t, Win, WS_WIN);
          pg8::Gemm g{h, Win + (size_t)l * INW * DM, T, INW, DM, DM, DM, 0}; pg8::StaticOrder S; S.init(T, INW, (int)gridDim.x, (int)blockIdx.x);
          pg8::gemm_phase<EpiZk, pg8::StaticOrder, true, true>((PG8_LAS unsigned char*)lds, g, S, EpiZk{z, (float*)(ws + WS_KM)}); }
        GRID_BAR();
        REP(2)
        { unsigned char* ws = a.ws; OPQ(ws); WSP(bf16_t, z, WS_Z); WSP(bf16_t, m, WS_M);
          ph_poolm2(z, m); }
        REP(3)
        { unsigned char* ws = a.ws; OPQ(ws); WSP(bf16_t, z, WS_Z); WSP(bf16_t, o, WS_O);
          ph_attn(lds, z, (const float*)(ws + WS_KM), o); }
        GRID_BAR();
        { float* km = (float*)(a.ws + WS_KM); for (int i = blockIdx.x * NTHR + opq_tid(); i < NB * NBLK * AW; i += gridDim.x * NTHR) km[i] = 0.f; }
        REP(11)
        { unsigned char* ws = a.ws; OPQ(ws); WSP(bf16_t, z, WS_Z); WSP(bf16_t, m, WS_M); WSP(bf16_t, gaa, WS_GAA); WSP(bf16_t, Wpool, WS_WPOOL);
          { pg8::Gemm g{m, Wpool + (size_t)l * DM * PW, T, DM, PW, PW, PW, 0}; pg8::StaticOrder S; S.init(T, DM, (int)gridDim.x, (int)blockIdx.x);
            pg8::gemm_phase<EpiAdapt8L<EpiPool8L>, pg8::StaticOrder, true, true>((PG8_LAS unsigned char*)lds, g, S, EpiAdapt8L<EpiPool8L>{EpiPool8L{z, a.pool_scale + l * DM, gaa}}); } }
        REP(4)
        { unsigned char* ws = a.ws; OPQ(ws); WSP(bf16_t, z, WS_Z); WSP(bf16_t, o, WS_O); WSP(bf16_t, gaa, WS_GAA); WSP(bf16_t, mrg, WS_MRG); WSP(bf16_t, Wup, WS_WUP);
          { pg8::Gemm g{o, Wup + (size_t)l * DM * AW, T, DM, AW, AW, AW, 0}; pg8::StaticOrder S; S.init(T, DM, (int)gridDim.x, (int)blockIdx.x);
            pg8::gemm_phase<EpiAdapt8L<EpiUp8L>, pg8::StaticOrder, true, true>((PG8_LAS unsigned char*)lds, g, S, EpiAdapt8L<EpiUp8L>{EpiUp8L{z, gaa, mrg}}); } }
        GRID_BAR();
        REP(5)
        { unsigned char* ws = a.ws; OPQ(ws); WSP(bf16_t, mrg, WS_MRG); WSP(bf16_t, Wout, WS_WOUT); WSP(bf16_t, h, WS_H); float* out = a.out; OPQ(out);
          pg8::Gemm g{mrg, Wout + (size_t)l * DM * DM, T, DM, DM, DM, DM, 0}; pg8::StaticOrder S; S.init(T, DM, (int)gridDim.x, (int)blockIdx.x);
          if (l == 0) pg8::gemm_phase<EpiAdapt8L<EpiResNormL<false>, 2>, pg8::StaticOrder, true, true>((PG8_LAS unsigned char*)lds, g, S, EpiAdapt8L<EpiResNormL<false>, 2>{EpiResNormL<false>{a.x, (const bf16_t*)(ws + WS_XB), (bf16_t*)(ws + WS_XB), (float*)(ws + WS_GAA)}});
          else pg8::gemm_phase<EpiAdapt8L<EpiResNormL<true>, 4>, pg8::StaticOrder, true, true>((PG8_LAS unsigned char*)lds, g, S, EpiAdapt8L<EpiResNormL<true>, 4>{EpiResNormL<true>{a.x, (const bf16_t*)(ws + WS_XB), (bf16_t*)(ws + WS_XB), (float*)(ws + WS_GAA)}}); }
        GRID_BAR();
        REP(7)
        { unsigned char* ws = a.ws; OPQ(ws); WSP(bf16_t, h, WS_H); WSP(float, sc, WS_SC); WSP(bf16_t, Wpeer, WS_WPEER);
          pg8::Gemm g{(const bf16_t*)(ws + WS_XB), Wpeer + (size_t)l * PQW * DM, T, PQW, DM, DM, DM, 0}; pg8::StaticOrder S; S.init(T, PQW, (int)gridDim.x, (int)blockIdx.x);
          pg8::Unit u0, u1; u0.pm = 0; u0.pn = 0; u1.pm = 0; u1.pn = 0; const bool h0 = S.next(0, u0), h1 = S.next(1, u1);
          LAS float* rl = (LAS float*)((LAS unsigned char*)lds + 131072);
          { const int t_ = opq_tid(); const int pmx = (t_ < 256) ? u0.pm : u1.pm; if ((t_ < 256) ? h0 : h1) rl[t_] = rstd_of((const float*)(ws + WS_GAA), (size_t)pmx * 256 + (t_ & 255)); }
          { const int t2_ = opq_tid(); if (t2_ < 2) ((LAS int*)((LAS unsigned char*)lds + 133120))[t2_] = (t2_ == 0) ? (h0 ? u0.pm : -1) : (h1 ? u1.pm : -1); }
          __syncthreads();
          pg8::gemm_phase<EpiI16s, pg8::StaticOrder, true, true>((PG8_LAS unsigned char*)lds, g, S, EpiI16s{(short*)sc, (const float*)(ws + WS_GAA)}); }
        GRID_BAR();
        { unsigned char* ws = a.ws; OPQ(ws); WSP(float, sc, WS_SC); WSP(int, eid, WS_EID); WSP(float, gw, WS_GW); WSP(float, wact, WS_WACT); WSP(bf16_t, h, WS_H); float* out = a.out; OPQ(out);
          ph_peer_all(lds, (const short*)sc, eid, gw, (int*)(ws + WS_KMEAN), wact, (const bf16_t*)(ws + WS_XB), a.ffn_norm + l * DM, (const float*)(ws + WS_GAA), ws + WS_UQ + (size_t)l * NEXP * DM, (const float*)(ws + WS_SU) + (size_t)l * NEXP,
                      ws + WS_VQ + (size_t)l * NEXP * DM, (const float*)(ws + WS_SV) + (size_t)l * NEXP, out, (bf16_t*)(ws + WS_XB), l == NL - 1 ? a.final_norm : a.mix_norm + (l + 1) * DM, h, l == NL - 1 ? 1 : 0, l == 0 ? a.peer_u : nullptr, a.peer_v, ws + WS_UQ, (float*)(ws + WS_SU) + NEXP); }
        if (l + 1 < NL) GRID_BAR();
    }
}

extern "C" void kernel_launch(void* const* d_in, const int* in_sizes, int n_in, void* d_out, int out_size, void* d_ws, size_t ws_size, hipStream_t stream) {
    static int grid = 0;
    if (grid == 0) {
        if (n_in != 13 || ws_size < WS_END) { fprintf(stderr, "kernel_launch: unexpected inputs / workspace (%d, %zu)\n", n_in, ws_size); grid = -1; return; }
        int dev = 0, cus = 0, per_cu = 0;
        hipGetDevice(&dev); hipDeviceGetAttribute(&cus, hipDeviceAttributeMultiprocessorCount, dev);
        if (hipFuncSetAttribute((const void*)mk_fwd, hipFuncAttributeMaxDynamicSharedMemorySize, LDS_BYTES) != hipSuccess) { fprintf(stderr, "kernel_launch: hipFuncSetAttribute failed\n"); grid = -1; return; }
        if (hipOccupancyMaxActiveBlocksPerMultiprocessor(&per_cu, (const void*)mk_fwd, NTHR, LDS_BYTES) != hipSuccess || per_cu < 1) { fprintf(stderr, "kernel_launch: occupancy query says %d\n", per_cu); grid = -1; return; }
        grid = cus;
    }
    if (grid < 0) return;
    Args a{};
    a.x = (const float*)d_in[0]; a.mix_norm = (const float*)d_in[1]; a.w_in = (const float*)d_in[2]; a.w_pool = (const float*)d_in[3]; a.pool_scale = (const float*)d_in[4];
    a.w_up = (const float*)d_in[5]; a.w_out = (const float*)d_in[6]; a.ffn_norm = (const float*)d_in[7]; a.peer_wq = (const float*)d_in[8]; a.peer_keys = (const float*)d_in[9];
    a.peer_u = (const float*)d_in[10]; a.peer_v = (const float*)d_in[11]; a.final_norm = (const float*)d_in[12]; a.out = (float*)d_out; a.ws = (unsigned char*)d_ws;
    if (hipMemsetAsync((char*)d_ws + WS_CTL, 0, 65536, stream) != hipSuccess) { fprintf(stderr, "kernel_launch: memset failed\n"); return; }
    void* args[] = {&a};
    hipError_t e = hipLaunchCooperativeKernel((const void*)mk_fwd, dim3(grid), dim3(NTHR), args, LDS_BYTES, stream);
    if (e != hipSuccess) fprintf(stderr, "kernel_launch: cooperative launch failed: %s (grid %d)\n", hipGetErrorString(e), grid);
}
```

```cpp
#include <hip/hip_runtime.h>
#include <hip/hip_cooperative_groups.h>
namespace cg = cooperative_groups;
#include <stdint.h>
#include <cstdio>
#include <type_traits>

typedef unsigned short bf16_t;
typedef float f32x4 __attribute__((ext_vector_type(4)));
typedef unsigned u32x4 __attribute__((ext_vector_type(4)));
typedef unsigned u32x2 __attribute__((ext_vector_type(2)));

constexpr int NB = 8, SEQ = 2048, DM = 1024, T = NB * SEQ, NL = 2;
constexpr int INW = 4096, PW = 512, AW = 512, NH = 8, HD = 64, MBLK = 256, NBLK = SEQ / MBLK;
constexpr int PH = 8, NKEY = 128, QD = 256, PK = 16, NEXP = NKEY * NKEY, PQW = PH * QD;
constexpr int NSLOT = PH * PK;
constexpr float EPS = 1e-6f;
constexpr float LOG2E = 1.4426950408889634f;
constexpr float C2 = 0.125f * LOG2E;

constexpr size_t MiB = 1u << 20;
constexpr size_t WS_CTL = 0, WS_KMEAN = 1 * MiB, WS_WPOOL = 2 * MiB, WS_WUP = 4 * MiB, WS_WOUT = 6 * MiB, WS_WPEER = 10 * MiB, WS_WIN = 18 * MiB;
constexpr size_t WS_UB = 34 * MiB, WS_VB = 98 * MiB, WS_H = 162 * MiB, WS_Z = 194 * MiB, WS_SC = 194 * MiB;
constexpr size_t WS_M = 322 * MiB, WS_O = 338 * MiB, WS_MRG = 354 * MiB, WS_GAA = 386 * MiB, WS_EID = 418 * MiB, WS_GW = 426 * MiB, WS_WACT = 434 * MiB, WS_END = 442 * MiB;

__device__ __forceinline__ float bf2f(bf16_t v) { return __uint_as_float(((unsigned)v) << 16); }
__device__ __forceinline__ unsigned f2bf(float f) { unsigned u = __float_as_uint(f); return (u + 0x7fffu + ((u >> 16) & 1u)) >> 16; }
typedef float f32x2_pk __attribute__((ext_vector_type(2))); typedef __bf16 bf16x2_pk __attribute__((ext_vector_type(2)));
__device__ __forceinline__ unsigned pk2(float lo, float hi) { f32x2_pk v = {lo, hi}; bf16x2_pk b = __builtin_convertvector(v, bf16x2_pk); return __builtin_bit_cast(unsigned, b); }
__device__ __forceinline__ float lo16(unsigned w) { return __uint_as_float(w << 16); }
__device__ __forceinline__ float hi16(unsigned w) { return __uint_as_float(w & 0xffff0000u); }
__device__ __forceinline__ float wave_sum(float v) {
#pragma unroll
    for (int o = 1; o < 64; o <<= 1) v += __shfl_xor(v, o);
    return v;
}
__device__ __forceinline__ float wave_max(float v) {
#pragma unroll
    for (int o = 1; o < 64; o <<= 1) v = fmaxf(v, __shfl_xor(v, o));
    return v;
}
__device__ __forceinline__ int opq_tid() { int t = threadIdx.x; asm volatile("" : "+v"(t)); return t; }
__device__ __forceinline__ int ldcg(const int* p) { return __hip_atomic_load(p, __ATOMIC_RELAXED, __HIP_MEMORY_SCOPE_AGENT); }
__device__ __forceinline__ float ldcg(const float* p) { return __hip_atomic_load(p, __ATOMIC_RELAXED, __HIP_MEMORY_SCOPE_AGENT); }
__device__ __forceinline__ float gelu_tanh(float x) {
    const float u = 0.7978845608028654f * (x + 0.044715f * x * x * x);
    const float e = __expf(2.f * u);
    const float th = 1.f - 2.f / (e + 1.f);
    return 0.5f * x * (1.f + th);
}

struct EpiZ {
    bf16_t* z;
    __device__ __forceinline__ void operator()(int row, int col0, f32x4 v) const {
        if (col0 >= 2048) { v.x = 1.f / (1.f + __expf(-v.x)); v.y = 1.f / (1.f + __expf(-v.y)); v.z = 1.f / (1.f + __expf(-v.z)); v.w = 1.f / (1.f + __expf(-v.w)); }
        else if (col0 >= 512 && col0 < 1024) { v = v * C2; }
        u32x2 o; o.x = pk2(v.x, v.y); o.y = pk2(v.z, v.w); *(u32x2*)(z + (size_t)row * INW + col0) = o;
    }
};
struct EpiPool {
    const bf16_t* z; const float* pscale; bf16_t* gaa;
    __device__ __forceinline__ void operator()(int row, int col0, f32x4 v) const {
        const u32x2 g = *(const u32x2*)(z + (size_t)row * INW + 2048 + col0); const f32x4 ps = *(const f32x4*)(pscale + col0);
        u32x2 o; o.x = pk2(v.x * ps.x * lo16(g.x), v.y * ps.y * hi16(g.x)); o.y = pk2(v.z * ps.z * lo16(g.y), v.w * ps.w * hi16(g.y));
        *(u32x2*)(gaa + (size_t)row * DM + col0) = o;
    }
};
struct EpiUp {
    const bf16_t* z; const bf16_t* gaa; bf16_t* mrg;
    __device__ __forceinline__ void operator()(int row, int col0, f32x4 v) const {
        const u32x2 g = *(const u32x2*)(z + (size_t)row * INW + 3072 + col0); const u32x2 a = *(const u32x2*)(gaa + (size_t)row * DM + col0);
        u32x2 o; o.x = pk2(lo16(a.x) + v.x * lo16(g.x), hi16(a.x) + v.y * hi16(g.x)); o.y = pk2(lo16(a.y) + v.z * lo16(g.y), hi16(a.y) + v.w * hi16(g.y));
        *(u32x2*)(mrg + (size_t)row * DM + col0) = o;
    }
};
struct EpiRes {
    const float* xin; float* xout;
    __device__ __forceinline__ void operator()(int row, int col0, f32x4 v) const {
        const f32x4 b = *(const f32x4*)(xin + (size_t)row * DM + col0); *(f32x4*)(xout + (size_t)row * DM + col0) = b + v;
    }
};
struct EpiF32 {
    float* out; int ldc;
    __device__ __forceinline__ void operator()(int row, int col0, f32x4 v) const { *(f32x4*)(out + (size_t)row * ldc + col0) = v; }
};

__device__ __forceinline__ float sigm(float v) { return __builtin_amdgcn_rcpf(1.f + __expf(-v)); }
struct EpiZ8 {
    bf16_t* z;
    __device__ __forceinline__ void operator()(int row, int col0, f32x4 a, f32x4 b) const {
        if (col0 >= 2048) { a.x = sigm(a.x); a.y = sigm(a.y); a.z = sigm(a.z); a.w = sigm(a.w); b.x = sigm(b.x); b.y = sigm(b.y); b.z = sigm(b.z); b.w = sigm(b.w); }
        else if (col0 >= 512 && col0 < 1024) { a = a * C2; b = b * C2; }
        u32x4 o; o.x = pk2(a.x, a.y); o.y = pk2(a.z, a.w); o.z = pk2(b.x, b.y); o.w = pk2(b.z, b.w); *(u32x4*)(z + (size_t)row * INW + col0) = o;
    }
};
struct EpiPool8 {
    const bf16_t* z; const float* pscale; bf16_t* gaa;
    __device__ __forceinline__ void operator()(int row, int col0, f32x4 a, f32x4 b) const {
        const u32x4 g = *(const u32x4*)(z + (size_t)row * INW + 2048 + col0); const f32x4 p0 = *(const f32x4*)(pscale + col0), p1 = *(const f32x4*)(pscale + col0 + 4);
        u32x4 o; o.x = pk2(a.x * p0.x * lo16(g.x), a.y * p0.y * hi16(g.x)); o.y = pk2(a.z * p0.z * lo16(g.y), a.w * p0.w * hi16(g.y));
        o.z = pk2(b.x * p1.x * lo16(g.z), b.y * p1.y * hi16(g.z)); o.w = pk2(b.z * p1.z * lo16(g.w), b.w * p1.w * hi16(g.w));
        *(u32x4*)(gaa + (size_t)row * DM + col0) = o;
    }
};
struct EpiUp8 {
    const bf16_t* z; const bf16_t* gaa; bf16_t* mrg;
    __device__ __forceinline__ void operator()(int row, int col0, f32x4 a, f32x4 b) const {
        const u32x4 g = *(const u32x4*)(z + (size_t)row * INW + 3072 + col0); const u32x4 q = *(const u32x4*)(gaa + (size_t)row * DM + col0);
        u32x4 o; o.x = pk2(lo16(q.x) + a.x * lo16(g.x), hi16(q.x) + a.y * hi16(g.x)); o.y = pk2(lo16(q.y) + a.z * lo16(g.y), hi16(q.y) + a.w * hi16(g.y));
        o.z = pk2(lo16(q.z) + b.x * lo16(g.z), hi16(q.z) + b.y * hi16(g.z)); o.w = pk2(lo16(q.w) + b.z * lo16(g.w), hi16(q.w) + b.w * hi16(g.w));
        *(u32x4*)(mrg + (size_t)row * DM + col0) = o;
    }
};


namespace pg8 {
#define PG8_LAS __attribute__((address_space(3)))
typedef unsigned short bf16_t;
typedef short bf16x8 __attribute__((ext_vector_type(8)));
typedef float f32x4 __attribute__((ext_vector_type(4)));
typedef unsigned u32x4 __attribute__((ext_vector_type(4)));
constexpr int BM = 256, BK = 64, HALF = 128, HTB = HALF * BK * 2  , STAGE_BYTES = 8 * HTB, NXCD = 8, WGM = 4;

__host__ __device__ __forceinline__ int lds_byte(int r, int c) { const int st = (r >> 4) * 2 + (c >> 5), rr = r & 15, cc = c & 31, ob = rr * 64 + cc * 2; return st * 1024 + (ob ^ (((ob >> 9) & 1) << 5)); }
__host__ __device__ __forceinline__ void stage_rc(int b, int& R, int& C) { const int st = b / 1024, sb = b % 1024, swz = sb ^ (((sb >> 9) & 1) << 5); R = (st >> 1) * 16 + swz / 64; C = (st & 1) * 32 + (swz % 64) / 2; }
__host__ __device__ __forceinline__ int perm32(int rho) { const int n = rho >> 4, i = rho & 15; return 8 * (i >> 2) + 4 * n + (i & 3); }

struct Unit { int pm, pn; };
struct Gemm { const bf16_t* A; const bf16_t* Bt; int M, N, K, lda, ldb, a_pn_off; };

struct StaticOrder {
    int nM, nN, nwg, G, c;
    __host__ __device__ void init(int M, int N, int G_, int c_) { nM = M / BM; nN = N / BM; nwg = nM * nN; G = G_; c = c_; }
    __host__ __device__ bool next(int i, Unit& u) const {
        const long L = (long)i * G + c; if (L >= nwg) return false;
        int wgid = (int)L; { const int q = nwg / NXCD, r = nwg % NXCD, xcd = wgid % NXCD, off = wgid / NXCD; wgid = (xcd < r ? xcd * (q + 1) : r * (q + 1) + (xcd - r) * q) + off; }
        const int nig = WGM * nN, gid = wgid / nig, fm = gid * WGM, gsz = (nM - fm) < WGM ? (nM - fm) : WGM;
        u.pm = fm + ((wgid % nig) % gsz); u.pn = (wgid % nig) / gsz; return true;
    }
    __device__ __forceinline__ void a_ready(const Unit&) const {}
    __device__ __forceinline__ void done(const Unit&) const {}
};
template <class Epi, class Sched, bool ALIGN_EPI = false, bool SP2 = false>
__device__ __forceinline__ void gemm_phase(PG8_LAS unsigned char* lds, const Gemm g, const Sched& S, const Epi& E) {
    const int tid = opq_tid(), wid = __builtin_amdgcn_readfirstlane(tid >> 6), lane = tid & 63, wr = wid >> 2, wc = wid & 3, fr = lane & 15, fq = lane >> 4;
    const int K = g.K, nt = K / BK;
    unsigned voffA[2], voffB[2];
#pragma unroll
    for (int i = 0; i < 2; ++i) { int R, C; stage_rc(tid * 16 + i * 8192, R, C); const int Rb = Epi::PERM ? ((R & ~31) + perm32(R & 31)) : R;
        voffA[i] = (unsigned)(R * g.lda + C) * 2u; voffB[i] = (unsigned)(Rb * g.ldb + C) * 2u; }
    const size_t kstep = (size_t)(BK * 2);
    const size_t hstepA = (size_t)HALF * g.lda * 2, hstepB = (size_t)HALF * g.ldb * 2;
    const size_t tstepA = 2 * hstepA, tstepB = 2 * hstepB; const size_t pnoff = (size_t)g.a_pn_off * 2;
    const unsigned ldsw = (unsigned)wid * 1024u;
    const int aoff = lds_byte(wr * 64 + fr, fq * 8), boff = lds_byte(wc * 32 + fr, fq * 8);
#define PG8_SA(b, h) (((b) * 2 + (h)) * HTB)
#define PG8_SB(b, h) ((4 + (b) * 2 + (h)) * HTB)
#define PG8_STAGE(bufoff, gbase, voff) do { _Pragma("unroll") for (int _i = 0; _i < 2; ++_i) \
        __builtin_amdgcn_global_load_lds((const unsigned*)((const char*)(gbase) + (voff)[_i]), (PG8_LAS unsigned*)(lds + (bufoff) + ldsw + _i * 8192), 16, 0, 0); } while (0)
#define PG8_LDA(dst, b, h) do { _Pragma("unroll") for (int m = 0; m < 4; ++m) _Pragma("unroll") for (int k = 0; k < 2; ++k) dst[m][k] = *(const PG8_LAS bf16x8*)(lds + PG8_SA(b, h) + aoff + m * 2048 + k * 1024); } while (0)
#define PG8_LDB(dst, b, h) do { _Pragma("unroll") for (int n = 0; n < 2; ++n) _Pragma("unroll") for (int k = 0; k < 2; ++k) dst[n][k] = *(const PG8_LAS bf16x8*)(lds + PG8_SB(b, h) + boff + n * 2048 + k * 1024); } while (0)
#define PG8_MMA(ai, bj, At, Bt) do { __builtin_amdgcn_s_setprio(1); _Pragma("unroll") for (int m = 0; m < 4; ++m) _Pragma("unroll") for (int n = 0; n < 2; ++n) _Pragma("unroll") for (int k = 0; k < 2; ++k) \
        acc[ai][bj][m][n] = __builtin_amdgcn_mfma_f32_16x16x32_bf16(Bt[n][k], At[m][k], acc[ai][bj][m][n], 0, 0, 0); __builtin_amdgcn_s_setprio(0); } while (0)
#define PG8_WAIT_V(n) asm volatile("s_waitcnt vmcnt(" #n ")" ::: "memory")
#define PG8_WAIT_L(n) asm volatile("s_waitcnt lgkmcnt(" #n ")" ::: "memory")
#define PG8_BAR __builtin_amdgcn_s_barrier()
#define PG8_SCHED __builtin_amdgcn_sched_barrier(0)
    Unit cur, nxt; int ui = 0;
    if (!S.next(0, cur)) return;
    f32x4 acc[2][2][4][2];
#pragma unroll
    for (int a = 0; a < 2; ++a)
#pragma unroll
        for (int b = 0; b < 2; ++b)
#pragma unroll
            for (int m = 0; m < 4; ++m)
#pragma unroll
                for (int n = 0; n < 2; ++n) acc[a][b][m][n] = (f32x4){0.f, 0.f, 0.f, 0.f};
    bf16x8 At[4][2], B0[2][2], B1[2][2];
    const char* cA = (const char*)g.A + (size_t)cur.pm * tstepA + (size_t)cur.pn * pnoff; const char* cB = (const char*)g.Bt + (size_t)cur.pn * tstepB;
    S.a_ready(cur);
    if constexpr (SP2) {
        PG8_STAGE(PG8_SB(0, 0), cB, voffB); PG8_STAGE(PG8_SB(0, 1), cB + hstepB, voffB); PG8_STAGE(PG8_SA(0, 0), cA, voffA); PG8_STAGE(PG8_SA(0, 1), cA + hstepA, voffA);
        if (wr == 1) PG8_BAR;
        PG8_WAIT_V(2); PG8_BAR;
        PG8_STAGE(PG8_SB(1, 0), cB + kstep, voffB); PG8_STAGE(PG8_SA(1, 0), cA + kstep, voffA); PG8_STAGE(PG8_SB(1, 1), cB + hstepB + kstep, voffB);
        PG8_WAIT_V(6); PG8_BAR;
    } else {
        PG8_STAGE(PG8_SB(0, 0), cB, voffB); PG8_STAGE(PG8_SA(0, 0), cA, voffA); PG8_STAGE(PG8_SB(0, 1), cB + hstepB, voffB); PG8_STAGE(PG8_SA(0, 1), cA + hstepA, voffA);
        if (wr == 1) PG8_BAR;
        PG8_WAIT_V(4); PG8_BAR;
        PG8_STAGE(PG8_SB(1, 0), cB + kstep, voffB); PG8_STAGE(PG8_SA(1, 0), cA + kstep, voffA); PG8_STAGE(PG8_SB(1, 1), cB + hstepB + kstep, voffB);
        PG8_WAIT_V(6); PG8_BAR;
    }
    for (;;) {
        const bool has_next = S.next(ui + 1, nxt);
        const char* nA = has_next ? (const char*)g.A + (size_t)nxt.pm * tstepA + (size_t)nxt.pn * pnoff : cA; const char* nB = has_next ? (const char*)g.Bt + (size_t)nxt.pn * tstepB : cB;
        for (int t = 0; t < nt; t += 2) {
            const bool last = (t == nt - 2);
            const char* a1 = cA + (size_t)(t + 1) * kstep;
            const char* a2 = last ? nA : cA + (size_t)(t + 2) * kstep; const char* b2 = last ? nB : cB + (size_t)(t + 2) * kstep;
            const char* a3 = a2 + kstep; const char* b3 = b2 + kstep;
            if (last && has_next) S.a_ready(nxt);
            if constexpr (SP2) {
            PG8_LDB(B0, 0, 0); PG8_LDB(B1, 0, 1); PG8_SCHED; PG8_LDA(At, 0, 0); PG8_STAGE(PG8_SA(1, 1), a1 + hstepA, voffA);
            PG8_WAIT_V(8); PG8_WAIT_L(0); PG8_BAR; PG8_MMA(0, 0, At, B0); PG8_MMA(0, 1, At, B1); PG8_BAR; PG8_SCHED;
            PG8_LDA(At, 0, 1); PG8_STAGE(PG8_SB(0, 0), b2, voffB); PG8_STAGE(PG8_SB(0, 1), b2 + hstepB, voffB); PG8_STAGE(PG8_SA(0, 0), a2, voffA);
            PG8_WAIT_V(8); PG8_WAIT_L(0); PG8_BAR; PG8_MMA(1, 0, At, B0); PG8_MMA(1, 1, At, B1); PG8_BAR; PG8_SCHED;
            PG8_LDB(B0, 1, 0); PG8_LDB(B1, 1, 1); PG8_SCHED; PG8_LDA(At, 1, 0); PG8_STAGE(PG8_SA(0, 1), a2 + hstepA, voffA);
            PG8_WAIT_V(8); PG8_WAIT_L(0); PG8_BAR; PG8_MMA(0, 0, At, B0); PG8_MMA(0, 1, At, B1); PG8_BAR; PG8_SCHED;
            PG8_LDA(At, 1, 1); PG8_STAGE(PG8_SB(1, 0), b3, voffB); PG8_STAGE(PG8_SB(1, 1), b3 + hstepB, voffB); PG8_STAGE(PG8_SA(1, 0), a3, voffA);
            PG8_WAIT_V(8); PG8_WAIT_L(0); PG8_BAR; PG8_MMA(1, 0, At, B0); PG8_MMA(1, 1, At, B1); PG8_BAR; PG8_SCHED;
            } else {
            PG8_LDB(B0, 0, 0); PG8_SCHED; PG8_LDA(At, 0, 0); PG8_STAGE(PG8_SA(1, 1), a1 + hstepA, voffA);
            PG8_WAIT_L(8); PG8_BAR; PG8_WAIT_L(0); PG8_MMA(0, 0, At, B0); PG8_BAR; PG8_SCHED;
            PG8_LDB(B1, 0, 1); PG8_STAGE(PG8_SB(0, 0), b2, voffB);
            PG8_BAR; PG8_WAIT_L(0); PG8_MMA(0, 1, At, B1); PG8_BAR;
            PG8_LDA(At, 0, 1); PG8_STAGE(PG8_SA(0, 0), a2, voffA);
            PG8_BAR; PG8_WAIT_L(0); PG8_MMA(1, 0, At, B0); PG8_BAR; PG8_SCHED;
            PG8_STAGE(PG8_SB(0, 1), b2 + hstepB, voffB);
            PG8_WAIT_V(6); PG8_BAR; PG8_MMA(1, 1, At, B1); PG8_BAR;
            PG8_LDB(B0, 1, 0); PG8_SCHED; PG8_LDA(At, 1, 0); PG8_STAGE(PG8_SA(0, 1), a2 + hstepA, voffA);
            PG8_WAIT_L(8); PG8_BAR; PG8_WAIT_L(0); PG8_MMA(0, 0, At, B0); PG8_BAR; PG8_SCHED;
            PG8_LDB(B1, 1, 1); PG8_STAGE(PG8_SB(1, 0), b3, voffB);
            PG8_BAR; PG8_WAIT_L(0); PG8_MMA(0, 1, At, B1); PG8_BAR;
            PG8_LDA(At, 1, 1); PG8_STAGE(PG8_SA(1, 0), a3, voffA);
            PG8_BAR; PG8_WAIT_L(0); PG8_MMA(1, 0, At, B0); PG8_BAR; PG8_SCHED;
            PG8_STAGE(PG8_SB(1, 1), b3 + hstepB, voffB);
            PG8_WAIT_V(6); PG8_BAR; PG8_MMA(1, 1, At, B1); PG8_BAR;
            }
        }
        if constexpr (ALIGN_EPI) { if (wr == 0) PG8_BAR; }
        if constexpr (!Epi::AFTER_DRAIN) { E(acc, cur, wr, wc, fr, fq); S.done(cur); }
        if (!has_next) break;
#pragma unroll
        for (int a = 0; a < 2; ++a)
#pragma unroll
            for (int b = 0; b < 2; ++b)
#pragma unroll
                for (int m = 0; m < 4; ++m)
#pragma unroll
                    for (int n = 0; n < 2; ++n) acc[a][b][m][n] = (f32x4){0.f, 0.f, 0.f, 0.f};
        cur = nxt; cA = nA; cB = nB; ++ui;
        if constexpr (ALIGN_EPI) { if (wr == 1) PG8_BAR; }
    }
    PG8_WAIT_V(0);
    if constexpr (!ALIGN_EPI) { if (wr == 0) PG8_BAR; }
    PG8_BAR;
    if constexpr (Epi::AFTER_DRAIN) { E.fused(acc, cur, wr, wc, fr, fq, lds, wid, lane); S.done(cur); }
#undef PG8_SA
#undef PG8_SB
#undef PG8_STAGE
#undef PG8_LDA
#undef PG8_LDB
#undef PG8_MMA
#undef PG8_WAIT_V
#undef PG8_WAIT_L
#undef PG8_BAR
#undef PG8_SCHED
}
}

template <class F> struct EpiAdapt {
    static constexpr bool PERM = false, AFTER_DRAIN = false;
    F f;
    __device__ __forceinline__ void operator()(const pg8::f32x4 (&acc)[2][2][4][2], const pg8::Unit& u, int wr, int wc, int fr, int fq) const {
        const int row0 = u.pm * 256 + wr * 64 + fr, col0 = u.pn * 256 + wc * 32 + 4 * fq;
#pragma unroll
        for (int ai = 0; ai < 2; ++ai)
#pragma unroll
            for (int m = 0; m < 4; ++m)
#pragma unroll
                for (int bj = 0; bj < 2; ++bj)
#pragma unroll
                    for (int n = 0; n < 2; ++n) { f(row0 + ai * 128 + m * 16, col0 + bj * 128 + n * 16, acc[ai][bj][m][n]); asm volatile("" ::: "memory"); }
    }
};
template <class F, bool ALIGN> __device__ __forceinline__ void ph_gemm(unsigned char* lds, const bf16_t* A, int lda, const bf16_t* Bt, int ldb, int N, int K, F f) {
    pg8::Gemm g{A, Bt, T, N, K, lda, ldb, 0}; pg8::StaticOrder S; S.init(T, N, (int)gridDim.x, (int)blockIdx.x);
    pg8::gemm_phase<EpiAdapt<F>, pg8::StaticOrder, ALIGN, true>((PG8_LAS unsigned char*)lds, g, S, EpiAdapt<F>{f});
}

template <class F> struct EpiAdapt8 {
    static constexpr bool PERM = true, AFTER_DRAIN = false;
    F f;
    __device__ __forceinline__ void operator()(const pg8::f32x4 (&acc)[2][2][4][2], const pg8::Unit& u, int wr, int wc, int fr, int fq) const {
        const int row0 = u.pm * 256 + wr * 64 + fr, col0 = u.pn * 256 + wc * 32 + 8 * fq;
#pragma unroll
        for (int ai = 0; ai < 2; ++ai)
#pragma unroll
            for (int m = 0; m < 4; ++m)
#pragma unroll
                for (int bj = 0; bj < 2; ++bj) { f(row0 + ai * 128 + m * 16, col0 + bj * 128, acc[ai][bj][m][0], acc[ai][bj][m][1]); asm volatile("" ::: "memory"); }
    }
};
template <class F, bool ALIGN> __device__ __forceinline__ void ph_gemm8(unsigned char* lds, const bf16_t* A, int lda, const bf16_t* Bt, int ldb, int N, int K, F f) {
    pg8::Gemm g{A, Bt, T, N, K, lda, ldb, 0}; pg8::StaticOrder S; S.init(T, N, (int)gridDim.x, (int)blockIdx.x);
    pg8::gemm_phase<EpiAdapt8<F>, pg8::StaticOrder, ALIGN, true>((PG8_LAS unsigned char*)lds, g, S, EpiAdapt8<F>{f});
}

__device__ __forceinline__ float rstd_of(const float* rowsq, size_t row) {
    const f32x4* p = (const f32x4*)(rowsq + row * 16); const f32x4 a = p[0], b = p[1], c = p[2], d = p[3];
    return rsqrtf((((a.x + a.y) + (a.z + a.w)) + ((b.x + b.y) + (b.z + b.w)) + ((c.x + c.y) + (c.z + c.w)) + ((d.x + d.y) + (d.z + d.w))) * (1.f / DM) + EPS);
}
struct EpiResNorm {
    static constexpr bool PERM = true, AFTER_DRAIN = false;
    const float* xin; const bf16_t* xbin; bf16_t* xb; bf16_t* xg; const float* g; float* rowsq; int use_xb;
    __device__ __forceinline__ void operator()(const pg8::f32x4 (&acc)[2][2][4][2], const pg8::Unit& u, int wr, int wc, int fr, int fq) const {
        const int row0 = u.pm * 256 + wr * 64 + fr, col0 = u.pn * 256 + wc * 32 + 8 * fq;
#pragma unroll
        for (int ai = 0; ai < 2; ++ai)
#pragma unroll
            for (int m = 0; m < 4; ++m) { const int row = row0 + ai * 128 + m * 16; float s = 0.f;
#pragma unroll
                for (int bj = 0; bj < 2; ++bj) { const int col = col0 + bj * 128; f32x4 x0, x1;
                    if (use_xb) { const u32x4 w = *(const u32x4*)(xbin + (size_t)row * DM + col); x0 = (f32x4){lo16(w.x), hi16(w.x), lo16(w.y), hi16(w.y)}; x1 = (f32x4){lo16(w.z), hi16(w.z), lo16(w.w), hi16(w.w)}; }
                    else { x0 = *(const f32x4*)(xin + (size_t)row * DM + col); x1 = *(const f32x4*)(xin + (size_t)row * DM + col + 4); }
                    f32x4 v0 = acc[ai][bj][m][0] + x0, v1 = acc[ai][bj][m][1] + x1;
                    u32x4 ox; ox.x = pk2(v0.x, v0.y); ox.y = pk2(v0.z, v0.w); ox.z = pk2(v1.x, v1.y); ox.w = pk2(v1.z, v1.w); *(u32x4*)(xb + (size_t)row * DM + col) = ox;
                    v0 = (f32x4){lo16(ox.x), hi16(ox.x), lo16(ox.y), hi16(ox.y)}; v1 = (f32x4){lo16(ox.z), hi16(ox.z), lo16(ox.w), hi16(ox.w)};
                    const f32x4 g0 = *(const f32x4*)(g + col), g1 = *(const f32x4*)(g + col + 4);
                    u32x4 o; o.x = pk2(v0.x * g0.x, v0.y * g0.y); o.y = pk2(v0.z * g0.z, v0.w * g0.w); o.z = pk2(v1.x * g1.x, v1.y * g1.y); o.w = pk2(v1.z * g1.z, v1.w * g1.w); *(u32x4*)(xg + (size_t)row * DM + col) = o;
                    s += (v0.x * v0.x + v0.y * v0.y + v0.z * v0.z + v0.w * v0.w) + (v1.x * v1.x + v1.y * v1.y + v1.z * v1.z + v1.w * v1.w); }
                s += __shfl_xor(s, 16); s += __shfl_xor(s, 32);
                if (fq == 0) rowsq[(size_t)row * 16 + u.pn * 4 + wc] = s;
                asm volatile("" ::: "memory"); }
    }
};
struct EpiI16s {
    static constexpr bool PERM = true, AFTER_DRAIN = false;
    short* out; const float* rowsq;
    __device__ __forceinline__ static unsigned q2(float a, float b) { const int ia = (int)__builtin_rintf(fminf(fmaxf(a, -32767.f), 32767.f)), ib = (int)__builtin_rintf(fminf(fmaxf(b, -32767.f), 32767.f)); return ((unsigned)ia & 0xffffu) | ((unsigned)ib << 16); }
    __device__ __forceinline__ void operator()(const pg8::f32x4 (&acc)[2][2][4][2], const pg8::Unit& u, int wr, int wc, int fr, int fq) const {
        const int rloc = wr * 64 + fr, row0 = u.pm * 256 + rloc, col0 = u.pn * 256 + wc * 32 + 8 * fq;
        constexpr int ldc = PQW; const PG8_LAS float* rl = (const PG8_LAS float*)131072u; const PG8_LAS int* tg = (const PG8_LAS int*)133120u;
        const int sel = (u.pm == tg[0]) ? 0 : ((u.pm == tg[1]) ? 256 : -1);
#pragma unroll
        for (int ai = 0; ai < 2; ++ai)
#pragma unroll
            for (int m = 0; m < 4; ++m) { const int row = row0 + ai * 128 + m * 16; const float r = ((sel >= 0) ? rl[sel + rloc + ai * 128 + m * 16] : rstd_of(rowsq, (size_t)row)) * 2048.f;
#pragma unroll
                for (int bj = 0; bj < 2; ++bj) { const f32x4 a = acc[ai][bj][m][0] * r, b = acc[ai][bj][m][1] * r;
                    *(u32x4*)(out + (size_t)row * ldc + col0 + bj * 128) = (u32x4){q2(a.x, a.y), q2(a.z, a.w), q2(b.x, b.y), q2(b.z, b.w)}; } }
    }
};

template <class F, int MB = 4> struct EpiAdapt8L {
    static constexpr bool PERM = true, AFTER_DRAIN = false;
    F f;
    __device__ __forceinline__ void operator()(const pg8::f32x4 (&acc)[2][2][4][2], const pg8::Unit& u, int wr, int wc, int fr, int fq) const {
        const int row0 = u.pm * 256 + wr * 64 + fr, col0 = u.pn * 256 + wc * 32 + 8 * fq;
        typename F::C cc[2];
#pragma unroll
        for (int bj = 0; bj < 2; ++bj) cc[bj] = f.cols(col0 + bj * 128);
#pragma unroll
        for (int ai = 0; ai < 2; ++ai)
#pragma unroll
          for (int mb = 0; mb < 4; mb += MB) {
            typename F::L ld[MB][2];
#pragma unroll
            for (int m = 0; m < MB; ++m)
#pragma unroll
                for (int bj = 0; bj < 2; ++bj) ld[m][bj] = f.load(row0 + ai * 128 + (mb + m) * 16, col0 + bj * 128);
#pragma unroll
            for (int m = 0; m < MB; ++m) { float s = 0.f;
#pragma unroll
                for (int bj = 0; bj < 2; ++bj) s += f.apply(row0 + ai * 128 + (mb + m) * 16, col0 + bj * 128, acc[ai][bj][mb + m][0], acc[ai][bj][mb + m][1], ld[m][bj], cc[bj]);
                f.rowdone(row0 + ai * 128 + (mb + m) * 16, u.pn, wc, fq, s); }
            asm volatile("" ::: "memory");
          }
    }
};
struct EpiPool8L {
    const bf16_t* z; const float* pscale; bf16_t* gaa;
    struct L { u32x4 g; }; struct C { f32x4 p0, p1; };
    __device__ __forceinline__ C cols(int col) const { C c; c.p0 = *(const f32x4*)(pscale + col); c.p1 = *(const f32x4*)(pscale + col + 4); return c; }
    __device__ __forceinline__ L load(int row, int col) const { L l; l.g = *(const u32x4*)(z + (size_t)row * INW + 2048 + col); return l; }
    __device__ __forceinline__ float apply(int row, int col, f32x4 a, f32x4 b, const L& l, const C& c) const {
        u32x4 o; o.x = pk2(a.x * c.p0.x * lo16(l.g.x), a.y * c.p0.y * hi16(l.g.x)); o.y = pk2(a.z * c.p0.z * lo16(l.g.y), a.w * c.p0.w * hi16(l.g.y));
        o.z = pk2(b.x * c.p1.x * lo16(l.g.z), b.y * c.p1.y * hi16(l.g.z)); o.w = pk2(b.z * c.p1.z * lo16(l.g.w), b.w * c.p1.w * hi16(l.g.w));
        *(u32x4*)(gaa + (size_t)row * DM + col) = o; return 0.f; }
    __device__ __forceinline__ void rowdone(int, int, int, int, float) const {}
};
struct EpiUp8L {
    const bf16_t* z; const bf16_t* gaa; bf16_t* mrg;
    struct L { u32x4 g, q; }; struct C { int dummy; };
    __device__ __forceinline__ C cols(int) const { C c; c.dummy = 0; return c; }
    __device__ __forceinline__ L load(int row, int col) const { L l; l.g = *(const u32x4*)(z + (size_t)row * INW + 3072 + col); l.q = *(const u32x4*)(gaa + (size_t)row * DM + col); return l; }
    __device__ __forceinline__ float apply(int row, int col, f32x4 a, f32x4 b, const L& l, const C&) const {
        u32x4 o; o.x = pk2(lo16(l.q.x) + a.x * lo16(l.g.x), hi16(l.q.x) + a.y * hi16(l.g.x)); o.y = pk2(lo16(l.q.y) + a.z * lo16(l.g.y), hi16(l.q.y) + a.w * hi16(l.g.y));
        o.z = pk2(lo16(l.q.z) + b.x * lo16(l.g.z), hi16(l.q.z) + b.y * hi16(l.g.z)); o.w = pk2(lo16(l.q.w) + b.z * lo16(l.g.w), hi16(l.q.w) + b.w * hi16(l.g.w));
        *(u32x4*)(mrg + (size_t)row * DM + col) = o; return 0.f; }
    __device__ __forceinline__ void rowdone(int, int, int, int, float) const {}
};
template <bool XB> struct EpiResNormL {
    const float* xin; const bf16_t* xbin; bf16_t* xb; float* rowsq;
    struct LB { u32x4 w; }; struct LF { f32x4 x0, x1; }; typedef typename std::conditional<XB, LB, LF>::type L; struct C { int dummy; };
    __device__ __forceinline__ C cols(int) const { C c; c.dummy = 0; return c; }
    __device__ __forceinline__ L load(int row, int col) const { L l;
        if constexpr (XB) { l.w = *(const u32x4*)(xbin + (size_t)row * DM + col); } else { l.x0 = *(const f32x4*)(xin + (size_t)row * DM + col); l.x1 = *(const f32x4*)(xin + (size_t)row * DM + col + 4); }
        return l; }
    __device__ __forceinline__ float apply(int row, int col, f32x4 a, f32x4 b, const L& l, const C&) const {
        f32x4 v0, v1;
        if constexpr (XB) { v0 = a + (f32x4){lo16(l.w.x), hi16(l.w.x), lo16(l.w.y), hi16(l.w.y)}; v1 = b + (f32x4){lo16(l.w.z), hi16(l.w.z), lo16(l.w.w), hi16(l.w.w)}; } else { v0 = a + l.x0; v1 = b + l.x1; }
        u32x4 ox; ox.x = pk2(v0.x, v0.y); ox.y = pk2(v0.z, v0.w); ox.z = pk2(v1.x, v1.y); ox.w = pk2(v1.z, v1.w); *(u32x4*)(xb + (size_t)row * DM + col) = ox;
        v0 = (f32x4){lo16(ox.x), hi16(ox.x), lo16(ox.y), hi16(ox.y)}; v1 = (f32x4){lo16(ox.z), hi16(ox.z), lo16(ox.w), hi16(ox.w)};
        return (v0.x * v0.x + v0.y * v0.y + v0.z * v0.z + v0.w * v0.w) + (v1.x * v1.x + v1.y * v1.y + v1.z * v1.z + v1.w * v1.w); }
    __device__ __forceinline__ void rowdone(int row, int pn, int wc, int fq, float s) const { s += __shfl_xor(s, 16); s += __shfl_xor(s, 32); if (fq == 0) rowsq[(size_t)row * 16 + pn * 4 + wc] = s; }
};

struct EpiZk {
    static constexpr bool PERM = true, AFTER_DRAIN = false;
    bf16_t* z; float* kmean;
    __device__ __forceinline__ void operator()(const pg8::f32x4 (&acc)[2][2][4][2], const pg8::Unit& u, int wr, int wc, int fr, int fq) const {
        const int row0 = u.pm * 256 + wr * 64 + fr, col0 = u.pn * 256 + wc * 32 + 8 * fq; const EpiZ8 f{z};
#pragma unroll
        for (int ai = 0; ai < 2; ++ai)
#pragma unroll
            for (int m = 0; m < 4; ++m)
#pragma unroll
                for (int bj = 0; bj < 2; ++bj) { f(row0 + ai * 128 + m * 16, col0 + bj * 128, acc[ai][bj][m][0], acc[ai][bj][m][1]); asm volatile("" ::: "memory"); }
        if (u.pn == 4 || u.pn == 5) {
#pragma unroll
            for (int bj = 0; bj < 2; ++bj) { float cs[8];
#pragma unroll
                for (int e = 0; e < 8; ++e) cs[e] = 0.f;
#pragma unroll
                for (int ai = 0; ai < 2; ++ai)
#pragma unroll
                    for (int m = 0; m < 4; ++m) { const f32x4 a = acc[ai][bj][m][0], b = acc[ai][bj][m][1]; cs[0] += a.x; cs[1] += a.y; cs[2] += a.z; cs[3] += a.w; cs[4] += b.x; cs[5] += b.y; cs[6] += b.z; cs[7] += b.w; }
#pragma unroll
                for (int e = 0; e < 8; ++e) { cs[e] += __shfl_xor(cs[e], 1); cs[e] += __shfl_xor(cs[e], 2); cs[e] += __shfl_xor(cs[e], 4); cs[e] += __shfl_xor(cs[e], 8); }
                if (fr == 0) { float* kb = kmean + (size_t)u.pm * AW + (u.pn - 4) * 256 + bj * 128 + wc * 32 + 8 * fq;
#pragma unroll
                    for (int e = 0; e < 8; ++e) atomicAdd(kb + e, cs[e] * (1.f / MBLK)); } }
        }
    }
};

constexpr int NTHR = 512, NWAVE = 8;
constexpr int LDS_BYTES = 147456;
struct Args {
    const float* x; const float* mix_norm; const float* w_in; const float* w_pool; const float* pool_scale; const float* w_up; const float* w_out; const float* ffn_norm;
    const float* peer_wq; const float* peer_keys; const float* peer_u; const float* peer_v; const float* final_norm; float* out; unsigned char* ws;
};
#define LAS __attribute__((address_space(3)))
#define GAS __attribute__((address_space(1)))

__device__ __forceinline__ void ph_transpose(const float* __restrict__ W, bf16_t* __restrict__ Wt, int K, int N, float* smem) {
    const int tid_ = opq_tid();
    float (*tile)[33] = (float (*)[33])smem;
    const int tx = tid_ & 31, ty = tid_ >> 5, nbx = N / 32, nit = nbx * (K / 32);
    for (int it = blockIdx.x; it < nit; it += gridDim.x) {
        const int n0 = (it % nbx) * 32, k0 = (it / nbx) * 32;
        for (int i = ty; i < 32; i += 16) tile[i][tx] = W[(size_t)(k0 + i) * N + n0 + tx];
        __syncthreads();
        for (int i = ty; i < 32; i += 16) Wt[(size_t)(n0 + i) * K + k0 + tx] = (bf16_t)f2bf(tile[tx][i]);
        __syncthreads();
    }
}

__device__ __forceinline__ void ph_transpose_w(const float* W, bf16_t* Wt, int K, int N, unsigned char* lds_) {
    const int tid_ = opq_tid(); const int lane = tid_ & 63, wv = tid_ >> 6;
    LAS float* scr = (LAS float*)lds_ + wv * (64 * 33 + 32);
    const int nblk = N / 32, nitems = (K / 64) * nblk;
    for (int item = blockIdx.x * NWAVE + wv; item < nitems; item += gridDim.x * NWAVE) {
        const int kb = item / nblk, nb = item % nblk, k0 = 64 * kb, n0 = 32 * nb;
#pragma unroll 8
        for (int i = 0; i < 32; ++i) { const int kk = 2 * i + (lane >> 5); scr[kk * 33 + (lane & 31)] = W[(size_t)(k0 + kk) * N + n0 + (lane & 31)]; }
        const int c = lane & 7;
#pragma unroll
        for (int j = 0; j < 4; ++j) { const int n = (lane >> 3) + 8 * j; const LAS float* s = scr + (8 * c) * 33 + n;
            u32x4 o; o.x = pk2(s[0 * 33], s[1 * 33]); o.y = pk2(s[2 * 33], s[3 * 33]); o.z = pk2(s[4 * 33], s[5 * 33]); o.w = pk2(s[6 * 33], s[7 * 33]);
            *(u32x4*)(Wt + (size_t)(n0 + n) * K + k0 + 8 * c) = o; }
    }
}
__device__ __forceinline__ void ph_wpeer(const float* __restrict__ wq, const float* __restrict__ keys, bf16_t* __restrict__ Wp) {
    const int tid_ = opq_tid();
    for (int it = blockIdx.x; it < PQW * DM / NTHR; it += gridDim.x) {
        const int idx = it * NTHR + tid_; const int c = idx & 1023, n = idx >> 10, hp = n >> 7, k = n & 127, p = hp & 1;
        const float* a = wq + (size_t)c * PQW + hp * 128; const float* b = keys + ((size_t)p * NKEY + k) * 128; float s = 0.f;
        for (int d = 0; d < 128; ++d) s += a[d] * b[d];
        Wp[(size_t)n * DM + c] = (bf16_t)f2bf(s);
    }
}
__device__ __forceinline__ void ph_wpool_bd(const float* __restrict__ wp, bf16_t* __restrict__ Wbd) {
    const int tid_ = opq_tid();
    for (int it = blockIdx.x; it < DM * 256 / NTHR; it += gridDim.x) {
        const int idx = it * NTHR + tid_; const int k = idx & 255, n = idx >> 8, g = n >> 8;
        const float v = (k < 128) ? wp[((size_t)g * 128 + k) * 256 + (n & 255)] : 0.f;
        Wbd[(size_t)n * 256 + k] = (bf16_t)f2bf(v);
    }
}
__device__ __forceinline__ void ph_cvt(const float* __restrict__ src, bf16_t* __restrict__ dst, size_t n4) {
    const int tid_ = opq_tid();
    for (size_t i = (size_t)blockIdx.x * NTHR + tid_; i < n4; i += (size_t)gridDim.x * NTHR) {
        const f32x4 v = ((const f32x4*)src)[i]; u32x2 o; o.x = pk2(v.x, v.y); o.y = pk2(v.z, v.w); ((u32x2*)dst)[i] = o; }
}
__device__ __forceinline__ void ph_rmsnorm(const float* __restrict__ x, const float* __restrict__ g, bf16_t* __restrict__ out) {
    const int tid_ = opq_tid();
    const int lane = tid_ & 63, wv = tid_ >> 6;
    for (int it = blockIdx.x; it < T / NWAVE; it += gridDim.x) {
        const int row = it * NWAVE + wv; const f32x4* xr = (const f32x4*)(x + (size_t)row * DM); f32x4 v[4]; float s = 0.f;
#pragma unroll
        for (int j = 0; j < 4; ++j) { v[j] = xr[lane + 64 * j]; s += v[j].x * v[j].x + v[j].y * v[j].y + v[j].z * v[j].z + v[j].w * v[j].w; }
        const float rstd = rsqrtf(wave_sum(s) * (1.f / DM) + EPS);
#pragma unroll
        for (int j = 0; j < 4; ++j) { const f32x4 gg = ((const f32x4*)g)[lane + 64 * j]; u32x2 o; o.x = pk2(v[j].x * rstd * gg.x, v[j].y * rstd * gg.y); o.y = pk2(v[j].z * rstd * gg.z, v[j].w * rstd * gg.w);
            ((u32x2*)(out + (size_t)row * DM))[lane + 64 * j] = o; }
    }
}
template <class Epi> __device__ __forceinline__ void ph_gemm_naive(const bf16_t* __restrict__ A, int lda, int a_pn_off, const bf16_t* __restrict__ Bt, int ldb, int N, int K, Epi E) {
    const int tid_ = opq_tid();
    const int cg_ = tid_ & 63, rr = tid_ >> 6, nbx = N / 256, nit = nbx * (T / 8);
    for (int it = blockIdx.x; it < nit; it += gridDim.x) {
        const int bx = it % nbx, by = it / nbx; const int col0 = bx * 256 + cg_ * 4, row = by * 8 + rr;
        const bf16_t* a = A + (size_t)row * lda + (size_t)bx * a_pn_off; const bf16_t* b = Bt + (size_t)col0 * ldb;
        float acc[4] = {0.f, 0.f, 0.f, 0.f};
        for (int k = 0; k < K; k += 8) {
            const u32x4 av = *(const u32x4*)(a + k);
#pragma unroll
            for (int i = 0; i < 4; ++i) { const u32x4 bv = *(const u32x4*)(b + (size_t)i * ldb + k);
                acc[i] += lo16(av.x) * lo16(bv.x) + hi16(av.x) * hi16(bv.x) + lo16(av.y) * lo16(bv.y) + hi16(av.y) * hi16(bv.y)
                        + lo16(av.z) * lo16(bv.z) + hi16(av.z) * hi16(bv.z) + lo16(av.w) * lo16(bv.w) + hi16(av.w) * hi16(bv.w); }
        }
        E(row, col0, (f32x4){acc[0], acc[1], acc[2], acc[3]});
    }
}
__device__ __forceinline__ void ph_kmean(const bf16_t* __restrict__ z, float* __restrict__ kmean) {
    const int tid_ = opq_tid();
    for (int it = blockIdx.x; it < NB * NBLK; it += gridDim.x) {
        const int b = it / NBLK, blk = it % NBLK, c = tid_;
        const bf16_t* p = z + ((size_t)b * SEQ + blk * MBLK) * INW + 1024 + c; float s = 0.f;
        for (int r = 0; r < MBLK; ++r) s += bf2f(p[(size_t)r * INW]);
        kmean[((size_t)b * NBLK + blk) * AW + c] = s * (1.f / MBLK);
    }
}
__device__ __forceinline__ void ph_poolm(const bf16_t* __restrict__ z, bf16_t* __restrict__ m) {
    const int tid_ = opq_tid();
    const int c = tid_, w = 2 << (c >> 7);
    for (int it = blockIdx.x; it < T / 64; it += gridDim.x) {
        const int t0 = it * 64;
        for (int i = 0; i < 64; ++i) { const int t = t0 + i, pos = t & (SEQ - 1); const int cnt = (pos + 1 < w) ? pos + 1 : w; float s = 0.f;
            for (int j = 0; j < cnt; ++j) s += bf2f(z[(size_t)(t - j) * INW + c]);
            const float pv = bf2f(z[(size_t)t * INW + c]);
            m[(size_t)t * PW + c] = (bf16_t)f2bf(s / (float)cnt - pv); }
    }
}
__device__ __forceinline__ void ph_attn_naive(const bf16_t* __restrict__ z, const float* __restrict__ kmean, bf16_t* __restrict__ o, float* smem) {
    const int tid_ = opq_tid();
    float (*sc)[1024] = (float (*)[1024])smem;
    const int w = tid_ >> 6, lane = tid_ & 63;
    for (int it = blockIdx.x; it < T; it += gridDim.x) {
        const int t = it, h = w; const int b = t / SEQ, pos = t % SEQ, own = pos / MBLK;
        float q[64];
        { const u32x4* qp = (const u32x4*)(z + (size_t)t * INW + 512 + h * 64);
#pragma unroll
          for (int i = 0; i < 8; ++i) { const u32x4 v = qp[i]; q[8 * i] = lo16(v.x); q[8 * i + 1] = hi16(v.x); q[8 * i + 2] = lo16(v.y); q[8 * i + 3] = hi16(v.y); q[8 * i + 4] = lo16(v.z); q[8 * i + 5] = hi16(v.z); q[8 * i + 6] = lo16(v.w); q[8 * i + 7] = hi16(v.w); } }
        float bs[7];
#pragma unroll
        for (int j = 0; j < 7; ++j) { float s = -INFINITY; if (j < own) { s = 0.f; const float* km = kmean + ((size_t)b * NBLK + j) * AW + h * 64;
#pragma unroll
            for (int d = 0; d < 64; ++d) s += q[d] * km[d]; } bs[j] = s; }
        int sel[3];
#pragma unroll
        for (int r = 0; r < 3; ++r) { float best = -INFINITY; int bi = -1;
#pragma unroll
            for (int j = 0; j < 7; ++j) if (bs[j] > best) { best = bs[j]; bi = j; }
            sel[r] = bi;
#pragma unroll
            for (int j = 0; j < 7; ++j) if (j == bi) bs[j] = -INFINITY; }
        const float slope2 = exp2f(-(float)(h + 1)) * LOG2E;
        float mx = -INFINITY;
#pragma unroll
        for (int sg = 0; sg < 4; ++sg) {
            const int blk = (sg < 3) ? sel[sg] : own; if (blk < 0) continue;
            const int kb = blk * MBLK, cnt = (sg < 3) ? MBLK : (pos - kb + 1);
            for (int kk = lane; kk < cnt; kk += 64) {
                const u32x4* kp = (const u32x4*)(z + ((size_t)b * SEQ + kb + kk) * INW + 1024 + h * 64); float s = 0.f;
#pragma unroll
                for (int i = 0; i < 8; ++i) { const u32x4 v = kp[i]; s += q[8 * i] * lo16(v.x) + q[8 * i + 1] * hi16(v.x) + q[8 * i + 2] * lo16(v.y) + q[8 * i + 3] * hi16(v.y) + q[8 * i + 4] * lo16(v.z) + q[8 * i + 5] * hi16(v.z) + q[8 * i + 6] * lo16(v.w) + q[8 * i + 7] * hi16(v.w); }
                s -= slope2 * (float)(pos - (kb + kk)); sc[w][sg * 256 + kk] = s; mx = fmaxf(mx, s); }
        }
        mx = wave_max(mx); float sum = 0.f;
#pragma unroll
        for (int sg = 0; sg < 4; ++sg) {
            const int blk = (sg < 3) ? sel[sg] : own; if (blk < 0) continue;
            const int kb = blk * MBLK, cnt = (sg < 3) ? MBLK : (pos - kb + 1);
            for (int kk = lane; kk < cnt; kk += 64) { const float p = exp2f(sc[w][sg * 256 + kk] - mx); sc[w][sg * 256 + kk] = p; sum += p; }
        }
        sum = wave_sum(sum);
        __syncthreads();
        float acc = 0.f;
#pragma unroll
        for (int sg = 0; sg < 4; ++sg) {
            const int blk = (sg < 3) ? sel[sg] : own; if (blk < 0) continue;
            const int kb = blk * MBLK, cnt = (sg < 3) ? MBLK : (pos - kb + 1);
            const bf16_t* vp = z + ((size_t)b * SEQ + kb) * INW + 1536 + h * 64 + lane;
            for (int kk = 0; kk < cnt; ++kk) acc += sc[w][sg * 256 + kk] * bf2f(vp[(size_t)kk * INW]);
        }
        o[(size_t)t * AW + h * 64 + lane] = (bf16_t)f2bf(acc / sum);
        __syncthreads();
    }
}
__device__ __forceinline__ void ph_topk_naive(const float* __restrict__ scores, int* __restrict__ eid, float* __restrict__ gw, float* smem) {
    const int tid_ = opq_tid();
    float (*svl)[2][16] = (float (*)[2][16])smem; int (*sil)[2][16] = (int (*)[2][16])(smem + 256); float (*cvl)[16] = (float (*)[16])(smem + 512); int (*cil)[16] = (int (*)[16])(smem + 640);
    const int w = tid_ >> 6, lane = tid_ & 63;
    for (int it = blockIdx.x; it < T; it += gridDim.x) {
        const int t = it, h = w;
        for (int p = 0; p < 2; ++p) {
            const float* s = scores + (size_t)t * PQW + h * 256 + p * 128;
            float v0 = s[lane], v1 = s[lane + 64];
            for (int r = 0; r < 16; ++r) {
                float bv; int bi; if (v0 >= v1) { bv = v0; bi = lane; } else { bv = v1; bi = lane + 64; }
#pragma unroll
                for (int o = 1; o < 64; o <<= 1) { const float ov = __shfl_xor(bv, o); const int oi = __shfl_xor(bi, o); if (ov > bv || (ov == bv && oi < bi)) { bv = ov; bi = oi; } }
                if (lane == 0) { svl[w][p][r] = bv; sil[w][p][r] = bi; }
                if (bi == lane) v0 = -INFINITY; if (bi == lane + 64) v1 = -INFINITY;
            }
        }
        __syncthreads();
        float cv[4];
#pragma unroll
        for (int m = 0; m < 4; ++m) { const int c = lane + 64 * m; cv[m] = svl[w][0][c >> 4] + svl[w][1][c & 15]; }
        for (int r = 0; r < 16; ++r) {
            float bv = cv[0]; int bi = lane;
#pragma unroll
            for (int m = 1; m < 4; ++m) if (cv[m] > bv) { bv = cv[m]; bi = lane + 64 * m; }
#pragma unroll
            for (int o = 1; o < 64; o <<= 1) { const float ov = __shfl_xor(bv, o); const int oi = __shfl_xor(bi, o); if (ov > bv || (ov == bv && oi < bi)) { bv = ov; bi = oi; } }
            if (lane == 0) { cvl[w][r] = bv; cil[w][r] = bi; }
#pragma unroll
            for (int m = 0; m < 4; ++m) if (bi == lane + 64 * m) cv[m] = -INFINITY;
        }
        __syncthreads();
        if (lane < 16) {
            const float mx = cvl[w][0]; float sum = 0.f;
            for (int r = 0; r < 16; ++r) sum += __expf(cvl[w][r] - mx);
            const int c = cil[w][lane];
            eid[(size_t)t * NSLOT + h * 16 + lane] = sil[w][0][c >> 4] * NKEY + sil[w][1][c & 15];
            gw[(size_t)t * NSLOT + h * 16 + lane] = __expf(cvl[w][lane] - mx) / sum;
        }
        __syncthreads();
    }
}
__device__ __forceinline__ void ph_peer_u(const bf16_t* __restrict__ hn, const bf16_t* __restrict__ Ub, const int* __restrict__ eid, const float* __restrict__ gw, float* __restrict__ wact) {
    const int tid_ = opq_tid();
    const int lane = tid_ & 63, wv = tid_ >> 6;
    for (int it = blockIdx.x; it < T / NWAVE; it += gridDim.x) {
        const int t = it * NWAVE + wv;
        const u32x4 h0 = *(const u32x4*)(hn + (size_t)t * DM + lane * 8), h1 = *(const u32x4*)(hn + (size_t)t * DM + 512 + lane * 8);
        for (int s = 0; s < NSLOT; ++s) {
            const int e = eid[(size_t)t * NSLOT + s]; const bf16_t* row = Ub + (size_t)e * DM;
            const u32x4 a = *(const u32x4*)(row + lane * 8), b = *(const u32x4*)(row + 512 + lane * 8);
            float d = lo16(a.x) * lo16(h0.x) + hi16(a.x) * hi16(h0.x) + lo16(a.y) * lo16(h0.y) + hi16(a.y) * hi16(h0.y) + lo16(a.z) * lo16(h0.z) + hi16(a.z) * hi16(h0.z) + lo16(a.w) * lo16(h0.w) + hi16(a.w) * hi16(h0.w)
                    + lo16(b.x) * lo16(h1.x) + hi16(b.x) * hi16(h1.x) + lo16(b.y) * lo16(h1.y) + hi16(b.y) * hi16(h1.y) + lo16(b.z) * lo16(h1.z) + hi16(b.z) * hi16(h1.z) + lo16(b.w) * lo16(h1.w) + hi16(b.w) * hi16(h1.w);
            d = wave_sum(d);
            if (lane == 0) wact[(size_t)t * NSLOT + s] = gw[(size_t)t * NSLOT + s] * gelu_tanh(d);
        }
    }
}
__device__ __forceinline__ void ph_peer_v(float* __restrict__ xres, const bf16_t* __restrict__ Vb, const int* __restrict__ eid, const float* __restrict__ wact, const float* __restrict__ gn, bf16_t* __restrict__ hout, int last) {
    const int tid_ = opq_tid();
    const int lane = tid_ & 63, wv = tid_ >> 6;
    for (int it = blockIdx.x; it < T / NWAVE; it += gridDim.x) {
        const int t = it * NWAVE + wv;
        float acc[16];
#pragma unroll
        for (int i = 0; i < 16; ++i) acc[i] = 0.f;
        for (int s = 0; s < NSLOT; ++s) {
            const int e = eid[(size_t)t * NSLOT + s]; const float w = wact[(size_t)t * NSLOT + s]; const bf16_t* row = Vb + (size_t)e * DM;
            const u32x4 a = *(const u32x4*)(row + lane * 8), b = *(const u32x4*)(row + 512 + lane * 8);
            acc[0] += w * lo16(a.x); acc[1] += w * hi16(a.x); acc[2] += w * lo16(a.y); acc[3] += w * hi16(a.y); acc[4] += w * lo16(a.z); acc[5] += w * hi16(a.z); acc[6] += w * lo16(a.w); acc[7] += w * hi16(a.w);
            acc[8] += w * lo16(b.x); acc[9] += w * hi16(b.x); acc[10] += w * lo16(b.y); acc[11] += w * hi16(b.y); acc[12] += w * lo16(b.z); acc[13] += w * hi16(b.z); acc[14] += w * lo16(b.w); acc[15] += w * hi16(b.w);
        }
        float* xr = xres + (size_t)t * DM; float ss = 0.f;
#pragma unroll
        for (int hf = 0; hf < 2; ++hf)
#pragma unroll
            for (int j = 0; j < 2; ++j) { const f32x4 xv = *(const f32x4*)(xr + hf * 512 + lane * 8 + j * 4);
                acc[hf * 8 + j * 4 + 0] += xv.x; acc[hf * 8 + j * 4 + 1] += xv.y; acc[hf * 8 + j * 4 + 2] += xv.z; acc[hf * 8 + j * 4 + 3] += xv.w; }
#pragma unroll
        for (int i = 0; i < 16; ++i) ss += acc[i] * acc[i];
        const float rstd = rsqrtf(wave_sum(ss) * (1.f / DM) + EPS);
#pragma unroll
        for (int hf = 0; hf < 2; ++hf)
#pragma unroll
            for (int j = 0; j < 2; ++j) { const int c = hf * 512 + lane * 8 + j * 4; const f32x4 g = *(const f32x4*)(gn + c); const int a0 = hf * 8 + j * 4;
                if (last) { *(f32x4*)(xr + c) = (f32x4){acc[a0] * rstd * g.x, acc[a0 + 1] * rstd * g.y, acc[a0 + 2] * rstd * g.z, acc[a0 + 3] * rstd * g.w}; }
                else { *(f32x4*)(xr + c) = (f32x4){acc[a0], acc[a0 + 1], acc[a0 + 2], acc[a0 + 3]};
                    u32x2 ob; ob.x = pk2(acc[a0] * rstd * g.x, acc[a0 + 1] * rstd * g.y); ob.y = pk2(acc[a0 + 2] * rstd * g.z, acc[a0 + 3] * rstd * g.w); *(u32x2*)(hout + (size_t)t * DM + c) = ob; } }
    }
}


__device__ __forceinline__ void ph_poolm2(const bf16_t* z, bf16_t* m) {
    const int tid_ = opq_tid(); const int c = tid_, wsel = c >> 7, w = 2 << wsel;
    for (int it = blockIdx.x; it < T / 64; it += gridDim.x) {
        const int t0 = it * 64, pos0 = t0 & (SEQ - 1);
        float x[32];
#pragma unroll
        for (int i = 0; i < 16; ++i) x[i] = (pos0 == 0) ? 0.f : bf2f(z[(size_t)(t0 - 16 + i) * INW + c]);
#pragma unroll 1
        for (int bt = 0; bt < 4; ++bt) {
#pragma unroll
            for (int i = 0; i < 16; ++i) x[16 + i] = bf2f(z[(size_t)(t0 + bt * 16 + i) * INW + c]);
            float s1[32], s2[32], s3[32], s4[32];
#pragma unroll
            for (int i = 1; i < 32; ++i) s1[i] = x[i] + x[i - 1];
#pragma unroll
            for (int i = 3; i < 32; ++i) s2[i] = s1[i] + s1[i - 2];
#pragma unroll
            for (int i = 7; i < 32; ++i) s3[i] = s2[i] + s2[i - 4];
#pragma unroll
            for (int i = 16; i < 32; ++i) s4[i] = s3[i] + s3[i - 8];
#pragma unroll
            for (int i = 16; i < 32; ++i) { const int pos = pos0 + bt * 16 + (i - 16); const int cnt = (pos + 1 < w) ? pos + 1 : w;
                const float s = (wsel == 0) ? s1[i] : (wsel == 1) ? s2[i] : (wsel == 2) ? s3[i] : s4[i];
                m[(size_t)(t0 + bt * 16 + i - 16) * PW + c] = (bf16_t)f2bf(s / (float)cnt - x[i]); }
#pragma unroll
            for (int i = 0; i < 16; ++i) x[i] = x[16 + i];
        }
    }
}
__device__ __forceinline__ void ph_wpeer2(const float* wq, const float* keys, const float* gf, bf16_t* Wp, float* smem) {
    const int tid_ = opq_tid(); const int kq = tid_ & 31, cq = tid_ >> 5;
    float* kl = smem; float* wl = smem + 128 * 129;
    for (int it = blockIdx.x; it < 16 * 16; it += gridDim.x) {
        const int hp = it >> 4, c0 = (it & 15) * 64, p = hp & 1;
        for (int i = tid_; i < 128 * 32; i += NTHR) { const int row = i >> 5, d4 = (i & 31) * 4; const f32x4 v = *(const f32x4*)(keys + ((size_t)p * NKEY + row) * 128 + d4);
            kl[row * 129 + d4] = v.x; kl[row * 129 + d4 + 1] = v.y; kl[row * 129 + d4 + 2] = v.z; kl[row * 129 + d4 + 3] = v.w; }
        for (int i = tid_; i < 64 * 32; i += NTHR) { const int row = i >> 5, d4 = (i & 31) * 4; const f32x4 v = *(const f32x4*)(wq + (size_t)(c0 + row) * PQW + hp * 128 + d4);
            wl[row * 129 + d4] = v.x; wl[row * 129 + d4 + 1] = v.y; wl[row * 129 + d4 + 2] = v.z; wl[row * 129 + d4 + 3] = v.w; }
        __syncthreads();
        float acc[4][4];
#pragma unroll
        for (int i = 0; i < 4; ++i)
#pragma unroll
            for (int j = 0; j < 4; ++j) acc[i][j] = 0.f;
        for (int d = 0; d < 128; ++d) {
            float av[4], bv[4];
#pragma unroll
            for (int i = 0; i < 4; ++i) { av[i] = kl[(kq + 32 * i) * 129 + d]; bv[i] = wl[(cq + 16 * i) * 129 + d]; }
#pragma unroll
            for (int i = 0; i < 4; ++i)
#pragma unroll
                for (int j = 0; j < 4; ++j) acc[i][j] += av[i] * bv[j];
        }
#pragma unroll
        for (int i = 0; i < 4; ++i)
#pragma unroll
            for (int j = 0; j < 4; ++j) Wp[(size_t)(hp * 128 + kq + 32 * i) * DM + c0 + cq + 16 * j] = (bf16_t)f2bf(acc[i][j] * gf[c0 + cq + 16 * j]);
        __syncthreads();
    }
}

typedef short bf16x8_t __attribute__((ext_vector_type(8)));
typedef float f32x16 __attribute__((ext_vector_type(16)));
typedef short v4i16_t __attribute__((ext_vector_type(4)));
typedef float f32x2_t __attribute__((ext_vector_type(2)));
typedef __bf16 bf16x2_t __attribute__((ext_vector_type(2)));
__device__ __forceinline__ unsigned cvtpk(float lo, float hi) { f32x2_t v = {lo, hi}; bf16x2_t b = __builtin_convertvector(v, bf16x2_t); return __builtin_bit_cast(unsigned, b); }
constexpr int AT_ROW = 144, AT_TILE = 64 * AT_ROW;
__device__ __forceinline__ void ph_attn(unsigned char* lds_, const bf16_t* z, const float* kmean, bf16_t* o) {
    LAS unsigned char* lds = (LAS unsigned char*)lds_;
    const int tid = opq_tid(), lane = tid & 63, wv = __builtin_amdgcn_readfirstlane(tid >> 6), r = lane & 31, hi = lane >> 5;
    const int srow = tid >> 3, sch = tid & 7;
    const unsigned st_off = srow * AT_ROW + sch * 16;
    const unsigned k_off = r * AT_ROW + hi * 16;
    const unsigned v_off = (4 * hi + ((lane & 15) >> 2)) * AT_ROW + (16 * ((lane >> 4) & 1) + 4 * (lane & 3)) * 2;
    LAS float* kml = (LAS float*)(lds + 4 * AT_TILE);
    for (int pr = blockIdx.x; pr < 256; pr += gridDim.x) {
#pragma unroll 1
        for (int uu = 0; uu < 2; ++uu) {
            const int bh = pr >> 2, qb = uu == 0 ? (pr & 3) : 7 - (pr & 3);
            const int b = bh >> 3, h = bh & 7, own = qb, q0 = qb * MBLK;
            const size_t rowbase = (size_t)b * SEQ;
            const int qrel = wv * 32 + r;
            bf16x8_t qf[4];
            { const bf16_t* qptr = z + (rowbase + q0 + qrel) * INW + 512 + h * 64 + hi * 8;
#pragma unroll
              for (int ds = 0; ds < 4; ++ds) qf[ds] = *(const bf16x8_t*)(qptr + ds * 16); }
            unsigned selmask = 0;
            if (own > 0) {
                float bs[7];
#pragma unroll
                for (int j = 0; j < 7; ++j) { float s = -INFINITY;
                    if (j < own) { const float* km = kmean + ((size_t)b * NBLK + j) * AW + h * 64 + hi * 8; s = 0.f;
#pragma unroll
                        for (int ds = 0; ds < 4; ++ds) { const f32x4 k0 = *(const f32x4*)(km + ds * 16), k1 = *(const f32x4*)(km + ds * 16 + 4);
                            s += bf2f((bf16_t)qf[ds][0]) * k0.x + bf2f((bf16_t)qf[ds][1]) * k0.y + bf2f((bf16_t)qf[ds][2]) * k0.z + bf2f((bf16_t)qf[ds][3]) * k0.w
                               + bf2f((bf16_t)qf[ds][4]) * k1.x + bf2f((bf16_t)qf[ds][5]) * k1.y + bf2f((bf16_t)qf[ds][6]) * k1.z + bf2f((bf16_t)qf[ds][7]) * k1.w; }
                        s += __shfl_xor(s, 32); }
                    bs[j] = s; }
#pragma unroll
                for (int rr = 0; rr < 3; ++rr) { float best = -INFINITY; int bi = -1;
#pragma unroll
                    for (int j = 0; j < 7; ++j) if (bs[j] > best) { best = bs[j]; bi = j; }
                    if (bi >= 0) selmask |= 1u << bi;
#pragma unroll
                    for (int j = 0; j < 7; ++j) if (j == bi) bs[j] = -INFINITY; }
            }
            const float slope2 = exp2f(-(float)(h + 1)) * LOG2E;
            const float hoff = slope2 * (float)(4 * hi);
            f32x16 o0, o1;
#pragma unroll
            for (int i = 0; i < 16; ++i) { o0[i] = 0.f; o1[i] = 0.f; }
            float mrun = 0.f, lrun = 0.f;
            const int NS = 2 * (own + 1);
            const unsigned kv_voff = (unsigned)(srow * INW + sch * 8) * 2u;
#define AT_KVLOAD(kd, vd, kvabs_) do { const GAS char* kvb_ = (const GAS char*)z + ((size_t)(rowbase + (kvabs_)) * INW + 1024 + h * 64) * 2; asm("" : "+s"(kvb_)); unsigned vo_ = kv_voff; asm("" : "+v"(vo_)); \
                kd[0] = *(const GAS u32x4*)(kvb_ + vo_); vd[0] = *(const GAS u32x4*)(kvb_ + 1024 + vo_); kd[1] = *(const GAS u32x4*)(kvb_ + 64 * INW * 2 + vo_); vd[1] = *(const GAS u32x4*)(kvb_ + 64 * INW * 2 + 1024 + vo_); } while (0)
#define AT_KVABS(s_) (((s_) < 2) ? own * MBLK + (s_) * 128 : ((s_) - 2) * 128)
#define AT_WRITE(buf_, kd, vd) do { *(LAS u32x4*)(lds + ((buf_) * 4 + 0) * AT_TILE + st_off) = kd[0]; *(LAS u32x4*)(lds + ((buf_) * 4 + 1) * AT_TILE + st_off) = kd[1]; \
                *(LAS u32x4*)(lds + ((buf_) * 4 + 2) * AT_TILE + st_off) = vd[0]; *(LAS u32x4*)(lds + ((buf_) * 4 + 3) * AT_TILE + st_off) = vd[1]; } while (0)
            u32x4 kr[2], vr[2];
            { AT_KVLOAD(kr, vr, own * MBLK); AT_WRITE(0, kr, vr); }
            __syncthreads();
            for (int i0 = 0; i0 < NS; i0 += 2) {
#pragma unroll
              for (int u = 0; u < 2; ++u) {
                const int i = i0 + u; const int cur = u;
                { const int i2 = (i + 1 < NS) ? i + 1 : NS - 1; AT_KVLOAD(kr, vr, AT_KVABS(i2)); }
                int mode[2]; float base[2]; int kv0[2];
#pragma unroll
                for (int sb = 0; sb < 2; ++sb) {
                    if (i < 2) { kv0[sb] = i * 128 + sb * 64; mode[sb] = (kv0[sb] > wv * 32 + 31) ? 0 : ((kv0[sb] + 63 <= wv * 32) ? 1 : 2); base[sb] = slope2 * (float)(kv0[sb] - qrel); }
                    else { kv0[sb] = 0; const int blk = (i - 2) >> 1; const bool sel = (selmask >> blk) & 1u; mode[sb] = __any(sel) ? 1 : 0; base[sb] = sel ? slope2 * (float)((i - 2) * 128 + sb * 64 - q0 - qrel) : -INFINITY; } }
                if (mode[0] | mode[1]) {
                    f32x16 p[2][2];
#pragma unroll
                    for (int sb = 0; sb < 2; ++sb) { const float base2 = (mode[sb] ? base[sb] : -INFINITY) + hoff - mrun;
#pragma unroll
                        for (int e = 0; e < 16; ++e) { p[sb][0][e] = fmaf(slope2, (float)((e & 3) + 8 * (e >> 2)), base2); p[sb][1][e] = fmaf(slope2, (float)((e & 3) + 8 * (e >> 2) + 32), base2); }
                        if (mode[sb] == 2) {
#pragma unroll
                            for (int e = 0; e < 16; ++e) { const int kvr = kv0[sb] + (e & 3) + 8 * (e >> 2) + 4 * hi; if (kvr > qrel) p[sb][0][e] = -INFINITY; if (kvr + 32 > qrel) p[sb][1][e] = -INFINITY; } } }
#pragma unroll
                    for (int sb = 0; sb < 2; ++sb) if (mode[sb]) {
                        const LAS unsigned char* kb = lds + (cur * 4 + sb) * AT_TILE + k_off;
#pragma unroll
                        for (int kh = 0; kh < 2; ++kh) { bf16x8_t ka[4];
#pragma unroll
                            for (int ds = 0; ds < 4; ++ds) ka[ds] = *(const LAS bf16x8_t*)(kb + kh * 32 * AT_ROW + ds * 32);
                            asm volatile("s_waitcnt lgkmcnt(0)" : "+v"(ka[0]), "+v"(ka[1]), "+v"(ka[2]), "+v"(ka[3]) :: "memory");
#pragma unroll
                            for (int ds = 0; ds < 4; ++ds) p[sb][kh] = __builtin_amdgcn_mfma_f32_32x32x16_bf16(ka[ds], qf[ds], p[sb][kh], 0, 0, 0); } }
                    float mloc = fmaxf(fmaxf(p[0][0][0], p[0][1][0]), fmaxf(p[1][0][0], p[1][1][0]));
#pragma unroll
                    for (int e = 1; e < 16; ++e) mloc = fmaxf(mloc, fmaxf(fmaxf(p[0][0][e], p[0][1][e]), fmaxf(p[1][0][e], p[1][1][e])));
                    mloc = fmaxf(mloc, __shfl_xor(mloc, 32));
                    const float delta = (i == 0) ? mloc : fmaxf(mloc, 0.f);
                    if (__any(delta != 0.f)) {
#pragma unroll
                        for (int e = 0; e < 16; ++e) { p[0][0][e] -= delta; p[0][1][e] -= delta; p[1][0][e] -= delta; p[1][1][e] -= delta; }
                        mrun += delta;
                        if (i > 0) { const float alpha = __builtin_amdgcn_exp2f(-delta); lrun *= alpha;
#pragma unroll
                            for (int e = 0; e < 16; ++e) { o0[e] *= alpha; o1[e] *= alpha; } }
                    }
#pragma unroll
                    for (int sb = 0; sb < 2; ++sb) if (mode[sb]) {
                        float ls = 0.f;
#pragma unroll
                        for (int e = 0; e < 16; ++e) { p[sb][0][e] = __builtin_amdgcn_exp2f(p[sb][0][e]); p[sb][1][e] = __builtin_amdgcn_exp2f(p[sb][1][e]); ls += p[sb][0][e] + p[sb][1][e]; }
                        lrun += ls;
                        u32x4 pb[2][2];
#pragma unroll
                        for (int s = 0; s < 2; ++s) { pb[0][s] = (u32x4){cvtpk(p[sb][0][8 * s], p[sb][0][8 * s + 1]), cvtpk(p[sb][0][8 * s + 2], p[sb][0][8 * s + 3]), cvtpk(p[sb][0][8 * s + 4], p[sb][0][8 * s + 5]), cvtpk(p[sb][0][8 * s + 6], p[sb][0][8 * s + 7])};
                            pb[1][s] = (u32x4){cvtpk(p[sb][1][8 * s], p[sb][1][8 * s + 1]), cvtpk(p[sb][1][8 * s + 2], p[sb][1][8 * s + 3]), cvtpk(p[sb][1][8 * s + 4], p[sb][1][8 * s + 5]), cvtpk(p[sb][1][8 * s + 6], p[sb][1][8 * s + 7])}; }
                        const LAS unsigned char* vb = lds + (cur * 4 + 2 + sb) * AT_TILE + v_off;
#pragma unroll
                        for (int kh = 0; kh < 2; ++kh) { v4i16_t vlo[4], vhh[4];
#pragma unroll
                            for (int s = 0; s < 2; ++s)
#pragma unroll
                                for (int dh = 0; dh < 2; ++dh) { const LAS unsigned char* va = vb + (32 * kh + 16 * s) * AT_ROW + dh * 64; const int ix = s * 2 + dh;
                                    vlo[ix] = __builtin_amdgcn_ds_read_tr16_b64_v4i16((LAS v4i16_t*)(va)); vhh[ix] = __builtin_amdgcn_ds_read_tr16_b64_v4i16((LAS v4i16_t*)(va + 8 * AT_ROW)); }
                            asm volatile("s_waitcnt lgkmcnt(0)" : "+v"(vlo[0]), "+v"(vlo[1]), "+v"(vlo[2]), "+v"(vlo[3]), "+v"(vhh[0]), "+v"(vhh[1]), "+v"(vhh[2]), "+v"(vhh[3]) :: "memory");
#pragma unroll
                            for (int s = 0; s < 2; ++s) { const bf16x8_t pf = __builtin_bit_cast(bf16x8_t, pb[kh][s]);
#pragma unroll
                                for (int dh = 0; dh < 2; ++dh) { const int ix = s * 2 + dh;
                                    const bf16x8_t vf = (bf16x8_t){vlo[ix][0], vlo[ix][1], vlo[ix][2], vlo[ix][3], vhh[ix][0], vhh[ix][1], vhh[ix][2], vhh[ix][3]};
                                    if (dh == 0) o0 = __builtin_amdgcn_mfma_f32_32x32x16_bf16(vf, pf, o0, 0, 0, 0); else o1 = __builtin_amdgcn_mfma_f32_32x32x16_bf16(vf, pf, o1, 0, 0, 0); } } }
                    }
                }
                AT_WRITE(cur ^ 1, kr, vr);
                __syncthreads();
              }
            }
#undef AT_KVLOAD
#undef AT_KVABS
#undef AT_WRITE
            lrun += __shfl_xor(lrun, 32);
            const float rl = 1.f / lrun;
            bf16_t* op = o + (rowbase + q0 + qrel) * AW + h * 64 + 4 * hi;
#pragma unroll
            for (int g = 0; g < 4; ++g) {
                u32x2 w0, w1; w0.x = cvtpk(o0[4 * g] * rl, o0[4 * g + 1] * rl); w0.y = cvtpk(o0[4 * g + 2] * rl, o0[4 * g + 3] * rl);
                w1.x = cvtpk(o1[4 * g] * rl, o1[4 * g + 1] * rl); w1.y = cvtpk(o1[4 * g + 2] * rl, o1[4 * g + 3] * rl);
                *(u32x2*)(op + 8 * g) = w0; *(u32x2*)(op + 32 + 8 * g) = w1; }
        }
    }
}


__device__ __forceinline__ void ce_desc(float& a, float& b) {
    float mx, mn; asm("v_max_f32 %0, %1, %2" : "=v"(mx) : "v"(a), "v"(b)); asm("v_min_f32 %0, %1, %2" : "=v"(mn) : "v"(a), "v"(b)); a = mx; b = mn;
}
__device__ __forceinline__ float vmaxf(float a, float b) { float mx; asm("v_max_f32 %0, %1, %2" : "=v"(mx) : "v"(a), "v"(b)); return mx; }
template <int N> __device__ __forceinline__ void bitonic_sort_desc(float (&v)[N]) {
#pragma unroll
    for (int k = 2; k <= N; k <<= 1)
#pragma unroll
        for (int j = k >> 1; j > 0; j >>= 1)
#pragma unroll
            for (int i = 0; i < N; ++i) { const int l = i ^ j; if (l > i) { if ((i & k) == 0) ce_desc(v[i], v[l]); else ce_desc(v[l], v[i]); } }
}
template <int N> __device__ __forceinline__ void bitonic_merge_desc(float (&v)[N]) {
#pragma unroll
    for (int j = N >> 1; j > 0; j >>= 1)
#pragma unroll
        for (int i = 0; i < N; ++i) { const int l = i ^ j; if (l > i) ce_desc(v[i], v[l]); }
}
__device__ __forceinline__ void merge_top16(float (&a)[16], const float (&b)[16]) {
#pragma unroll
    for (int i = 0; i < 16; ++i) a[i] = vmaxf(a[i], b[15 - i]);
    bitonic_merge_desc<16>(a);
}
constexpr int TK_ROW = 68;
__device__ __forceinline__ void ph_topk(unsigned char* lds_, const short* scores, int* eid, float* gw, int* offs, const int task) {
    const int tid = opq_tid(), lane = tid & 63, wv = __builtin_amdgcn_readfirstlane(tid >> 6);
    LAS float* stg = (LAS float*)lds_ + wv * (64 * TK_ROW);
    {
        const short* base = scores + (size_t)task * 64 * 256;
        float top[2][16];
        u32x2 pre[16];
#pragma unroll
        for (int i = 0; i < 16; ++i) pre[i] = *(const u32x2*)(base + (size_t)(4 * i + (lane >> 4)) * 256 + (lane & 15) * 4);
#pragma unroll
        for (int p = 0; p < 2; ++p) {
#pragma unroll
            for (int rd = 0; rd < 2; ++rd) {
#pragma unroll
                for (int i = 0; i < 16; ++i) { const int jj = 4 * i + (lane >> 4);
                    const u32x2 w = pre[i];
                    const f32x4 v = (f32x4){(float)(short)(w.x & 0xffffu), (float)((int)w.x >> 16), (float)(short)(w.y & 0xffffu), (float)((int)w.y >> 16)} * (1.f / 2048.f);
                    *(LAS f32x4*)(stg + jj * TK_ROW + (lane & 15) * 4) = v; }
                if (p * 2 + rd < 3) { const int qn = p * 2 + rd + 1;
#pragma unroll
                    for (int i = 0; i < 16; ++i) pre[i] = *(const u32x2*)(base + (size_t)(4 * i + (lane >> 4)) * 256 + (qn >> 1) * 128 + (qn & 1) * 64 + (lane & 15) * 4); }
                float blk[4][16];
#pragma unroll
                for (int g = 0; g < 4; ++g)
#pragma unroll
                    for (int c = 0; c < 4; ++c) { const f32x4 v = *(const LAS f32x4*)(stg + lane * TK_ROW + g * 16 + c * 4);
#pragma unroll
                        for (int e = 0; e < 4; ++e) { const unsigned idx = rd * 64 + g * 16 + c * 4 + e; blk[g][c * 4 + e] = __uint_as_float((__float_as_uint(v[e]) & ~127u) | idx); } }
#pragma unroll
                for (int g = 0; g < 4; ++g) bitonic_sort_desc<16>(blk[g]);
                merge_top16(blk[0], blk[1]); merge_top16(blk[2], blk[3]); merge_top16(blk[0], blk[2]);
                if (rd == 0) {
#pragma unroll
                    for (int e = 0; e < 16; ++e) top[p][e] = blk[0][e];
                } else merge_top16(top[p], blk[0]);
            }
        }
        LAS unsigned* tab = (LAS unsigned*)(stg + lane * TK_ROW);
#pragma unroll
        for (int p = 0; p < 2; ++p)
#pragma unroll
            for (int q = 0; q < 4; ++q) { unsigned w = 0;
#pragma unroll
                for (int e = 0; e < 4; ++e) w |= (__float_as_uint(top[p][4 * q + e]) & 127u) << (8 * e);
                tab[p * 4 + q] = w; }
#define CAND(i, j) __uint_as_float((__float_as_uint(top[0][i] + top[1][j]) & ~255u) | (unsigned)((i) * 16 + (j)))
        float A[16], Bv[16], C[16], Dv[16];
#pragma unroll
        for (int j = 0; j < 16; ++j) A[j] = CAND(0, j);
#pragma unroll
        for (int i = 1; i < 16; ++i) Bv[i - 1] = CAND(i, 0);
        Bv[15] = -INFINITY;
#pragma unroll
        for (int j = 1; j < 8; ++j) Dv[j - 1] = CAND(1, j);
#pragma unroll
        for (int j = 7; j < 16; ++j) Dv[j] = -INFINITY;
        C[0] = CAND(2, 1); C[1] = CAND(2, 2); C[2] = CAND(2, 3); C[3] = CAND(2, 4); C[4] = CAND(3, 1); C[5] = CAND(3, 2); C[6] = CAND(3, 3); C[7] = CAND(4, 1); C[8] = CAND(4, 2);
        C[9] = CAND(5, 1); C[10] = CAND(6, 1); C[11] = CAND(7, 1); C[12] = -INFINITY; C[13] = -INFINITY; C[14] = -INFINITY; C[15] = -INFINITY;
#undef CAND
        bitonic_sort_desc<16>(C);
        merge_top16(A, Bv); merge_top16(C, Dv); merge_top16(A, C);
        float g[16]; int ex[16]; float sum = 0.f; const float mx = __uint_as_float(__float_as_uint(A[0]) & ~255u);
#pragma unroll
        for (int e = 0; e < 16; ++e) { const unsigned bits = __float_as_uint(A[e]); const unsigned id = bits & 255u;
            g[e] = __expf(__uint_as_float(bits & ~255u) - mx); sum += g[e];
            const unsigned i0 = ((const LAS unsigned char*)tab)[id >> 4], i1 = ((const LAS unsigned char*)tab)[16 + (id & 15)];
            ex[e] = (int)(i0 * NKEY + i1); }
        const float rs = 1.f / sum;
        LAS unsigned* si = (LAS unsigned*)stg; LAS float* sf = stg + 1024;
        { const int sb = (lane >> 3) * 128 + (lane & 7) * 16;
#pragma unroll
          for (int q = 0; q < 4; ++q) { *(LAS u32x4*)(si + sb + 4 * q) = (u32x4){(unsigned)ex[4 * q], (unsigned)ex[4 * q + 1], (unsigned)ex[4 * q + 2], (unsigned)ex[4 * q + 3]};
              *(LAS f32x4*)(sf + sb + 4 * q) = (f32x4){g[4 * q] * rs, g[4 * q + 1] * rs, g[4 * q + 2] * rs, g[4 * q + 3] * rs}; } }
#pragma unroll 1
        for (int j = 0; j < 8; ++j) {
            const unsigned e0 = si[j * 128 + lane], e1 = si[j * 128 + 64 + lane]; const float g0 = sf[j * 128 + lane], g1 = sf[j * 128 + 64 + lane];
            const unsigned k0 = e0 >> 11, k1 = e1 >> 11; int pos0 = 0, pos1 = 0, offq = 0, offv = 0;
#pragma unroll
            for (int q = 0; q < 8; ++q) {
                const unsigned long long m0 = __builtin_amdgcn_ballot_w64(k0 == (unsigned)q), m1 = __builtin_amdgcn_ballot_w64(k1 == (unsigned)q);
                const int c0 = __builtin_popcountll(m0), c1 = __builtin_popcountll(m1);
                const int r0 = __builtin_amdgcn_mbcnt_hi((unsigned)(m0 >> 32), __builtin_amdgcn_mbcnt_lo((unsigned)m0, 0)), r1 = __builtin_amdgcn_mbcnt_hi((unsigned)(m1 >> 32), __builtin_amdgcn_mbcnt_lo((unsigned)m1, 0));
                if (k0 == (unsigned)q) pos0 = offq + r0;
                if (k1 == (unsigned)q) pos1 = offq + c0 + r1;
                offq += c0 + c1; if (lane == q + 1) offv = offq;
            }
            const size_t tb = ((size_t)task * 8 + j) * NSLOT;
            eid[tb + pos0] = (int)e0; eid[tb + pos1] = (int)e1; gw[tb + pos0] = g0; gw[tb + pos1] = g1;
            if (lane < 16) offs[((size_t)task * 8 + j) * 16 + lane] = (lane <= 8) ? offv : NSLOT;
        }
    }
}

typedef __bf16 bf16x2v __attribute__((ext_vector_type(2)));
__device__ __forceinline__ float dot2bf(unsigned a, unsigned b, float c) { return __builtin_amdgcn_fdot2_f32_bf16(__builtin_bit_cast(bf16x2v, a), __builtin_bit_cast(bf16x2v, b), c, false); }
__device__ __forceinline__ float dot8(u32x4 a, u32x4 b, float c) { c = dot2bf(a.x, b.x, c); c = dot2bf(a.y, b.y, c); c = dot2bf(a.z, b.z, c); return dot2bf(a.w, b.w, c); }
__device__ __forceinline__ void ph_peer_u2(const bf16_t* hn, const bf16_t* Ub, const int* eid, const float* gw, float* wact) {
    const int tid = opq_tid(), lane = tid & 63, wv = __builtin_amdgcn_readfirstlane(tid >> 6); const unsigned voff = (unsigned)lane * 16u;
    for (int t = blockIdx.x * NWAVE + wv; t < T; t += gridDim.x * NWAVE) {
        const u32x4 h0 = *(const u32x4*)(hn + (size_t)t * DM + lane * 8), h1 = *(const u32x4*)(hn + (size_t)t * DM + 512 + lane * 8);
        const int e_lo = eid[(size_t)t * NSLOT + lane], e_hi = eid[(size_t)t * NSLOT + 64 + lane];
        u32x4 bufA[16], bufB[16];
#define U_ISSUE(buf, st) do { unsigned vo = voff; asm("" : "+v"(vo)); _Pragma("unroll") for (int k = 0; k < 8; ++k) { const int sl = (st) * 8 + k; const int e = __builtin_amdgcn_readlane((sl < 64) ? e_lo : e_hi, sl & 63); \
            const GAS char* row = (const GAS char*)Ub + (size_t)e * (DM * 2); asm("" : "+s"(row)); buf[2 * k] = *(const GAS u32x4*)(row + vo); buf[2 * k + 1] = *(const GAS u32x4*)(row + 1024 + vo); } } while (0)
#define U_DOT(buf, dst, off) do { _Pragma("unroll") for (int k = 0; k < 8; ++k) dst[(off) + k] = dot8(buf[2 * k + 1], h1, dot8(buf[2 * k], h0, 0.f)); } while (0)
#define U_REDUCE(hh_) do { float r8[8], r4[4], r2[2], r1; \
            _Pragma("unroll") for (int k = 0; k < 8; ++k) { const bool up = lane & 32; const float keep = up ? part[k + 8] : part[k], send = up ? part[k] : part[k + 8]; r8[k] = keep + __shfl_xor(send, 32); } \
            _Pragma("unroll") for (int k = 0; k < 4; ++k) { const bool up = lane & 16; const float keep = up ? r8[k + 4] : r8[k], send = up ? r8[k] : r8[k + 4]; r4[k] = keep + __shfl_xor(send, 16); } \
            _Pragma("unroll") for (int k = 0; k < 2; ++k) { const bool up = lane & 8; const float keep = up ? r4[k + 2] : r4[k], send = up ? r4[k] : r4[k + 2]; r2[k] = keep + __shfl_xor(send, 8); } \
            { const bool up = lane & 4; const float keep = up ? r2[1] : r2[0], send = up ? r2[0] : r2[1]; r1 = keep + __shfl_xor(send, 4); } \
            r1 += __shfl_xor(r1, 2); r1 += __shfl_xor(r1, 1); \
            if ((lane & 3) == 0) { const int s = (hh_) * 16 + (lane >> 2); wact[(size_t)t * NSLOT + s] = gw[(size_t)t * NSLOT + s] * gelu_tanh(r1); } } while (0)
        U_ISSUE(bufA, 0); U_ISSUE(bufB, 1);
#pragma unroll 1
        for (int hh = 0; hh < PH - 1; ++hh) {
            float part[16];
            U_DOT(bufA, part, 0); U_ISSUE(bufA, 2 * hh + 2);
            U_DOT(bufB, part, 8); U_ISSUE(bufB, 2 * hh + 3);
            U_REDUCE(hh);
        }
        { float part[16]; U_DOT(bufA, part, 0); U_DOT(bufB, part, 8); U_REDUCE(PH - 1); }
#undef U_REDUCE
#undef U_ISSUE
#undef U_DOT
    }
}
__device__ __forceinline__ void ph_peer_v2(float* xres, const bf16_t* Vb, const int* eid, const float* wact, const float* gn, bf16_t* hout, int last) {
    const int tid = opq_tid(), lane = tid & 63, wv = __builtin_amdgcn_readfirstlane(tid >> 6); const unsigned voff = (unsigned)lane * 16u;
    for (int t = blockIdx.x * NWAVE + wv; t < T; t += gridDim.x * NWAVE) {
        const int e_lo = eid[(size_t)t * NSLOT + lane], e_hi = eid[(size_t)t * NSLOT + 64 + lane];
        const float w_lo = wact[(size_t)t * NSLOT + lane], w_hi = wact[(size_t)t * NSLOT + 64 + lane];
        float acc[16];
#pragma unroll
        for (int i = 0; i < 16; ++i) acc[i] = 0.f;
        u32x4 bufA[16], bufB[16];
#define V_ISSUE(buf, st) do { unsigned vo = voff; asm("" : "+v"(vo)); _Pragma("unroll") for (int k = 0; k < 8; ++k) { const int sl = (st) * 8 + k; const int e = __builtin_amdgcn_readlane((sl < 64) ? e_lo : e_hi, sl & 63); \
            const GAS char* row = (const GAS char*)Vb + (size_t)e * (DM * 2); asm("" : "+s"(row)); buf[2 * k] = *(const GAS u32x4*)(row + vo); buf[2 * k + 1] = *(const GAS u32x4*)(row + 1024 + vo); } } while (0)
#define V_ACC(buf, st) do { _Pragma("unroll") for (int k = 0; k < 8; ++k) { const int sl = (st) * 8 + k; const float w = __builtin_bit_cast(float, __builtin_amdgcn_readlane(__builtin_bit_cast(int, (sl < 64) ? w_lo : w_hi), sl & 63)); \
            const u32x4 a = buf[2 * k], b = buf[2 * k + 1]; \
            acc[0] += w * lo16(a.x); acc[1] += w * hi16(a.x); acc[2] += w * lo16(a.y); acc[3] += w * hi16(a.y); acc[4] += w * lo16(a.z); acc[5] += w * hi16(a.z); acc[6] += w * lo16(a.w); acc[7] += w * hi16(a.w); \
            acc[8] += w * lo16(b.x); acc[9] += w * hi16(b.x); acc[10] += w * lo16(b.y); acc[11] += w * hi16(b.y); acc[12] += w * lo16(b.z); acc[13] += w * hi16(b.z); acc[14] += w * lo16(b.w); acc[15] += w * hi16(b.w); } } while (0)
        V_ISSUE(bufA, 0); V_ISSUE(bufB, 1);
#pragma unroll 1
        for (int st = 0; st < 14; st += 2) {
            V_ACC(bufA, st); V_ISSUE(bufA, st + 2);
            V_ACC(bufB, st + 1); V_ISSUE(bufB, st + 3);
        }
        V_ACC(bufA, 14); V_ACC(bufB, 15);
#undef V_ISSUE
#undef V_ACC
        float* xr = xres + (size_t)t * DM; float ss = 0.f;
#pragma unroll
        for (int hf = 0; hf < 2; ++hf)
#pragma unroll
            for (int j = 0; j < 2; ++j) { const f32x4 xv = *(const f32x4*)(xr + hf * 512 + lane * 8 + j * 4);
                acc[hf * 8 + j * 4 + 0] += xv.x; acc[hf * 8 + j * 4 + 1] += xv.y; acc[hf * 8 + j * 4 + 2] += xv.z; acc[hf * 8 + j * 4 + 3] += xv.w; }
#pragma unroll
        for (int i = 0; i < 16; ++i) ss += acc[i] * acc[i];
        const float rstd = rsqrtf(wave_sum(ss) * (1.f / DM) + EPS);
#pragma unroll
        for (int hf = 0; hf < 2; ++hf)
#pragma unroll
            for (int j = 0; j < 2; ++j) { const int c = hf * 512 + lane * 8 + j * 4; const f32x4 g = *(const f32x4*)(gn + c); const int a0 = hf * 8 + j * 4;
                if (last) { *(f32x4*)(xr + c) = (f32x4){acc[a0] * rstd * g.x, acc[a0 + 1] * rstd * g.y, acc[a0 + 2] * rstd * g.z, acc[a0 + 3] * rstd * g.w}; }
                else { *(f32x4*)(xr + c) = (f32x4){acc[a0], acc[a0 + 1], acc[a0 + 2], acc[a0 + 3]};
                    u32x2 ob; ob.x = pk2(acc[a0] * rstd * g.x, acc[a0 + 1] * rstd * g.y); ob.y = pk2(acc[a0 + 2] * rstd * g.z, acc[a0 + 3] * rstd * g.w); *(u32x2*)(hout + (size_t)t * DM + c) = ob; } }
    }
}


constexpr size_t WS_KM = WS_VB + 40 * MiB;
constexpr size_t WS_XB = WS_VB + 4 * MiB;
constexpr size_t WS_UQ = WS_UB, WS_VQ = WS_UB + 32 * MiB, WS_SU = WS_VB, WS_SV = WS_VB + 1 * MiB, WS_HQ = WS_VB + 2 * MiB, WS_SH = WS_VB + 18 * MiB;
__device__ __forceinline__ float ub0(unsigned x) { float f; asm("v_cvt_f32_ubyte0 %0, %1" : "=v"(f) : "v"(x)); return f; }
__device__ __forceinline__ float ub1(unsigned x) { float f; asm("v_cvt_f32_ubyte1 %0, %1" : "=v"(f) : "v"(x)); return f; }
__device__ __forceinline__ float ub2(unsigned x) { float f; asm("v_cvt_f32_ubyte2 %0, %1" : "=v"(f) : "v"(x)); return f; }
__device__ __forceinline__ float ub3(unsigned x) { float f; asm("v_cvt_f32_ubyte3 %0, %1" : "=v"(f) : "v"(x)); return f; }
__device__ __forceinline__ unsigned q8(float v, float inv, int offs) { return (unsigned)((int)__builtin_rintf(v * inv) + offs) & 255u; }
__device__ __forceinline__ void ph_quant_rows_w(const float* src, unsigned char* dst, float* scale, int nrows, int offs, int widx, int nw) {
    const int tid_ = opq_tid(); const int lane = tid_ & 63;
    for (int row0 = widx * 4; row0 < nrows; row0 += nw * 4) {
        f32x4 v[4][4]; float am[4];
#pragma unroll
        for (int r = 0; r < 4; ++r) { const f32x4* s4 = (const f32x4*)(src + (size_t)(row0 + r) * DM);
#pragma unroll
            for (int j = 0; j < 4; ++j) v[r][j] = s4[lane + 64 * j]; }
#pragma unroll
        for (int r = 0; r < 4; ++r) { float a = 0.f;
#pragma unroll
            for (int j = 0; j < 4; ++j) a = fmaxf(a, fmaxf(fmaxf(fabsf(v[r][j].x), fabsf(v[r][j].y)), fmaxf(fabsf(v[r][j].z), fabsf(v[r][j].w))));
            am[r] = wave_max(a); }
#pragma unroll
        for (int r = 0; r < 4; ++r) { const float inv = am[r] > 0.f ? 127.f / am[r] : 0.f;
#pragma unroll
            for (int j = 0; j < 4; ++j) ((unsigned*)(dst + (size_t)(row0 + r) * DM))[lane + 64 * j] = q8(v[r][j].x, inv, offs) | (q8(v[r][j].y, inv, offs) << 8) | (q8(v[r][j].z, inv, offs) << 16) | (q8(v[r][j].w, inv, offs) << 24);
            if (lane == 0) scale[row0 + r] = am[r] > 0.f ? am[r] * (1.f / 127.f) : 1.f; }
    }
}
__device__ __forceinline__ void ph_quant_rows(const float* src, unsigned char* dst, float* scale, int nrows, int offs) {
    const int wv = __builtin_amdgcn_readfirstlane((int)(threadIdx.x >> 6)); ph_quant_rows_w(src, dst, scale, nrows, offs, blockIdx.x * NWAVE + wv, gridDim.x * NWAVE);
}
__device__ __forceinline__ void ph_rmsnorm_q(const float* x, const float* g, bf16_t* out, unsigned char* hq, float* sh) {
    const int tid_ = opq_tid(); const int lane = tid_ & 63, wv = tid_ >> 6;
    for (int it = blockIdx.x; it < T / NWAVE; it += gridDim.x) {
        const int row = it * NWAVE + wv; const f32x4* xr = (const f32x4*)(x + (size_t)row * DM); f32x4 v[4]; float s = 0.f;
#pragma unroll
        for (int j = 0; j < 4; ++j) { v[j] = xr[lane + 64 * j]; s += v[j].x * v[j].x + v[j].y * v[j].y + v[j].z * v[j].z + v[j].w * v[j].w; }
        const float rstd = rsqrtf(wave_sum(s) * (1.f / DM) + EPS); float am = 0.f;
#pragma unroll
        for (int j = 0; j < 4; ++j) { const f32x4 gg = ((const f32x4*)g)[lane + 64 * j]; v[j] = v[j] * rstd * gg; am = fmaxf(am, fmaxf(fmaxf(fabsf(v[j].x), fabsf(v[j].y)), fmaxf(fabsf(v[j].z), fabsf(v[j].w))));
            u32x2 o; o.x = pk2(v[j].x, v[j].y); o.y = pk2(v[j].z, v[j].w); ((u32x2*)(out + (size_t)row * DM))[lane + 64 * j] = o; }
        am = wave_max(am); const float inv = am > 0.f ? 127.f / am : 0.f;
#pragma unroll
        for (int j = 0; j < 4; ++j) ((unsigned*)(hq + (size_t)row * DM))[lane + 64 * j] = q8(v[j].x, inv, 0) | (q8(v[j].y, inv, 0) << 8) | (q8(v[j].z, inv, 0) << 16) | (q8(v[j].w, inv, 0) << 24);
        if (lane == 0) sh[row] = am > 0.f ? am * (1.f / 127.f) : 1.f;
    }
}
__device__ __forceinline__ int dot16i(u32x4 a, u32x4 b) { int c = __builtin_amdgcn_sdot4((int)a.x, (int)b.x, 0, false); c = __builtin_amdgcn_sdot4((int)a.y, (int)b.y, c, false); c = __builtin_amdgcn_sdot4((int)a.z, (int)b.z, c, false); return __builtin_amdgcn_sdot4((int)a.w, (int)b.w, c, false); }
template <int EMASK> __device__ __forceinline__ void ph_peer_u3(const unsigned char* hq, const float* sh, const unsigned char* Uq, const float* su, const int* eid, const float* gw, float* wact) {
    const int tid = opq_tid(), lane = tid & 63, wv = __builtin_amdgcn_readfirstlane(tid >> 6); const unsigned voff = (unsigned)lane * 16u;
    for (int t = blockIdx.x * NWAVE + wv; t < T; t += gridDim.x * NWAVE) {
        const u32x4 h4 = *(const u32x4*)(hq + (size_t)t * DM + lane * 16);
        const int e_lo = eid[(size_t)t * NSLOT + lane], e_hi = eid[(size_t)t * NSLOT + 64 + lane];
        const float sht = sh[t];
        const float g_lo = gw[(size_t)t * NSLOT + lane], g_hi = gw[(size_t)t * NSLOT + 64 + lane];
        const float sc_lo = su[e_lo] * sht, sc_hi = su[e_hi] * sht;
        u32x4 bufA[16], bufB[16];
#define U_ISSUE(buf, hh_) do { unsigned vo = voff; asm("" : "+v"(vo)); _Pragma("unroll") for (int k = 0; k < 16; ++k) { const int sl = (hh_) * 16 + k; const int e = __builtin_amdgcn_readlane((sl < 64) ? e_lo : e_hi, sl & 63) & EMASK; \
            const GAS char* row = (const GAS char*)Uq + (size_t)e * DM; asm("" : "+s"(row)); buf[k] = *(const GAS u32x4*)(row + vo); } } while (0)
#define U_HEAD(buf, hh_) do { float part[16]; _Pragma("unroll") for (int k = 0; k < 16; ++k) part[k] = (float)dot16i(buf[k], h4); \
            float r8[8], r4[4], r2[2], r1; \
            _Pragma("unroll") for (int k = 0; k < 8; ++k) { const bool up = lane & 32; const float keep = up ? part[k + 8] : part[k], send = up ? part[k] : part[k + 8]; r8[k] = keep + __shfl_xor(send, 32); } \
            _Pragma("unroll") for (int k = 0; k < 4; ++k) { const bool up = lane & 16; const float keep = up ? r8[k + 4] : r8[k], send = up ? r8[k] : r8[k + 4]; r4[k] = keep + __shfl_xor(send, 16); } \
            _Pragma("unroll") for (int k = 0; k < 2; ++k) { const bool up = lane & 8; const float keep = up ? r4[k + 2] : r4[k], send = up ? r4[k] : r4[k + 2]; r2[k] = keep + __shfl_xor(send, 8); } \
            { const bool up = lane & 4; const float keep = up ? r2[1] : r2[0], send = up ? r2[0] : r2[1]; r1 = keep + __shfl_xor(send, 4); } \
            r1 += __shfl_xor(r1, 2); r1 += __shfl_xor(r1, 1); \
            const int sl_ = ((hh_) & 3) * 16 + (lane >> 2); const float scl = __shfl(((hh_) < 4) ? sc_lo : sc_hi, sl_), gg = __shfl(((hh_) < 4) ? g_lo : g_hi, sl_); \
            if ((lane & 3) == 0) wact[(size_t)t * NSLOT + (hh_) * 16 + (lane >> 2)] = gg * gelu_tanh(r1 * scl); } while (0)
        U_ISSUE(bufA, 0); U_ISSUE(bufB, 1);
#pragma unroll 1
        for (int hp = 0; hp < 3; ++hp) {
            U_HEAD(bufA, 2 * hp); U_ISSUE(bufA, 2 * hp + 2);
            U_HEAD(bufB, 2 * hp + 1); U_ISSUE(bufB, 2 * hp + 3);
        }
        U_HEAD(bufA, 6); U_HEAD(bufB, 7);
#undef U_ISSUE
#undef U_HEAD
    }
}
__device__ __forceinline__ void ph_peer_v3(float* xres, const unsigned char* Vq, const float* sv, const int* eid, const float* wact, const float* gn, bf16_t* hout, int last) {
    const int tid = opq_tid(), lane = tid & 63, wv = __builtin_amdgcn_readfirstlane(tid >> 6); const unsigned voff = (unsigned)lane * 16u;
    for (int t = blockIdx.x * NWAVE + wv; t < T; t += gridDim.x * NWAVE) {
        const int e_lo = eid[(size_t)t * NSLOT + lane], e_hi = eid[(size_t)t * NSLOT + 64 + lane];
        const float c_lo = wact[(size_t)t * NSLOT + lane] * sv[e_lo], c_hi = wact[(size_t)t * NSLOT + 64 + lane] * sv[e_hi];
        float acc[16]; float corr = 0.f;
#pragma unroll
        for (int i = 0; i < 16; ++i) acc[i] = 0.f;
        u32x4 bufA[8], bufB[8];
#define V_ISSUE(buf, st_) do { unsigned vo = voff; asm("" : "+v"(vo)); _Pragma("unroll") for (int k = 0; k < 8; ++k) { const int sl = (st_) * 8 + k; const int e = __builtin_amdgcn_readlane((sl < 64) ? e_lo : e_hi, sl & 63); \
            const GAS char* row = (const GAS char*)Vq + (size_t)e * DM; asm("" : "+s"(row)); buf[k] = *(const GAS u32x4*)(row + vo); } } while (0)
#define V_ACC(buf, st_) do { _Pragma("unroll") for (int k = 0; k < 8; ++k) { const int sl = (st_) * 8 + k; const float w = __builtin_bit_cast(float, __builtin_amdgcn_readlane(__builtin_bit_cast(int, (sl < 64) ? c_lo : c_hi), sl & 63)); \
            const u32x4 a = buf[k]; corr += w; \
            acc[0] += w * ub0(a.x); acc[1] += w * ub1(a.x); acc[2] += w * ub2(a.x); acc[3] += w * ub3(a.x); acc[4] += w * ub0(a.y); acc[5] += w * ub1(a.y); acc[6] += w * ub2(a.y); acc[7] += w * ub3(a.y); \
            acc[8] += w * ub0(a.z); acc[9] += w * ub1(a.z); acc[10] += w * ub2(a.z); acc[11] += w * ub3(a.z); acc[12] += w * ub0(a.w); acc[13] += w * ub1(a.w); acc[14] += w * ub2(a.w); acc[15] += w * ub3(a.w); } } while (0)
        V_ISSUE(bufA, 0); V_ISSUE(bufB, 1);
#pragma unroll 1
        for (int st = 0; st < 14; st += 2) {
            V_ACC(bufA, st); V_ISSUE(bufA, st + 2);
            V_ACC(bufB, st + 1); V_ISSUE(bufB, st + 3);
        }
        V_ACC(bufA, 14); V_ACC(bufB, 15);
#undef V_ISSUE
#undef V_ACC
        float* xr = xres + (size_t)t * DM + lane * 16; float ss = 0.f; const float c128 = 128.f * corr;
#pragma unroll
        for (int j = 0; j < 4; ++j) { const f32x4 xv = *(const f32x4*)(xr + j * 4);
            acc[j * 4 + 0] += xv.x - c128; acc[j * 4 + 1] += xv.y - c128; acc[j * 4 + 2] += xv.z - c128; acc[j * 4 + 3] += xv.w - c128; }
#pragma unroll
        for (int i = 0; i < 16; ++i) ss += acc[i] * acc[i];
        const float rstd = rsqrtf(wave_sum(ss) * (1.f / DM) + EPS);
#pragma unroll
        for (int j = 0; j < 4; ++j) { const int c = lane * 16 + j * 4; const f32x4 g = *(const f32x4*)(gn + c); const int a0 = j * 4;
            if (last) { *(f32x4*)(xr + j * 4) = (f32x4){acc[a0] * rstd * g.x, acc[a0 + 1] * rstd * g.y, acc[a0 + 2] * rstd * g.z, acc[a0 + 3] * rstd * g.w}; }
            else { *(f32x4*)(xr + j * 4) = (f32x4){acc[a0], acc[a0 + 1], acc[a0 + 2], acc[a0 + 3]};
                u32x2 ob; ob.x = pk2(acc[a0] * rstd * g.x, acc[a0 + 1] * rstd * g.y); ob.y = pk2(acc[a0 + 2] * rstd * g.z, acc[a0 + 3] * rstd * g.w); *(u32x2*)(hout + (size_t)t * DM + c) = ob; } }
    }
}


__device__ __forceinline__ void ph_peer_v5(float* xres, const unsigned char* Vq, const float* sv, const int* eid, const float* wact, const float* gn, bf16_t* hout, int last) {
    const int tid = opq_tid(), lane = tid & 63, wv = __builtin_amdgcn_readfirstlane(tid >> 6); const unsigned voff = (unsigned)lane * 16u;
    for (int t = blockIdx.x * NWAVE + wv; t < T; t += gridDim.x * NWAVE) {
        const int e_lo = eid[(size_t)t * NSLOT + lane], e_hi = eid[(size_t)t * NSLOT + 64 + lane];
        const float c_lo = wact[(size_t)t * NSLOT + lane] * sv[e_lo], c_hi = wact[(size_t)t * NSLOT + 64 + lane] * sv[e_hi];
        float acc[16]; float corr = 0.f;
#pragma unroll
        for (int i = 0; i < 16; ++i) acc[i] = 0.f;
        u32x4 bufA[16], bufB[16];
#define V_ISSUE(buf, hh_) do { _Pragma("unroll") for (int k = 0; k < 16; ++k) { const int sl = (hh_) * 16 + k; const int e = __builtin_amdgcn_readlane((sl < 64) ? e_lo : e_hi, sl & 63); \
            const GAS char* row = (const GAS char*)Vq + (size_t)e * DM; asm("" : "+s"(row)); unsigned vo = voff; asm("" : "+v"(vo)); buf[k] = *(const GAS u32x4*)(row + vo); } } while (0)
#define V_ACC(buf, hh_) do { _Pragma("unroll") for (int k = 0; k < 16; ++k) { const int sl = (hh_) * 16 + k; const float w = __builtin_bit_cast(float, __builtin_amdgcn_readlane(__builtin_bit_cast(int, (sl < 64) ? c_lo : c_hi), sl & 63)); \
            const u32x4 a = buf[k]; corr += w; \
            acc[0] += w * ub0(a.x); acc[1] += w * ub1(a.x); acc[2] += w * ub2(a.x); acc[3] += w * ub3(a.x); acc[4] += w * ub0(a.y); acc[5] += w * ub1(a.y); acc[6] += w * ub2(a.y); acc[7] += w * ub3(a.y); \
            acc[8] += w * ub0(a.z); acc[9] += w * ub1(a.z); acc[10] += w * ub2(a.z); acc[11] += w * ub3(a.z); acc[12] += w * ub0(a.w); acc[13] += w * ub1(a.w); acc[14] += w * ub2(a.w); acc[15] += w * ub3(a.w); \
            __builtin_amdgcn_sched_barrier(0); } } while (0)
        V_ISSUE(bufA, 0); V_ISSUE(bufB, 1);
#pragma unroll 1
        for (int hp = 0; hp < 3; ++hp) {
            V_ACC(bufA, 2 * hp); V_ISSUE(bufA, 2 * hp + 2);
            V_ACC(bufB, 2 * hp + 1); V_ISSUE(bufB, 2 * hp + 3);
        }
        V_ACC(bufA, 6); V_ACC(bufB, 7);
#undef V_ISSUE
#undef V_ACC
        float* xr = xres + (size_t)t * DM + lane * 16; float ss = 0.f; const float c128 = 128.f * corr;
#pragma unroll
        for (int j = 0; j < 4; ++j) { const f32x4 xv = *(const f32x4*)(xr + j * 4);
            acc[j * 4 + 0] += xv.x - c128; acc[j * 4 + 1] += xv.y - c128; acc[j * 4 + 2] += xv.z - c128; acc[j * 4 + 3] += xv.w - c128; }
#pragma unroll
        for (int i = 0; i < 16; ++i) ss += acc[i] * acc[i];
        const float rstd = rsqrtf(wave_sum(ss) * (1.f / DM) + EPS);
#pragma unroll
        for (int j = 0; j < 4; ++j) { const int c = lane * 16 + j * 4; const f32x4 g = *(const f32x4*)(gn + c); const int a0 = j * 4;
            if (last) { *(f32x4*)(xr + j * 4) = (f32x4){acc[a0] * rstd * g.x, acc[a0 + 1] * rstd * g.y, acc[a0 + 2] * rstd * g.z, acc[a0 + 3] * rstd * g.w}; }
            else { *(f32x4*)(xr + j * 4) = (f32x4){acc[a0], acc[a0 + 1], acc[a0 + 2], acc[a0 + 3]};
                u32x2 ob; ob.x = pk2(acc[a0] * rstd * g.x, acc[a0 + 1] * rstd * g.y); ob.y = pk2(acc[a0 + 2] * rstd * g.z, acc[a0 + 3] * rstd * g.w); *(u32x2*)(hout + (size_t)t * DM + c) = ob; } }
    }
}


__device__ __forceinline__ void fma_ub4(float& a0, float& a1, float& a2, float& a3, unsigned a, float w) {
    float t0, t1;
    asm("v_cvt_f32_ubyte0 %4, %6\n\tv_cvt_f32_ubyte1 %5, %6\n\tv_fmac_f32 %0, %7, %4\n\tv_fmac_f32 %1, %7, %5\n\tv_cvt_f32_ubyte2 %4, %6\n\tv_cvt_f32_ubyte3 %5, %6\n\tv_fmac_f32 %2, %7, %4\n\tv_fmac_f32 %3, %7, %5"
        : "+v"(a0), "+v"(a1), "+v"(a2), "+v"(a3), "=&v"(t0), "=&v"(t1) : "v"(a), "s"(w));
}
__device__ __forceinline__ void ph_peer_v4(float* xres, const unsigned char* Vq, const float* sv, const int* eid, const float* wact, const float* gw, const float* su, const float* sh, const float* gn, bf16_t* hout, int last) {
    const int tid = opq_tid(), lane = tid & 63, wv = __builtin_amdgcn_readfirstlane(tid >> 6); const unsigned voff = (unsigned)lane * 16u;
    const int tstride = gridDim.x * NWAVE;
    int t = blockIdx.x * NWAVE + wv;
    const int ntok = (T - t + tstride - 1) / tstride;
    int tn = (t + tstride < T) ? t + tstride : t;
    int e_lo = eid[(size_t)t * NSLOT + lane], e_hi = eid[(size_t)t * NSLOT + 64 + lane];
    float c_lo, c_hi;
    { const float sht = sh[t]; c_lo = gw[(size_t)t * NSLOT + lane] * gelu_tanh(wact[(size_t)t * NSLOT + lane] * su[e_lo] * sht) * sv[e_lo];
      c_hi = gw[(size_t)t * NSLOT + 64 + lane] * gelu_tanh(wact[(size_t)t * NSLOT + 64 + lane] * su[e_hi] * sht) * sv[e_hi]; }
    u32x4 ring[32];
#define V_LOAD(slot, esrc, ln) do { const int e = __builtin_amdgcn_readlane(esrc, ln); const GAS char* row = (const GAS char*)Vq + (size_t)e * DM; asm("" : "+s"(row)); \
        unsigned vo = voff; asm("" : "+v"(vo)); ring[slot] = *(const GAS u32x4*)(row + vo); } while (0)
#pragma unroll
    for (int k = 0; k < 32; ++k) V_LOAD(k, e_lo, k);
    f32x4 xv[4];
#pragma unroll
    for (int j = 0; j < 4; ++j) xv[j] = *(const f32x4*)(xres + (size_t)t * DM + lane * 16 + j * 4);
    int ne_lo = eid[(size_t)tn * NSLOT + lane], ne_hi = eid[(size_t)tn * NSLOT + 64 + lane];
    float nw_lo = wact[(size_t)tn * NSLOT + lane], nw_hi = wact[(size_t)tn * NSLOT + 64 + lane], ng_lo = gw[(size_t)tn * NSLOT + lane], ng_hi = gw[(size_t)tn * NSLOT + 64 + lane], nsh = sh[tn];
    float nc_lo = 0.f, nc_hi = 0.f;
    float acc[16]; float corr = 0.f;
#pragma unroll
    for (int i = 0; i < 16; ++i) acc[i] = 0.f;
#pragma unroll 1
    for (int q = 0; q < 4 * ntok; ++q) {
        const int rr = q & 3;
        const int csrc = __builtin_bit_cast(int, (rr < 2) ? c_lo : c_hi), cbase = (rr & 1) * 32;
        const int esrc = (rr == 0) ? e_lo : ((rr < 3) ? e_hi : ne_lo), ebase = (rr & 1) ? 0 : 32;
        if (rr == 2) { nc_lo = ng_lo * gelu_tanh(nw_lo * su[ne_lo] * nsh) * sv[ne_lo]; nc_hi = ng_hi * gelu_tanh(nw_hi * su[ne_hi] * nsh) * sv[ne_hi]; }
#pragma unroll
        for (int k = 0; k < 32; ++k) {
            const float w = __builtin_bit_cast(float, __builtin_amdgcn_readlane(csrc, cbase + k));
            const u32x4 a = ring[k]; corr += w;
            fma_ub4(acc[0], acc[1], acc[2], acc[3], a.x, w); fma_ub4(acc[4], acc[5], acc[6], acc[7], a.y, w); fma_ub4(acc[8], acc[9], acc[10], acc[11], a.z, w); fma_ub4(acc[12], acc[13], acc[14], acc[15], a.w, w);
            V_LOAD(k, esrc, ebase + k);
        }
        if (rr == 3) {
            float* xr = xres + (size_t)t * DM + lane * 16;
            float ss = 0.f; const float c128 = 128.f * corr;
#pragma unroll
            for (int j = 0; j < 4; ++j) { acc[j * 4 + 0] += xv[j].x - c128; acc[j * 4 + 1] += xv[j].y - c128; acc[j * 4 + 2] += xv[j].z - c128; acc[j * 4 + 3] += xv[j].w - c128; }
#pragma unroll
            for (int i = 0; i < 16; ++i) ss += acc[i] * acc[i];
            const float rstd = rsqrtf(wave_sum(ss) * (1.f / DM) + EPS);
#pragma unroll
            for (int j = 0; j < 4; ++j) { const int c = lane * 16 + j * 4; const f32x4 g = *(const f32x4*)(gn + c); const int a0 = j * 4;
                if (last) { *(f32x4*)(xr + j * 4) = (f32x4){acc[a0] * rstd * g.x, acc[a0 + 1] * rstd * g.y, acc[a0 + 2] * rstd * g.z, acc[a0 + 3] * rstd * g.w}; }
                else { *(f32x4*)(xr + j * 4) = (f32x4){acc[a0], acc[a0 + 1], acc[a0 + 2], acc[a0 + 3]};
                    u32x2 ob; ob.x = pk2(acc[a0] * rstd * g.x, acc[a0 + 1] * rstd * g.y); ob.y = pk2(acc[a0 + 2] * rstd * g.z, acc[a0 + 3] * rstd * g.w); *(u32x2*)(hout + (size_t)t * DM + c) = ob; } }
            t = tn; tn = (t + tstride < T) ? t + tstride : t;
            e_lo = ne_lo; e_hi = ne_hi; c_lo = nc_lo; c_hi = nc_hi; corr = 0.f;
#pragma unroll
            for (int i = 0; i < 16; ++i) acc[i] = 0.f;
#pragma unroll
            for (int j = 0; j < 4; ++j) xv[j] = *(const f32x4*)(xres + (size_t)t * DM + lane * 16 + j * 4);
            ne_lo = eid[(size_t)tn * NSLOT + lane]; ne_hi = eid[(size_t)tn * NSLOT + 64 + lane];
            nw_lo = wact[(size_t)tn * NSLOT + lane]; nw_hi = wact[(size_t)tn * NSLOT + 64 + lane]; ng_lo = gw[(size_t)tn * NSLOT + lane]; ng_hi = gw[(size_t)tn * NSLOT + 64 + lane]; nsh = sh[tn];
        }
    }
#undef V_LOAD
}


__device__ __forceinline__ void ph_peer_u5(const unsigned char* hq, const float* sh, const unsigned char* Uq, const float* su, const int* eid, const float* gw, const int* offs, float* wact) {
    const int tid = opq_tid(), lane = tid & 63, wv = __builtin_amdgcn_readfirstlane(tid >> 6); const unsigned voff = (unsigned)lane * 16u;
    for (int task = blockIdx.x * NWAVE + wv; task < T / 8; task += gridDim.x * NWAVE) {
        int es_lo[8], es_hi[8], offv[8]; float g_lo[8], g_hi[8], sc_lo[8], sc_hi[8]; u32x4 h4[8];
#pragma unroll
        for (int j = 0; j < 8; ++j) { const size_t t = (size_t)task * 8 + j;
            es_lo[j] = eid[t * NSLOT + lane]; es_hi[j] = eid[t * NSLOT + 64 + lane]; g_lo[j] = gw[t * NSLOT + lane]; g_hi[j] = gw[t * NSLOT + 64 + lane];
            h4[j] = *(const u32x4*)(hq + t * DM + lane * 16); offv[j] = offs[t * 16 + (lane & 15)]; }
#pragma unroll
        for (int j = 0; j < 8; ++j) { const float sht = sh[(size_t)task * 8 + j]; sc_lo[j] = su[es_lo[j]] * sht; sc_hi[j] = su[es_hi[j]] * sht; }
#pragma unroll 1
        for (int r = 0; r < 8; ++r) {
#pragma unroll
            for (int j = 0; j < 8; ++j) {
                const int p0 = __builtin_amdgcn_readlane(offv[j], r), p1 = __builtin_amdgcn_readlane(offv[j], r + 1);
#pragma unroll 1
                for (int base = p0; base < p1; base += 16) {
                    u32x4 buf[16];
#pragma unroll
                    for (int k = 0; k < 16; ++k) { const int p = base + k; buf[k] = (u32x4){0u, 0u, 0u, 0u};
                        if (p < p1) { const int e = __builtin_amdgcn_readlane((p < 64) ? es_lo[j] : es_hi[j], p & 63); const GAS char* row = (const GAS char*)Uq + (size_t)e * DM; asm("" : "+s"(row));
                            unsigned vo = voff; asm("" : "+v"(vo)); buf[k] = *(const GAS u32x4*)(row + vo); } }
                    float part[16];
#pragma unroll
                    for (int k = 0; k < 16; ++k) part[k] = (float)dot16i(buf[k], h4[j]);
                    float r8[8], r4[4], r2[2], r1;
#pragma unroll
                    for (int k = 0; k < 8; ++k) { const bool up = lane & 32; const float keep = up ? part[k + 8] : part[k], send = up ? part[k] : part[k + 8]; r8[k] = keep + __shfl_xor(send, 32); }
#pragma unroll
                    for (int k = 0; k < 4; ++k) { const bool up = lane & 16; const float keep = up ? r8[k + 4] : r8[k], send = up ? r8[k] : r8[k + 4]; r4[k] = keep + __shfl_xor(send, 16); }
#pragma unroll
                    for (int k = 0; k < 2; ++k) { const bool up = lane & 8; const float keep = up ? r4[k + 2] : r4[k], send = up ? r4[k] : r4[k + 2]; r2[k] = keep + __shfl_xor(send, 8); }
                    { const bool up = lane & 4; const float keep = up ? r2[1] : r2[0], send = up ? r2[0] : r2[1]; r1 = keep + __shfl_xor(send, 4); }
                    r1 += __shfl_xor(r1, 2); r1 += __shfl_xor(r1, 1);
                    const int pp = base + (lane >> 2);
                    const float s0 = __shfl(sc_lo[j], pp & 63), s1 = __shfl(sc_hi[j], pp & 63), q0 = __shfl(g_lo[j], pp & 63), q1 = __shfl(g_hi[j], pp & 63);
                    const float scl = (pp < 64) ? s0 : s1, gg = (pp < 64) ? q0 : q1;
                    if ((lane & 3) == 0 && pp < p1) wact[((size_t)task * 8 + j) * NSLOT + pp] = gg * gelu_tanh(r1 * scl);
                }
            }
        }
    }
}
__device__ __forceinline__ void ph_peer_v6(float* xres, const unsigned char* Vq, const float* sv, const int* eid, const float* wact, const int* offs, const float* gn, bf16_t* hout, int last) {
    const int tid = opq_tid(), lane = tid & 63, wv = __builtin_amdgcn_readfirstlane(tid >> 6); const unsigned voff = (unsigned)lane * 16u;
    for (int task = blockIdx.x * NWAVE + wv; task < T / 4; task += gridDim.x * NWAVE) {
        int es_lo[4], es_hi[4], offv[4]; float c_lo[4], c_hi[4];
#pragma unroll
        for (int j = 0; j < 4; ++j) { const size_t t = (size_t)task * 4 + j;
            es_lo[j] = eid[t * NSLOT + lane]; es_hi[j] = eid[t * NSLOT + 64 + lane]; c_lo[j] = wact[t * NSLOT + lane]; c_hi[j] = wact[t * NSLOT + 64 + lane]; offv[j] = offs[t * 16 + (lane & 15)]; }
#pragma unroll
        for (int j = 0; j < 4; ++j) { c_lo[j] *= sv[es_lo[j]]; c_hi[j] *= sv[es_hi[j]]; }
        float acc[4][16], corr[4];
#pragma unroll
        for (int j = 0; j < 4; ++j) { corr[j] = 0.f;
#pragma unroll
            for (int i = 0; i < 16; ++i) acc[j][i] = 0.f; }
#pragma unroll 1
        for (int r = 0; r < 8; ++r) {
#pragma unroll
            for (int j = 0; j < 4; ++j) {
                const int p0 = __builtin_amdgcn_readlane(offv[j], r), p1 = __builtin_amdgcn_readlane(offv[j], r + 1);
#pragma unroll 1
                for (int base = p0; base < p1; base += 16) {
                    u32x4 buf[16];
#pragma unroll
                    for (int k = 0; k < 16; ++k) { const int p = base + k; buf[k] = (u32x4){0u, 0u, 0u, 0u};
                        if (p < p1) { const int e = __builtin_amdgcn_readlane((p < 64) ? es_lo[j] : es_hi[j], p & 63); const GAS char* row = (const GAS char*)Vq + (size_t)e * DM; asm("" : "+s"(row));
                            unsigned vo = voff; asm("" : "+v"(vo)); buf[k] = *(const GAS u32x4*)(row + vo); } }
#pragma unroll
                    for (int k = 0; k < 16; ++k) { const int p = base + k; const int pc = (p < NSLOT) ? p : NSLOT - 1;
                        float w = __builtin_bit_cast(float, __builtin_amdgcn_readlane(__builtin_bit_cast(int, (pc < 64) ? c_lo[j] : c_hi[j]), pc & 63)); w = (p < p1) ? w : 0.f;
                        corr[j] += w; const u32x4 a = buf[k];
                        fma_ub4(acc[j][0], acc[j][1], acc[j][2], acc[j][3], a.x, w); fma_ub4(acc[j][4], acc[j][5], acc[j][6], acc[j][7], a.y, w);
                        fma_ub4(acc[j][8], acc[j][9], acc[j][10], acc[j][11], a.z, w); fma_ub4(acc[j][12], acc[j][13], acc[j][14], acc[j][15], a.w, w); }
                }
            }
        }
#pragma unroll
        for (int j = 0; j < 4; ++j) {
            const size_t t = (size_t)task * 4 + j; float* xr = xres + t * DM + lane * 16; float ss = 0.f; const float c128 = 128.f * corr[j];
#pragma unroll
            for (int q = 0; q < 4; ++q) { const f32x4 xv = *(const f32x4*)(xr + q * 4);
                acc[j][q * 4 + 0] += xv.x - c128; acc[j][q * 4 + 1] += xv.y - c128; acc[j][q * 4 + 2] += xv.z - c128; acc[j][q * 4 + 3] += xv.w - c128; }
#pragma unroll
            for (int i = 0; i < 16; ++i) ss += acc[j][i] * acc[j][i];
            const float rstd = rsqrtf(wave_sum(ss) * (1.f / DM) + EPS);
#pragma unroll
            for (int q = 0; q < 4; ++q) { const int c = lane * 16 + q * 4; const f32x4 g = *(const f32x4*)(gn + c); const int a0 = q * 4;
                if (last) { *(f32x4*)(xr + q * 4) = (f32x4){acc[j][a0] * rstd * g.x, acc[j][a0 + 1] * rstd * g.y, acc[j][a0 + 2] * rstd * g.z, acc[j][a0 + 3] * rstd * g.w}; }
                else { *(f32x4*)(xr + q * 4) = (f32x4){acc[j][a0], acc[j][a0 + 1], acc[j][a0 + 2], acc[j][a0 + 3]};
                    u32x2 ob; ob.x = pk2(acc[j][a0] * rstd * g.x, acc[j][a0 + 1] * rstd * g.y); ob.y = pk2(acc[j][a0 + 2] * rstd * g.z, acc[j][a0 + 3] * rstd * g.w); *(u32x2*)(hout + t * DM + c) = ob; } }
        }
    }
}


constexpr int US_LDS = 12288;
__device__ __forceinline__ void ph_peer_u6(unsigned char* lds_, const bf16_t* xg, const float* gf, const float* rowsq, const unsigned char* Uq, const int* eid, const int* offs, float* dots, const int task) {
    const int tid = opq_tid(), lane = tid & 63, wv = __builtin_amdgcn_readfirstlane(tid >> 6); const unsigned voff = (unsigned)lane * 16u;
    LAS unsigned char* hqL = (LAS unsigned char*)lds_ + wv * (64 * TK_ROW * 4); LAS unsigned* sched = (LAS unsigned*)(hqL + 8192); LAS float* shL = (LAS float*)(hqL + 12288);
    {
        int es_lo[8], es_hi[8], offv[8]; float gv[16];
#pragma unroll
        for (int i = 0; i < 4; ++i) { const f32x4 g4 = *(const f32x4*)(gf + lane * 16 + i * 4); gv[i * 4] = g4.x; gv[i * 4 + 1] = g4.y; gv[i * 4 + 2] = g4.z; gv[i * 4 + 3] = g4.w; }
#pragma unroll
        for (int j = 0; j < 8; ++j) { const size_t t = (size_t)task * 8 + j;
            es_lo[j] = ldcg(eid + t * NSLOT + lane); es_hi[j] = ldcg(eid + t * NSLOT + 64 + lane); offv[j] = ldcg(offs + t * 16 + (lane & 15));
            const u32x4 xa = *(const u32x4*)(xg + t * DM + lane * 16), xb = *(const u32x4*)(xg + t * DM + lane * 16 + 8); const float rstd = rstd_of(rowsq, t);
            float hv[16] = {lo16(xa.x), hi16(xa.x), lo16(xa.y), hi16(xa.y), lo16(xa.z), hi16(xa.z), lo16(xa.w), hi16(xa.w), lo16(xb.x), hi16(xb.x), lo16(xb.y), hi16(xb.y), lo16(xb.z), hi16(xb.z), lo16(xb.w), hi16(xb.w)};
            float am = 0.f;
#pragma unroll
            for (int i = 0; i < 16; ++i) { hv[i] *= rstd * gv[i]; am = fmaxf(am, fabsf(hv[i])); }
            am = wave_max(am); const float inv = am > 0.f ? 127.f / am : 0.f;
            u32x4 hq4;
            hq4.x = q8(hv[0], inv, 0) | (q8(hv[1], inv, 0) << 8) | (q8(hv[2], inv, 0) << 16) | (q8(hv[3], inv, 0) << 24); hq4.y = q8(hv[4], inv, 0) | (q8(hv[5], inv, 0) << 8) | (q8(hv[6], inv, 0) << 16) | (q8(hv[7], inv, 0) << 24);
            hq4.z = q8(hv[8], inv, 0) | (q8(hv[9], inv, 0) << 8) | (q8(hv[10], inv, 0) << 16) | (q8(hv[11], inv, 0) << 24); hq4.w = q8(hv[12], inv, 0) | (q8(hv[13], inv, 0) << 8) | (q8(hv[14], inv, 0) << 16) | (q8(hv[15], inv, 0) << 24);
            *(LAS u32x4*)(hqL + j * 1024 + lane * 16) = hq4; if (lane == 0) shL[j] = am * (1.f / 127.f); }
        int ncell = 0;
#pragma unroll
        for (int j = 0; j < 8; ++j) { const int v = __shfl(offv[j], (lane >> 3) + 1) - __shfl(offv[j], lane >> 3); if ((lane & 7) == j) ncell = v; }
        int scan = ncell;
#pragma unroll
        for (int o = 1; o < 64; o <<= 1) { const int u = __shfl_up(scan, o); if (lane >= o) scan += u; }
        const int sexc = scan - ncell;
#pragma unroll
        for (int j = 0; j < 8; ++j) {
            const int r0 = es_lo[j] >> 11, r1 = es_hi[j] >> 11;
            const int i0 = __shfl(sexc, r0 * 8 + j) + lane - __shfl(offv[j], r0), i1 = __shfl(sexc, r1 * 8 + j) + 64 + lane - __shfl(offv[j], r1);
            sched[i0] = (unsigned)es_lo[j] | ((unsigned)j << 14) | ((unsigned)lane << 17); sched[i1] = (unsigned)es_hi[j] | ((unsigned)j << 14) | ((unsigned)(64 + lane) << 17);
        }
        u32x4 bufA[16], bufB[16]; unsigned entA, entB;
#define US_ISSUE(buf, ent, s_) do { ent = sched[(s_) * 16 + (lane & 15)]; unsigned vo = voff; asm("" : "+v"(vo)); _Pragma("unroll") for (int k = 0; k < 16; ++k) { \
            const unsigned e = (unsigned)__builtin_amdgcn_readlane((int)ent, k) & 16383u; const GAS char* row = (const GAS char*)Uq + (size_t)e * DM; asm("" : "+s"(row)); buf[k] = *(const GAS u32x4*)(row + vo); } } while (0)
#define US_CONS(buf, ent) do { float part[16]; _Pragma("unroll") for (int k = 0; k < 16; ++k) { const unsigned jj = ((unsigned)__builtin_amdgcn_readlane((int)ent, k) >> 14) & 7u; \
                const u32x4 hrow = *(const LAS u32x4*)(hqL + jj * 1024 + lane * 16); part[k] = (float)dot16i(buf[k], hrow); } \
            float r8[8], r4[4], r2[2], r1; \
            _Pragma("unroll") for (int k = 0; k < 8; ++k) { const bool up = lane & 32; const float keep = up ? part[k + 8] : part[k], send = up ? part[k] : part[k + 8]; r8[k] = keep + __shfl_xor(send, 32); } \
            _Pragma("unroll") for (int k = 0; k < 4; ++k) { const bool up = lane & 16; const float keep = up ? r8[k + 4] : r8[k], send = up ? r8[k] : r8[k + 4]; r4[k] = keep + __shfl_xor(send, 16); } \
            _Pragma("unroll") for (int k = 0; k < 2; ++k) { const bool up = lane & 8; const float keep = up ? r4[k + 2] : r4[k], send = up ? r4[k] : r4[k + 2]; r2[k] = keep + __shfl_xor(send, 8); } \
            { const bool up = lane & 4; const float keep = up ? r2[1] : r2[0], send = up ? r2[0] : r2[1]; r1 = keep + __shfl_xor(send, 4); } \
            r1 += __shfl_xor(r1, 2); r1 += __shfl_xor(r1, 1); \
            const unsigned me = (unsigned)__shfl((int)ent, lane >> 2); \
            if ((lane & 3) == 0) dots[(((size_t)task * 8 + ((me >> 14) & 7u)) << 7) + (me >> 17)] = r1 * shL[(me >> 14) & 7u]; } while (0)
        US_ISSUE(bufA, entA, 0); US_ISSUE(bufB, entB, 1);
#pragma unroll 1
        for (int s = 0; s < 62; s += 2) {
            US_CONS(bufA, entA); US_ISSUE(bufA, entA, s + 2);
            US_CONS(bufB, entB); US_ISSUE(bufB, entB, s + 3);
        }
        US_CONS(bufA, entA); US_CONS(bufB, entB);
#undef US_ISSUE
#undef US_CONS
    }
}


__device__ __forceinline__ void fma_ub4v(float& a0, float& a1, float& a2, float& a3, unsigned a, float w) {
    float t0, t1;
    asm("v_cvt_f32_ubyte0 %4, %6\n\tv_cvt_f32_ubyte1 %5, %6\n\tv_fmac_f32 %0, %7, %4\n\tv_fmac_f32 %1, %7, %5\n\tv_cvt_f32_ubyte2 %4, %6\n\tv_cvt_f32_ubyte3 %5, %6\n\tv_fmac_f32 %2, %7, %4\n\tv_fmac_f32 %3, %7, %5"
        : "+v"(a0), "+v"(a1), "+v"(a2), "+v"(a3), "=&v"(t0), "=&v"(t1) : "v"(a), "v"(w));
}
constexpr int VS_LDS = 16384 + 256;
template <int MODE> __device__ __forceinline__ void ph_peer_v7(unsigned char* lds_, float* xres, const unsigned char* Vq, const float* sv, const int* eid, const float* dots, const float* gw, const float* su, const float* sh,
                                           const int* offs, const float* gn, bf16_t* hout, int last) {
    const int tid = opq_tid(), lane = tid & 63, wv = __builtin_amdgcn_readfirstlane(tid >> 6); const int j = lane >> 4, li = lane & 15;
    LAS int* slotE = (LAS int*)((LAS unsigned char*)lds_ + wv * VS_LDS); LAS float* slotC = (LAS float*)(slotE + 2048);
    for (int task = blockIdx.x * NWAVE + wv; task < T / 4; task += gridDim.x * NWAVE) {
        int nmax = 0, sexc;
        int offq[4];
#pragma unroll
        for (int q = 0; q < 4; ++q) { offq[q] = offs[((size_t)task * 4 + q) * 16 + (lane & 15)]; const int n = __shfl(offq[q], (lane & 15) + 1) - offq[q]; nmax = (n > nmax) ? n : nmax; }
        nmax = (lane < 8) ? nmax : 0;
        { int sc = nmax;
#pragma unroll
          for (int o = 1; o < 8; o <<= 1) { const int u = __shfl_up(sc, o); if (lane >= o) sc += u; }
          sexc = sc - nmax; }
        const int total = __builtin_amdgcn_readlane(sexc, 7) + __builtin_amdgcn_readlane(nmax, 7);
        for (int i = lane; i < total * 4; i += 64) { slotE[i] = -1; slotC[i] = 0.f; }
#pragma unroll
        for (int q = 0; q < 4; ++q) { const size_t t = (size_t)task * 4 + q; const float sht = sh[t];
#pragma unroll
            for (int hf = 0; hf < 2; ++hf) { const int p = hf * 64 + lane; const int e = eid[t * NSLOT + p]; const float c = gw[t * NSLOT + p] * gelu_tanh(dots[t * NSLOT + p] * su[e] * sht) * sv[e];
                const int r = e >> 11; const int s = __shfl(sexc, r) + p - __shfl(offq[q], r); slotE[s * 4 + q] = e; slotC[s * 4 + q] = c; } }
        float acc[64]; float corr = 0.f;
#pragma unroll
        for (int i = 0; i < 64; ++i) acc[i] = 0.f;
        constexpr int RING = 6; u32x4 ring[RING][4]; float cR[RING];
#define VS_ISSUE(u_, s_) do { const int s__ = (s_); int e = -1; float c = 0.f; if (s__ < total) { e = slotE[s__ * 4 + j]; c = slotC[s__ * 4 + j]; } cR[u_] = c; \
            if (e >= 0) { const u32x4* rp = (const u32x4*)(Vq + (size_t)(MODE == 2 ? (e & 2047) : e) * DM) + li; ring[u_][0] = rp[0]; ring[u_][1] = rp[16]; ring[u_][2] = rp[32]; ring[u_][3] = rp[48]; } } while (0)
#define VS_CONS(u_) do { const float w = cR[u_]; corr += w; if (MODE >= 1) { acc[0] += w * __uint_as_float((ring[u_][0].x ^ ring[u_][1].y ^ ring[u_][2].z ^ ring[u_][3].w) & 0x3f800000u); } else _Pragma("unroll") for (int m = 0; m < 4; ++m) { const u32x4 a = ring[u_][m]; \
            fma_ub4v(acc[m * 16 + 0], acc[m * 16 + 1], acc[m * 16 + 2], acc[m * 16 + 3], a.x, w); fma_ub4v(acc[m * 16 + 4], acc[m * 16 + 5], acc[m * 16 + 6], acc[m * 16 + 7], a.y, w); \
            fma_ub4v(acc[m * 16 + 8], acc[m * 16 + 9], acc[m * 16 + 10], acc[m * 16 + 11], a.z, w); fma_ub4v(acc[m * 16 + 12], acc[m * 16 + 13], acc[m * 16 + 14], acc[m * 16 + 15], a.w, w); } } while (0)
#pragma unroll
        for (int u = 0; u < RING; ++u) {
#pragma unroll
            for (int m = 0; m < 4; ++m) ring[u][m] = (u32x4){0u, 0u, 0u, 0u};
            VS_ISSUE(u, u); }
#pragma unroll 1
        for (int base = 0; base < total; base += RING) {
#pragma unroll
            for (int u = 0; u < RING; ++u) { VS_CONS(u); VS_ISSUE(u, base + RING + u); }
        }
#undef VS_ISSUE
#undef VS_CONS
        const size_t t = (size_t)task * 4 + j; float* xr = xres + t * DM + li * 16; float ss = 0.f; const float c128 = 128.f * corr;
#pragma unroll
        for (int m = 0; m < 4; ++m)
#pragma unroll
            for (int q = 0; q < 4; ++q) { const f32x4 xv = *(const f32x4*)(xr + m * 256 + q * 4); const int a0 = m * 16 + q * 4;
                acc[a0] += xv.x - c128; acc[a0 + 1] += xv.y - c128; acc[a0 + 2] += xv.z - c128; acc[a0 + 3] += xv.w - c128; }
#pragma unroll
        for (int i = 0; i < 64; ++i) ss += acc[i] * acc[i];
        ss += __shfl_xor(ss, 1); ss += __shfl_xor(ss, 2); ss += __shfl_xor(ss, 4); ss += __shfl_xor(ss, 8);
        const float rstd = rsqrtf(ss * (1.f / DM) + EPS);
#pragma unroll
        for (int m = 0; m < 4; ++m)
#pragma unroll
            for (int q = 0; q < 4; ++q) { const int c = m * 256 + li * 16 + q * 4; const f32x4 g = *(const f32x4*)(gn + c); const int a0 = m * 16 + q * 4;
                if (last) { *(f32x4*)(xres + t * DM + c) = (f32x4){acc[a0] * rstd * g.x, acc[a0 + 1] * rstd * g.y, acc[a0 + 2] * rstd * g.z, acc[a0 + 3] * rstd * g.w}; }
                else { *(f32x4*)(xres + t * DM + c) = (f32x4){acc[a0], acc[a0 + 1], acc[a0 + 2], acc[a0 + 3]};
                    u32x2 ob; ob.x = pk2(acc[a0] * rstd * g.x, acc[a0 + 1] * rstd * g.y); ob.y = pk2(acc[a0 + 2] * rstd * g.z, acc[a0 + 3] * rstd * g.w); *(u32x2*)(hout + t * DM + c) = ob; } }
    }
}


constexpr int VS8_LDS = 4096;
template <int MODE> __device__ __forceinline__ void ph_peer_v8(unsigned char* lds_, float* xres, const unsigned char* Vq, const float* sv, const int* eid, const float* dots, const float* gw, const float* su, const float* sh,
                                           const int* offs, const float* gn, bf16_t* hout, int last) {
    const int tid = opq_tid(), lane = tid & 63, wv = __builtin_amdgcn_readfirstlane(tid >> 6); const unsigned voff = (unsigned)lane * 16u;
    LAS unsigned* sched = (LAS unsigned*)((LAS unsigned char*)lds_ + wv * VS8_LDS); LAS unsigned char* schedW = (LAS unsigned char*)(sched + 640);
    for (int task = blockIdx.x * NWAVE + wv; task < T / 4; task += gridDim.x * NWAVE) {
        int offq[4]; int npad = 0;
#pragma unroll
        for (int q = 0; q < 4; ++q) { offq[q] = offs[((size_t)task * 4 + q) * 16 + (lane & 15)]; const int n = __shfl(offq[q], (lane >> 2) + 1) - __shfl(offq[q], lane >> 2); if ((lane & 3) == q) npad = (n + 3) & ~3; }
        npad = (lane < 32) ? npad : 0;
        int sc_ = npad;
#pragma unroll
        for (int o = 1; o < 32; o <<= 1) { const int u = __shfl_up(sc_, o); if (lane >= o) sc_ += u; }
        const int sexc = sc_ - npad;
        const int slen = __builtin_amdgcn_readlane(sc_, 31), nst = (slen + 15) >> 4;
        for (int i = lane; i < 160; i += 64) { ((LAS u32x4*)sched)[i] = (u32x4){0u, 0u, 0u, 0u}; }
        for (int i = lane; i < 40; i += 64) { ((LAS u32x4*)schedW)[i] = (u32x4){0u, 0u, 0u, 0u}; }
        float tsc[4];
#pragma unroll
        for (int q = 0; q < 4; ++q) { const size_t t = (size_t)task * 4 + q; const float sht = sh[t];
            const int e0 = eid[t * NSLOT + lane], e1 = eid[t * NSLOT + 64 + lane];
            const float c0 = gw[t * NSLOT + lane] * gelu_tanh(dots[t * NSLOT + lane] * su[e0] * sht) * sv[e0], c1 = gw[t * NSLOT + 64 + lane] * gelu_tanh(dots[t * NSLOT + 64 + lane] * su[e1] * sht) * sv[e1];
            const float am = wave_max(fmaxf(fabsf(c0), fabsf(c1))); const float inv = am > 0.f ? 127.f / am : 0.f; tsc[q] = am * (1.f / 127.f);
            const int r0 = e0 >> 11, r1 = e1 >> 11;
            const int i0 = __shfl(sexc, r0 * 4 + q) + lane - __shfl(offq[q], r0), i1 = __shfl(sexc, r1 * 4 + q) + 64 + lane - __shfl(offq[q], r1);
            sched[i0] = (unsigned)e0 | ((unsigned)q << 14); sched[i1] = (unsigned)e1 | ((unsigned)q << 14);
            schedW[i0] = (unsigned char)((int)__builtin_rintf(c0 * inv) & 255); schedW[i1] = (unsigned char)((int)__builtin_rintf(c1 * inv) & 255); }
        int acc[4][16];
#pragma unroll
        for (int q = 0; q < 4; ++q)
#pragma unroll
            for (int i = 0; i < 16; ++i) acc[q][i] = 0;
        u32x4 bufA[8], bufB[8], bufC[8]; unsigned entA, entB, entC, wqA, wqB, wqC;
#define V8_ISSUE(buf, ent, wq, s_) do { ent = sched[(s_) * 8 + (lane & 7)]; wq = ((LAS unsigned*)schedW)[(s_) * 2 + (lane & 1)]; unsigned vo = voff; asm("" : "+v"(vo)); _Pragma("unroll") for (int k = 0; k < 8; ++k) { \
            const unsigned e = (unsigned)__builtin_amdgcn_readlane((int)ent, k) & 16383u; const GAS char* row = (const GAS char*)Vq + (size_t)e * DM; asm("" : "+s"(row)); buf[k] = *(const GAS u32x4*)(row + vo); } } while (0)
#define V8_CONS(buf, ent, wq) do { if (MODE == 1) { _Pragma("unroll") for (int k = 0; k < 8; ++k) acc[0][k] ^= (int)(buf[k].x ^ buf[k].y ^ buf[k].z ^ buf[k].w) & (int)wq; } else _Pragma("unroll") for (int g = 0; g < 2; ++g) { \
            const unsigned jg = ((unsigned)__builtin_amdgcn_readlane((int)ent, 4 * g) >> 14) & 3u; const int wg = __builtin_amdgcn_readlane((int)wq, g); \
            const int w0 = (jg == 0u) ? wg : 0, w1 = (jg == 1u) ? wg : 0, w2 = (jg == 2u) ? wg : 0, w3 = (jg == 3u) ? wg : 0;        \
            _Pragma("unroll") for (int xi = 0; xi < 4; ++xi) { const unsigned ra = buf[4 * g][xi], rb = buf[4 * g + 1][xi], rc = buf[4 * g + 2][xi], rd = buf[4 * g + 3][xi]; \
                const unsigned t0 = __builtin_amdgcn_perm(rb, ra, 0x05010400u), t1 = __builtin_amdgcn_perm(rb, ra, 0x07030602u), t2 = __builtin_amdgcn_perm(rd, rc, 0x05010400u), t3 = __builtin_amdgcn_perm(rd, rc, 0x07030602u); \
                const int o0 = (int)__builtin_amdgcn_perm(t2, t0, 0x05040100u), o1 = (int)__builtin_amdgcn_perm(t2, t0, 0x07060302u), o2 = (int)__builtin_amdgcn_perm(t3, t1, 0x05040100u), o3 = (int)__builtin_amdgcn_perm(t3, t1, 0x07060302u); \
                acc[0][4 * xi] = __builtin_amdgcn_sdot4(o0, w0, acc[0][4 * xi], false); acc[0][4 * xi + 1] = __builtin_amdgcn_sdot4(o1, w0, acc[0][4 * xi + 1], false); acc[0][4 * xi + 2] = __builtin_amdgcn_sdot4(o2, w0, acc[0][4 * xi + 2], false); acc[0][4 * xi + 3] = __builtin_amdgcn_sdot4(o3, w0, acc[0][4 * xi + 3], false); \
                acc[1][4 * xi] = __builtin_amdgcn_sdot4(o0, w1, acc[1][4 * xi], false); acc[1][4 * xi + 1] = __builtin_amdgcn_sdot4(o1, w1, acc[1][4 * xi + 1], false); acc[1][4 * xi + 2] = __builtin_amdgcn_sdot4(o2, w1, acc[1][4 * xi + 2], false); acc[1][4 * xi + 3] = __builtin_amdgcn_sdot4(o3, w1, acc[1][4 * xi + 3], false); \
                acc[2][4 * xi] = __builtin_amdgcn_sdot4(o0, w2, acc[2][4 * xi], false); acc[2][4 * xi + 1] = __builtin_amdgcn_sdot4(o1, w2, acc[2][4 * xi + 1], false); acc[2][4 * xi + 2] = __builtin_amdgcn_sdot4(o2, w2, acc[2][4 * xi + 2], false); acc[2][4 * xi + 3] = __builtin_amdgcn_sdot4(o3, w2, acc[2][4 * xi + 3], false); \
                acc[3][4 * xi] = __builtin_amdgcn_sdot4(o0, w3, acc[3][4 * xi], false); acc[3][4 * xi + 1] = __builtin_amdgcn_sdot4(o1, w3, acc[3][4 * xi + 1], false); acc[3][4 * xi + 2] = __builtin_amdgcn_sdot4(o2, w3, acc[3][4 * xi + 2], false); acc[3][4 * xi + 3] = __builtin_amdgcn_sdot4(o3, w3, acc[3][4 * xi + 3], false); } } } while (0)
        const int nst8 = (slen + 7) >> 3;
        V8_ISSUE(bufA, entA, wqA, 0); V8_ISSUE(bufB, entB, wqB, 1); V8_ISSUE(bufC, entC, wqC, 2);
#pragma unroll 1
        for (int s = 0; s < ((MODE == 2) ? 3 : nst8); s += 3) {
            V8_CONS(bufA, entA, wqA); V8_ISSUE(bufA, entA, wqA, (s + 3 < 80) ? s + 3 : 79);
            V8_CONS(bufB, entB, wqB); V8_ISSUE(bufB, entB, wqB, (s + 4 < 80) ? s + 4 : 79);
            V8_CONS(bufC, entC, wqC); V8_ISSUE(bufC, entC, wqC, (s + 5 < 80) ? s + 5 : 79);
        }
#undef V8_ISSUE
#undef V8_CONS
        int task2 = task; asm volatile("" : "+s"(task2)); int lane2 = lane; asm volatile("" : "+v"(lane2));
#pragma unroll
        for (int q = 0; q < 4; ++q) {
            const size_t t = (size_t)task2 * 4 + q; float* xr = xres + t * DM + lane2 * 16; float ss = 0.f; float y[16];
#pragma unroll
            for (int c4 = 0; c4 < 4; ++c4) { const f32x4 xv = *(const f32x4*)(xr + c4 * 4);
                y[c4 * 4 + 0] = xv.x + tsc[q] * (float)acc[q][c4 * 4 + 0]; y[c4 * 4 + 1] = xv.y + tsc[q] * (float)acc[q][c4 * 4 + 1]; y[c4 * 4 + 2] = xv.z + tsc[q] * (float)acc[q][c4 * 4 + 2]; y[c4 * 4 + 3] = xv.w + tsc[q] * (float)acc[q][c4 * 4 + 3]; }
#pragma unroll
            for (int i = 0; i < 16; ++i) ss += y[i] * y[i];
            const float rstd = rsqrtf(wave_sum(ss) * (1.f / DM) + EPS);
#pragma unroll
            for (int c4 = 0; c4 < 4; ++c4) { const int c = lane2 * 16 + c4 * 4; const f32x4 g = *(const f32x4*)(gn + c); const int a0 = c4 * 4;
                if (last) { *(f32x4*)(xr + c4 * 4) = (f32x4){y[a0] * rstd * g.x, y[a0 + 1] * rstd * g.y, y[a0 + 2] * rstd * g.z, y[a0 + 3] * rstd * g.w}; }
                else { *(f32x4*)(xr + c4 * 4) = (f32x4){y[a0], y[a0 + 1], y[a0 + 2], y[a0 + 3]};
                    u32x2 ob; ob.x = pk2(y[a0] * rstd * g.x, y[a0 + 1] * rstd * g.y); ob.y = pk2(y[a0 + 2] * rstd * g.z, y[a0 + 3] * rstd * g.w); *(u32x2*)(hout + t * DM + c) = ob; } }
        }
    }
}


template <int MODE> __device__ __forceinline__ void ph_peer_v9(float* xout, bf16_t* xb, const unsigned char* Vq, const float* sv, const int* eid, const float* dots, const float* gw, const float* su,
                                                              const float* gn, bf16_t* hout, int last, const int task) {
    const int tid = opq_tid(), lane = tid & 63, wv = __builtin_amdgcn_readfirstlane(tid >> 6); const unsigned voff = (unsigned)lane * 16u;
    {
        int e_lo[4], e_hi[4]; unsigned cw[4]; float tsc[4]; float c0[4], c1[4];
#pragma unroll
        for (int q = 0; q < 4; ++q) { const size_t t = (size_t)task * 4 + q; e_lo[q] = ldcg(eid + t * NSLOT + lane); e_hi[q] = ldcg(eid + t * NSLOT + 64 + lane); c0[q] = ldcg(gw + t * NSLOT + lane); c1[q] = ldcg(gw + t * NSLOT + 64 + lane); }
#pragma unroll
        for (int q = 0; q < 4; ++q) { const size_t t = (size_t)task * 4 + q;
            c0[q] *= gelu_tanh(ldcg(dots + t * NSLOT + lane) * su[e_lo[q]]) * sv[e_lo[q]]; c1[q] *= gelu_tanh(ldcg(dots + t * NSLOT + 64 + lane) * su[e_hi[q]]) * sv[e_hi[q]]; }
#pragma unroll
        for (int q = 0; q < 4; ++q) {
            const float am = wave_max(fmaxf(fabsf(c0[q]), fabsf(c1[q]))); const float inv = am > 0.f ? 127.f / am : 0.f; tsc[q] = am * (1.f / 127.f);
            const unsigned b0 = (unsigned)((int)__builtin_rintf(c0[q] * inv) & 255), b1 = (unsigned)((int)__builtin_rintf(c1[q] * inv) & 255);
            const unsigned p0 = b0 | (__shfl_down(b0, 1) << 8) | (__shfl_down(b0, 2) << 16) | (__shfl_down(b0, 3) << 24), p1 = b1 | (__shfl_down(b1, 1) << 8) | (__shfl_down(b1, 2) << 16) | (__shfl_down(b1, 3) << 24);
            const unsigned g0 = __shfl(p0, (lane & 15) * 4), g1 = __shfl(p1, (lane & 15) * 4); cw[q] = (lane < 16) ? g0 : g1; }
        int acc[4][16];
#pragma unroll
        for (int q = 0; q < 4; ++q)
#pragma unroll
            for (int i = 0; i < 16; ++i) acc[q][i] = 0;
        u32x4 bufA[16], bufB[16];
#define V9_ISSUE(buf, s_) do { const int s__ = (s_); unsigned vo = voff; asm("" : "+v"(vo)); _Pragma("unroll") for (int q = 0; q < 4; ++q) { const int esrc = (s__ < 16) ? e_lo[q] : e_hi[q]; _Pragma("unroll") for (int k = 0; k < 4; ++k) { \
            const int e = __builtin_amdgcn_readlane(esrc, (4 * s__ + k) & 63); const GAS char* row = (const GAS char*)Vq + (size_t)e * DM; asm("" : "+s"(row)); buf[4 * q + k] = *(const GAS u32x4*)(row + vo); } } } while (0)
#define V9_CONS(buf, s_) do { if (MODE == 1) { _Pragma("unroll") for (int k = 0; k < 16; ++k) acc[0][k] ^= (int)(buf[k].x ^ buf[k].y ^ buf[k].z ^ buf[k].w); } else { _Pragma("unroll") for (int q = 0; q < 4; ++q) { const int wg = __builtin_amdgcn_readlane((int)cw[q], (s_)); \
            _Pragma("unroll") for (int xi = 0; xi < 4; ++xi) { const unsigned ra = buf[4 * q][xi], rb = buf[4 * q + 1][xi], rc = buf[4 * q + 2][xi], rd = buf[4 * q + 3][xi]; \
                const unsigned t0 = __builtin_amdgcn_perm(rb, ra, 0x05010400u), t1 = __builtin_amdgcn_perm(rb, ra, 0x07030602u), t2 = __builtin_amdgcn_perm(rd, rc, 0x05010400u), t3 = __builtin_amdgcn_perm(rd, rc, 0x07030602u); \
                acc[q][4 * xi] = __builtin_amdgcn_sdot4((int)__builtin_amdgcn_perm(t2, t0, 0x05040100u), wg, acc[q][4 * xi], false); acc[q][4 * xi + 1] = __builtin_amdgcn_sdot4((int)__builtin_amdgcn_perm(t2, t0, 0x07060302u), wg, acc[q][4 * xi + 1], false); \
                acc[q][4 * xi + 2] = __builtin_amdgcn_sdot4((int)__builtin_amdgcn_perm(t3, t1, 0x05040100u), wg, acc[q][4 * xi + 2], false); acc[q][4 * xi + 3] = __builtin_amdgcn_sdot4((int)__builtin_amdgcn_perm(t3, t1, 0x07060302u), wg, acc[q][4 * xi + 3], false); } } } } while (0)
        V9_ISSUE(bufA, 0); V9_ISSUE(bufB, 1);
#pragma unroll 1
        for (int s = 0; s < ((MODE == 2) ? 2 : 30); s += 2) {
            V9_CONS(bufA, s); V9_ISSUE(bufA, s + 2);
            V9_CONS(bufB, s + 1); V9_ISSUE(bufB, s + 3);
        }
        V9_CONS(bufA, 30); V9_CONS(bufB, 31);
#undef V9_ISSUE
#undef V9_CONS
        int task2 = task; asm volatile("" : "+s"(task2)); int lane2 = lane; asm volatile("" : "+v"(lane2));
        f32x4 xv[4][4];
#pragma unroll
        for (int q = 0; q < 4; ++q)
#pragma unroll
            for (int c4 = 0; c4 < 4; ++c4) { const u32x2 w = *(const u32x2*)(xb + ((size_t)task2 * 4 + q) * DM + lane2 * 16 + c4 * 4); xv[q][c4] = (f32x4){lo16(w.x), hi16(w.x), lo16(w.y), hi16(w.y)}; }
        float rstd[4];
#pragma unroll
        for (int q = 0; q < 4; ++q) { float ss = 0.f;
#pragma unroll
            for (int c4 = 0; c4 < 4; ++c4) { xv[q][c4].x += tsc[q] * (float)acc[q][c4 * 4 + 0]; xv[q][c4].y += tsc[q] * (float)acc[q][c4 * 4 + 1]; xv[q][c4].z += tsc[q] * (float)acc[q][c4 * 4 + 2]; xv[q][c4].w += tsc[q] * (float)acc[q][c4 * 4 + 3];
                ss += xv[q][c4].x * xv[q][c4].x + xv[q][c4].y * xv[q][c4].y + xv[q][c4].z * xv[q][c4].z + xv[q][c4].w * xv[q][c4].w; }
            rstd[q] = rsqrtf(wave_sum(ss) * (1.f / DM) + EPS); }
#pragma unroll
        for (int q = 0; q < 4; ++q) { const size_t t = (size_t)task2 * 4 + q;
#pragma unroll
            for (int c4 = 0; c4 < 4; ++c4) { const int c = lane2 * 16 + c4 * 4; const f32x4 g = *(const f32x4*)(gn + c); const f32x4 y = xv[q][c4];
                if (last) { *(f32x4*)(xout + t * DM + c) = (f32x4){y.x * rstd[q] * g.x, y.y * rstd[q] * g.y, y.z * rstd[q] * g.z, y.w * rstd[q] * g.w}; }
                else { u32x2 ox; ox.x = pk2(y.x, y.y); ox.y = pk2(y.z, y.w); *(u32x2*)(xb + t * DM + c) = ox;
                    u32x2 ob; ob.x = pk2(y.x * rstd[q] * g.x, y.y * rstd[q] * g.y); ob.y = pk2(y.z * rstd[q] * g.z, y.w * rstd[q] * g.w); *(u32x2*)(hout + t * DM + c) = ob; } } }
    }
}


__device__ __forceinline__ void ph_peer_all(unsigned char* lds_, const short* scores, int* eid, float* gw, int* offs, float* dots, const bf16_t* xg, const float* gf, const float* rowsq, const unsigned char* Uq, const float* su,
                                            const unsigned char* Vq, const float* sv, float* xres, bf16_t* xb, const float* gn, bf16_t* hout, int last, const float* qsrc_u, const float* qsrc_v, unsigned char* qdst, float* qsc) {
    const int wv0 = __builtin_amdgcn_readfirstlane((int)(threadIdx.x >> 6));
    for (int task = blockIdx.x * NWAVE + wv0; task < T / 8; task += gridDim.x * NWAVE) {
        if (qsrc_u && wv0 >= 4) {
            const int widx = blockIdx.x * 4 + (wv0 - 4), nw = gridDim.x * 4;
            ph_quant_rows_w(qsrc_u + (size_t)NEXP * DM, qdst + (size_t)NEXP * DM, qsc, (NL - 1) * NEXP, 0, widx, nw);
            ph_quant_rows_w(qsrc_v + (size_t)NEXP * DM, qdst + (size_t)32 * MiB + (size_t)NEXP * DM, qsc + (1 * MiB / 4), (NL - 1) * NEXP, 0, widx, nw); }
        if (wv0 < 4) __builtin_amdgcn_s_setprio(3);
        ph_topk(lds_, scores, eid, gw, offs, task);
        __builtin_amdgcn_s_setprio(0);
        asm volatile("s_waitcnt vmcnt(0)" ::: "memory");
        ph_peer_u6(lds_, xg, gf, rowsq, Uq, eid, offs, dots, task);
        asm volatile("s_waitcnt vmcnt(0)" ::: "memory");
        ph_peer_v9<0>(xres, xb, Vq, sv, eid, dots, gw, su, gn, hout, last, 2 * task);
        ph_peer_v9<0>(xres, xb, Vq, sv, eid, dots, gw, su, gn, hout, last, 2 * task + 1);
    }
}

typedef GAS unsigned gu32;
#define XB_TMO      128
#define XB_XCNT(j)  (256  + 64 * (j))
#define XB_XSUB(j)  (1280 + 64 * (j))
#define XB_XGEN(j)  (2304 + 64 * (j))
#define XB_TOP      3328
#define XB_TOPGEN   3392
#define XCD_BAR_WORDS 3456
#define XB_SPIN_CAP (1u << 18)

__device__ __forceinline__ unsigned xb_ld(unsigned* p)              { return __hip_atomic_load(p, __ATOMIC_RELAXED, __HIP_MEMORY_SCOPE_AGENT); }
__device__ __forceinline__ unsigned xb_add(unsigned* p, unsigned v) { return __hip_atomic_fetch_add(p, v, __ATOMIC_RELAXED, __HIP_MEMORY_SCOPE_AGENT); }
__device__ __forceinline__ unsigned xb_xcc_id() { return (unsigned)__builtin_amdgcn_s_getreg((3 << 11) | 20) & 0xFu; }
#define XB_SPIN(cond, bar) do { unsigned _sp = 0; while (cond) { __builtin_amdgcn_s_sleep(1); \
    if ((++_sp & 255u) == 0u) { if (xb_ld(&(bar)[XB_TMO])) break; if (_sp > XB_SPIN_CAP) { atomicAdd(&(bar)[XB_TMO], 1u); break; } } } } while (0)

struct XcdBarrier {
    unsigned* bar; unsigned x;
    volatile LAS unsigned* st;
};

__device__ __forceinline__ XcdBarrier xcd_barrier_post(unsigned* bar, volatile LAS unsigned* st) {
    XcdBarrier b; b.bar = bar; b.x = xb_xcc_id(); b.st = st;
    if (threadIdx.x == 0) (void)xb_add(&bar[XB_XCNT(b.x)], 1u);
    return b;
}
__device__ __forceinline__ void xcd_barrier_complete(unsigned* bar, unsigned x, unsigned& nloc, unsigned& nx) {
    const unsigned G = gridDim.x * gridDim.y * gridDim.z;
    unsigned sum, cnt, mine, sp = 0u;
    for (;;) {
        sum = 0u; cnt = 0u; mine = 0u;
#pragma unroll
        for (unsigned j = 0; j < 16; ++j) { const unsigned c = xb_ld(&bar[XB_XCNT(j)]); sum += c; cnt += (c > 0u) ? 1u : 0u; mine = (j == x) ? c : mine; }
        if (sum == G) break;
        __builtin_amdgcn_s_sleep(1);
        if ((++sp & 255u) == 0u) { if (xb_ld(&bar[XB_TMO])) break; if (sp > XB_SPIN_CAP) { atomicAdd(&bar[XB_TMO], 1u); break; } }
    }
    nloc = mine > 0u ? mine : 1u; nx = cnt > 0u ? cnt : 1u;
}

__device__ __forceinline__ void xcd_barrier(const XcdBarrier& b) {
    asm volatile("s_waitcnt vmcnt(0)" ::: "memory");
    __syncthreads();
    if (threadIdx.x == 0) {
        unsigned* bar = b.bar;
        __builtin_amdgcn_s_waitcnt(0);
        unsigned nloc = b.st[0], nx = b.st[1];
        if (nloc == 0u) { xcd_barrier_complete(bar, b.x, nloc, nx); b.st[0] = nloc; b.st[1] = nx; }
        const unsigned old = xb_add(&bar[XB_XSUB(b.x)], 1u);
        const unsigned gen = old / nloc;
        if (old + 1u == (gen + 1u) * nloc) {
            __builtin_amdgcn_fence(__ATOMIC_RELEASE, "agent");
            asm volatile("s_waitcnt vmcnt(0)" ::: "memory");
            const unsigned og = xb_add(&bar[XB_TOP], 1u);
            const unsigned tg = og / nx;
            if (og + 1u == (tg + 1u) * nx) xb_add(&bar[XB_TOPGEN], 1u);
            else XB_SPIN(xb_ld(&bar[XB_TOPGEN]) == tg, bar);
            __builtin_amdgcn_fence(__ATOMIC_ACQUIRE, "agent");
            xb_add(&bar[XB_XGEN(b.x)], 1u);
            asm volatile("s_waitcnt vmcnt(0)" ::: "memory");
        } else {
            XB_SPIN(xb_ld(&bar[XB_XGEN(b.x)]) == gen, bar);
            __builtin_amdgcn_fence(__ATOMIC_ACQUIRE, "agent");
            asm volatile("s_waitcnt vmcnt(0)" ::: "memory");
        }
    }
    __syncthreads();
}

#define OPQ(p) do { size_t z_ = 0; asm volatile("" : "+s"(z_)); p = (decltype(p))((unsigned char*)(p) + z_); } while (0)
#define WSP(type, name, off) type* name = (type*)(ws + (off))
__global__ void __launch_bounds__(NTHR, 2) mk_fwd(Args a) {
    extern __shared__ __attribute__((aligned(16))) unsigned char lds[];
    float* smem = (float*)lds;
    volatile LAS unsigned* bst = (volatile LAS unsigned*)((LAS unsigned char*)lds + (LDS_BYTES - 64));
    if (threadIdx.x < 2) bst[threadIdx.x] = 0u;
    __syncthreads();
    (void)xcd_barrier_post((unsigned*)(a.ws + WS_CTL), bst);
#ifndef PROBE_I
#define PROBE_I -1
#endif
#define GRID_BAR() do { XcdBarrier b_; b_.bar = (unsigned*)(a.ws + WS_CTL); b_.x = xb_xcc_id(); b_.st = (volatile LAS unsigned*)((LAS unsigned char*)lds + (LDS_BYTES - 64)); xcd_barrier(b_); } while (0)
#define REP(idx) for (int rep_ = 0; rep_ < ((PROBE_I == (idx) && l == 0) ? 2 : 1); ++rep_)
    for (int rep_ = 0; rep_ < (PROBE_I == 0 ? 2 : 1); ++rep_) {
        unsigned char* ws = a.ws; OPQ(ws);
        WSP(bf16_t, Wpool, WS_WPOOL); WSP(bf16_t, Wup, WS_WUP); WSP(bf16_t, Wout, WS_WOUT); WSP(bf16_t, Wpeer, WS_WPEER); WSP(bf16_t, Win, WS_WIN); WSP(bf16_t, Ub, WS_UB); WSP(bf16_t, Vb, WS_VB); WSP(bf16_t, h, WS_H);
#define PRO_WEIGHTS() do { for (int l = 0; l < NL; ++l) { \
            ph_transpose_w(a.w_in + (size_t)l * DM * INW, Win + (size_t)l * INW * DM, DM, INW, lds); \
            ph_wpool_bd(a.w_pool + (size_t)l * 4 * 128 * 256, Wpool + (size_t)l * DM * 256); \
            ph_transpose_w(a.w_up + (size_t)l * AW * DM, Wup + (size_t)l * DM * AW, AW, DM, lds); \
            ph_transpose_w(a.w_out + (size_t)l * DM * DM, Wout + (size_t)l * DM * DM, DM, DM, lds); \
            __syncthreads(); \
            ph_wpeer2(a.peer_wq + (size_t)l * DM * PQW, a.peer_keys + (size_t)l * 2 * NKEY * 128, a.ffn_norm + l * DM, Wpeer + (size_t)l * PQW * DM, smem); } } while (0)
#define PRO_STREAM() do { ph_quant_rows(a.peer_u, ws + WS_UQ, (float*)(ws + WS_SU), NEXP, 0); ph_quant_rows(a.peer_v, ws + WS_VQ, (float*)(ws + WS_SV), NEXP, 0);        ph_rmsnorm(a.x, a.mix_norm, h); } while (0)
        if (blockIdx.x & 8) { PRO_STREAM(); PRO_WEIGHTS(); } else { PRO_WEIGHTS(); PRO_STREAM(); }
#undef PRO_WEIGHTS
#undef PRO_STREAM
        { float* km = (float*)(ws + WS_KM); for (int i = blockIdx.x * NTHR + opq_tid(); i < NB * NBLK * AW; i += gridDim.x * NTHR) km[i] = 0.f; }
    }
    GRID_BAR();
    for (int l = 0; l < NL; ++l) {
        REP(1)
        { unsigned char* ws = a.ws; OPQ(ws); WSP(bf16_t, h, WS_H); WSP(bf16_t, z, WS_Z); WSP(bf16_t, Win, WS_WIN);
          pg8::Gemm g{h, Win + (size_t)l * INW * DM, T, INW, DM, DM, DM, 0}; pg8::StaticOrder S; S.init(T, INW, (int)gridDim.x, (int)blockIdx.x);
          pg8::gemm_phase<EpiZk, pg8::StaticOrder, true, true>((PG8_LAS unsigned char*)lds, g, S, EpiZk{z, (float*)(ws + WS_KM)}); }
        GRID_BAR();
        REP(2)
        { unsigned char* ws = a.ws; OPQ(ws); WSP(bf16_t, z, WS_Z); WSP(bf16_t, m, WS_M);
          ph_poolm2(z, m); }
        REP(3)
        { unsigned char* ws = a.ws; OPQ(ws); WSP(bf16_t, z, WS_Z); WSP(bf16_t, o, WS_O);
          ph_attn(lds, z, (const float*)(ws + WS_KM), o); }
        GRID_BAR();
        { float* km = (float*)(a.ws + WS_KM); for (int i = blockIdx.x * NTHR + opq_tid(); i < NB * NBLK * AW; i += gridDim.x * NTHR) km[i] = 0.f; }
        REP(11)
        { unsigned char* ws = a.ws; OPQ(ws); WSP(bf16_t, z, WS_Z); WSP(bf16_t, m, WS_M); WSP(bf16_t, gaa, WS_GAA); WSP(bf16_t, Wpool, WS_WPOOL);
          { int kpool = 256; asm volatile("" : "+s"(kpool)); pg8::Gemm g{m, Wpool + (size_t)l * DM * 256, T, DM, kpool, PW, 256, 128};        pg8::StaticOrder S; S.init(T, DM, (int)gridDim.x, (int)blockIdx.x);
            pg8::gemm_phase<EpiAdapt8L<EpiPool8L>, pg8::StaticOrder, true, true>((PG8_LAS unsigned char*)lds, g, S, EpiAdapt8L<EpiPool8L>{EpiPool8L{z, a.pool_scale + l * DM, gaa}}); } }
        REP(4)
        { unsigned char* ws = a.ws; OPQ(ws); WSP(bf16_t, z, WS_Z); WSP(bf16_t, o, WS_O); WSP(bf16_t, gaa, WS_GAA); WSP(bf16_t, mrg, WS_MRG); WSP(bf16_t, Wup, WS_WUP);
          { pg8::Gemm g{o, Wup + (size_t)l * DM * AW, T, DM, AW, AW, AW, 0}; pg8::StaticOrder S; S.init(T, DM, (int)gridDim.x, (int)blockIdx.x);
            pg8::gemm_phase<EpiAdapt8L<EpiUp8L>, pg8::StaticOrder, true, true>((PG8_LAS unsigned char*)lds, g, S, EpiAdapt8L<EpiUp8L>{EpiUp8L{z, gaa, mrg}}); } }
        GRID_BAR();
        REP(5)
        { unsigned char* ws = a.ws; OPQ(ws); WSP(bf16_t, mrg, WS_MRG); WSP(bf16_t, Wout, WS_WOUT); WSP(bf16_t, h, WS_H); float* out = a.out; OPQ(out);
          pg8::Gemm g{mrg, Wout + (size_t)l * DM * DM, T, DM, DM, DM, DM, 0}; pg8::StaticOrder S; S.init(T, DM, (int)gridDim.x, (int)blockIdx.x);
          if (l == 0) pg8::gemm_phase<EpiAdapt8L<EpiResNormL<false>, 2>, pg8::StaticOrder, true, true>((PG8_LAS unsigned char*)lds, g, S, EpiAdapt8L<EpiResNormL<false>, 2>{EpiResNormL<false>{a.x, (const bf16_t*)(ws + WS_XB), (bf16_t*)(ws + WS_XB), (float*)(ws + WS_GAA)}});
          else pg8::gemm_phase<EpiAdapt8L<EpiResNormL<true>, 4>, pg8::StaticOrder, true, true>((PG8_LAS unsigned char*)lds, g, S, EpiAdapt8L<EpiResNormL<true>, 4>{EpiResNormL<true>{a.x, (const bf16_t*)(ws + WS_XB), (bf16_t*)(ws + WS_XB), (float*)(ws + WS_GAA)}}); }
        GRID_BAR();
        REP(7)
        { unsigned char* ws = a.ws; OPQ(ws); WSP(bf16_t, h, WS_H); WSP(float, sc, WS_SC); WSP(bf16_t, Wpeer, WS_WPEER);
          pg8::Gemm g{(const bf16_t*)(ws + WS_XB), Wpeer + (size_t)l * PQW * DM, T, PQW, DM, DM, DM, 0}; pg8::StaticOrder S; S.init(T, PQW, (int)gridDim.x, (int)blockIdx.x);
          pg8::Unit u0, u1; u0.pm = 0; u0.pn = 0; u1.pm = 0; u1.pn = 0; const bool h0 = S.next(0, u0), h1 = S.next(1, u1);
          LAS float* rl = (LAS float*)((LAS unsigned char*)lds + 131072);
          { const int t_ = opq_tid(); const int pmx = (t_ < 256) ? u0.pm : u1.pm; if ((t_ < 256) ? h0 : h1) rl[t_] = rstd_of((const float*)(ws + WS_GAA), (size_t)pmx * 256 + (t_ & 255)); }
          { const int t2_ = opq_tid(); if (t2_ < 2) ((LAS int*)((LAS unsigned char*)lds + 133120))[t2_] = (t2_ == 0) ? (h0 ? u0.pm : -1) : (h1 ? u1.pm : -1); }
          __syncthreads();
          pg8::gemm_phase<EpiI16s, pg8::StaticOrder, true, true>((PG8_LAS unsigned char*)lds, g, S, EpiI16s{(short*)sc, (const float*)(ws + WS_GAA)}); }
        GRID_BAR();
        { unsigned char* ws = a.ws; OPQ(ws); WSP(float, sc, WS_SC); WSP(int, eid, WS_EID); WSP(float, gw, WS_GW); WSP(float, wact, WS_WACT); WSP(bf16_t, h, WS_H); float* out = a.out; OPQ(out);
          ph_peer_all(lds, (const short*)sc, eid, gw, (int*)(ws + WS_KMEAN), wact, (const bf16_t*)(ws + WS_XB), a.ffn_norm + l * DM, (const float*)(ws + WS_GAA), ws + WS_UQ + (size_t)l * NEXP * DM, (const float*)(ws + WS_SU) + (size_t)l * NEXP,
                      ws + WS_VQ + (size_t)l * NEXP * DM, (const float*)(ws + WS_SV) + (size_t)l * NEXP, out, (bf16_t*)(ws + WS_XB), l == NL - 1 ? a.final_norm : a.mix_norm + (l + 1) * DM, h, l == NL - 1 ? 1 : 0, l == 0 ? a.peer_u : nullptr, a.peer_v, ws + WS_UQ, (float*)(ws + WS_SU) + NEXP); }
        if (l + 1 < NL) GRID_BAR();
    }
}

extern "C" void kernel_launch(void* const* d_in, const int* in_sizes, int n_in, void* d_out, int out_size, void* d_ws, size_t ws_size, hipStream_t stream) {
    static int grid = 0;
    if (grid == 0) {
        if (n_in != 13 || ws_size < WS_END) { fprintf(stderr, "kernel_launch: unexpected inputs / workspace (%d, %zu)\n", n_in, ws_size); grid = -1; return; }
        int dev = 0, cus = 0, per_cu = 0;
        hipGetDevice(&dev); hipDeviceGetAttribute(&cus, hipDeviceAttributeMultiprocessorCount, dev);
        if (hipFuncSetAttribute((const void*)mk_fwd, hipFuncAttributeMaxDynamicSharedMemorySize, LDS_BYTES) != hipSuccess) { fprintf(stderr, "kernel_launch: hipFuncSetAttribute failed\n"); grid = -1; return; }
        if (hipOccupancyMaxActiveBlocksPerMultiprocessor(&per_cu, (const void*)mk_fwd, NTHR, LDS_BYTES) != hipSuccess || per_cu < 1) { fprintf(stderr, "kernel_launch: occupancy query says %d\n", per_cu); grid = -1; return; }
        grid = cus;
    }
    if (grid < 0) return;
    Args a{};
    a.x = (const float*)d_in[0]; a.mix_norm = (const float*)d_in[1]; a.w_in = (const float*)d_in[2]; a.w_pool = (const float*)d_in[3]; a.pool_scale = (const float*)d_in[4];
    a.w_up = (const float*)d_in[5]; a.w_out = (const float*)d_in[6]; a.ffn_norm = (const float*)d_in[7]; a.peer_wq = (const float*)d_in[8]; a.peer_keys = (const float*)d_in[9];
    a.peer_u = (const float*)d_in[10]; a.peer_v = (const float*)d_in[11]; a.final_norm = (const float*)d_in[12]; a.out = (float*)d_out; a.ws = (unsigned char*)d_ws;
    if (hipMemsetAsync((char*)d_ws + WS_CTL, 0, 65536, stream) != hipSuccess) { fprintf(stderr, "kernel_launch: memset failed\n"); return; }
    void* args[] = {&a};
    hipError_t e = hipLaunchCooperativeKernel((const void*)mk_fwd, dim3(grid), dim3(NTHR), args, LDS_BYTES, stream);
    if (e != hipSuccess) fprintf(stderr, "kernel_launch: cooperative launch failed: %s (grid %d)\n", hipGetErrorString(e), grid);
}
```

```cpp
#include <hip/hip_runtime.h>
#include <hip/hip_cooperative_groups.h>
namespace cg = cooperative_groups;
#include <stdint.h>
#include <cstdio>
#include <type_traits>

typedef unsigned short bf16_t;
typedef float f32x4 __attribute__((ext_vector_type(4)));
typedef unsigned u32x4 __attribute__((ext_vector_type(4)));
typedef unsigned u32x2 __attribute__((ext_vector_type(2)));

constexpr int NB = 8, SEQ = 2048, DM = 1024, T = NB * SEQ, NL = 2;
constexpr int INW = 4096, PW = 512, AW = 512, NH = 8, HD = 64, MBLK = 256, NBLK = SEQ / MBLK;
constexpr int PH = 8, NKEY = 128, QD = 256, PK = 16, NEXP = NKEY * NKEY, PQW = PH * QD;
constexpr int NSLOT = PH * PK;
constexpr float EPS = 1e-6f;
constexpr float LOG2E = 1.4426950408889634f;
constexpr float C2 = 0.125f * LOG2E;

constexpr size_t MiB = 1u << 20;
constexpr size_t WS_CTL = 0, WS_KMEAN = 1 * MiB, WS_WPOOL = 2 * MiB, WS_WUP = 4 * MiB, WS_WOUT = 6 * MiB, WS_WPEER = 10 * MiB, WS_WIN = 18 * MiB;
constexpr size_t WS_UB = 34 * MiB, WS_VB = 98 * MiB, WS_H = 162 * MiB, WS_Z = 194 * MiB, WS_SC = 194 * MiB;
constexpr size_t WS_M = 322 * MiB, WS_O = 338 * MiB, WS_MRG = 354 * MiB, WS_GAA = 386 * MiB, WS_EID = 418 * MiB, WS_GW = 426 * MiB, WS_WACT = 434 * MiB, WS_END = 442 * MiB;

__device__ __forceinline__ float bf2f(bf16_t v) { return __uint_as_float(((unsigned)v) << 16); }
__device__ __forceinline__ unsigned f2bf(float f) { unsigned u = __float_as_uint(f); return (u + 0x7fffu + ((u >> 16) & 1u)) >> 16; }
typedef float f32x2_pk __attribute__((ext_vector_type(2))); typedef __bf16 bf16x2_pk __attribute__((ext_vector_type(2)));
__device__ __forceinline__ unsigned pk2(float lo, float hi) { f32x2_pk v = {lo, hi}; bf16x2_pk b = __builtin_convertvector(v, bf16x2_pk); return __builtin_bit_cast(unsigned, b); }
__device__ __forceinline__ float lo16(unsigned w) { return __uint_as_float(w << 16); }
__device__ __forceinline__ float hi16(unsigned w) { return __uint_as_float(w & 0xffff0000u); }
__device__ __forceinline__ float wave_sum(float v) {
#pragma unroll
    for (int o = 1; o < 64; o <<= 1) v += __shfl_xor(v, o);
    return v;
}
__device__ __forceinline__ float wave_max(float v) {
#pragma unroll
    for (int o = 1; o < 64; o <<= 1) v = fmaxf(v, __shfl_xor(v, o));
    return v;
}
__device__ __forceinline__ int opq_tid() { int t = threadIdx.x; asm volatile("" : "+v"(t)); return t; }
__device__ __forceinline__ int ldcg(const int* p) { return __hip_atomic_load(p, __ATOMIC_RELAXED, __HIP_MEMORY_SCOPE_AGENT); }
__device__ __forceinline__ float ldcg(const float* p) { return __hip_atomic_load(p, __ATOMIC_RELAXED, __HIP_MEMORY_SCOPE_AGENT); }
__device__ __forceinline__ float gelu_tanh(float x) {
    const float u = 0.7978845608028654f * (x + 0.044715f * x * x * x);
    const float e = __expf(2.f * u);
    const float th = 1.f - 2.f / (e + 1.f);
    return 0.5f * x * (1.f + th);
}

struct EpiZ {
    bf16_t* z;
    __device__ __forceinline__ void operator()(int row, int col0, f32x4 v) const {
        if (col0 >= 2048) { v.x = 1.f / (1.f + __expf(-v.x)); v.y = 1.f / (1.f + __expf(-v.y)); v.z = 1.f / (1.f + __expf(-v.z)); v.w = 1.f / (1.f + __expf(-v.w)); }
        else if (col0 >= 512 && col0 < 1024) { v = v * C2; }
        u32x2 o; o.x = pk2(v.x, v.y); o.y = pk2(v.z, v.w); *(u32x2*)(z + (size_t)row * INW + col0) = o;
    }
};
struct EpiPool {
    const bf16_t* z; const float* pscale; bf16_t* gaa;
    __device__ __forceinline__ void operator()(int row, int col0, f32x4 v) const {
        const u32x2 g = *(const u32x2*)(z + (size_t)row * INW + 2048 + col0); const f32x4 ps = *(const f32x4*)(pscale + col0);
        u32x2 o; o.x = pk2(v.x * ps.x * lo16(g.x), v.y * ps.y * hi16(g.x)); o.y = pk2(v.z * ps.z * lo16(g.y), v.w * ps.w * hi16(g.y));
        *(u32x2*)(gaa + (size_t)row * DM + col0) = o;
    }
};
struct EpiUp {
    const bf16_t* z; const bf16_t* gaa; bf16_t* mrg;
    __device__ __forceinline__ void operator()(int row, int col0, f32x4 v) const {
        const u32x2 g = *(const u32x2*)(z + (size_t)row * INW + 3072 + col0); const u32x2 a = *(const u32x2*)(gaa + (size_t)row * DM + col0);
        u32x2 o; o.x = pk2(lo16(a.x) + v.x * lo16(g.x), hi16(a.x) + v.y * hi16(g.x)); o.y = pk2(lo16(a.y) + v.z * lo16(g.y), hi16(a.y) + v.w * hi16(g.y));
        *(u32x2*)(mrg + (size_t)row * DM + col0) = o;
    }
};
struct EpiRes {
    const float* xin; float* xout;
    __device__ __forceinline__ void operator()(int row, int col0, f32x4 v) const {
        const f32x4 b = *(const f32x4*)(xin + (size_t)row * DM + col0); *(f32x4*)(xout + (size_t)row * DM + col0) = b + v;
    }
};
struct EpiF32 {
    float* out; int ldc;
    __device__ __forceinline__ void operator()(int row, int col0, f32x4 v) const { *(f32x4*)(out + (size_t)row * ldc + col0) = v; }
};

__device__ __forceinline__ float sigm(float v) { return __builtin_amdgcn_rcpf(1.f + __expf(-v)); }
struct EpiZ8 {
    bf16_t* z;
    __device__ __forceinline__ void operator()(int row, int col0, f32x4 a, f32x4 b) const {
        if (col0 >= 2048) { a.x = sigm(a.x); a.y = sigm(a.y); a.z = sigm(a.z); a.w = sigm(a.w); b.x = sigm(b.x); b.y = sigm(b.y); b.z = sigm(b.z); b.w = sigm(b.w); }
        else if (col0 >= 512 && col0 < 1024) { a = a * C2; b = b * C2; }
        u32x4 o; o.x = pk2(a.x, a.y); o.y = pk2(a.z, a.w); o.z = pk2(b.x, b.y); o.w = pk2(b.z, b.w); *(u32x4*)(z + (size_t)row * INW + col0) = o;
    }
};
struct EpiPool8 {
    const bf16_t* z; const float* pscale; bf16_t* gaa;
    __device__ __forceinline__ void operator()(int row, int col0, f32x4 a, f32x4 b) const {
        const u32x4 g = *(const u32x4*)(z + (size_t)row * INW + 2048 + col0); const f32x4 p0 = *(const f32x4*)(pscale + col0), p1 = *(const f32x4*)(pscale + col0 + 4);
        u32x4 o; o.x = pk2(a.x * p0.x * lo16(g.x), a.y * p0.y * hi16(g.x)); o.y = pk2(a.z * p0.z * lo16(g.y), a.w * p0.w * hi16(g.y));
        o.z = pk2(b.x * p1.x * lo16(g.z), b.y * p1.y * hi16(g.z)); o.w = pk2(b.z * p1.z * lo16(g.w), b.w * p1.w * hi16(g.w));
        *(u32x4*)(gaa + (size_t)row * DM + col0) = o;
    }
};
struct EpiUp8 {
    const bf16_t* z; const bf16_t* gaa; bf16_t* mrg;
    __device__ __forceinline__ void operator()(int row, int col0, f32x4 a, f32x4 b) const {
        const u32x4 g = *(const u32x4*)(z + (size_t)row * INW + 3072 + col0); const u32x4 q = *(const u32x4*)(gaa + (size_t)row * DM + col0);
        u32x4 o; o.x = pk2(lo16(q.x) + a.x * lo16(g.x), hi16(q.x) + a.y * hi16(g.x)); o.y = pk2(lo16(q.y) + a.z * lo16(g.y), hi16(q.y) + a.w * hi16(g.y));
        o.z = pk2(lo16(q.z) + b.x * lo16(g.z), hi16(q.z) + b.y * hi16(g.z)); o.w = pk2(lo16(q.w) + b.z * lo16(g.w), hi16(q.w) + b.w * hi16(g.w));
        *(u32x4*)(mrg + (size_t)row * DM + col0) = o;
    }
};


namespace pg8 {
#define PG8_LAS __attribute__((address_space(3)))
typedef unsigned short bf16_t;
typedef short bf16x8 __attribute__((ext_vector_type(8)));
typedef float f32x4 __attribute__((ext_vector_type(4)));
typedef unsigned u32x4 __attribute__((ext_vector_type(4)));
constexpr int BM = 256, BK = 64, HALF = 128, HTB = HALF * BK * 2  , STAGE_BYTES = 8 * HTB, NXCD = 8, WGM = 4;

__host__ __device__ __forceinline__ int lds_byte(int r, int c) { const int st = (r >> 4) * 2 + (c >> 5), rr = r & 15, cc = c & 31, ob = rr * 64 + cc * 2; return st * 1024 + (ob ^ (((ob >> 9) & 1) << 5)); }
__host__ __device__ __forceinline__ void stage_rc(int b, int& R, int& C) { const int st = b / 1024, sb = b % 1024, swz = sb ^ (((sb >> 9) & 1) << 5); R = (st >> 1) * 16 + swz / 64; C = (st & 1) * 32 + (swz % 64) / 2; }
__host__ __device__ __forceinline__ int perm32(int rho) { const int n = rho >> 4, i = rho & 15; return 8 * (i >> 2) + 4 * n + (i & 3); }

struct Unit { int pm, pn; };
struct Gemm { const bf16_t* A; const bf16_t* Bt; int M, N, K, lda, ldb, a_pn_off; };

struct StaticOrder {
    int nM, nN, nwg, G, c;
    __host__ __device__ void init(int M, int N, int G_, int c_) { nM = M / BM; nN = N / BM; nwg = nM * nN; G = G_; c = c_; }
    __host__ __device__ bool next(int i, Unit& u) const {
        const long L = (long)i * G + c; if (L >= nwg) return false;
        int wgid = (int)L; { const int q = nwg / NXCD, r = nwg % NXCD, xcd = wgid % NXCD, off = wgid / NXCD; wgid = (xcd < r ? xcd * (q + 1) : r * (q + 1) + (xcd - r) * q) + off; }
        const int nig = WGM * nN, gid = wgid / nig, fm = gid * WGM, gsz = (nM - fm) < WGM ? (nM - fm) : WGM;
        u.pm = fm + ((wgid % nig) % gsz); u.pn = (wgid % nig) / gsz; return true;
    }
    __device__ __forceinline__ void a_ready(const Unit&) const {}
    __device__ __forceinline__ void done(const Unit&) const {}
};
template <class Epi, class Sched, bool ALIGN_EPI = false, bool SP2 = false>
__device__ __forceinline__ void gemm_phase(PG8_LAS unsigned char* lds, const Gemm g, const Sched& S, const Epi& E) {
    const int tid = opq_tid(), wid = __builtin_amdgcn_readfirstlane(tid >> 6), lane = tid & 63, wr = wid >> 2, wc = wid & 3, fr = lane & 15, fq = lane >> 4;
    const int K = g.K, nt = K / BK;
    unsigned voffA[2], voffB[2];
#pragma unroll
    for (int i = 0; i < 2; ++i) { int R, C; stage_rc(tid * 16 + i * 8192, R, C); const int Rb = Epi::PERM ? ((R & ~31) + perm32(R & 31)) : R;
        voffA[i] = (unsigned)(R * g.lda + C) * 2u; voffB[i] = (unsigned)(Rb * g.ldb + C) * 2u; }
    const size_t kstep = (size_t)(BK * 2);
    const size_t hstepA = (size_t)HALF * g.lda * 2, hstepB = (size_t)HALF * g.ldb * 2;
    const size_t tstepA = 2 * hstepA, tstepB = 2 * hstepB; const size_t pnoff = (size_t)g.a_pn_off * 2;
    const unsigned ldsw = (unsigned)wid * 1024u;
    const int aoff = lds_byte(wr * 64 + fr, fq * 8), boff = lds_byte(wc * 32 + fr, fq * 8);
#define PG8_SA(b, h) (((b) * 2 + (h)) * HTB)
#define PG8_SB(b, h) ((4 + (b) * 2 + (h)) * HTB)
#define PG8_STAGE(bufoff, gbase, voff) do { _Pragma("unroll") for (int _i = 0; _i < 2; ++_i) \
        __builtin_amdgcn_global_load_lds((const unsigned*)((const char*)(gbase) + (voff)[_i]), (PG8_LAS unsigned*)(lds + (bufoff) + ldsw + _i * 8192), 16, 0, 0); } while (0)
#define PG8_LDA(dst, b, h) do { _Pragma("unroll") for (int m = 0; m < 4; ++m) _Pragma("unroll") for (int k = 0; k < 2; ++k) dst[m][k] = *(const PG8_LAS bf16x8*)(lds + PG8_SA(b, h) + aoff + m * 2048 + k * 1024); } while (0)
#define PG8_LDB(dst, b, h) do { _Pragma("unroll") for (int n = 0; n < 2; ++n) _Pragma("unroll") for (int k = 0; k < 2; ++k) dst[n][k] = *(const PG8_LAS bf16x8*)(lds + PG8_SB(b, h) + boff + n * 2048 + k * 1024); } while (0)
#define PG8_MMA(ai, bj, At, Bt) do { __builtin_amdgcn_s_setprio(1); _Pragma("unroll") for (int m = 0; m < 4; ++m) _Pragma("unroll") for (int n = 0; n < 2; ++n) _Pragma("unroll") for (int k = 0; k < 2; ++k) \
        acc[ai][bj][m][n] = __builtin_amdgcn_mfma_f32_16x16x32_bf16(Bt[n][k], At[m][k], acc[ai][bj][m][n], 0, 0, 0); __builtin_amdgcn_s_setprio(0); } while (0)
#define PG8_WAIT_V(n) asm volatile("s_waitcnt vmcnt(" #n ")" ::: "memory")
#define PG8_WAIT_L(n) asm volatile("s_waitcnt lgkmcnt(" #n ")" ::: "memory")
#define PG8_BAR __builtin_amdgcn_s_barrier()
#define PG8_SCHED __builtin_amdgcn_sched_barrier(0)
    Unit cur, nxt; int ui = 0;
    if (!S.next(0, cur)) return;
    f32x4 acc[2][2][4][2];
#pragma unroll
    for (int a = 0; a < 2; ++a)
#pragma unroll
        for (int b = 0; b < 2; ++b)
#pragma unroll
            for (int m = 0; m < 4; ++m)
#pragma unroll
                for (int n = 0; n < 2; ++n) acc[a][b][m][n] = (f32x4){0.f, 0.f, 0.f, 0.f};
    bf16x8 At[4][2], B0[2][2], B1[2][2];
    const char* cA = (const char*)g.A + (size_t)cur.pm * tstepA + (size_t)cur.pn * pnoff; const char* cB = (const char*)g.Bt + (size_t)cur.pn * tstepB;
    S.a_ready(cur);
    if constexpr (SP2) {
        PG8_STAGE(PG8_SB(0, 0), cB, voffB); PG8_STAGE(PG8_SB(0, 1), cB + hstepB, voffB); PG8_STAGE(PG8_SA(0, 0), cA, voffA); PG8_STAGE(PG8_SA(0, 1), cA + hstepA, voffA);
        if (wr == 1) PG8_BAR;
        PG8_WAIT_V(2); PG8_BAR;
        PG8_STAGE(PG8_SB(1, 0), cB + kstep, voffB); PG8_STAGE(PG8_SA(1, 0), cA + kstep, voffA); PG8_STAGE(PG8_SB(1, 1), cB + hstepB + kstep, voffB);
        PG8_WAIT_V(6); PG8_BAR;
    } else {
        PG8_STAGE(PG8_SB(0, 0), cB, voffB); PG8_STAGE(PG8_SA(0, 0), cA, voffA); PG8_STAGE(PG8_SB(0, 1), cB + hstepB, voffB); PG8_STAGE(PG8_SA(0, 1), cA + hstepA, voffA);
        if (wr == 1) PG8_BAR;
        PG8_WAIT_V(4); PG8_BAR;
        PG8_STAGE(PG8_SB(1, 0), cB + kstep, voffB); PG8_STAGE(PG8_SA(1, 0), cA + kstep, voffA); PG8_STAGE(PG8_SB(1, 1), cB + hstepB + kstep, voffB);
        PG8_WAIT_V(6); PG8_BAR;
    }
    for (;;) {
        const bool has_next = S.next(ui + 1, nxt);
        const char* nA = has_next ? (const char*)g.A + (size_t)nxt.pm * tstepA + (size_t)nxt.pn * pnoff : cA; const char* nB = has_next ? (const char*)g.Bt + (size_t)nxt.pn * tstepB : cB;
        for (int t = 0; t < nt; t += 2) {
            const bool last = (t == nt - 2);
            const char* a1 = cA + (size_t)(t + 1) * kstep;
            const char* a2 = last ? nA : cA + (size_t)(t + 2) * kstep; const char* b2 = last ? nB : cB + (size_t)(t + 2) * kstep;
            const char* a3 = a2 + kstep; const char* b3 = b2 + kstep;
            if (last && has_next) S.a_ready(nxt);
            if constexpr (SP2) {
            PG8_LDB(B0, 0, 0); PG8_LDB(B1, 0, 1); PG8_SCHED; PG8_LDA(At, 0, 0); PG8_STAGE(PG8_SA(1, 1), a1 + hstepA, voffA);
            PG8_WAIT_V(8); PG8_WAIT_L(0); PG8_BAR; PG8_MMA(0, 0, At, B0); PG8_MMA(0, 1, At, B1); PG8_BAR; PG8_SCHED;
            PG8_LDA(At, 0, 1); PG8_STAGE(PG8_SB(0, 0), b2, voffB); PG8_STAGE(PG8_SB(0, 1), b2 + hstepB, voffB); PG8_STAGE(PG8_SA(0, 0), a2, voffA);
            PG8_WAIT_V(8); PG8_WAIT_L(0); PG8_BAR; PG8_MMA(1, 0, At, B0); PG8_MMA(1, 1, At, B1); PG8_BAR; PG8_SCHED;
            PG8_LDB(B0, 1, 0); PG8_LDB(B1, 1, 1); PG8_SCHED; PG8_LDA(At, 1, 0); PG8_STAGE(PG8_SA(0, 1), a2 + hstepA, voffA);
            PG8_WAIT_V(8); PG8_WAIT_L(0); PG8_BAR; PG8_MMA(0, 0, At, B0); PG8_MMA(0, 1, At, B1); PG8_BAR; PG8_SCHED;
            PG8_LDA(At, 1, 1); PG8_STAGE(PG8_SB(1, 0), b3, voffB); PG8_STAGE(PG8_SB(1, 1), b3 + hstepB, voffB); PG8_STAGE(PG8_SA(1, 0), a3, voffA);
            PG8_WAIT_V(8); PG8_WAIT_L(0); PG8_BAR; PG8_MMA(1, 0, At, B0); PG8_MMA(1, 1, At, B1); PG8_BAR; PG8_SCHED;
            } else {
            PG8_LDB(B0, 0, 0); PG8_SCHED; PG8_LDA(At, 0, 0); PG8_STAGE(PG8_SA(1, 1), a1 + hstepA, voffA);
            PG8_WAIT_L(8); PG8_BAR; PG8_WAIT_L(0); PG8_MMA(0, 0, At, B0); PG8_BAR; PG8_SCHED;
            PG8_LDB(B1, 0, 1); PG8_STAGE(PG8_SB(0, 0), b2, voffB);
            PG8_BAR; PG8_WAIT_L(0); PG8_MMA(0, 1, At, B1); PG8_BAR;
            PG8_LDA(At, 0, 1); PG8_STAGE(PG8_SA(0, 0), a2, voffA);
            PG8_BAR; PG8_WAIT_L(0); PG8_MMA(1, 0, At, B0); PG8_BAR; PG8_SCHED;
            PG8_STAGE(PG8_SB(0, 1), b2 + hstepB, voffB);
            PG8_WAIT_V(6); PG8_BAR; PG8_MMA(1, 1, At, B1); PG8_BAR;
            PG8_LDB(B0, 1, 0); PG8_SCHED; PG8_LDA(At, 1, 0); PG8_STAGE(PG8_SA(0, 1), a2 + hstepA, voffA);
            PG8_WAIT_L(8); PG8_BAR; PG8_WAIT_L(0); PG8_MMA(0, 0, At, B0); PG8_BAR; PG8_SCHED;
            PG8_LDB(B1, 1, 1); PG8_STAGE(PG8_SB(1, 0), b3, voffB);
            PG8_BAR; PG8_WAIT_L(0); PG8_MMA(0, 1, At, B1); PG8_BAR;
            PG8_LDA(At, 1, 1); PG8_STAGE(PG8_SA(1, 0), a3, voffA);
            PG8_BAR; PG8_WAIT_L(0); PG8_MMA(1, 0, At, B0); PG8_BAR; PG8_SCHED;
            PG8_STAGE(PG8_SB(1, 1), b3 + hstepB, voffB);
            PG8_WAIT_V(6); PG8_BAR; PG8_MMA(1, 1, At, B1); PG8_BAR;
            }
        }
        if constexpr (ALIGN_EPI) { if (wr == 0) PG8_BAR; }
        if constexpr (!Epi::AFTER_DRAIN) { E(acc, cur, wr, wc, fr, fq); S.done(cur); }
        if (!has_next) break;
#pragma unroll
        for (int a = 0; a < 2; ++a)
#pragma unroll
            for (int b = 0; b < 2; ++b)
#pragma unroll
                for (int m = 0; m < 4; ++m)
#pragma unroll
                    for (int n = 0; n < 2; ++n) acc[a][b][m][n] = (f32x4){0.f, 0.f, 0.f, 0.f};
        cur = nxt; cA = nA; cB = nB; ++ui;
        if constexpr (ALIGN_EPI) { if (wr == 1) PG8_BAR; }
    }
    PG8_WAIT_V(0);
    if constexpr (!ALIGN_EPI) { if (wr == 0) PG8_BAR; }
    PG8_BAR;
    if constexpr (Epi::AFTER_DRAIN) { E.fused(acc, cur, wr, wc, fr, fq, lds, wid, lane); S.done(cur); }
#undef PG8_SA
#undef PG8_SB
#undef PG8_STAGE
#undef PG8_LDA
#undef PG8_LDB
#undef PG8_MMA
#undef PG8_WAIT_V
#undef PG8_WAIT_L
#undef PG8_BAR
#undef PG8_SCHED
}
}

template <class F> struct EpiAdapt {
    static constexpr bool PERM = false, AFTER_DRAIN = false;
    F f;
    __device__ __forceinline__ void operator()(const pg8::f32x4 (&acc)[2][2][4][2], const pg8::Unit& u, int wr, int wc, int fr, int fq) const {
        const int row0 = u.pm * 256 + wr * 64 + fr, col0 = u.pn * 256 + wc * 32 + 4 * fq;
#pragma unroll
        for (int ai = 0; ai < 2; ++ai)
#pragma unroll
            for (int m = 0; m < 4; ++m)
#pragma unroll
                for (int bj = 0; bj < 2; ++bj)
#pragma unroll
                    for (int n = 0; n < 2; ++n) { f(row0 + ai * 128 + m * 16, col0 + bj * 128 + n * 16, acc[ai][bj][m][n]); asm volatile("" ::: "memory"); }
    }
};
template <class F, bool ALIGN> __device__ __forceinline__ void ph_gemm(unsigned char* lds, const bf16_t* A, int lda, const bf16_t* Bt, int ldb, int N, int K, F f) {
    pg8::Gemm g{A, Bt, T, N, K, lda, ldb, 0}; pg8::StaticOrder S; S.init(T, N, (int)gridDim.x, (int)blockIdx.x);
    pg8::gemm_phase<EpiAdapt<F>, pg8::StaticOrder, ALIGN, true>((PG8_LAS unsigned char*)lds, g, S, EpiAdapt<F>{f});
}

template <class F> struct EpiAdapt8 {
    static constexpr bool PERM = true, AFTER_DRAIN = false;
    F f;
    __device__ __forceinline__ void operator()(const pg8::f32x4 (&acc)[2][2][4][2], const pg8::Unit& u, int wr, int wc, int fr, int fq) const {
        const int row0 = u.pm * 256 + wr * 64 + fr, col0 = u.pn * 256 + wc * 32 + 8 * fq;
#pragma unroll
        for (int ai = 0; ai < 2; ++ai)
#pragma unroll
            for (int m = 0; m < 4; ++m)
#pragma unroll
                for (int bj = 0; bj < 2; ++bj) { f(row0 + ai * 128 + m * 16, col0 + bj * 128, acc[ai][bj][m][0], acc[ai][bj][m][1]); asm volatile("" ::: "memory"); }
    }
};
template <class F, bool ALIGN> __device__ __forceinline__ void ph_gemm8(unsigned char* lds, const bf16_t* A, int lda, const bf16_t* Bt, int ldb, int N, int K, F f) {
    pg8::Gemm g{A, Bt, T, N, K, lda, ldb, 0}; pg8::StaticOrder S; S.init(T, N, (int)gridDim.x, (int)blockIdx.x);
    pg8::gemm_phase<EpiAdapt8<F>, pg8::StaticOrder, ALIGN, true>((PG8_LAS unsigned char*)lds, g, S, EpiAdapt8<F>{f});
}

__device__ __forceinline__ float rstd_of(const float* rowsq, size_t row) {
    const f32x4* p = (const f32x4*)(rowsq + row * 16); const f32x4 a = p[0], b = p[1], c = p[2], d = p[3];
    return rsqrtf((((a.x + a.y) + (a.z + a.w)) + ((b.x + b.y) + (b.z + b.w)) + ((c.x + c.y) + (c.z + c.w)) + ((d.x + d.y) + (d.z + d.w))) * (1.f / DM) + EPS);
}
struct EpiResNorm {
    static constexpr bool PERM = true, AFTER_DRAIN = false;
    const float* xin; const bf16_t* xbin; bf16_t* xb; bf16_t* xg; const float* g; float* rowsq; int use_xb;
    __device__ __forceinline__ void operator()(const pg8::f32x4 (&acc)[2][2][4][2], const pg8::Unit& u, int wr, int wc, int fr, int fq) const {
        const int row0 = u.pm * 256 + wr * 64 + fr, col0 = u.pn * 256 + wc * 32 + 8 * fq;
#pragma unroll
        for (int ai = 0; ai < 2; ++ai)
#pragma unroll
            for (int m = 0; m < 4; ++m) { const int row = row0 + ai * 128 + m * 16; float s = 0.f;
#pragma unroll
                for (int bj = 0; bj < 2; ++bj) { const int col = col0 + bj * 128; f32x4 x0, x1;
                    if (use_xb) { const u32x4 w = *(const u32x4*)(xbin + (size_t)row * DM + col); x0 = (f32x4){lo16(w.x), hi16(w.x), lo16(w.y), hi16(w.y)}; x1 = (f32x4){lo16(w.z), hi16(w.z), lo16(w.w), hi16(w.w)}; }
                    else { x0 = *(const f32x4*)(xin + (size_t)row * DM + col); x1 = *(const f32x4*)(xin + (size_t)row * DM + col + 4); }
                    f32x4 v0 = acc[ai][bj][m][0] + x0, v1 = acc[ai][bj][m][1] + x1;
                    u32x4 ox; ox.x = pk2(v0.x, v0.y); ox.y = pk2(v0.z, v0.w); ox.z = pk2(v1.x, v1.y); ox.w = pk2(v1.z, v1.w); *(u32x4*)(xb + (size_t)row * DM + col) = ox;
                    v0 = (f32x4){lo16(ox.x), hi16(ox.x), lo16(ox.y), hi16(ox.y)}; v1 = (f32x4){lo16(ox.z), hi16(ox.z), lo16(ox.w), hi16(ox.w)};
                    const f32x4 g0 = *(const f32x4*)(g + col), g1 = *(const f32x4*)(g + col + 4);
                    u32x4 o; o.x = pk2(v0.x * g0.x, v0.y * g0.y); o.y = pk2(v0.z * g0.z, v0.w * g0.w); o.z = pk2(v1.x * g1.x, v1.y * g1.y); o.w = pk2(v1.z * g1.z, v1.w * g1.w); *(u32x4*)(xg + (size_t)row * DM + col) = o;
                    s += (v0.x * v0.x + v0.y * v0.y + v0.z * v0.z + v0.w * v0.w) + (v1.x * v1.x + v1.y * v1.y + v1.z * v1.z + v1.w * v1.w); }
                s += __shfl_xor(s, 16); s += __shfl_xor(s, 32);
                if (fq == 0) rowsq[(size_t)row * 16 + u.pn * 4 + wc] = s;
                asm volatile("" ::: "memory"); }
    }
};
struct EpiI16s {
    static constexpr bool PERM = true, AFTER_DRAIN = false;
    short* out; const float* rowsq;
    __device__ __forceinline__ static unsigned q2(float a, float b) { const int ia = (int)__builtin_rintf(fminf(fmaxf(a, -32767.f), 32767.f)), ib = (int)__builtin_rintf(fminf(fmaxf(b, -32767.f), 32767.f)); return ((unsigned)ia & 0xffffu) | ((unsigned)ib << 16); }
    __device__ __forceinline__ void operator()(const pg8::f32x4 (&acc)[2][2][4][2], const pg8::Unit& u, int wr, int wc, int fr, int fq) const {
        const int rloc = wr * 64 + fr, row0 = u.pm * 256 + rloc, col0 = u.pn * 256 + wc * 32 + 8 * fq;
        constexpr int ldc = PQW; const PG8_LAS float* rl = (const PG8_LAS float*)131072u; const PG8_LAS int* tg = (const PG8_LAS int*)133120u;
        const int sel = (u.pm == tg[0]) ? 0 : ((u.pm == tg[1]) ? 256 : -1);
#pragma unroll
        for (int ai = 0; ai < 2; ++ai)
#pragma unroll
            for (int m = 0; m < 4; ++m) { const int row = row0 + ai * 128 + m * 16; const float r = ((sel >= 0) ? rl[sel + rloc + ai * 128 + m * 16] : rstd_of(rowsq, (size_t)row)) * 2048.f;
#pragma unroll
                for (int bj = 0; bj < 2; ++bj) { const f32x4 a = acc[ai][bj][m][0] * r, b = acc[ai][bj][m][1] * r;
                    *(u32x4*)(out + (size_t)row * ldc + col0 + bj * 128) = (u32x4){q2(a.x, a.y), q2(a.z, a.w), q2(b.x, b.y), q2(b.z, b.w)}; } }
    }
};

template <class F, int MB = 4> struct EpiAdapt8L {
    static constexpr bool PERM = true, AFTER_DRAIN = false;
    F f;
    __device__ __forceinline__ void operator()(const pg8::f32x4 (&acc)[2][2][4][2], const pg8::Unit& u, int wr, int wc, int fr, int fq) const {
        const int row0 = u.pm * 256 + wr * 64 + fr, col0 = u.pn * 256 + wc * 32 + 8 * fq;
        typename F::C cc[2];
#pragma unroll
        for (int bj = 0; bj < 2; ++bj) cc[bj] = f.cols(col0 + bj * 128);
#pragma unroll
        for (int ai = 0; ai < 2; ++ai)
#pragma unroll
          for (int mb = 0; mb < 4; mb += MB) {
            typename F::L ld[MB][2];
#pragma unroll
            for (int m = 0; m < MB; ++m)
#pragma unroll
                for (int bj = 0; bj < 2; ++bj) ld[m][bj] = f.load(row0 + ai * 128 + (mb + m) * 16, col0 + bj * 128);
#pragma unroll
            for (int m = 0; m < MB; ++m) { float s = 0.f;
#pragma unroll
                for (int bj = 0; bj < 2; ++bj) s += f.apply(row0 + ai * 128 + (mb + m) * 16, col0 + bj * 128, acc[ai][bj][mb + m][0], acc[ai][bj][mb + m][1], ld[m][bj], cc[bj]);
                f.rowdone(row0 + ai * 128 + (mb + m) * 16, u.pn, wc, fq, s); }
            asm volatile("" ::: "memory");
          }
    }
};
struct EpiPool8L {
    const bf16_t* z; const float* pscale; bf16_t* gaa;
    struct L { u32x4 g; }; struct C { f32x4 p0, p1; };
    __device__ __forceinline__ C cols(int col) const { C c; c.p0 = *(const f32x4*)(pscale + col); c.p1 = *(const f32x4*)(pscale + col + 4); return c; }
    __device__ __forceinline__ L load(int row, int col) const { L l; l.g = *(const u32x4*)(z + (size_t)row * INW + 2048 + col); return l; }
    __device__ __forceinline__ float apply(int row, int col, f32x4 a, f32x4 b, const L& l, const C& c) const {
        u32x4 o; o.x = pk2(a.x * c.p0.x * lo16(l.g.x), a.y * c.p0.y * hi16(l.g.x)); o.y = pk2(a.z * c.p0.z * lo16(l.g.y), a.w * c.p0.w * hi16(l.g.y));
        o.z = pk2(b.x * c.p1.x * lo16(l.g.z), b.y * c.p1.y * hi16(l.g.z)); o.w = pk2(b.z * c.p1.z * lo16(l.g.w), b.w * c.p1.w * hi16(l.g.w));
        *(u32x4*)(gaa + (size_t)row * DM + col) = o; return 0.f; }
    __device__ __forceinline__ void rowdone(int, int, int, int, float) const {}
};
struct EpiUp8L {
    const bf16_t* z; const bf16_t* gaa; bf16_t* mrg;
    struct L { u32x4 g, q; }; struct C { int dummy; };
    __device__ __forceinline__ C cols(int) const { C c; c.dummy = 0; return c; }
    __device__ __forceinline__ L load(int row, int col) const { L l; l.g = *(const u32x4*)(z + (size_t)row * INW + 3072 + col); l.q = *(const u32x4*)(gaa + (size_t)row * DM + col); return l; }
    __device__ __forceinline__ float apply(int row, int col, f32x4 a, f32x4 b, const L& l, const C&) const {
        u32x4 o; o.x = pk2(lo16(l.q.x) + a.x * lo16(l.g.x), hi16(l.q.x) + a.y * hi16(l.g.x)); o.y = pk2(lo16(l.q.y) + a.z * lo16(l.g.y), hi16(l.q.y) + a.w * hi16(l.g.y));
        o.z = pk2(lo16(l.q.z) + b.x * lo16(l.g.z), hi16(l.q.z) + b.y * hi16(l.g.z)); o.w = pk2(lo16(l.q.w) + b.z * lo16(l.g.w), hi16(l.q.w) + b.w * hi16(l.g.w));
        *(u32x4*)(mrg + (size_t)row * DM + col) = o; return 0.f; }
    __device__ __forceinline__ void rowdone(int, int, int, int, float) const {}
};
template <bool XB> struct EpiResNormL {
    const float* xin; const bf16_t* xbin; bf16_t* xb; float* rowsq;
    struct LB { u32x4 w; }; struct LF { f32x4 x0, x1; }; typedef typename std::conditional<XB, LB, LF>::type L; struct C { int dummy; };
    __device__ __forceinline__ C cols(int) const { C c; c.dummy = 0; return c; }
    __device__ __forceinline__ L load(int row, int col) const { L l;
        if constexpr (XB) { l.w = *(const u32x4*)(xbin + (size_t)row * DM + col); } else { l.x0 = *(const f32x4*)(xin + (size_t)row * DM + col); l.x1 = *(const f32x4*)(xin + (size_t)row * DM + col + 4); }
        return l; }
    __device__ __forceinline__ float apply(int row, int col, f32x4 a, f32x4 b, const L& l, const C&) const {
        f32x4 v0, v1;
        if constexpr (XB) { v0 = a + (f32x4){lo16(l.w.x), hi16(l.w.x), lo16(l.w.y), hi16(l.w.y)}; v1 = b + (f32x4){lo16(l.w.z), hi16(l.w.z), lo16(l.w.w), hi16(l.w.w)}; } else { v0 = a + l.x0; v1 = b + l.x1; }
        u32x4 ox; ox.x = pk2(v0.x, v0.y); ox.y = pk2(v0.z, v0.w); ox.z = pk2(v1.x, v1.y); ox.w = pk2(v1.z, v1.w); *(u32x4*)(xb + (size_t)row * DM + col) = ox;
        v0 = (f32x4){lo16(ox.x), hi16(ox.x), lo16(ox.y), hi16(ox.y)}; v1 = (f32x4){lo16(ox.z), hi16(ox.z), lo16(ox.w), hi16(ox.w)};
        return (v0.x * v0.x + v0.y * v0.y + v0.z * v0.z + v0.w * v0.w) + (v1.x * v1.x + v1.y * v1.y + v1.z * v1.z + v1.w * v1.w); }
    __device__ __forceinline__ void rowdone(int row, int pn, int wc, int fq, float s) const { s += __shfl_xor(s, 16); s += __shfl_xor(s, 32); if (fq == 0) rowsq[(size_t)row * 16 + pn * 4 + wc] = s; }
};

struct EpiZk {
    static constexpr bool PERM = true, AFTER_DRAIN = false;
    bf16_t* z; float* kmean;
    __device__ __forceinline__ void operator()(const pg8::f32x4 (&acc)[2][2][4][2], const pg8::Unit& u, int wr, int wc, int fr, int fq) const {
        const int row0 = u.pm * 256 + wr * 64 + fr, col0 = u.pn * 256 + wc * 32 + 8 * fq; const EpiZ8 f{z};
#pragma unroll
        for (int ai = 0; ai < 2; ++ai)
#pragma unroll
            for (int m = 0; m < 4; ++m)
#pragma unroll
                for (int bj = 0; bj < 2; ++bj) { f(row0 + ai * 128 + m * 16, col0 + bj * 128, acc[ai][bj][m][0], acc[ai][bj][m][1]); asm volatile("" ::: "memory"); }
        if (u.pn == 4 || u.pn == 5) {
#pragma unroll
            for (int bj = 0; bj < 2; ++bj) { float cs[8];
#pragma unroll
                for (int e = 0; e < 8; ++e) cs[e] = 0.f;
#pragma unroll
                for (int ai = 0; ai < 2; ++ai)
#pragma unroll
                    for (int m = 0; m < 4; ++m) { const f32x4 a = acc[ai][bj][m][0], b = acc[ai][bj][m][1]; cs[0] += a.x; cs[1] += a.y; cs[2] += a.z; cs[3] += a.w; cs[4] += b.x; cs[5] += b.y; cs[6] += b.z; cs[7] += b.w; }
#pragma unroll
                for (int e = 0; e < 8; ++e) { cs[e] += __shfl_xor(cs[e], 1); cs[e] += __shfl_xor(cs[e], 2); cs[e] += __shfl_xor(cs[e], 4); cs[e] += __shfl_xor(cs[e], 8); }
                if (fr == 0) { float* kb = kmean + (size_t)u.pm * AW + (u.pn - 4) * 256 + bj * 128 + wc * 32 + 8 * fq;
#pragma unroll
                    for (int e = 0; e < 8; ++e) atomicAdd(kb + e, cs[e] * (1.f / MBLK)); } }
        }
    }
};

constexpr int NTHR = 512, NWAVE = 8;
constexpr int LDS_BYTES = 147456;
struct Args {
    const float* x; const float* mix_norm; const float* w_in; const float* w_pool; const float* pool_scale; const float* w_up; const float* w_out; const float* ffn_norm;
    const float* peer_wq; const float* peer_keys; const float* peer_u; const float* peer_v; const float* final_norm; float* out; unsigned char* ws;
};
#define LAS __attribute__((address_space(3)))
#define GAS __attribute__((address_space(1)))

__device__ __forceinline__ void ph_transpose(const float* __restrict__ W, bf16_t* __restrict__ Wt, int K, int N, float* smem) {
    const int tid_ = opq_tid();
    float (*tile)[33] = (float (*)[33])smem;
    const int tx = tid_ & 31, ty = tid_ >> 5, nbx = N / 32, nit = nbx * (K / 32);
    for (int it = blockIdx.x; it < nit; it += gridDim.x) {
        const int n0 = (it % nbx) * 32, k0 = (it / nbx) * 32;
        for (int i = ty; i < 32; i += 16) tile[i][tx] = W[(size_t)(k0 + i) * N + n0 + tx];
        __syncthreads();
        for (int i = ty; i < 32; i += 16) Wt[(size_t)(n0 + i) * K + k0 + tx] = (bf16_t)f2bf(tile[tx][i]);
        __syncthreads();
    }
}

__device__ __forceinline__ void ph_transpose_w(const float* W, bf16_t* Wt, int K, int N, unsigned char* lds_) {
    const int tid_ = opq_tid(); const int lane = tid_ & 63, wv = tid_ >> 6;
    LAS float* scr = (LAS float*)lds_ + wv * (64 * 33 + 32);
    const int nblk = N / 32, nitems = (K / 64) * nblk;
    for (int item = blockIdx.x * NWAVE + wv; item < nitems; item += gridDim.x * NWAVE) {
        const int kb = item / nblk, nb = item % nblk, k0 = 64 * kb, n0 = 32 * nb;
#pragma unroll 8
        for (int i = 0; i < 32; ++i) { const int kk = 2 * i + (lane >> 5); scr[kk * 33 + (lane & 31)] = W[(size_t)(k0 + kk) * N + n0 + (lane & 31)]; }
        const int c = lane & 7;
#pragma unroll
        for (int j = 0; j < 4; ++j) { const int n = (lane >> 3) + 8 * j; const LAS float* s = scr + (8 * c) * 33 + n;
            u32x4 o; o.x = pk2(s[0 * 33], s[1 * 33]); o.y = pk2(s[2 * 33], s[3 * 33]); o.z = pk2(s[4 * 33], s[5 * 33]); o.w = pk2(s[6 * 33], s[7 * 33]);
            *(u32x4*)(Wt + (size_t)(n0 + n) * K + k0 + 8 * c) = o; }
    }
}
__device__ __forceinline__ void ph_wpeer(const float* __restrict__ wq, const float* __restrict__ keys, bf16_t* __restrict__ Wp) {
    const int tid_ = opq_tid();
    for (int it = blockIdx.x; it < PQW * DM / NTHR; it += gridDim.x) {
        const int idx = it * NTHR + tid_; const int c = idx & 1023, n = idx >> 10, hp = n >> 7, k = n & 127, p = hp & 1;
        const float* a = wq + (size_t)c * PQW + hp * 128; const float* b = keys + ((size_t)p * NKEY + k) * 128; float s = 0.f;
        for (int d = 0; d < 128; ++d) s += a[d] * b[d];
        Wp[(size_t)n * DM + c] = (bf16_t)f2bf(s);
    }
}
__device__ __forceinline__ void ph_wpool_bd(const float* __restrict__ wp, bf16_t* __restrict__ Wbd) {
    const int tid_ = opq_tid();
    for (int it = blockIdx.x; it < DM * 256 / NTHR; it += gridDim.x) {
        const int idx = it * NTHR + tid_; const int k = idx & 255, n = idx >> 8, g = n >> 8;
        const float v = (k < 128) ? wp[((size_t)g * 128 + k) * 256 + (n & 255)] : 0.f;
        Wbd[(size_t)n * 256 + k] = (bf16_t)f2bf(v);
    }
}
__device__ __forceinline__ void ph_cvt(const float* __restrict__ src, bf16_t* __restrict__ dst, size_t n4) {
    const int tid_ = opq_tid();
    for (size_t i = (size_t)blockIdx.x * NTHR + tid_; i < n4; i += (size_t)gridDim.x * NTHR) {
        const f32x4 v = ((const f32x4*)src)[i]; u32x2 o; o.x = pk2(v.x, v.y); o.y = pk2(v.z, v.w); ((u32x2*)dst)[i] = o; }
}
__device__ __forceinline__ void ph_rmsnorm(const float* __restrict__ x, const float* __restrict__ g, bf16_t* __restrict__ out) {
    const int tid_ = opq_tid();
    const int lane = tid_ & 63, wv = tid_ >> 6;
    for (int it = blockIdx.x; it < T / NWAVE; it += gridDim.x) {
        const int row = it * NWAVE + wv; const f32x4* xr = (const f32x4*)(x + (size_t)row * DM); f32x4 v[4]; float s = 0.f;
#pragma unroll
        for (int j = 0; j < 4; ++j) { v[j] = xr[lane + 64 * j]; s += v[j].x * v[j].x + v[j].y * v[j].y + v[j].z * v[j].z + v[j].w * v[j].w; }
        const float rstd = rsqrtf(wave_sum(s) * (1.f / DM) + EPS);
#pragma unroll
        for (int j = 0; j < 4; ++j) { const f32x4 gg = ((const f32x4*)g)[lane + 64 * j]; u32x2 o; o.x = pk2(v[j].x * rstd * gg.x, v[j].y * rstd * gg.y); o.y = pk2(v[j].z * rstd * gg.z, v[j].w * rstd * gg.w);
            ((u32x2*)(out + (size_t)row * DM))[lane + 64 * j] = o; }
    }
}
template <class Epi> __device__ __forceinline__ void ph_gemm_naive(const bf16_t* __restrict__ A, int lda, int a_pn_off, const bf16_t* __restrict__ Bt, int ldb, int N, int K, Epi E) {
    const int tid_ = opq_tid();
    const int cg_ = tid_ & 63, rr = tid_ >> 6, nbx = N / 256, nit = nbx * (T / 8);
    for (int it = blockIdx.x; it < nit; it += gridDim.x) {
        const int bx = it % nbx, by = it / nbx; const int col0 = bx * 256 + cg_ * 4, row = by * 8 + rr;
        const bf16_t* a = A + (size_t)row * lda + (size_t)bx * a_pn_off; const bf16_t* b = Bt + (size_t)col0 * ldb;
        float acc[4] = {0.f, 0.f, 0.f, 0.f};
        for (int k = 0; k < K; k += 8) {
            const u32x4 av = *(const u32x4*)(a + k);
#pragma unroll
            for (int i = 0; i < 4; ++i) { const u32x4 bv = *(const u32x4*)(b + (size_t)i * ldb + k);
                acc[i] += lo16(av.x) * lo16(bv.x) + hi16(av.x) * hi16(bv.x) + lo16(av.y) * lo16(bv.y) + hi16(av.y) * hi16(bv.y)
                        + lo16(av.z) * lo16(bv.z) + hi16(av.z) * hi16(bv.z) + lo16(av.w) * lo16(bv.w) + hi16(av.w) * hi16(bv.w); }
        }
        E(row, col0, (f32x4){acc[0], acc[1], acc[2], acc[3]});
    }
}
__device__ __forceinline__ void ph_kmean(const bf16_t* __restrict__ z, float* __restrict__ kmean) {
    const int tid_ = opq_tid();
    for (int it = blockIdx.x; it < NB * NBLK; it += gridDim.x) {
        const int b = it / NBLK, blk = it % NBLK, c = tid_;
        const bf16_t* p = z + ((size_t)b * SEQ + blk * MBLK) * INW + 1024 + c; float s = 0.f;
        for (int r = 0; r < MBLK; ++r) s += bf2f(p[(size_t)r * INW]);
        kmean[((size_t)b * NBLK + blk) * AW + c] = s * (1.f / MBLK);
    }
}
__device__ __forceinline__ void ph_poolm(const bf16_t* __restrict__ z, bf16_t* __restrict__ m) {
    const int tid_ = opq_tid();
    const int c = tid_, w = 2 << (c >> 7);
    for (int it = blockIdx.x; it < T / 64; it += gridDim.x) {
        const int t0 = it * 64;
        for (int i = 0; i < 64; ++i) { const int t = t0 + i, pos = t & (SEQ - 1); const int cnt = (pos + 1 < w) ? pos + 1 : w; float s = 0.f;
            for (int j = 0; j < cnt; ++j) s += bf2f(z[(size_t)(t - j) * INW + c]);
            const float pv = bf2f(z[(size_t)t * INW + c]);
            m[(size_t)t * PW + c] = (bf16_t)f2bf(s / (float)cnt - pv); }
    }
}
__device__ __forceinline__ void ph_attn_naive(const bf16_t* __restrict__ z, const float* __restrict__ kmean, bf16_t* __restrict__ o, float* smem) {
    const int tid_ = opq_tid();
    float (*sc)[1024] = (float (*)[1024])smem;
    const int w = tid_ >> 6, lane = tid_ & 63;
    for (int it = blockIdx.x; it < T; it += gridDim.x) {
        const int t = it, h = w; const int b = t / SEQ, pos = t % SEQ, own = pos / MBLK;
        float q[64];
        { const u32x4* qp = (const u32x4*)(z + (size_t)t * INW + 512 + h * 64);
#pragma unroll
          for (int i = 0; i < 8; ++i) { const u32x4 v = qp[i]; q[8 * i] = lo16(v.x); q[8 * i + 1] = hi16(v.x); q[8 * i + 2] = lo16(v.y); q[8 * i + 3] = hi16(v.y); q[8 * i + 4] = lo16(v.z); q[8 * i + 5] = hi16(v.z); q[8 * i + 6] = lo16(v.w); q[8 * i + 7] = hi16(v.w); } }
        float bs[7];
#pragma unroll
        for (int j = 0; j < 7; ++j) { float s = -INFINITY; if (j < own) { s = 0.f; const float* km = kmean + ((size_t)b * NBLK + j) * AW + h * 64;
#pragma unroll
            for (int d = 0; d < 64; ++d) s += q[d] * km[d]; } bs[j] = s; }
        int sel[3];
#pragma unroll
        for (int r = 0; r < 3; ++r) { float best = -INFINITY; int bi = -1;
#pragma unroll
            for (int j = 0; j < 7; ++j) if (bs[j] > best) { best = bs[j]; bi = j; }
            sel[r] = bi;
#pragma unroll
            for (int j = 0; j < 7; ++j) if (j == bi) bs[j] = -INFINITY; }
        const float slope2 = exp2f(-(float)(h + 1)) * LOG2E;
        float mx = -INFINITY;
#pragma unroll
        for (int sg = 0; sg < 4; ++sg) {
            const int blk = (sg < 3) ? sel[sg] : own; if (blk < 0) continue;
            const int kb = blk * MBLK, cnt = (sg < 3) ? MBLK : (pos - kb + 1);
            for (int kk = lane; kk < cnt; kk += 64) {
                const u32x4* kp = (const u32x4*)(z + ((size_t)b * SEQ + kb + kk) * INW + 1024 + h * 64); float s = 0.f;
#pragma unroll
                for (int i = 0; i < 8; ++i) { const u32x4 v = kp[i]; s += q[8 * i] * lo16(v.x) + q[8 * i + 1] * hi16(v.x) + q[8 * i + 2] * lo16(v.y) + q[8 * i + 3] * hi16(v.y) + q[8 * i + 4] * lo16(v.z) + q[8 * i + 5] * hi16(v.z) + q[8 * i + 6] * lo16(v.w) + q[8 * i + 7] * hi16(v.w); }
                s -= slope2 * (float)(pos - (kb + kk)); sc[w][sg * 256 + kk] = s; mx = fmaxf(mx, s); }
        }
        mx = wave_max(mx); float sum = 0.f;
#pragma unroll
        for (int sg = 0; sg < 4; ++sg) {
            const int blk = (sg < 3) ? sel[sg] : own; if (blk < 0) continue;
            const int kb = blk * MBLK, cnt = (sg < 3) ? MBLK : (pos - kb + 1);
            for (int kk = lane; kk < cnt; kk += 64) { const float p = exp2f(sc[w][sg * 256 + kk] - mx); sc[w][sg * 256 + kk] = p; sum += p; }
        }
        sum = wave_sum(sum);
        __syncthreads();
        float acc = 0.f;
#pragma unroll
        for (int sg = 0; sg < 4; ++sg) {
            const int blk = (sg < 3) ? sel[sg] : own; if (blk < 0) continue;
            const int kb = blk * MBLK, cnt = (sg < 3) ? MBLK : (pos - kb + 1);
            const bf16_t* vp = z + ((size_t)b * SEQ + kb) * INW + 1536 + h * 64 + lane;
            for (int kk = 0; kk < cnt; ++kk) acc += sc[w][sg * 256 + kk] * bf2f(vp[(size_t)kk * INW]);
        }
        o[(size_t)t * AW + h * 64 + lane] = (bf16_t)f2bf(acc / sum);
        __syncthreads();
    }
}
__device__ __forceinline__ void ph_topk_naive(const float* __restrict__ scores, int* __restrict__ eid, float* __restrict__ gw, float* smem) {
    const int tid_ = opq_tid();
    float (*svl)[2][16] = (float (*)[2][16])smem; int (*sil)[2][16] = (int (*)[2][16])(smem + 256); float (*cvl)[16] = (float (*)[16])(smem + 512); int (*cil)[16] = (int (*)[16])(smem + 640);
    const int w = tid_ >> 6, lane = tid_ & 63;
    for (int it = blockIdx.x; it < T; it += gridDim.x) {
        const int t = it, h = w;
        for (int p = 0; p < 2; ++p) {
            const float* s = scores + (size_t)t * PQW + h * 256 + p * 128;
            float v0 = s[lane], v1 = s[lane + 64];
            for (int r = 0; r < 16; ++r) {
                float bv; int bi; if (v0 >= v1) { bv = v0; bi = lane; } else { bv = v1; bi = lane + 64; }
#pragma unroll
                for (int o = 1; o < 64; o <<= 1) { const float ov = __shfl_xor(bv, o); const int oi = __shfl_xor(bi, o); if (ov > bv || (ov == bv && oi < bi)) { bv = ov; bi = oi; } }
                if (lane == 0) { svl[w][p][r] = bv; sil[w][p][r] = bi; }
                if (bi == lane) v0 = -INFINITY; if (bi == lane + 64) v1 = -INFINITY;
            }
        }
        __syncthreads();
        float cv[4];
#pragma unroll
        for (int m = 0; m < 4; ++m) { const int c = lane + 64 * m; cv[m] = svl[w][0][c >> 4] + svl[w][1][c & 15]; }
        for (int r = 0; r < 16; ++r) {
            float bv = cv[0]; int bi = lane;
#pragma unroll
            for (int m = 1; m < 4; ++m) if (cv[m] > bv) { bv = cv[m]; bi = lane + 64 * m; }
#pragma unroll
            for (int o = 1; o < 64; o <<= 1) { const float ov = __shfl_xor(bv, o); const int oi = __shfl_xor(bi, o); if (ov > bv || (ov == bv && oi < bi)) { bv = ov; bi = oi; } }
            if (lane == 0) { cvl[w][r] = bv; cil[w][r] = bi; }
#pragma unroll
            for (int m = 0; m < 4; ++m) if (bi == lane + 64 * m) cv[m] = -INFINITY;
        }
        __syncthreads();
        if (lane < 16) {
            const float mx = cvl[w][0]; float sum = 0.f;
            for (int r = 0; r < 16; ++r) sum += __expf(cvl[w][r] - mx);
            const int c = cil[w][lane];
            eid[(size_t)t * NSLOT + h * 16 + lane] = sil[w][0][c >> 4] * NKEY + sil[w][1][c & 15];
            gw[(size_t)t * NSLOT + h * 16 + lane] = __expf(cvl[w][lane] - mx) / sum;
        }
        __syncthreads();
    }
}
__device__ __forceinline__ void ph_peer_u(const bf16_t* __restrict__ hn, const bf16_t* __restrict__ Ub, const int* __restrict__ eid, const float* __restrict__ gw, float* __restrict__ wact) {
    const int tid_ = opq_tid();
    const int lane = tid_ & 63, wv = tid_ >> 6;
    for (int it = blockIdx.x; it < T / NWAVE; it += gridDim.x) {
        const int t = it * NWAVE + wv;
        const u32x4 h0 = *(const u32x4*)(hn + (size_t)t * DM + lane * 8), h1 = *(const u32x4*)(hn + (size_t)t * DM + 512 + lane * 8);
        for (int s = 0; s < NSLOT; ++s) {
            const int e = eid[(size_t)t * NSLOT + s]; const bf16_t* row = Ub + (size_t)e * DM;
            const u32x4 a = *(const u32x4*)(row + lane * 8), b = *(const u32x4*)(row + 512 + lane * 8);
            float d = lo16(a.x) * lo16(h0.x) + hi16(a.x) * hi16(h0.x) + lo16(a.y) * lo16(h0.y) + hi16(a.y) * hi16(h0.y) + lo16(a.z) * lo16(h0.z) + hi16(a.z) * hi16(h0.z) + lo16(a.w) * lo16(h0.w) + hi16(a.w) * hi16(h0.w)
                    + lo16(b.x) * lo16(h1.x) + hi16(b.x) * hi16(h1.x) + lo16(b.y) * lo16(h1.y) + hi16(b.y) * hi16(h1.y) + lo16(b.z) * lo16(h1.z) + hi16(b.z) * hi16(h1.z) + lo16(b.w) * lo16(h1.w) + hi16(b.w) * hi16(h1.w);
            d = wave_sum(d);
            if (lane == 0) wact[(size_t)t * NSLOT + s] = gw[(size_t)t * NSLOT + s] * gelu_tanh(d);
        }
    }
}
__device__ __forceinline__ void ph_peer_v(float* __restrict__ xres, const bf16_t* __restrict__ Vb, const int* __restrict__ eid, const float* __restrict__ wact, const float* __restrict__ gn, bf16_t* __restrict__ hout, int last) {
    const int tid_ = opq_tid();
    const int lane = tid_ & 63, wv = tid_ >> 6;
    for (int it = blockIdx.x; it < T / NWAVE; it += gridDim.x) {
        const int t = it * NWAVE + wv;
        float acc[16];
#pragma unroll
        for (int i = 0; i < 16; ++i) acc[i] = 0.f;
        for (int s = 0; s < NSLOT; ++s) {
            const int e = eid[(size_t)t * NSLOT + s]; const float w = wact[(size_t)t * NSLOT + s]; const bf16_t* row = Vb + (size_t)e * DM;
            const u32x4 a = *(const u32x4*)(row + lane * 8), b = *(const u32x4*)(row + 512 + lane * 8);
            acc[0] += w * lo16(a.x); acc[1] += w * hi16(a.x); acc[2] += w * lo16(a.y); acc[3] += w * hi16(a.y); acc[4] += w * lo16(a.z); acc[5] += w * hi16(a.z); acc[6] += w * lo16(a.w); acc[7] += w * hi16(a.w);
            acc[8] += w * lo16(b.x); acc[9] += w * hi16(b.x); acc[10] += w * lo16(b.y); acc[11] += w * hi16(b.y); acc[12] += w * lo16(b.z); acc[13] += w * hi16(b.z); acc[14] += w * lo16(b.w); acc[15] += w * hi16(b.w);
        }
        float* xr = xres + (size_t)t * DM; float ss = 0.f;
#pragma unroll
        for (int hf = 0; hf < 2; ++hf)
#pragma unroll
            for (int j = 0; j < 2; ++j) { const f32x4 xv = *(const f32x4*)(xr + hf * 512 + lane * 8 + j * 4);
                acc[hf * 8 + j * 4 + 0] += xv.x; acc[hf * 8 + j * 4 + 1] += xv.y; acc[hf * 8 + j * 4 + 2] += xv.z; acc[hf * 8 + j * 4 + 3] += xv.w; }
#pragma unroll
        for (int i = 0; i < 16; ++i) ss += acc[i] * acc[i];
        const float rstd = rsqrtf(wave_sum(ss) * (1.f / DM) + EPS);
#pragma unroll
        for (int hf = 0; hf < 2; ++hf)
#pragma unroll
            for (int j = 0; j < 2; ++j) { const int c = hf * 512 + lane * 8 + j * 4; const f32x4 g = *(const f32x4*)(gn + c); const int a0 = hf * 8 + j * 4;
                if (last) { *(f32x4*)(xr + c) = (f32x4){acc[a0] * rstd * g.x, acc[a0 + 1] * rstd * g.y, acc[a0 + 2] * rstd * g.z, acc[a0 + 3] * rstd * g.w}; }
                else { *(f32x4*)(xr + c) = (f32x4){acc[a0], acc[a0 + 1], acc[a0 + 2], acc[a0 + 3]};
                    u32x2 ob; ob.x = pk2(acc[a0] * rstd * g.x, acc[a0 + 1] * rstd * g.y); ob.y = pk2(acc[a0 + 2] * rstd * g.z, acc[a0 + 3] * rstd * g.w); *(u32x2*)(hout + (size_t)t * DM + c) = ob; } }
    }
}


__device__ __forceinline__ void ph_poolm2(const bf16_t* z, bf16_t* m) {
    const int tid_ = opq_tid(); const int c = tid_, wsel = c >> 7, w = 2 << wsel;
    for (int it = blockIdx.x; it < T / 64; it += gridDim.x) {
        const int t0 = it * 64, pos0 = t0 & (SEQ - 1);
        float x[32];
#pragma unroll
        for (int i = 0; i < 16; ++i) x[i] = (pos0 == 0) ? 0.f : bf2f(z[(size_t)(t0 - 16 + i) * INW + c]);
#pragma unroll 1
        for (int bt = 0; bt < 4; ++bt) {
#pragma unroll
            for (int i = 0; i < 16; ++i) x[16 + i] = bf2f(z[(size_t)(t0 + bt * 16 + i) * INW + c]);
            float s1[32], s2[32], s3[32], s4[32];
#pragma unroll
            for (int i = 1; i < 32; ++i) s1[i] = x[i] + x[i - 1];
#pragma unroll
            for (int i = 3; i < 32; ++i) s2[i] = s1[i] + s1[i - 2];
#pragma unroll
            for (int i = 7; i < 32; ++i) s3[i] = s2[i] + s2[i - 4];
#pragma unroll
            for (int i = 16; i < 32; ++i) s4[i] = s3[i] + s3[i - 8];
#pragma unroll
            for (int i = 16; i < 32; ++i) { const int pos = pos0 + bt * 16 + (i - 16); const int cnt = (pos + 1 < w) ? pos + 1 : w;
                const float s = (wsel == 0) ? s1[i] : (wsel == 1) ? s2[i] : (wsel == 2) ? s3[i] : s4[i];
                m[(size_t)(t0 + bt * 16 + i - 16) * PW + c] = (bf16_t)f2bf(s / (float)cnt - x[i]); }
#pragma unroll
            for (int i = 0; i < 16; ++i) x[i] = x[16 + i];
        }
    }
}
__device__ __forceinline__ void ph_wpeer2(const float* wq, const float* keys, const float* gf, bf16_t* Wp, float* smem) {
    const int tid_ = opq_tid(); const int kq = tid_ & 31, cq = tid_ >> 5;
    float* kl = smem; float* wl = smem + 128 * 129;
    for (int it = blockIdx.x; it < 16 * 16; it += gridDim.x) {
        const int hp = it >> 4, c0 = (it & 15) * 64, p = hp & 1;
        for (int i = tid_; i < 128 * 32; i += NTHR) { const int row = i >> 5, d4 = (i & 31) * 4; const f32x4 v = *(const f32x4*)(keys + ((size_t)p * NKEY + row) * 128 + d4);
            kl[row * 129 + d4] = v.x; kl[row * 129 + d4 + 1] = v.y; kl[row * 129 + d4 + 2] = v.z; kl[row * 129 + d4 + 3] = v.w; }
        for (int i = tid_; i < 64 * 32; i += NTHR) { const int row = i >> 5, d4 = (i & 31) * 4; const f32x4 v = *(const f32x4*)(wq + (size_t)(c0 + row) * PQW + hp * 128 + d4);
            wl[row * 129 + d4] = v.x; wl[row * 129 + d4 + 1] = v.y; wl[row * 129 + d4 + 2] = v.z; wl[row * 129 + d4 + 3] = v.w; }
        __syncthreads();
        float acc[4][4];
#pragma unroll
        for (int i = 0; i < 4; ++i)
#pragma unroll
            for (int j = 0; j < 4; ++j) acc[i][j] = 0.f;
        for (int d = 0; d < 128; ++d) {
            float av[4], bv[4];
#pragma unroll
            for (int i = 0; i < 4; ++i) { av[i] = kl[(kq + 32 * i) * 129 + d]; bv[i] = wl[(cq + 16 * i) * 129 + d]; }
#pragma unroll
            for (int i = 0; i < 4; ++i)
#pragma unroll
                for (int j = 0; j < 4; ++j) acc[i][j] += av[i] * bv[j];
        }
#pragma unroll
        for (int i = 0; i < 4; ++i)
#pragma unroll
            for (int j = 0; j < 4; ++j) Wp[(size_t)(hp * 128 + kq + 32 * i) * DM + c0 + cq + 16 * j] = (bf16_t)f2bf(acc[i][j] * gf[c0 + cq + 16 * j]);
        __syncthreads();
    }
}

typedef short bf16x8_t __attribute__((ext_vector_type(8)));
typedef float f32x16 __attribute__((ext_vector_type(16)));
typedef short v4i16_t __attribute__((ext_vector_type(4)));
typedef float f32x2_t __attribute__((ext_vector_type(2)));
typedef __bf16 bf16x2_t __attribute__((ext_vector_type(2)));
__device__ __forceinline__ unsigned cvtpk(float lo, float hi) { f32x2_t v = {lo, hi}; bf16x2_t b = __builtin_convertvector(v, bf16x2_t); return __builtin_bit_cast(unsigned, b); }
constexpr int AT_ROW = 144, AT_TILE = 64 * AT_ROW;
__device__ __forceinline__ void ph_attn(unsigned char* lds_, const bf16_t* z, const float* kmean, bf16_t* o) {
    LAS unsigned char* lds = (LAS unsigned char*)lds_;
    const int tid = opq_tid(), lane = tid & 63, wv = __builtin_amdgcn_readfirstlane(tid >> 6), r = lane & 31, hi = lane >> 5;
    const int srow = tid >> 3, sch = tid & 7;
    const unsigned st_off = srow * AT_ROW + sch * 16;
    const unsigned k_off = r * AT_ROW + hi * 16;
    const unsigned v_off = (4 * hi + ((lane & 15) >> 2)) * AT_ROW + (16 * ((lane >> 4) & 1) + 4 * (lane & 3)) * 2;
    LAS float* kml = (LAS float*)(lds + 4 * AT_TILE);
    for (int pr = blockIdx.x; pr < 256; pr += gridDim.x) {
#pragma unroll 1
        for (int uu = 0; uu < 2; ++uu) {
            const int bh = pr >> 2, qb = uu == 0 ? (pr & 3) : 7 - (pr & 3);
            const int b = bh >> 3, h = bh & 7, own = qb, q0 = qb * MBLK;
            const size_t rowbase = (size_t)b * SEQ;
            const int qrel = wv * 32 + r;
            bf16x8_t qf[4];
            { const bf16_t* qptr = z + (rowbase + q0 + qrel) * INW + 512 + h * 64 + hi * 8;
#pragma unroll
              for (int ds = 0; ds < 4; ++ds) qf[ds] = *(const bf16x8_t*)(qptr + ds * 16); }
            unsigned selmask = 0;
            if (own > 0) {
                float bs[7];
#pragma unroll
                for (int j = 0; j < 7; ++j) { float s = -INFINITY;
                    if (j < own) { const float* km = kmean + ((size_t)b * NBLK + j) * AW + h * 64 + hi * 8; s = 0.f;
#pragma unroll
                        for (int ds = 0; ds < 4; ++ds) { const f32x4 k0 = *(const f32x4*)(km + ds * 16), k1 = *(const f32x4*)(km + ds * 16 + 4);
                            s += bf2f((bf16_t)qf[ds][0]) * k0.x + bf2f((bf16_t)qf[ds][1]) * k0.y + bf2f((bf16_t)qf[ds][2]) * k0.z + bf2f((bf16_t)qf[ds][3]) * k0.w
                               + bf2f((bf16_t)qf[ds][4]) * k1.x + bf2f((bf16_t)qf[ds][5]) * k1.y + bf2f((bf16_t)qf[ds][6]) * k1.z + bf2f((bf16_t)qf[ds][7]) * k1.w; }
                        s += __shfl_xor(s, 32); }
                    bs[j] = s; }
#pragma unroll
                for (int rr = 0; rr < 3; ++rr) { float best = -INFINITY; int bi = -1;
#pragma unroll
                    for (int j = 0; j < 7; ++j) if (bs[j] > best) { best = bs[j]; bi = j; }
                    if (bi >= 0) selmask |= 1u << bi;
#pragma unroll
                    for (int j = 0; j < 7; ++j) if (j == bi) bs[j] = -INFINITY; }
            }
            const float slope2 = exp2f(-(float)(h + 1)) * LOG2E;
            const float hoff = slope2 * (float)(4 * hi);
            f32x16 o0, o1;
#pragma unroll
            for (int i = 0; i < 16; ++i) { o0[i] = 0.f; o1[i] = 0.f; }
            float mrun = 0.f, lrun = 0.f;
            const int NS = 2 * (own + 1);
            const unsigned kv_voff = (unsigned)(srow * INW + sch * 8) * 2u;
#define AT_KVLOAD(kd, vd, kvabs_) do { const GAS char* kvb_ = (const GAS char*)z + ((size_t)(rowbase + (kvabs_)) * INW + 1024 + h * 64) * 2; asm("" : "+s"(kvb_)); unsigned vo_ = kv_voff; asm("" : "+v"(vo_)); \
                kd[0] = *(const GAS u32x4*)(kvb_ + vo_); vd[0] = *(const GAS u32x4*)(kvb_ + 1024 + vo_); kd[1] = *(const GAS u32x4*)(kvb_ + 64 * INW * 2 + vo_); vd[1] = *(const GAS u32x4*)(kvb_ + 64 * INW * 2 + 1024 + vo_); } while (0)
#define AT_KVABS(s_) (((s_) < 2) ? own * MBLK + (s_) * 128 : ((s_) - 2) * 128)
#define AT_WRITE(buf_, kd, vd) do { *(LAS u32x4*)(lds + ((buf_) * 4 + 0) * AT_TILE + st_off) = kd[0]; *(LAS u32x4*)(lds + ((buf_) * 4 + 1) * AT_TILE + st_off) = kd[1]; \
                *(LAS u32x4*)(lds + ((buf_) * 4 + 2) * AT_TILE + st_off) = vd[0]; *(LAS u32x4*)(lds + ((buf_) * 4 + 3) * AT_TILE + st_off) = vd[1]; } while (0)
            u32x4 kr[2], vr[2];
            { AT_KVLOAD(kr, vr, own * MBLK); AT_WRITE(0, kr, vr); }
            __syncthreads();
            for (int i0 = 0; i0 < NS; i0 += 2) {
#pragma unroll
              for (int u = 0; u < 2; ++u) {
                const int i = i0 + u; const int cur = u;
                { const int i2 = (i + 1 < NS) ? i + 1 : NS - 1; AT_KVLOAD(kr, vr, AT_KVABS(i2)); }
                int mode[2]; float base[2]; int kv0[2];
#pragma unroll
                for (int sb = 0; sb < 2; ++sb) {
                    if (i < 2) { kv0[sb] = i * 128 + sb * 64; mode[sb] = (kv0[sb] > wv * 32 + 31) ? 0 : ((kv0[sb] + 63 <= wv * 32) ? 1 : 2); base[sb] = slope2 * (float)(kv0[sb] - qrel); }
                    else { kv0[sb] = 0; const int blk = (i - 2) >> 1; const bool sel = (selmask >> blk) & 1u; mode[sb] = __any(sel) ? 1 : 0; base[sb] = sel ? slope2 * (float)((i - 2) * 128 + sb * 64 - q0 - qrel) : -INFINITY; } }
                if (mode[0] | mode[1]) {
                    f32x16 p[2][2];
#pragma unroll
                    for (int sb = 0; sb < 2; ++sb) { const float base2 = (mode[sb] ? base[sb] : -INFINITY) + hoff - mrun;
#pragma unroll
                        for (int e = 0; e < 16; ++e) { p[sb][0][e] = fmaf(slope2, (float)((e & 3) + 8 * (e >> 2)), base2); p[sb][1][e] = fmaf(slope2, (float)((e & 3) + 8 * (e >> 2) + 32), base2); }
                        if (mode[sb] == 2) {
#pragma unroll
                            for (int e = 0; e < 16; ++e) { const int kvr = kv0[sb] + (e & 3) + 8 * (e >> 2) + 4 * hi; if (kvr > qrel) p[sb][0][e] = -INFINITY; if (kvr + 32 > qrel) p[sb][1][e] = -INFINITY; } } }
#pragma unroll
                    for (int sb = 0; sb < 2; ++sb) if (mode[sb]) {
                        const LAS unsigned char* kb = lds + (cur * 4 + sb) * AT_TILE + k_off;
#pragma unroll
                        for (int kh = 0; kh < 2; ++kh) { bf16x8_t ka[4];
#pragma unroll
                            for (int ds = 0; ds < 4; ++ds) ka[ds] = *(const LAS bf16x8_t*)(kb + kh * 32 * AT_ROW + ds * 32);
                            asm volatile("s_waitcnt lgkmcnt(0)" : "+v"(ka[0]), "+v"(ka[1]), "+v"(ka[2]), "+v"(ka[3]) :: "memory");
#pragma unroll
                            for (int ds = 0; ds < 4; ++ds) p[sb][kh] = __builtin_amdgcn_mfma_f32_32x32x16_bf16(ka[ds], qf[ds], p[sb][kh], 0, 0, 0); } }
                    float mloc = fmaxf(fmaxf(p[0][0][0], p[0][1][0]), fmaxf(p[1][0][0], p[1][1][0]));
#pragma unroll
                    for (int e = 1; e < 16; ++e) mloc = fmaxf(mloc, fmaxf(fmaxf(p[0][0][e], p[0][1][e]), fmaxf(p[1][0][e], p[1][1][e])));
                    mloc = fmaxf(mloc, __shfl_xor(mloc, 32));
                    const float delta = (i == 0) ? mloc : fmaxf(mloc, 0.f);
                    if (__any(delta != 0.f)) {
#pragma unroll
                        for (int e = 0; e < 16; ++e) { p[0][0][e] -= delta; p[0][1][e] -= delta; p[1][0][e] -= delta; p[1][1][e] -= delta; }
                        mrun += delta;
                        if (i > 0) { const float alpha = __builtin_amdgcn_exp2f(-delta); lrun *= alpha;
#pragma unroll
                            for (int e = 0; e < 16; ++e) { o0[e] *= alpha; o1[e] *= alpha; } }
                    }
#pragma unroll
                    for (int sb = 0; sb < 2; ++sb) if (mode[sb]) {
                        float ls = 0.f;
#pragma unroll
                        for (int e = 0; e < 16; ++e) { p[sb][0][e] = __builtin_amdgcn_exp2f(p[sb][0][e]); p[sb][1][e] = __builtin_amdgcn_exp2f(p[sb][1][e]); ls += p[sb][0][e] + p[sb][1][e]; }
                        lrun += ls;
                        u32x4 pb[2][2];
#pragma unroll
                        for (int s = 0; s < 2; ++s) { pb[0][s] = (u32x4){cvtpk(p[sb][0][8 * s], p[sb][0][8 * s + 1]), cvtpk(p[sb][0][8 * s + 2], p[sb][0][8 * s + 3]), cvtpk(p[sb][0][8 * s + 4], p[sb][0][8 * s + 5]), cvtpk(p[sb][0][8 * s + 6], p[sb][0][8 * s + 7])};
                            pb[1][s] = (u32x4){cvtpk(p[sb][1][8 * s], p[sb][1][8 * s + 1]), cvtpk(p[sb][1][8 * s + 2], p[sb][1][8 * s + 3]), cvtpk(p[sb][1][8 * s + 4], p[sb][1][8 * s + 5]), cvtpk(p[sb][1][8 * s + 6], p[sb][1][8 * s + 7])}; }
                        const LAS unsigned char* vb = lds + (cur * 4 + 2 + sb) * AT_TILE + v_off;
#pragma unroll
                        for (int kh = 0; kh < 2; ++kh) { v4i16_t vlo[4], vhh[4];
#pragma unroll
                            for (int s = 0; s < 2; ++s)
#pragma unroll
                                for (int dh = 0; dh < 2; ++dh) { const LAS unsigned char* va = vb + (32 * kh + 16 * s) * AT_ROW + dh * 64; const int ix = s * 2 + dh;
                                    vlo[ix] = __builtin_amdgcn_ds_read_tr16_b64_v4i16((LAS v4i16_t*)(va)); vhh[ix] = __builtin_amdgcn_ds_read_tr16_b64_v4i16((LAS v4i16_t*)(va + 8 * AT_ROW)); }
                            asm volatile("s_waitcnt lgkmcnt(0)" : "+v"(vlo[0]), "+v"(vlo[1]), "+v"(vlo[2]), "+v"(vlo[3]), "+v"(vhh[0]), "+v"(vhh[1]), "+v"(vhh[2]), "+v"(vhh[3]) :: "memory");
#pragma unroll
                            for (int s = 0; s < 2; ++s) { const bf16x8_t pf = __builtin_bit_cast(bf16x8_t, pb[kh][s]);
#pragma unroll
                                for (int dh = 0; dh < 2; ++dh) { const int ix = s * 2 + dh;
                                    const bf16x8_t vf = (bf16x8_t){vlo[ix][0], vlo[ix][1], vlo[ix][2], vlo[ix][3], vhh[ix][0], vhh[ix][1], vhh[ix][2], vhh[ix][3]};
                                    if (dh == 0) o0 = __builtin_amdgcn_mfma_f32_32x32x16_bf16(vf, pf, o0, 0, 0, 0); else o1 = __builtin_amdgcn_mfma_f32_32x32x16_bf16(vf, pf, o1, 0, 0, 0); } } }
                    }
                }
                AT_WRITE(cur ^ 1, kr, vr);
                __syncthreads();
              }
            }
#undef AT_KVLOAD
#undef AT_KVABS
#undef AT_WRITE
            lrun += __shfl_xor(lrun, 32);
            const float rl = 1.f / lrun;
            bf16_t* op = o + (rowbase + q0 + qrel) * AW + h * 64 + 4 * hi;
#pragma unroll
            for (int g = 0; g < 4; ++g) {
                u32x2 w0, w1; w0.x = cvtpk(o0[4 * g] * rl, o0[4 * g + 1] * rl); w0.y = cvtpk(o0[4 * g + 2] * rl, o0[4 * g + 3] * rl);
                w1.x = cvtpk(o1[4 * g] * rl, o1[4 * g + 1] * rl); w1.y = cvtpk(o1[4 * g + 2] * rl, o1[4 * g + 3] * rl);
                *(u32x2*)(op + 8 * g) = w0; *(u32x2*)(op + 32 + 8 * g) = w1; }
        }
    }
}


__device__ __forceinline__ void ce_desc(float& a, float& b) {
    float mx, mn; asm("v_max_f32 %0, %1, %2" : "=v"(mx) : "v"(a), "v"(b)); asm("v_min_f32 %0, %1, %2" : "=v"(mn) : "v"(a), "v"(b)); a = mx; b = mn;
}
__device__ __forceinline__ float vmaxf(float a, float b) { float mx; asm("v_max_f32 %0, %1, %2" : "=v"(mx) : "v"(a), "v"(b)); return mx; }
template <int N> __device__ __forceinline__ void bitonic_sort_desc(float (&v)[N]) {
#pragma unroll
    for (int k = 2; k <= N; k <<= 1)
#pragma unroll
        for (int j = k >> 1; j > 0; j >>= 1)
#pragma unroll
            for (int i = 0; i < N; ++i) { const int l = i ^ j; if (l > i) { if ((i & k) == 0) ce_desc(v[i], v[l]); else ce_desc(v[l], v[i]); } }
}
template <int N> __device__ __forceinline__ void bitonic_merge_desc(float (&v)[N]) {
#pragma unroll
    for (int j = N >> 1; j > 0; j >>= 1)
#pragma unroll
        for (int i = 0; i < N; ++i) { const int l = i ^ j; if (l > i) ce_desc(v[i], v[l]); }
}
__device__ __forceinline__ void merge_top16(float (&a)[16], const float (&b)[16]) {
#pragma unroll
    for (int i = 0; i < 16; ++i) a[i] = vmaxf(a[i], b[15 - i]);
    bitonic_merge_desc<16>(a);
}
constexpr int TK_ROW = 68;
__device__ __forceinline__ void ph_topk(unsigned char* lds_, const short* scores, int* eid, float* gw, int* offs, const int task) {
    const int tid = opq_tid(), lane = tid & 63, wv = __builtin_amdgcn_readfirstlane(tid >> 6);
    LAS float* stg = (LAS float*)lds_ + wv * (64 * TK_ROW);
    {
        const short* base = scores + (size_t)task * 64 * 256;
        float top[2][16];
        u32x2 pre[16];
#pragma unroll
        for (int i = 0; i < 16; ++i) pre[i] = *(const u32x2*)(base + (size_t)(4 * i + (lane >> 4)) * 256 + (lane & 15) * 4);
#pragma unroll
        for (int p = 0; p < 2; ++p) {
#pragma unroll
            for (int rd = 0; rd < 2; ++rd) {
#pragma unroll
                for (int i = 0; i < 16; ++i) { const int jj = 4 * i + (lane >> 4);
                    const u32x2 w = pre[i];
                    const f32x4 v = (f32x4){(float)(short)(w.x & 0xffffu), (float)((int)w.x >> 16), (float)(short)(w.y & 0xffffu), (float)((int)w.y >> 16)} * (1.f / 2048.f);
                    *(LAS f32x4*)(stg + jj * TK_ROW + (lane & 15) * 4) = v; }
                if (p * 2 + rd < 3) { const int qn = p * 2 + rd + 1;
#pragma unroll
                    for (int i = 0; i < 16; ++i) pre[i] = *(const u32x2*)(base + (size_t)(4 * i + (lane >> 4)) * 256 + (qn >> 1) * 128 + (qn & 1) * 64 + (lane & 15) * 4); }
                float blk[4][16];
#pragma unroll
                for (int g = 0; g < 4; ++g)
#pragma unroll
                    for (int c = 0; c < 4; ++c) { const f32x4 v = *(const LAS f32x4*)(stg + lane * TK_ROW + g * 16 + c * 4);
#pragma unroll
                        for (int e = 0; e < 4; ++e) { const unsigned idx = rd * 64 + g * 16 + c * 4 + e; blk[g][c * 4 + e] = __uint_as_float((__float_as_uint(v[e]) & ~127u) | idx); } }
#pragma unroll
                for (int g = 0; g < 4; ++g) bitonic_sort_desc<16>(blk[g]);
                merge_top16(blk[0], blk[1]); merge_top16(blk[2], blk[3]); merge_top16(blk[0], blk[2]);
                if (rd == 0) {
#pragma unroll
                    for (int e = 0; e < 16; ++e) top[p][e] = blk[0][e];
                } else merge_top16(top[p], blk[0]);
            }
        }
        LAS unsigned* tab = (LAS unsigned*)(stg + lane * TK_ROW);
#pragma unroll
        for (int p = 0; p < 2; ++p)
#pragma unroll
            for (int q = 0; q < 4; ++q) { unsigned w = 0;
#pragma unroll
                for (int e = 0; e < 4; ++e) w |= (__float_as_uint(top[p][4 * q + e]) & 127u) << (8 * e);
                tab[p * 4 + q] = w; }
#define CAND(i, j) __uint_as_float((__float_as_uint(top[0][i] + top[1][j]) & ~255u) | (unsigned)((i) * 16 + (j)))
        float A[16], Bv[16], C[16], Dv[16];
#pragma unroll
        for (int j = 0; j < 16; ++j) A[j] = CAND(0, j);
#pragma unroll
        for (int i = 1; i < 16; ++i) Bv[i - 1] = CAND(i, 0);
        Bv[15] = -INFINITY;
#pragma unroll
        for (int j = 1; j < 8; ++j) Dv[j - 1] = CAND(1, j);
#pragma unroll
        for (int j = 7; j < 16; ++j) Dv[j] = -INFINITY;
        C[0] = CAND(2, 1); C[1] = CAND(2, 2); C[2] = CAND(2, 3); C[3] = CAND(2, 4); C[4] = CAND(3, 1); C[5] = CAND(3, 2); C[6] = CAND(3, 3); C[7] = CAND(4, 1); C[8] = CAND(4, 2);
        C[9] = CAND(5, 1); C[10] = CAND(6, 1); C[11] = CAND(7, 1); C[12] = -INFINITY; C[13] = -INFINITY; C[14] = -INFINITY; C[15] = -INFINITY;
#undef CAND
        bitonic_sort_desc<16>(C);
        merge_top16(A, Bv); merge_top16(C, Dv); merge_top16(A, C);
        float g[16]; int ex[16]; float sum = 0.f; const float mx = __uint_as_float(__float_as_uint(A[0]) & ~255u);
#pragma unroll
        for (int e = 0; e < 16; ++e) { const unsigned bits = __float_as_uint(A[e]); const unsigned id = bits & 255u;
            g[e] = __expf(__uint_as_float(bits & ~255u) - mx); sum += g[e];
            const unsigned i0 = ((const LAS unsigned char*)tab)[id >> 4], i1 = ((const LAS unsigned char*)tab)[16 + (id & 15)];
            ex[e] = (int)(i0 * NKEY + i1); }
        const float rs = 1.f / sum;
        LAS unsigned* si = (LAS unsigned*)stg; LAS float* sf = stg + 1024;
        { const int sb = (lane >> 3) * 128 + (lane & 7) * 16;
#pragma unroll
          for (int q = 0; q < 4; ++q) { *(LAS u32x4*)(si + sb + 4 * q) = (u32x4){(unsigned)ex[4 * q], (unsigned)ex[4 * q + 1], (unsigned)ex[4 * q + 2], (unsigned)ex[4 * q + 3]};
              *(LAS f32x4*)(sf + sb + 4 * q) = (f32x4){g[4 * q] * rs, g[4 * q + 1] * rs, g[4 * q + 2] * rs, g[4 * q + 3] * rs}; } }
#pragma unroll 1
        for (int j = 0; j < 8; ++j) {
            const unsigned e0 = si[j * 128 + lane], e1 = si[j * 128 + 64 + lane]; const float g0 = sf[j * 128 + lane], g1 = sf[j * 128 + 64 + lane];
            const unsigned k0 = e0 >> 11, k1 = e1 >> 11; int pos0 = 0, pos1 = 0, offq = 0, offv = 0;
#pragma unroll
            for (int q = 0; q < 8; ++q) {
                const unsigned long long m0 = __builtin_amdgcn_ballot_w64(k0 == (unsigned)q), m1 = __builtin_amdgcn_ballot_w64(k1 == (unsigned)q);
                const int c0 = __builtin_popcountll(m0), c1 = __builtin_popcountll(m1);
                const int r0 = __builtin_amdgcn_mbcnt_hi((unsigned)(m0 >> 32), __builtin_amdgcn_mbcnt_lo((unsigned)m0, 0)), r1 = __builtin_amdgcn_mbcnt_hi((unsigned)(m1 >> 32), __builtin_amdgcn_mbcnt_lo((unsigned)m1, 0));
                if (k0 == (unsigned)q) pos0 = offq + r0;
                if (k1 == (unsigned)q) pos1 = offq + c0 + r1;
                offq += c0 + c1; if (lane == q + 1) offv = offq;
            }
            const size_t tb = ((size_t)task * 8 + j) * NSLOT;
            eid[tb + pos0] = (int)e0; eid[tb + pos1] = (int)e1; gw[tb + pos0] = g0; gw[tb + pos1] = g1;
            if (lane < 16) offs[((size_t)task * 8 + j) * 16 + lane] = (lane <= 8) ? offv : NSLOT;
        }
    }
}

typedef __bf16 bf16x2v __attribute__((ext_vector_type(2)));
__device__ __forceinline__ float dot2bf(unsigned a, unsigned b, float c) { return __builtin_amdgcn_fdot2_f32_bf16(__builtin_bit_cast(bf16x2v, a), __builtin_bit_cast(bf16x2v, b), c, false); }
__device__ __forceinline__ float dot8(u32x4 a, u32x4 b, float c) { c = dot2bf(a.x, b.x, c); c = dot2bf(a.y, b.y, c); c = dot2bf(a.z, b.z, c); return dot2bf(a.w, b.w, c); }
__device__ __forceinline__ void ph_peer_u2(const bf16_t* hn, const bf16_t* Ub, const int* eid, const float* gw, float* wact) {
    const int tid = opq_tid(), lane = tid & 63, wv = __builtin_amdgcn_readfirstlane(tid >> 6); const unsigned voff = (unsigned)lane * 16u;
    for (int t = blockIdx.x * NWAVE + wv; t < T; t += gridDim.x * NWAVE) {
        const u32x4 h0 = *(const u32x4*)(hn + (size_t)t * DM + lane * 8), h1 = *(const u32x4*)(hn + (size_t)t * DM + 512 + lane * 8);
        const int e_lo = eid[(size_t)t * NSLOT + lane], e_hi = eid[(size_t)t * NSLOT + 64 + lane];
        u32x4 bufA[16], bufB[16];
#define U_ISSUE(buf, st) do { unsigned vo = voff; asm("" : "+v"(vo)); _Pragma("unroll") for (int k = 0; k < 8; ++k) { const int sl = (st) * 8 + k; const int e = __builtin_amdgcn_readlane((sl < 64) ? e_lo : e_hi, sl & 63); \
            const GAS char* row = (const GAS char*)Ub + (size_t)e * (DM * 2); asm("" : "+s"(row)); buf[2 * k] = *(const GAS u32x4*)(row + vo); buf[2 * k + 1] = *(const GAS u32x4*)(row + 1024 + vo); } } while (0)
#define U_DOT(buf, dst, off) do { _Pragma("unroll") for (int k = 0; k < 8; ++k) dst[(off) + k] = dot8(buf[2 * k + 1], h1, dot8(buf[2 * k], h0, 0.f)); } while (0)
#define U_REDUCE(hh_) do { float r8[8], r4[4], r2[2], r1; \
            _Pragma("unroll") for (int k = 0; k < 8; ++k) { const bool up = lane & 32; const float keep = up ? part[k + 8] : part[k], send = up ? part[k] : part[k + 8]; r8[k] = keep + __shfl_xor(send, 32); } \
            _Pragma("unroll") for (int k = 0; k < 4; ++k) { const bool up = lane & 16; const float keep = up ? r8[k + 4] : r8[k], send = up ? r8[k] : r8[k + 4]; r4[k] = keep + __shfl_xor(send, 16); } \
            _Pragma("unroll") for (int k = 0; k < 2; ++k) { const bool up = lane & 8; const float keep = up ? r4[k + 2] : r4[k], send = up ? r4[k] : r4[k + 2]; r2[k] = keep + __shfl_xor(send, 8); } \
            { const bool up = lane & 4; const float keep = up ? r2[1] : r2[0], send = up ? r2[0] : r2[1]; r1 = keep + __shfl_xor(send, 4); } \
            r1 += __shfl_xor(r1, 2); r1 += __shfl_xor(r1, 1); \
            if ((lane & 3) == 0) { const int s = (hh_) * 16 + (lane >> 2); wact[(size_t)t * NSLOT + s] = gw[(size_t)t * NSLOT + s] * gelu_tanh(r1); } } while (0)
        U_ISSUE(bufA, 0); U_ISSUE(bufB, 1);
#pragma unroll 1
        for (int hh = 0; hh < PH - 1; ++hh) {
            float part[16];
            U_DOT(bufA, part, 0); U_ISSUE(bufA, 2 * hh + 2);
            U_DOT(bufB, part, 8); U_ISSUE(bufB, 2 * hh + 3);
            U_REDUCE(hh);
        }
        { float part[16]; U_DOT(bufA, part, 0); U_DOT(bufB, part, 8); U_REDUCE(PH - 1); }
#undef U_REDUCE
#undef U_ISSUE
#undef U_DOT
    }
}
__device__ __forceinline__ void ph_peer_v2(float* xres, const bf16_t* Vb, const int* eid, const float* wact, const float* gn, bf16_t* hout, int last) {
    const int tid = opq_tid(), lane = tid & 63, wv = __builtin_amdgcn_readfirstlane(tid >> 6); const unsigned voff = (unsigned)lane * 16u;
    for (int t = blockIdx.x * NWAVE + wv; t < T; t += gridDim.x * NWAVE) {
        const int e_lo = eid[(size_t)t * NSLOT + lane], e_hi = eid[(size_t)t * NSLOT + 64 + lane];
        const float w_lo = wact[(size_t)t * NSLOT + lane], w_hi = wact[(size_t)t * NSLOT + 64 + lane];
        float acc[16];
#pragma unroll
        for (int i = 0; i < 16; ++i) acc[i] = 0.f;
        u32x4 bufA[16], bufB[16];
#define V_ISSUE(buf, st) do { unsigned vo = voff; asm("" : "+v"(vo)); _Pragma("unroll") for (int k = 0; k < 8; ++k) { const int sl = (st) * 8 + k; const int e = __builtin_amdgcn_readlane((sl < 64) ? e_lo : e_hi, sl & 63); \
            const GAS char* row = (const GAS char*)Vb + (size_t)e * (DM * 2); asm("" : "+s"(row)); buf[2 * k] = *(const GAS u32x4*)(row + vo); buf[2 * k + 1] = *(const GAS u32x4*)(row + 1024 + vo); } } while (0)
#define V_ACC(buf, st) do { _Pragma("unroll") for (int k = 0; k < 8; ++k) { const int sl = (st) * 8 + k; const float w = __builtin_bit_cast(float, __builtin_amdgcn_readlane(__builtin_bit_cast(int, (sl < 64) ? w_lo : w_hi), sl & 63)); \
            const u32x4 a = buf[2 * k], b = buf[2 * k + 1]; \
            acc[0] += w * lo16(a.x); acc[1] += w * hi16(a.x); acc[2] += w * lo16(a.y); acc[3] += w * hi16(a.y); acc[4] += w * lo16(a.z); acc[5] += w * hi16(a.z); acc[6] += w * lo16(a.w); acc[7] += w * hi16(a.w); \
            acc[8] += w * lo16(b.x); acc[9] += w * hi16(b.x); acc[10] += w * lo16(b.y); acc[11] += w * hi16(b.y); acc[12] += w * lo16(b.z); acc[13] += w * hi16(b.z); acc[14] += w * lo16(b.w); acc[15] += w * hi16(b.w); } } while (0)
        V_ISSUE(bufA, 0); V_ISSUE(bufB, 1);
#pragma unroll 1
        for (int st = 0; st < 14; st += 2) {
            V_ACC(bufA, st); V_ISSUE(bufA, st + 2);
            V_ACC(bufB, st + 1); V_ISSUE(bufB, st + 3);
        }
        V_ACC(bufA, 14); V_ACC(bufB, 15);
#undef V_ISSUE
#undef V_ACC
        float* xr = xres + (size_t)t * DM; float ss = 0.f;
#pragma unroll
        for (int hf = 0; hf < 2; ++hf)
#pragma unroll
            for (int j = 0; j < 2; ++j) { const f32x4 xv = *(const f32x4*)(xr + hf * 512 + lane * 8 + j * 4);
                acc[hf * 8 + j * 4 + 0] += xv.x; acc[hf * 8 + j * 4 + 1] += xv.y; acc[hf * 8 + j * 4 + 2] += xv.z; acc[hf * 8 + j * 4 + 3] += xv.w; }
#pragma unroll
        for (int i = 0; i < 16; ++i) ss += acc[i] * acc[i];
        const float rstd = rsqrtf(wave_sum(ss) * (1.f / DM) + EPS);
#pragma unroll
        for (int hf = 0; hf < 2; ++hf)
#pragma unroll
            for (int j = 0; j < 2; ++j) { const int c = hf * 512 + lane * 8 + j * 4; const f32x4 g = *(const f32x4*)(gn + c); const int a0 = hf * 8 + j * 4;
                if (last) { *(f32x4*)(xr + c) = (f32x4){acc[a0] * rstd * g.x, acc[a0 + 1] * rstd * g.y, acc[a0 + 2] * rstd * g.z, acc[a0 + 3] * rstd * g.w}; }
                else { *(f32x4*)(xr + c) = (f32x4){acc[a0], acc[a0 + 1], acc[a0 + 2], acc[a0 + 3]};
                    u32x2 ob; ob.x = pk2(acc[a0] * rstd * g.x, acc[a0 + 1] * rstd * g.y); ob.y = pk2(acc[a0 + 2] * rstd * g.z, acc[a0 + 3] * rstd * g.w); *(u32x2*)(hout + (size_t)t * DM + c) = ob; } }
    }
}


constexpr size_t WS_KM = WS_VB + 40 * MiB;
constexpr size_t WS_XB = WS_VB + 4 * MiB;
constexpr size_t WS_UQ = WS_UB, WS_VQ = WS_UB + 32 * MiB, WS_SU = WS_VB, WS_SV = WS_VB + 1 * MiB, WS_HQ = WS_VB + 2 * MiB, WS_SH = WS_VB + 18 * MiB;
__device__ __forceinline__ float ub0(unsigned x) { float f; asm("v_cvt_f32_ubyte0 %0, %1" : "=v"(f) : "v"(x)); return f; }
__device__ __forceinline__ float ub1(unsigned x) { float f; asm("v_cvt_f32_ubyte1 %0, %1" : "=v"(f) : "v"(x)); return f; }
__device__ __forceinline__ float ub2(unsigned x) { float f; asm("v_cvt_f32_ubyte2 %0, %1" : "=v"(f) : "v"(x)); return f; }
__device__ __forceinline__ float ub3(unsigned x) { float f; asm("v_cvt_f32_ubyte3 %0, %1" : "=v"(f) : "v"(x)); return f; }
__device__ __forceinline__ unsigned q8(float v, float inv, int offs) { return (unsigned)((int)__builtin_rintf(v * inv) + offs) & 255u; }
__device__ __forceinline__ void ph_quant_rows_w(const float* src, unsigned char* dst, float* scale, int nrows, int offs, int widx, int nw) {
    const int tid_ = opq_tid(); const int lane = tid_ & 63;
    for (int row0 = widx * 4; row0 < nrows; row0 += nw * 4) {
        f32x4 v[4][4]; float am[4];
#pragma unroll
        for (int r = 0; r < 4; ++r) { const f32x4* s4 = (const f32x4*)(src + (size_t)(row0 + r) * DM);
#pragma unroll
            for (int j = 0; j < 4; ++j) v[r][j] = s4[lane + 64 * j]; }
#pragma unroll
        for (int r = 0; r < 4; ++r) { float a = 0.f;
#pragma unroll
            for (int j = 0; j < 4; ++j) a = fmaxf(a, fmaxf(fmaxf(fabsf(v[r][j].x), fabsf(v[r][j].y)), fmaxf(fabsf(v[r][j].z), fabsf(v[r][j].w))));
            am[r] = wave_max(a); }
#pragma unroll
        for (int r = 0; r < 4; ++r) { const float inv = am[r] > 0.f ? 127.f / am[r] : 0.f;
#pragma unroll
            for (int j = 0; j < 4; ++j) ((unsigned*)(dst + (size_t)(row0 + r) * DM))[lane + 64 * j] = q8(v[r][j].x, inv, offs) | (q8(v[r][j].y, inv, offs) << 8) | (q8(v[r][j].z, inv, offs) << 16) | (q8(v[r][j].w, inv, offs) << 24);
            if (lane == 0) scale[row0 + r] = am[r] > 0.f ? am[r] * (1.f / 127.f) : 1.f; }
    }
}
__device__ __forceinline__ void ph_quant_rows(const float* src, unsigned char* dst, float* scale, int nrows, int offs) {
    const int wv = __builtin_amdgcn_readfirstlane((int)(threadIdx.x >> 6)); ph_quant_rows_w(src, dst, scale, nrows, offs, blockIdx.x * NWAVE + wv, gridDim.x * NWAVE);
}
__device__ __forceinline__ void ph_rmsnorm_q(const float* x, const float* g, bf16_t* out, unsigned char* hq, float* sh) {
    const int tid_ = opq_tid(); const int lane = tid_ & 63, wv = tid_ >> 6;
    for (int it = blockIdx.x; it < T / NWAVE; it += gridDim.x) {
        const int row = it * NWAVE + wv; const f32x4* xr = (const f32x4*)(x + (size_t)row * DM); f32x4 v[4]; float s = 0.f;
#pragma unroll
        for (int j = 0; j < 4; ++j) { v[j] = xr[lane + 64 * j]; s += v[j].x * v[j].x + v[j].y * v[j].y + v[j].z * v[j].z + v[j].w * v[j].w; }
        const float rstd = rsqrtf(wave_sum(s) * (1.f / DM) + EPS); float am = 0.f;
#pragma unroll
        for (int j = 0; j < 4; ++j) { const f32x4 gg = ((const f32x4*)g)[lane + 64 * j]; v[j] = v[j] * rstd * gg; am = fmaxf(am, fmaxf(fmaxf(fabsf(v[j].x), fabsf(v[j].y)), fmaxf(fabsf(v[j].z), fabsf(v[j].w))));
            u32x2 o; o.x = pk2(v[j].x, v[j].y); o.y = pk2(v[j].z, v[j].w); ((u32x2*)(out + (size_t)row * DM))[lane + 64 * j] = o; }
        am = wave_max(am); const float inv = am > 0.f ? 127.f / am : 0.f;
#pragma unroll
        for (int j = 0; j < 4; ++j) ((unsigned*)(hq + (size_t)row * DM))[lane + 64 * j] = q8(v[j].x, inv, 0) | (q8(v[j].y, inv, 0) << 8) | (q8(v[j].z, inv, 0) << 16) | (q8(v[j].w, inv, 0) << 24);
        if (lane == 0) sh[row] = am > 0.f ? am * (1.f / 127.f) : 1.f;
    }
}
__device__ __forceinline__ int dot16i(u32x4 a, u32x4 b) { int c = __builtin_amdgcn_sdot4((int)a.x, (int)b.x, 0, false); c = __builtin_amdgcn_sdot4((int)a.y, (int)b.y, c, false); c = __builtin_amdgcn_sdot4((int)a.z, (int)b.z, c, false); return __builtin_amdgcn_sdot4((int)a.w, (int)b.w, c, false); }
template <int EMASK> __device__ __forceinline__ void ph_peer_u3(const unsigned char* hq, const float* sh, const unsigned char* Uq, const float* su, const int* eid, const float* gw, float* wact) {
    const int tid = opq_tid(), lane = tid & 63, wv = __builtin_amdgcn_readfirstlane(tid >> 6); const unsigned voff = (unsigned)lane * 16u;
    for (int t = blockIdx.x * NWAVE + wv; t < T; t += gridDim.x * NWAVE) {
        const u32x4 h4 = *(const u32x4*)(hq + (size_t)t * DM + lane * 16);
        const int e_lo = eid[(size_t)t * NSLOT + lane], e_hi = eid[(size_t)t * NSLOT + 64 + lane];
        const float sht = sh[t];
        const float g_lo = gw[(size_t)t * NSLOT + lane], g_hi = gw[(size_t)t * NSLOT + 64 + lane];
        const float sc_lo = su[e_lo] * sht, sc_hi = su[e_hi] * sht;
        u32x4 bufA[16], bufB[16];
#define U_ISSUE(buf, hh_) do { unsigned vo = voff; asm("" : "+v"(vo)); _Pragma("unroll") for (int k = 0; k < 16; ++k) { const int sl = (hh_) * 16 + k; const int e = __builtin_amdgcn_readlane((sl < 64) ? e_lo : e_hi, sl & 63) & EMASK; \
            const GAS char* row = (const GAS char*)Uq + (size_t)e * DM; asm("" : "+s"(row)); buf[k] = *(const GAS u32x4*)(row + vo); } } while (0)
#define U_HEAD(buf, hh_) do { float part[16]; _Pragma("unroll") for (int k = 0; k < 16; ++k) part[k] = (float)dot16i(buf[k], h4); \
            float r8[8], r4[4], r2[2], r1; \
            _Pragma("unroll") for (int k = 0; k < 8; ++k) { const bool up = lane & 32; const float keep = up ? part[k + 8] : part[k], send = up ? part[k] : part[k + 8]; r8[k] = keep + __shfl_xor(send, 32); } \
            _Pragma("unroll") for (int k = 0; k < 4; ++k) { const bool up = lane & 16; const float keep = up ? r8[k + 4] : r8[k], send = up ? r8[k] : r8[k + 4]; r4[k] = keep + __shfl_xor(send, 16); } \
            _Pragma("unroll") for (int k = 0; k < 2; ++k) { const bool up = lane & 8; const float keep = up ? r4[k + 2] : r4[k], send = up ? r4[k] : r4[k + 2]; r2[k] = keep + __shfl_xor(send, 8); } \
            { const bool up = lane & 4; const float keep = up ? r2[1] : r2[0], send = up ? r2[0] : r2[1]; r1 = keep + __shfl_xor(send, 4); } \
            r1 += __shfl_xor(r1, 2); r1 += __shfl_xor(r1, 1); \
            const int sl_ = ((hh_) & 3) * 16 + (lane >> 2); const float scl = __shfl(((hh_) < 4) ? sc_lo : sc_hi, sl_), gg = __shfl(((hh_) < 4) ? g_lo : g_hi, sl_); \
            if ((lane & 3) == 0) wact[(size_t)t * NSLOT + (hh_) * 16 + (lane >> 2)] = gg * gelu_tanh(r1 * scl); } while (0)
        U_ISSUE(bufA, 0); U_ISSUE(bufB, 1);
#pragma unroll 1
        for (int hp = 0; hp < 3; ++hp) {
            U_HEAD(bufA, 2 * hp); U_ISSUE(bufA, 2 * hp + 2);
            U_HEAD(bufB, 2 * hp + 1); U_ISSUE(bufB, 2 * hp + 3);
        }
        U_HEAD(bufA, 6); U_HEAD(bufB, 7);
#undef U_ISSUE
#undef U_HEAD
    }
}
__device__ __forceinline__ void ph_peer_v3(float* xres, const unsigned char* Vq, const float* sv, const int* eid, const float* wact, const float* gn, bf16_t* hout, int last) {
    const int tid = opq_tid(), lane = tid & 63, wv = __builtin_amdgcn_readfirstlane(tid >> 6); const unsigned voff = (unsigned)lane * 16u;
    for (int t = blockIdx.x * NWAVE + wv; t < T; t += gridDim.x * NWAVE) {
        const int e_lo = eid[(size_t)t * NSLOT + lane], e_hi = eid[(size_t)t * NSLOT + 64 + lane];
        const float c_lo = wact[(size_t)t * NSLOT + lane] * sv[e_lo], c_hi = wact[(size_t)t * NSLOT + 64 + lane] * sv[e_hi];
        float acc[16]; float corr = 0.f;
#pragma unroll
        for (int i = 0; i < 16; ++i) acc[i] = 0.f;
        u32x4 bufA[8], bufB[8];
#define V_ISSUE(buf, st_) do { unsigned vo = voff; asm("" : "+v"(vo)); _Pragma("unroll") for (int k = 0; k < 8; ++k) { const int sl = (st_) * 8 + k; const int e = __builtin_amdgcn_readlane((sl < 64) ? e_lo : e_hi, sl & 63); \
            const GAS char* row = (const GAS char*)Vq + (size_t)e * DM; asm("" : "+s"(row)); buf[k] = *(const GAS u32x4*)(row + vo); } } while (0)
#define V_ACC(buf, st_) do { _Pragma("unroll") for (int k = 0; k < 8; ++k) { const int sl = (st_) * 8 + k; const float w = __builtin_bit_cast(float, __builtin_amdgcn_readlane(__builtin_bit_cast(int, (sl < 64) ? c_lo : c_hi), sl & 63)); \
            const u32x4 a = buf[k]; corr += w; \
            acc[0] += w * ub0(a.x); acc[1] += w * ub1(a.x); acc[2] += w * ub2(a.x); acc[3] += w * ub3(a.x); acc[4] += w * ub0(a.y); acc[5] += w * ub1(a.y); acc[6] += w * ub2(a.y); acc[7] += w * ub3(a.y); \
            acc[8] += w * ub0(a.z); acc[9] += w * ub1(a.z); acc[10] += w * ub2(a.z); acc[11] += w * ub3(a.z); acc[12] += w * ub0(a.w); acc[13] += w * ub1(a.w); acc[14] += w * ub2(a.w); acc[15] += w * ub3(a.w); } } while (0)
        V_ISSUE(bufA, 0); V_ISSUE(bufB, 1);
#pragma unroll 1
        for (int st = 0; st < 14; st += 2) {
            V_ACC(bufA, st); V_ISSUE(bufA, st + 2);
            V_ACC(bufB, st + 1); V_ISSUE(bufB, st + 3);
        }
        V_ACC(bufA, 14); V_ACC(bufB, 15);
#undef V_ISSUE
#undef V_ACC
        float* xr = xres + (size_t)t * DM + lane * 16; float ss = 0.f; const float c128 = 128.f * corr;
#pragma unroll
        for (int j = 0; j < 4; ++j) { const f32x4 xv = *(const f32x4*)(xr + j * 4);
            acc[j * 4 + 0] += xv.x - c128; acc[j * 4 + 1] += xv.y - c128; acc[j * 4 + 2] += xv.z - c128; acc[j * 4 + 3] += xv.w - c128; }
#pragma unroll
        for (int i = 0; i < 16; ++i) ss += acc[i] * acc[i];
        const float rstd = rsqrtf(wave_sum(ss) * (1.f / DM) + EPS);
#pragma unroll
        for (int j = 0; j < 4; ++j) { const int c = lane * 16 + j * 4; const f32x4 g = *(const f32x4*)(gn + c); const int a0 = j * 4;
            if (last) { *(f32x4*)(xr + j * 4) = (f32x4){acc[a0] * rstd * g.x, acc[a0 + 1] * rstd * g.y, acc[a0 + 2] * rstd * g.z, acc[a0 + 3] * rstd * g.w}; }
            else { *(f32x4*)(xr + j * 4) = (f32x4){acc[a0], acc[a0 + 1], acc[a0 + 2], acc[a0 + 3]};
                u32x2 ob; ob.x = pk2(acc[a0] * rstd * g.x, acc[a0 + 1] * rstd * g.y); ob.y = pk2(acc[a0 + 2] * rstd * g.z, acc[a0 + 3] * rstd * g.w); *(u32x2*)(hout + (size_t)t * DM + c) = ob; } }
    }
}


__device__ __forceinline__ void ph_peer_v5(float* xres, const unsigned char* Vq, const float* sv, const int* eid, const float* wact, const float* gn, bf16_t* hout, int last) {
    const int tid = opq_tid(), lane = tid & 63, wv = __builtin_amdgcn_readfirstlane(tid >> 6); const unsigned voff = (unsigned)lane * 16u;
    for (int t = blockIdx.x * NWAVE + wv; t < T; t += gridDim.x * NWAVE) {
        const int e_lo = eid[(size_t)t * NSLOT + lane], e_hi = eid[(size_t)t * NSLOT + 64 + lane];
        const float c_lo = wact[(size_t)t * NSLOT + lane] * sv[e_lo], c_hi = wact[(size_t)t * NSLOT + 64 + lane] * sv[e_hi];
        float acc[16]; float corr = 0.f;
#pragma unroll
        for (int i = 0; i < 16; ++i) acc[i] = 0.f;
        u32x4 bufA[16], bufB[16];
#define V_ISSUE(buf, hh_) do { _Pragma("unroll") for (int k = 0; k < 16; ++k) { const int sl = (hh_) * 16 + k; const int e = __builtin_amdgcn_readlane((sl < 64) ? e_lo : e_hi, sl & 63); \
            const GAS char* row = (const GAS char*)Vq + (size_t)e * DM; asm("" : "+s"(row)); unsigned vo = voff; asm("" : "+v"(vo)); buf[k] = *(const GAS u32x4*)(row + vo); } } while (0)
#define V_ACC(buf, hh_) do { _Pragma("unroll") for (int k = 0; k < 16; ++k) { const int sl = (hh_) * 16 + k; const float w = __builtin_bit_cast(float, __builtin_amdgcn_readlane(__builtin_bit_cast(int, (sl < 64) ? c_lo : c_hi), sl & 63)); \
            const u32x4 a = buf[k]; corr += w; \
            acc[0] += w * ub0(a.x); acc[1] += w * ub1(a.x); acc[2] += w * ub2(a.x); acc[3] += w * ub3(a.x); acc[4] += w * ub0(a.y); acc[5] += w * ub1(a.y); acc[6] += w * ub2(a.y); acc[7] += w * ub3(a.y); \
            acc[8] += w * ub0(a.z); acc[9] += w * ub1(a.z); acc[10] += w * ub2(a.z); acc[11] += w * ub3(a.z); acc[12] += w * ub0(a.w); acc[13] += w * ub1(a.w); acc[14] += w * ub2(a.w); acc[15] += w * ub3(a.w); \
            __builtin_amdgcn_sched_barrier(0); } } while (0)
        V_ISSUE(bufA, 0); V_ISSUE(bufB, 1);
#pragma unroll 1
        for (int hp = 0; hp < 3; ++hp) {
            V_ACC(bufA, 2 * hp); V_ISSUE(bufA, 2 * hp + 2);
            V_ACC(bufB, 2 * hp + 1); V_ISSUE(bufB, 2 * hp + 3);
        }
        V_ACC(bufA, 6); V_ACC(bufB, 7);
#undef V_ISSUE
#undef V_ACC
        float* xr = xres + (size_t)t * DM + lane * 16; float ss = 0.f; const float c128 = 128.f * corr;
#pragma unroll
        for (int j = 0; j < 4; ++j) { const f32x4 xv = *(const f32x4*)(xr + j * 4);
            acc[j * 4 + 0] += xv.x - c128; acc[j * 4 + 1] += xv.y - c128; acc[j * 4 + 2] += xv.z - c128; acc[j * 4 + 3] += xv.w - c128; }
#pragma unroll
        for (int i = 0; i < 16; ++i) ss += acc[i] * acc[i];
        const float rstd = rsqrtf(wave_sum(ss) * (1.f / DM) + EPS);
#pragma unroll
        for (int j = 0; j < 4; ++j) { const int c = lane * 16 + j * 4; const f32x4 g = *(const f32x4*)(gn + c); const int a0 = j * 4;
            if (last) { *(f32x4*)(xr + j * 4) = (f32x4){acc[a0] * rstd * g.x, acc[a0 + 1] * rstd * g.y, acc[a0 + 2] * rstd * g.z, acc[a0 + 3] * rstd * g.w}; }
            else { *(f32x4*)(xr + j * 4) = (f32x4){acc[a0], acc[a0 + 1], acc[a0 + 2], acc[a0 + 3]};
                u32x2 ob; ob.x = pk2(acc[a0] * rstd * g.x, acc[a0 + 1] * rstd * g.y); ob.y = pk2(acc[a0 + 2] * rstd * g.z, acc[a0 + 3] * rstd * g.w); *(u32x2*)(hout + (size_t)t * DM + c) = ob; } }
    }
}


__device__ __forceinline__ void fma_ub4(float& a0, float& a1, float& a2, float& a3, unsigned a, float w) {
    float t0, t1;
    asm("v_cvt_f32_ubyte0 %4, %6\n\tv_cvt_f32_ubyte1 %5, %6\n\tv_fmac_f32 %0, %7, %4\n\tv_fmac_f32 %1, %7, %5\n\tv_cvt_f32_ubyte2 %4, %6\n\tv_cvt_f32_ubyte3 %5, %6\n\tv_fmac_f32 %2, %7, %4\n\tv_fmac_f32 %3, %7, %5"
        : "+v"(a0), "+v"(a1), "+v"(a2), "+v"(a3), "=&v"(t0), "=&v"(t1) : "v"(a), "s"(w));
}
__device__ __forceinline__ void ph_peer_v4(float* xres, const unsigned char* Vq, const float* sv, const int* eid, const float* wact, const float* gw, const float* su, const float* sh, const float* gn, bf16_t* hout, int last) {
    const int tid = opq_tid(), lane = tid & 63, wv = __builtin_amdgcn_readfirstlane(tid >> 6); const unsigned voff = (unsigned)lane * 16u;
    const int tstride = gridDim.x * NWAVE;
    int t = blockIdx.x * NWAVE + wv;
    const int ntok = (T - t + tstride - 1) / tstride;
    int tn = (t + tstride < T) ? t + tstride : t;
    int e_lo = eid[(size_t)t * NSLOT + lane], e_hi = eid[(size_t)t * NSLOT + 64 + lane];
    float c_lo, c_hi;
    { const float sht = sh[t]; c_lo = gw[(size_t)t * NSLOT + lane] * gelu_tanh(wact[(size_t)t * NSLOT + lane] * su[e_lo] * sht) * sv[e_lo];
      c_hi = gw[(size_t)t * NSLOT + 64 + lane] * gelu_tanh(wact[(size_t)t * NSLOT + 64 + lane] * su[e_hi] * sht) * sv[e_hi]; }
    u32x4 ring[32];
#define V_LOAD(slot, esrc, ln) do { const int e = __builtin_amdgcn_readlane(esrc, ln); const GAS char* row = (const GAS char*)Vq + (size_t)e * DM; asm("" : "+s"(row)); \
        unsigned vo = voff; asm("" : "+v"(vo)); ring[slot] = *(const GAS u32x4*)(row + vo); } while (0)
#pragma unroll
    for (int k = 0; k < 32; ++k) V_LOAD(k, e_lo, k);
    f32x4 xv[4];
#pragma unroll
    for (int j = 0; j < 4; ++j) xv[j] = *(const f32x4*)(xres + (size_t)t * DM + lane * 16 + j * 4);
    int ne_lo = eid[(size_t)tn * NSLOT + lane], ne_hi = eid[(size_t)tn * NSLOT + 64 + lane];
    float nw_lo = wact[(size_t)tn * NSLOT + lane], nw_hi = wact[(size_t)tn * NSLOT + 64 + lane], ng_lo = gw[(size_t)tn * NSLOT + lane], ng_hi = gw[(size_t)tn * NSLOT + 64 + lane], nsh = sh[tn];
    float nc_lo = 0.f, nc_hi = 0.f;
    float acc[16]; float corr = 0.f;
#pragma unroll
    for (int i = 0; i < 16; ++i) acc[i] = 0.f;
#pragma unroll 1
    for (int q = 0; q < 4 * ntok; ++q) {
        const int rr = q & 3;
        const int csrc = __builtin_bit_cast(int, (rr < 2) ? c_lo : c_hi), cbase = (rr & 1) * 32;
        const int esrc = (rr == 0) ? e_lo : ((rr < 3) ? e_hi : ne_lo), ebase = (rr & 1) ? 0 : 32;
        if (rr == 2) { nc_lo = ng_lo * gelu_tanh(nw_lo * su[ne_lo] * nsh) * sv[ne_lo]; nc_hi = ng_hi * gelu_tanh(nw_hi * su[ne_hi] * nsh) * sv[ne_hi]; }
#pragma unroll
        for (int k = 0; k < 32; ++k) {
            const float w = __builtin_bit_cast(float, __builtin_amdgcn_readlane(csrc, cbase + k));
            const u32x4 a = ring[k]; corr += w;
            fma_ub4(acc[0], acc[1], acc[2], acc[3], a.x, w); fma_ub4(acc[4], acc[5], acc[6], acc[7], a.y, w); fma_ub4(acc[8], acc[9], acc[10], acc[11], a.z, w); fma_ub4(acc[12], acc[13], acc[14], acc[15], a.w, w);
            V_LOAD(k, esrc, ebase + k);
        }
        if (rr == 3) {
            float* xr = xres + (size_t)t * DM + lane * 16;
            float ss = 0.f; const float c128 = 128.f * corr;
#pragma unroll
            for (int j = 0; j < 4; ++j) { acc[j * 4 + 0] += xv[j].x - c128; acc[j * 4 + 1] += xv[j].y - c128; acc[j * 4 + 2] += xv[j].z - c128; acc[j * 4 + 3] += xv[j].w - c128; }
#pragma unroll
            for (int i = 0; i < 16; ++i) ss += acc[i] * acc[i];
            const float rstd = rsqrtf(wave_sum(ss) * (1.f / DM) + EPS);
#pragma unroll
            for (int j = 0; j < 4; ++j) { const int c = lane * 16 + j * 4; const f32x4 g = *(const f32x4*)(gn + c); const int a0 = j * 4;
                if (last) { *(f32x4*)(xr + j * 4) = (f32x4){acc[a0] * rstd * g.x, acc[a0 + 1] * rstd * g.y, acc[a0 + 2] * rstd * g.z, acc[a0 + 3] * rstd * g.w}; }
                else { *(f32x4*)(xr + j * 4) = (f32x4){acc[a0], acc[a0 + 1], acc[a0 + 2], acc[a0 + 3]};
                    u32x2 ob; ob.x = pk2(acc[a0] * rstd * g.x, acc[a0 + 1] * rstd * g.y); ob.y = pk2(acc[a0 + 2] * rstd * g.z, acc[a0 + 3] * rstd * g.w); *(u32x2*)(hout + (size_t)t * DM + c) = ob; } }
            t = tn; tn = (t + tstride < T) ? t + tstride : t;
            e_lo = ne_lo; e_hi = ne_hi; c_lo = nc_lo; c_hi = nc_hi; corr = 0.f;
#pragma unroll
            for (int i = 0; i < 16; ++i) acc[i] = 0.f;
#pragma unroll
            for (int j = 0; j < 4; ++j) xv[j] = *(const f32x4*)(xres + (size_t)t * DM + lane * 16 + j * 4);
            ne_lo = eid[(size_t)tn * NSLOT + lane]; ne_hi = eid[(size_t)tn * NSLOT + 64 + lane];
            nw_lo = wact[(size_t)tn * NSLOT + lane]; nw_hi = wact[(size_t)tn * NSLOT + 64 + lane]; ng_lo = gw[(size_t)tn * NSLOT + lane]; ng_hi = gw[(size_t)tn * NSLOT + 64 + lane]; nsh = sh[tn];
        }
    }
#undef V_LOAD
}


__device__ __forceinline__ void ph_peer_u5(const unsigned char* hq, const float* sh, const unsigned char* Uq, const float* su, const int* eid, const float* gw, const int* offs, float* wact) {
    const int tid = opq_tid(), lane = tid & 63, wv = __builtin_amdgcn_readfirstlane(tid >> 6); const unsigned voff = (unsigned)lane * 16u;
    for (int task = blockIdx.x * NWAVE + wv; task < T / 8; task += gridDim.x * NWAVE) {
        int es_lo[8], es_hi[8], offv[8]; float g_lo[8], g_hi[8], sc_lo[8], sc_hi[8]; u32x4 h4[8];
#pragma unroll
        for (int j = 0; j < 8; ++j) { const size_t t = (size_t)task * 8 + j;
            es_lo[j] = eid[t * NSLOT + lane]; es_hi[j] = eid[t * NSLOT + 64 + lane]; g_lo[j] = gw[t * NSLOT + lane]; g_hi[j] = gw[t * NSLOT + 64 + lane];
            h4[j] = *(const u32x4*)(hq + t * DM + lane * 16); offv[j] = offs[t * 16 + (lane & 15)]; }
#pragma unroll
        for (int j = 0; j < 8; ++j) { const float sht = sh[(size_t)task * 8 + j]; sc_lo[j] = su[es_lo[j]] * sht; sc_hi[j] = su[es_hi[j]] * sht; }
#pragma unroll 1
        for (int r = 0; r < 8; ++r) {
#pragma unroll
            for (int j = 0; j < 8; ++j) {
                const int p0 = __builtin_amdgcn_readlane(offv[j], r), p1 = __builtin_amdgcn_readlane(offv[j], r + 1);
#pragma unroll 1
                for (int base = p0; base < p1; base += 16) {
                    u32x4 buf[16];
#pragma unroll
                    for (int k = 0; k < 16; ++k) { const int p = base + k; buf[k] = (u32x4){0u, 0u, 0u, 0u};
                        if (p < p1) { const int e = __builtin_amdgcn_readlane((p < 64) ? es_lo[j] : es_hi[j], p & 63); const GAS char* row = (const GAS char*)Uq + (size_t)e * DM; asm("" : "+s"(row));
                            unsigned vo = voff; asm("" : "+v"(vo)); buf[k] = *(const GAS u32x4*)(row + vo); } }
                    float part[16];
#pragma unroll
                    for (int k = 0; k < 16; ++k) part[k] = (float)dot16i(buf[k], h4[j]);
                    float r8[8], r4[4], r2[2], r1;
#pragma unroll
                    for (int k = 0; k < 8; ++k) { const bool up = lane & 32; const float keep = up ? part[k + 8] : part[k], send = up ? part[k] : part[k + 8]; r8[k] = keep + __shfl_xor(send, 32); }
#pragma unroll
                    for (int k = 0; k < 4; ++k) { const bool up = lane & 16; const float keep = up ? r8[k + 4] : r8[k], send = up ? r8[k] : r8[k + 4]; r4[k] = keep + __shfl_xor(send, 16); }
#pragma unroll
                    for (int k = 0; k < 2; ++k) { const bool up = lane & 8; const float keep = up ? r4[k + 2] : r4[k], send = up ? r4[k] : r4[k + 2]; r2[k] = keep + __shfl_xor(send, 8); }
                    { const bool up = lane & 4; const float keep = up ? r2[1] : r2[0], send = up ? r2[0] : r2[1]; r1 = keep + __shfl_xor(send, 4); }
                    r1 += __shfl_xor(r1, 2); r1 += __shfl_xor(r1, 1);
                    const int pp = base + (lane >> 2);
                    const float s0 = __shfl(sc_lo[j], pp & 63), s1 = __shfl(sc_hi[j], pp & 63), q0 = __shfl(g_lo[j], pp & 63), q1 = __shfl(g_hi[j], pp & 63);
                    const float scl = (pp < 64) ? s0 : s1, gg = (pp < 64) ? q0 : q1;
                    if ((lane & 3) == 0 && pp < p1) wact[((size_t)task * 8 + j) * NSLOT + pp] = gg * gelu_tanh(r1 * scl);
                }
            }
        }
    }
}
__device__ __forceinline__ void ph_peer_v6(float* xres, const unsigned char* Vq, const float* sv, const int* eid, const float* wact, const int* offs, const float* gn, bf16_t* hout, int last) {
    const int tid = opq_tid(), lane = tid & 63, wv = __builtin_amdgcn_readfirstlane(tid >> 6); const unsigned voff = (unsigned)lane * 16u;
    for (int task = blockIdx.x * NWAVE + wv; task < T / 4; task += gridDim.x * NWAVE) {
        int es_lo[4], es_hi[4], offv[4]; float c_lo[4], c_hi[4];
#pragma unroll
        for (int j = 0; j < 4; ++j) { const size_t t = (size_t)task * 4 + j;
            es_lo[j] = eid[t * NSLOT + lane]; es_hi[j] = eid[t * NSLOT + 64 + lane]; c_lo[j] = wact[t * NSLOT + lane]; c_hi[j] = wact[t * NSLOT + 64 + lane]; offv[j] = offs[t * 16 + (lane & 15)]; }
#pragma unroll
        for (int j = 0; j < 4; ++j) { c_lo[j] *= sv[es_lo[j]]; c_hi[j] *= sv[es_hi[j]]; }
        float acc[4][16], corr[4];
#pragma unroll
        for (int j = 0; j < 4; ++j) { corr[j] = 0.f;
#pragma unroll
            for (int i = 0; i < 16; ++i) acc[j][i] = 0.f; }
#pragma unroll 1
        for (int r = 0; r < 8; ++r) {
#pragma unroll
            for (int j = 0; j < 4; ++j) {
                const int p0 = __builtin_amdgcn_readlane(offv[j], r), p1 = __builtin_amdgcn_readlane(offv[j], r + 1);
#pragma unroll 1
                for (int base = p0; base < p1; base += 16) {
                    u32x4 buf[16];
#pragma unroll
                    for (int k = 0; k < 16; ++k) { const int p = base + k; buf[k] = (u32x4){0u, 0u, 0u, 0u};
                        if (p < p1) { const int e = __builtin_amdgcn_readlane((p < 64) ? es_lo[j] : es_hi[j], p & 63); const GAS char* row = (const GAS char*)Vq + (size_t)e * DM; asm("" : "+s"(row));
                            unsigned vo = voff; asm("" : "+v"(vo)); buf[k] = *(const GAS u32x4*)(row + vo); } }
#pragma unroll
                    for (int k = 0; k < 16; ++k) { const int p = base + k; const int pc = (p < NSLOT) ? p : NSLOT - 1;
                        float w = __builtin_bit_cast(float, __builtin_amdgcn_readlane(__builtin_bit_cast(int, (pc < 64) ? c_lo[j] : c_hi[j]), pc & 63)); w = (p < p1) ? w : 0.f;
                        corr[j] += w; const u32x4 a = buf[k];
                        fma_ub4(acc[j][0], acc[j][1], acc[j][2], acc[j][3], a.x, w); fma_ub4(acc[j][4], acc[j][5], acc[j][6], acc[j][7], a.y, w);
                        fma_ub4(acc[j][8], acc[j][9], acc[j][10], acc[j][11], a.z, w); fma_ub4(acc[j][12], acc[j][13], acc[j][14], acc[j][15], a.w, w); }
                }
            }
        }
#pragma unroll
        for (int j = 0; j < 4; ++j) {
            const size_t t = (size_t)task * 4 + j; float* xr = xres + t * DM + lane * 16; float ss = 0.f; const float c128 = 128.f * corr[j];
#pragma unroll
            for (int q = 0; q < 4; ++q) { const f32x4 xv = *(const f32x4*)(xr + q * 4);
                acc[j][q * 4 + 0] += xv.x - c128; acc[j][q * 4 + 1] += xv.y - c128; acc[j][q * 4 + 2] += xv.z - c128; acc[j][q * 4 + 3] += xv.w - c128; }
#pragma unroll
            for (int i = 0; i < 16; ++i) ss += acc[j][i] * acc[j][i];
            const float rstd = rsqrtf(wave_sum(ss) * (1.f / DM) + EPS);
#pragma unroll
            for (int q = 0; q < 4; ++q) { const int c = lane * 16 + q * 4; const f32x4 g = *(const f32x4*)(gn + c); const int a0 = q * 4;
                if (last) { *(f32x4*)(xr + q * 4) = (f32x4){acc[j][a0] * rstd * g.x, acc[j][a0 + 1] * rstd * g.y, acc[j][a0 + 2] * rstd * g.z, acc[j][a0 + 3] * rstd * g.w}; }
                else { *(f32x4*)(xr + q * 4) = (f32x4){acc[j][a0], acc[j][a0 + 1], acc[j][a0 + 2], acc[j][a0 + 3]};
                    u32x2 ob; ob.x = pk2(acc[j][a0] * rstd * g.x, acc[j][a0 + 1] * rstd * g.y); ob.y = pk2(acc[j][a0 + 2] * rstd * g.z, acc[j][a0 + 3] * rstd * g.w); *(u32x2*)(hout + t * DM + c) = ob; } }
        }
    }
}


constexpr int US_LDS = 12288;
__device__ __forceinline__ void ph_peer_u6(unsigned char* lds_, const bf16_t* xg, const float* gf, const float* rowsq, const unsigned char* Uq, const int* eid, const int* offs, float* dots, const int task) {
    const int tid = opq_tid(), lane = tid & 63, wv = __builtin_amdgcn_readfirstlane(tid >> 6); const unsigned voff = (unsigned)lane * 16u;
    LAS unsigned char* hqL = (LAS unsigned char*)lds_ + wv * (64 * TK_ROW * 4); LAS unsigned* sched = (LAS unsigned*)(hqL + 8192); LAS float* shL = (LAS float*)(hqL + 12288);
    {
        int es_lo[8], es_hi[8], offv[8]; float gv[16];
#pragma unroll
        for (int i = 0; i < 4; ++i) { const f32x4 g4 = *(const f32x4*)(gf + lane * 16 + i * 4); gv[i * 4] = g4.x; gv[i * 4 + 1] = g4.y; gv[i * 4 + 2] = g4.z; gv[i * 4 + 3] = g4.w; }
#pragma unroll
        for (int j = 0; j < 8; ++j) { const size_t t = (size_t)task * 8 + j;
            es_lo[j] = ldcg(eid + t * NSLOT + lane); es_hi[j] = ldcg(eid + t * NSLOT + 64 + lane); offv[j] = ldcg(offs + t * 16 + (lane & 15));
            const u32x4 xa = *(const u32x4*)(xg + t * DM + lane * 16), xb = *(const u32x4*)(xg + t * DM + lane * 16 + 8); const float rstd = rstd_of(rowsq, t);
            float hv[16] = {lo16(xa.x), hi16(xa.x), lo16(xa.y), hi16(xa.y), lo16(xa.z), hi16(xa.z), lo16(xa.w), hi16(xa.w), lo16(xb.x), hi16(xb.x), lo16(xb.y), hi16(xb.y), lo16(xb.z), hi16(xb.z), lo16(xb.w), hi16(xb.w)};
            float am = 0.f;
#pragma unroll
            for (int i = 0; i < 16; ++i) { hv[i] *= rstd * gv[i]; am = fmaxf(am, fabsf(hv[i])); }
            am = wave_max(am); const float inv = am > 0.f ? 127.f / am : 0.f;
            u32x4 hq4;
            hq4.x = q8(hv[0], inv, 0) | (q8(hv[1], inv, 0) << 8) | (q8(hv[2], inv, 0) << 16) | (q8(hv[3], inv, 0) << 24); hq4.y = q8(hv[4], inv, 0) | (q8(hv[5], inv, 0) << 8) | (q8(hv[6], inv, 0) << 16) | (q8(hv[7], inv, 0) << 24);
            hq4.z = q8(hv[8], inv, 0) | (q8(hv[9], inv, 0) << 8) | (q8(hv[10], inv, 0) << 16) | (q8(hv[11], inv, 0) << 24); hq4.w = q8(hv[12], inv, 0) | (q8(hv[13], inv, 0) << 8) | (q8(hv[14], inv, 0) << 16) | (q8(hv[15], inv, 0) << 24);
            *(LAS u32x4*)(hqL + j * 1024 + lane * 16) = hq4; if (lane == 0) shL[j] = am * (1.f / 127.f); }
        int ncell = 0;
#pragma unroll
        for (int j = 0; j < 8; ++j) { const int v = __shfl(offv[j], (lane >> 3) + 1) - __shfl(offv[j], lane >> 3); if ((lane & 7) == j) ncell = v; }
        int scan = ncell;
#pragma unroll
        for (int o = 1; o < 64; o <<= 1) { const int u = __shfl_up(scan, o); if (lane >= o) scan += u; }
        const int sexc = scan - ncell;
#pragma unroll
        for (int j = 0; j < 8; ++j) {
            const int r0 = es_lo[j] >> 11, r1 = es_hi[j] >> 11;
            const int i0 = __shfl(sexc, r0 * 8 + j) + lane - __shfl(offv[j], r0), i1 = __shfl(sexc, r1 * 8 + j) + 64 + lane - __shfl(offv[j], r1);
            sched[i0] = (unsigned)es_lo[j] | ((unsigned)j << 14) | ((unsigned)lane << 17); sched[i1] = (unsigned)es_hi[j] | ((unsigned)j << 14) | ((unsigned)(64 + lane) << 17);
        }
        u32x4 bufA[16], bufB[16]; unsigned entA, entB;
#define US_ISSUE(buf, ent, s_) do { ent = sched[(s_) * 16 + (lane & 15)]; unsigned vo = voff; asm("" : "+v"(vo)); _Pragma("unroll") for (int k = 0; k < 16; ++k) { \
            const unsigned e = (unsigned)__builtin_amdgcn_readlane((int)ent, k) & 16383u; const GAS char* row = (const GAS char*)Uq + (size_t)e * DM; asm("" : "+s"(row)); buf[k] = *(const GAS u32x4*)(row + vo); } } while (0)
#define US_CONS(buf, ent) do { float part[16]; _Pragma("unroll") for (int k = 0; k < 16; ++k) { const unsigned jj = ((unsigned)__builtin_amdgcn_readlane((int)ent, k) >> 14) & 7u; \
                const u32x4 hrow = *(const LAS u32x4*)(hqL + jj * 1024 + lane * 16); part[k] = (float)dot16i(buf[k], hrow); } \
            float r8[8], r4[4], r2[2], r1; \
            _Pragma("unroll") for (int k = 0; k < 8; ++k) { const bool up = lane & 32; const float keep = up ? part[k + 8] : part[k], send = up ? part[k] : part[k + 8]; r8[k] = keep + __shfl_xor(send, 32); } \
            _Pragma("unroll") for (int k = 0; k < 4; ++k) { const bool up = lane & 16; const float keep = up ? r8[k + 4] : r8[k], send = up ? r8[k] : r8[k + 4]; r4[k] = keep + __shfl_xor(send, 16); } \
            _Pragma("unroll") for (int k = 0; k < 2; ++k) { const bool up = lane & 8; const float keep = up ? r4[k + 2] : r4[k], send = up ? r4[k] : r4[k + 2]; r2[k] = keep + __shfl_xor(send, 8); } \
            { const bool up = lane & 4; const float keep = up ? r2[1] : r2[0], send = up ? r2[0] : r2[1]; r1 = keep + __shfl_xor(send, 4); } \
            r1 += __shfl_xor(r1, 2); r1 += __shfl_xor(r1, 1); \
            const unsigned me = (unsigned)__shfl((int)ent, lane >> 2); \
            if ((lane & 3) == 0) dots[(((size_t)task * 8 + ((me >> 14) & 7u)) << 7) + (me >> 17)] = r1 * shL[(me >> 14) & 7u]; } while (0)
        US_ISSUE(bufA, entA, 0); US_ISSUE(bufB, entB, 1);
#pragma unroll 1
        for (int s = 0; s < 62; s += 2) {
            US_CONS(bufA, entA); US_ISSUE(bufA, entA, s + 2);
            US_CONS(bufB, entB); US_ISSUE(bufB, entB, s + 3);
        }
        US_CONS(bufA, entA); US_CONS(bufB, entB);
#undef US_ISSUE
#undef US_CONS
    }
}


__device__ __forceinline__ void fma_ub4v(float& a0, float& a1, float& a2, float& a3, unsigned a, float w) {
    float t0, t1;
    asm("v_cvt_f32_ubyte0 %4, %6\n\tv_cvt_f32_ubyte1 %5, %6\n\tv_fmac_f32 %0, %7, %4\n\tv_fmac_f32 %1, %7, %5\n\tv_cvt_f32_ubyte2 %4, %6\n\tv_cvt_f32_ubyte3 %5, %6\n\tv_fmac_f32 %2, %7, %4\n\tv_fmac_f32 %3, %7, %5"
        : "+v"(a0), "+v"(a1), "+v"(a2), "+v"(a3), "=&v"(t0), "=&v"(t1) : "v"(a), "v"(w));
}
constexpr int VS_LDS = 16384 + 256;
template <int MODE> __device__ __forceinline__ void ph_peer_v7(unsigned char* lds_, float* xres, const unsigned char* Vq, const float* sv, const int* eid, const float* dots, const float* gw, const float* su, const float* sh,
                                           const int* offs, const float* gn, bf16_t* hout, int last) {
    const int tid = opq_tid(), lane = tid & 63, wv = __builtin_amdgcn_readfirstlane(tid >> 6); const int j = lane >> 4, li = lane & 15;
    LAS int* slotE = (LAS int*)((LAS unsigned char*)lds_ + wv * VS_LDS); LAS float* slotC = (LAS float*)(slotE + 2048);
    for (int task = blockIdx.x * NWAVE + wv; task < T / 4; task += gridDim.x * NWAVE) {
        int nmax = 0, sexc;
        int offq[4];
#pragma unroll
        for (int q = 0; q < 4; ++q) { offq[q] = offs[((size_t)task * 4 + q) * 16 + (lane & 15)]; const int n = __shfl(offq[q], (lane & 15) + 1) - offq[q]; nmax = (n > nmax) ? n : nmax; }
        nmax = (lane < 8) ? nmax : 0;
        { int sc = nmax;
#pragma unroll
          for (int o = 1; o < 8; o <<= 1) { const int u = __shfl_up(sc, o); if (lane >= o) sc += u; }
          sexc = sc - nmax; }
        const int total = __builtin_amdgcn_readlane(sexc, 7) + __builtin_amdgcn_readlane(nmax, 7);
        for (int i = lane; i < total * 4; i += 64) { slotE[i] = -1; slotC[i] = 0.f; }
#pragma unroll
        for (int q = 0; q < 4; ++q) { const size_t t = (size_t)task * 4 + q; const float sht = sh[t];
#pragma unroll
            for (int hf = 0; hf < 2; ++hf) { const int p = hf * 64 + lane; const int e = eid[t * NSLOT + p]; const float c = gw[t * NSLOT + p] * gelu_tanh(dots[t * NSLOT + p] * su[e] * sht) * sv[e];
                const int r = e >> 11; const int s = __shfl(sexc, r) + p - __shfl(offq[q], r); slotE[s * 4 + q] = e; slotC[s * 4 + q] = c; } }
        float acc[64]; float corr = 0.f;
#pragma unroll
        for (int i = 0; i < 64; ++i) acc[i] = 0.f;
        constexpr int RING = 6; u32x4 ring[RING][4]; float cR[RING];
#define VS_ISSUE(u_, s_) do { const int s__ = (s_); int e = -1; float c = 0.f; if (s__ < total) { e = slotE[s__ * 4 + j]; c = slotC[s__ * 4 + j]; } cR[u_] = c; \
            if (e >= 0) { const u32x4* rp = (const u32x4*)(Vq + (size_t)(MODE == 2 ? (e & 2047) : e) * DM) + li; ring[u_][0] = rp[0]; ring[u_][1] = rp[16]; ring[u_][2] = rp[32]; ring[u_][3] = rp[48]; } } while (0)
#define VS_CONS(u_) do { const float w = cR[u_]; corr += w; if (MODE >= 1) { acc[0] += w * __uint_as_float((ring[u_][0].x ^ ring[u_][1].y ^ ring[u_][2].z ^ ring[u_][3].w) & 0x3f800000u); } else _Pragma("unroll") for (int m = 0; m < 4; ++m) { const u32x4 a = ring[u_][m]; \
            fma_ub4v(acc[m * 16 + 0], acc[m * 16 + 1], acc[m * 16 + 2], acc[m * 16 + 3], a.x, w); fma_ub4v(acc[m * 16 + 4], acc[m * 16 + 5], acc[m * 16 + 6], acc[m * 16 + 7], a.y, w); \
            fma_ub4v(acc[m * 16 + 8], acc[m * 16 + 9], acc[m * 16 + 10], acc[m * 16 + 11], a.z, w); fma_ub4v(acc[m * 16 + 12], acc[m * 16 + 13], acc[m * 16 + 14], acc[m * 16 + 15], a.w, w); } } while (0)
#pragma unroll
        for (int u = 0; u < RING; ++u) {
#pragma unroll
            for (int m = 0; m < 4; ++m) ring[u][m] = (u32x4){0u, 0u, 0u, 0u};
            VS_ISSUE(u, u); }
#pragma unroll 1
        for (int base = 0; base < total; base += RING) {
#pragma unroll
            for (int u = 0; u < RING; ++u) { VS_CONS(u); VS_ISSUE(u, base + RING + u); }
        }
#undef VS_ISSUE
#undef VS_CONS
        const size_t t = (size_t)task * 4 + j; float* xr = xres + t * DM + li * 16; float ss = 0.f; const float c128 = 128.f * corr;
#pragma unroll
        for (int m = 0; m < 4; ++m)
#pragma unroll
            for (int q = 0; q < 4; ++q) { const f32x4 xv = *(const f32x4*)(xr + m * 256 + q * 4); const int a0 = m * 16 + q * 4;
                acc[a0] += xv.x - c128; acc[a0 + 1] += xv.y - c128; acc[a0 + 2] += xv.z - c128; acc[a0 + 3] += xv.w - c128; }
#pragma unroll
        for (int i = 0; i < 64; ++i) ss += acc[i] * acc[i];
        ss += __shfl_xor(ss, 1); ss += __shfl_xor(ss, 2); ss += __shfl_xor(ss, 4); ss += __shfl_xor(ss, 8);
        const float rstd = rsqrtf(ss * (1.f / DM) + EPS);
#pragma unroll
        for (int m = 0; m < 4; ++m)
#pragma unroll
            for (int q = 0; q < 4; ++q) { const int c = m * 256 + li * 16 + q * 4; const f32x4 g = *(const f32x4*)(gn + c); const int a0 = m * 16 + q * 4;
                if (last) { *(f32x4*)(xres + t * DM + c) = (f32x4){acc[a0] * rstd * g.x, acc[a0 + 1] * rstd * g.y, acc[a0 + 2] * rstd * g.z, acc[a0 + 3] * rstd * g.w}; }
                else { *(f32x4*)(xres + t * DM + c) = (f32x4){acc[a0], acc[a0 + 1], acc[a0 + 2], acc[a0 + 3]};
                    u32x2 ob; ob.x = pk2(acc[a0] * rstd * g.x, acc[a0 + 1] * rstd * g.y); ob.y = pk2(acc[a0 + 2] * rstd * g.z, acc[a0 + 3] * rstd * g.w); *(u32x2*)(hout + t * DM + c) = ob; } }
    }
}


constexpr int VS8_LDS = 4096;
template <int MODE> __device__ __forceinline__ void ph_peer_v8(unsigned char* lds_, float* xres, const unsigned char* Vq, const float* sv, const int* eid, const float* dots, const float* gw, const float* su, const float* sh,
                                           const int* offs, const float* gn, bf16_t* hout, int last) {
    const int tid = opq_tid(), lane = tid & 63, wv = __builtin_amdgcn_readfirstlane(tid >> 6); const unsigned voff = (unsigned)lane * 16u;
    LAS unsigned* sched = (LAS unsigned*)((LAS unsigned char*)lds_ + wv * VS8_LDS); LAS unsigned char* schedW = (LAS unsigned char*)(sched + 640);
    for (int task = blockIdx.x * NWAVE + wv; task < T / 4; task += gridDim.x * NWAVE) {
        int offq[4]; int npad = 0;
#pragma unroll
        for (int q = 0; q < 4; ++q) { offq[q] = offs[((size_t)task * 4 + q) * 16 + (lane & 15)]; const int n = __shfl(offq[q], (lane >> 2) + 1) - __shfl(offq[q], lane >> 2); if ((lane & 3) == q) npad = (n + 3) & ~3; }
        npad = (lane < 32) ? npad : 0;
        int sc_ = npad;
#pragma unroll
        for (int o = 1; o < 32; o <<= 1) { const int u = __shfl_up(sc_, o); if (lane >= o) sc_ += u; }
        const int sexc = sc_ - npad;
        const int slen = __builtin_amdgcn_readlane(sc_, 31), nst = (slen + 15) >> 4;
        for (int i = lane; i < 160; i += 64) { ((LAS u32x4*)sched)[i] = (u32x4){0u, 0u, 0u, 0u}; }
        for (int i = lane; i < 40; i += 64) { ((LAS u32x4*)schedW)[i] = (u32x4){0u, 0u, 0u, 0u}; }
        float tsc[4];
#pragma unroll
        for (int q = 0; q < 4; ++q) { const size_t t = (size_t)task * 4 + q; const float sht = sh[t];
            const int e0 = eid[t * NSLOT + lane], e1 = eid[t * NSLOT + 64 + lane];
            const float c0 = gw[t * NSLOT + lane] * gelu_tanh(dots[t * NSLOT + lane] * su[e0] * sht) * sv[e0], c1 = gw[t * NSLOT + 64 + lane] * gelu_tanh(dots[t * NSLOT + 64 + lane] * su[e1] * sht) * sv[e1];
            const float am = wave_max(fmaxf(fabsf(c0), fabsf(c1))); const float inv = am > 0.f ? 127.f / am : 0.f; tsc[q] = am * (1.f / 127.f);
            const int r0 = e0 >> 11, r1 = e1 >> 11;
            const int i0 = __shfl(sexc, r0 * 4 + q) + lane - __shfl(offq[q], r0), i1 = __shfl(sexc, r1 * 4 + q) + 64 + lane - __shfl(offq[q], r1);
            sched[i0] = (unsigned)e0 | ((unsigned)q << 14); sched[i1] = (unsigned)e1 | ((unsigned)q << 14);
            schedW[i0] = (unsigned char)((int)__builtin_rintf(c0 * inv) & 255); schedW[i1] = (unsigned char)((int)__builtin_rintf(c1 * inv) & 255); }
        int acc[4][16];
#pragma unroll
        for (int q = 0; q < 4; ++q)
#pragma unroll
            for (int i = 0; i < 16; ++i) acc[q][i] = 0;
        u32x4 bufA[8], bufB[8], bufC[8]; unsigned entA, entB, entC, wqA, wqB, wqC;
#define V8_ISSUE(buf, ent, wq, s_) do { ent = sched[(s_) * 8 + (lane & 7)]; wq = ((LAS unsigned*)schedW)[(s_) * 2 + (lane & 1)]; unsigned vo = voff; asm("" : "+v"(vo)); _Pragma("unroll") for (int k = 0; k < 8; ++k) { \
            const unsigned e = (unsigned)__builtin_amdgcn_readlane((int)ent, k) & 16383u; const GAS char* row = (const GAS char*)Vq + (size_t)e * DM; asm("" : "+s"(row)); buf[k] = *(const GAS u32x4*)(row + vo); } } while (0)
#define V8_CONS(buf, ent, wq) do { if (MODE == 1) { _Pragma("unroll") for (int k = 0; k < 8; ++k) acc[0][k] ^= (int)(buf[k].x ^ buf[k].y ^ buf[k].z ^ buf[k].w) & (int)wq; } else _Pragma("unroll") for (int g = 0; g < 2; ++g) { \
            const unsigned jg = ((unsigned)__builtin_amdgcn_readlane((int)ent, 4 * g) >> 14) & 3u; const int wg = __builtin_amdgcn_readlane((int)wq, g); \
            const int w0 = (jg == 0u) ? wg : 0, w1 = (jg == 1u) ? wg : 0, w2 = (jg == 2u) ? wg : 0, w3 = (jg == 3u) ? wg : 0;        \
            _Pragma("unroll") for (int xi = 0; xi < 4; ++xi) { const unsigned ra = buf[4 * g][xi], rb = buf[4 * g + 1][xi], rc = buf[4 * g + 2][xi], rd = buf[4 * g + 3][xi]; \
                const unsigned t0 = __builtin_amdgcn_perm(rb, ra, 0x05010400u), t1 = __builtin_amdgcn_perm(rb, ra, 0x07030602u), t2 = __builtin_amdgcn_perm(rd, rc, 0x05010400u), t3 = __builtin_amdgcn_perm(rd, rc, 0x07030602u); \
                const int o0 = (int)__builtin_amdgcn_perm(t2, t0, 0x05040100u), o1 = (int)__builtin_amdgcn_perm(t2, t0, 0x07060302u), o2 = (int)__builtin_amdgcn_perm(t3, t1, 0x05040100u), o3 = (int)__builtin_amdgcn_perm(t3, t1, 0x07060302u); \
                acc[0][4 * xi] = __builtin_amdgcn_sdot4(o0, w0, acc[0][4 * xi], false); acc[0][4 * xi + 1] = __builtin_amdgcn_sdot4(o1, w0, acc[0][4 * xi + 1], false); acc[0][4 * xi + 2] = __builtin_amdgcn_sdot4(o2, w0, acc[0][4 * xi + 2], false); acc[0][4 * xi + 3] = __builtin_amdgcn_sdot4(o3, w0, acc[0][4 * xi + 3], false); \
                acc[1][4 * xi] = __builtin_amdgcn_sdot4(o0, w1, acc[1][4 * xi], false); acc[1][4 * xi + 1] = __builtin_amdgcn_sdot4(o1, w1, acc[1][4 * xi + 1], false); acc[1][4 * xi + 2] = __builtin_amdgcn_sdot4(o2, w1, acc[1][4 * xi + 2], false); acc[1][4 * xi + 3] = __builtin_amdgcn_sdot4(o3, w1, acc[1][4 * xi + 3], false); \
                acc[2][4 * xi] = __builtin_amdgcn_sdot4(o0, w2, acc[2][4 * xi], false); acc[2][4 * xi + 1] = __builtin_amdgcn_sdot4(o1, w2, acc[2][4 * xi + 1], false); acc[2][4 * xi + 2] = __builtin_amdgcn_sdot4(o2, w2, acc[2][4 * xi + 2], false); acc[2][4 * xi + 3] = __builtin_amdgcn_sdot4(o3, w2, acc[2][4 * xi + 3], false); \
                acc[3][4 * xi] = __builtin_amdgcn_sdot4(o0, w3, acc[3][4 * xi], false); acc[3][4 * xi + 1] = __builtin_amdgcn_sdot4(o1, w3, acc[3][4 * xi + 1], false); acc[3][4 * xi + 2] = __builtin_amdgcn_sdot4(o2, w3, acc[3][4 * xi + 2], false); acc[3][4 * xi + 3] = __builtin_amdgcn_sdot4(o3, w3, acc[3][4 * xi + 3], false); } } } while (0)
        const int nst8 = (slen + 7) >> 3;
        V8_ISSUE(bufA, entA, wqA, 0); V8_ISSUE(bufB, entB, wqB, 1); V8_ISSUE(bufC, entC, wqC, 2);
#pragma unroll 1
        for (int s = 0; s < ((MODE == 2) ? 3 : nst8); s += 3) {
            V8_CONS(bufA, entA, wqA); V8_ISSUE(bufA, entA, wqA, (s + 3 < 80) ? s + 3 : 79);
            V8_CONS(bufB, entB, wqB); V8_ISSUE(bufB, entB, wqB, (s + 4 < 80) ? s + 4 : 79);
            V8_CONS(bufC, entC, wqC); V8_ISSUE(bufC, entC, wqC, (s + 5 < 80) ? s + 5 : 79);
        }
#undef V8_ISSUE
#undef V8_CONS
        int task2 = task; asm volatile("" : "+s"(task2)); int lane2 = lane; asm volatile("" : "+v"(lane2));
#pragma unroll
        for (int q = 0; q < 4; ++q) {
            const size_t t = (size_t)task2 * 4 + q; float* xr = xres + t * DM + lane2 * 16; float ss = 0.f; float y[16];
#pragma unroll
            for (int c4 = 0; c4 < 4; ++c4) { const f32x4 xv = *(const f32x4*)(xr + c4 * 4);
                y[c4 * 4 + 0] = xv.x + tsc[q] * (float)acc[q][c4 * 4 + 0]; y[c4 * 4 + 1] = xv.y + tsc[q] * (float)acc[q][c4 * 4 + 1]; y[c4 * 4 + 2] = xv.z + tsc[q] * (float)acc[q][c4 * 4 + 2]; y[c4 * 4 + 3] = xv.w + tsc[q] * (float)acc[q][c4 * 4 + 3]; }
#pragma unroll
            for (int i = 0; i < 16; ++i) ss += y[i] * y[i];
            const float rstd = rsqrtf(wave_sum(ss) * (1.f / DM) + EPS);
#pragma unroll
            for (int c4 = 0; c4 < 4; ++c4) { const int c = lane2 * 16 + c4 * 4; const f32x4 g = *(const f32x4*)(gn + c); const int a0 = c4 * 4;
                if (last) { *(f32x4*)(xr + c4 * 4) = (f32x4){y[a0] * rstd * g.x, y[a0 + 1] * rstd * g.y, y[a0 + 2] * rstd * g.z, y[a0 + 3] * rstd * g.w}; }
                else { *(f32x4*)(xr + c4 * 4) = (f32x4){y[a0], y[a0 + 1], y[a0 + 2], y[a0 + 3]};
                    u32x2 ob; ob.x = pk2(y[a0] * rstd * g.x, y[a0 + 1] * rstd * g.y); ob.y = pk2(y[a0 + 2] * rstd * g.z, y[a0 + 3] * rstd * g.w); *(u32x2*)(hout + t * DM + c) = ob; } }
        }
    }
}


template <int MODE> __device__ __forceinline__ void ph_peer_v9(float* xout, bf16_t* xb, const unsigned char* Vq, const float* sv, const int* eid, const float* dots, const float* gw, const float* su,
                                                              const float* gn, bf16_t* hout, int last, const int task) {
    const int tid = opq_tid(), lane = tid & 63, wv = __builtin_amdgcn_readfirstlane(tid >> 6); const unsigned voff = (unsigned)lane * 16u;
    {
        int e_lo[4], e_hi[4]; unsigned cw[4]; float tsc[4]; float c0[4], c1[4];
#pragma unroll
        for (int q = 0; q < 4; ++q) { const size_t t = (size_t)task * 4 + q; e_lo[q] = ldcg(eid + t * NSLOT + lane); e_hi[q] = ldcg(eid + t * NSLOT + 64 + lane); c0[q] = ldcg(gw + t * NSLOT + lane); c1[q] = ldcg(gw + t * NSLOT + 64 + lane); }
#pragma unroll
        for (int q = 0; q < 4; ++q) { const size_t t = (size_t)task * 4 + q;
            c0[q] *= gelu_tanh(ldcg(dots + t * NSLOT + lane) * su[e_lo[q]]) * sv[e_lo[q]]; c1[q] *= gelu_tanh(ldcg(dots + t * NSLOT + 64 + lane) * su[e_hi[q]]) * sv[e_hi[q]]; }
#pragma unroll
        for (int q = 0; q < 4; ++q) {
            const float am = wave_max(fmaxf(fabsf(c0[q]), fabsf(c1[q]))); const float inv = am > 0.f ? 127.f / am : 0.f; tsc[q] = am * (1.f / 127.f);
            const unsigned b0 = (unsigned)((int)__builtin_rintf(c0[q] * inv) & 255), b1 = (unsigned)((int)__builtin_rintf(c1[q] * inv) & 255);
            const unsigned p0 = b0 | (__shfl_down(b0, 1) << 8) | (__shfl_down(b0, 2) << 16) | (__shfl_down(b0, 3) << 24), p1 = b1 | (__shfl_down(b1, 1) << 8) | (__shfl_down(b1, 2) << 16) | (__shfl_down(b1, 3) << 24);
            const unsigned g0 = __shfl(p0, (lane & 15) * 4), g1 = __shfl(p1, (lane & 15) * 4); cw[q] = (lane < 16) ? g0 : g1; }
        int acc[4][16];
#pragma unroll
        for (int q = 0; q < 4; ++q)
#pragma unroll
            for (int i = 0; i < 16; ++i) acc[q][i] = 0;
        u32x4 bufA[16], bufB[16];
#define V9_ISSUE(buf, s_) do { const int s__ = (s_); unsigned vo = voff; asm("" : "+v"(vo)); _Pragma("unroll") for (int q = 0; q < 4; ++q) { const int esrc = (s__ < 16) ? e_lo[q] : e_hi[q]; _Pragma("unroll") for (int k = 0; k < 4; ++k) { \
            const int e = __builtin_amdgcn_readlane(esrc, (4 * s__ + k) & 63); const GAS char* row = (const GAS char*)Vq + (size_t)e * DM; asm("" : "+s"(row)); buf[4 * q + k] = *(const GAS u32x4*)(row + vo); } } } while (0)
#define V9_CONS(buf, s_) do { if (MODE == 1) { _Pragma("unroll") for (int k = 0; k < 16; ++k) acc[0][k] ^= (int)(buf[k].x ^ buf[k].y ^ buf[k].z ^ buf[k].w); } else { _Pragma("unroll") for (int q = 0; q < 4; ++q) { const int wg = __builtin_amdgcn_readlane((int)cw[q], (s_)); \
            _Pragma("unroll") for (int xi = 0; xi < 4; ++xi) { const unsigned ra = buf[4 * q][xi], rb = buf[4 * q + 1][xi], rc = buf[4 * q + 2][xi], rd = buf[4 * q + 3][xi]; \
                const unsigned t0 = __builtin_amdgcn_perm(rb, ra, 0x05010400u), t1 = __builtin_amdgcn_perm(rb, ra, 0x07030602u), t2 = __builtin_amdgcn_perm(rd, rc, 0x05010400u), t3 = __builtin_amdgcn_perm(rd, rc, 0x07030602u); \
                acc[q][4 * xi] = __builtin_amdgcn_sdot4((int)__builtin_amdgcn_perm(t2, t0, 0x05040100u), wg, acc[q][4 * xi], false); acc[q][4 * xi + 1] = __builtin_amdgcn_sdot4((int)__builtin_amdgcn_perm(t2, t0, 0x07060302u), wg, acc[q][4 * xi + 1], false); \
                acc[q][4 * xi + 2] = __builtin_amdgcn_sdot4((int)__builtin_amdgcn_perm(t3, t1, 0x05040100u), wg, acc[q][4 * xi + 2], false); acc[q][4 * xi + 3] = __builtin_amdgcn_sdot4((int)__builtin_amdgcn_perm(t3, t1, 0x07060302u), wg, acc[q][4 * xi + 3], false); } } } } while (0)
        V9_ISSUE(bufA, 0); V9_ISSUE(bufB, 1);
#pragma unroll 1
        for (int s = 0; s < ((MODE == 2) ? 2 : 30); s += 2) {
            V9_CONS(bufA, s); V9_ISSUE(bufA, s + 2);
            V9_CONS(bufB, s + 1); V9_ISSUE(bufB, s + 3);
        }
        V9_CONS(bufA, 30); V9_CONS(bufB, 31);
#undef V9_ISSUE
#undef V9_CONS
        int task2 = task; asm volatile("" : "+s"(task2)); int lane2 = lane; asm volatile("" : "+v"(lane2));
        f32x4 xv[4][4];
#pragma unroll
        for (int q = 0; q < 4; ++q)
#pragma unroll
            for (int c4 = 0; c4 < 4; ++c4) { const u32x2 w = *(const u32x2*)(xb + ((size_t)task2 * 4 + q) * DM + lane2 * 16 + c4 * 4); xv[q][c4] = (f32x4){lo16(w.x), hi16(w.x), lo16(w.y), hi16(w.y)}; }
        float rstd[4];
#pragma unroll
        for (int q = 0; q < 4; ++q) { float ss = 0.f;
#pragma unroll
            for (int c4 = 0; c4 < 4; ++c4) { xv[q][c4].x += tsc[q] * (float)acc[q][c4 * 4 + 0]; xv[q][c4].y += tsc[q] * (float)acc[q][c4 * 4 + 1]; xv[q][c4].z += tsc[q] * (float)acc[q][c4 * 4 + 2]; xv[q][c4].w += tsc[q] * (float)acc[q][c4 * 4 + 3];
                ss += xv[q][c4].x * xv[q][c4].x + xv[q][c4].y * xv[q][c4].y + xv[q][c4].z * xv[q][c4].z + xv[q][c4].w * xv[q][c4].w; }
            rstd[q] = rsqrtf(wave_sum(ss) * (1.f / DM) + EPS); }
#pragma unroll
        for (int q = 0; q < 4; ++q) { const size_t t = (size_t)task2 * 4 + q;
#pragma unroll
            for (int c4 = 0; c4 < 4; ++c4) { const int c = lane2 * 16 + c4 * 4; const f32x4 g = *(const f32x4*)(gn + c); const f32x4 y = xv[q][c4];
                if (last) { *(f32x4*)(xout + t * DM + c) = (f32x4){y.x * rstd[q] * g.x, y.y * rstd[q] * g.y, y.z * rstd[q] * g.z, y.w * rstd[q] * g.w}; }
                else { u32x2 ox; ox.x = pk2(y.x, y.y); ox.y = pk2(y.z, y.w); *(u32x2*)(xb + t * DM + c) = ox;
                    u32x2 ob; ob.x = pk2(y.x * rstd[q] * g.x, y.y * rstd[q] * g.y); ob.y = pk2(y.z * rstd[q] * g.z, y.w * rstd[q] * g.w); *(u32x2*)(hout + t * DM + c) = ob; } } }
    }
}


__device__ __forceinline__ void ph_peer_u7(unsigned char* lds_, const bf16_t* xg, const float* gf, const float* rowsq, const unsigned char* Uq, const int* eid, const int* offs, const float* gw, const float* su, const float* sv, const int task) {
    const int tid = opq_tid(), lane = tid & 63, wv = __builtin_amdgcn_readfirstlane(tid >> 6); const unsigned voff = (unsigned)lane * 16u;
    LAS unsigned char* hqL = (LAS unsigned char*)lds_ + wv * (64 * TK_ROW * 4); LAS unsigned* sched = (LAS unsigned*)(hqL + 8192); LAS float* shL = (LAS float*)(hqL + 12288);
    LAS _Float16* cL = (LAS _Float16*)(hqL + 12320); LAS unsigned short* eL = (LAS unsigned short*)(hqL + 14368);
    {
        int es_lo[8], es_hi[8], offv[8]; float gv[16];
#pragma unroll
        for (int i = 0; i < 4; ++i) { const f32x4 g4 = *(const f32x4*)(gf + lane * 16 + i * 4); gv[i * 4] = g4.x; gv[i * 4 + 1] = g4.y; gv[i * 4 + 2] = g4.z; gv[i * 4 + 3] = g4.w; }
#pragma unroll
        for (int j = 0; j < 8; ++j) { const size_t t = (size_t)task * 8 + j;
            es_lo[j] = ldcg(eid + t * NSLOT + lane); es_hi[j] = ldcg(eid + t * NSLOT + 64 + lane); offv[j] = ldcg(offs + t * 16 + (lane & 15));
            const u32x4 xa = *(const u32x4*)(xg + t * DM + lane * 16), xb = *(const u32x4*)(xg + t * DM + lane * 16 + 8); const float rstd = rstd_of(rowsq, t);
            float hv[16] = {lo16(xa.x), hi16(xa.x), lo16(xa.y), hi16(xa.y), lo16(xa.z), hi16(xa.z), lo16(xa.w), hi16(xa.w), lo16(xb.x), hi16(xb.x), lo16(xb.y), hi16(xb.y), lo16(xb.z), hi16(xb.z), lo16(xb.w), hi16(xb.w)};
            float am = 0.f;
#pragma unroll
            for (int i = 0; i < 16; ++i) { hv[i] *= rstd * gv[i]; am = fmaxf(am, fabsf(hv[i])); }
            am = wave_max(am); const float inv = am > 0.f ? 127.f / am : 0.f;
            u32x4 hq4;
            hq4.x = q8(hv[0], inv, 0) | (q8(hv[1], inv, 0) << 8) | (q8(hv[2], inv, 0) << 16) | (q8(hv[3], inv, 0) << 24); hq4.y = q8(hv[4], inv, 0) | (q8(hv[5], inv, 0) << 8) | (q8(hv[6], inv, 0) << 16) | (q8(hv[7], inv, 0) << 24);
            hq4.z = q8(hv[8], inv, 0) | (q8(hv[9], inv, 0) << 8) | (q8(hv[10], inv, 0) << 16) | (q8(hv[11], inv, 0) << 24); hq4.w = q8(hv[12], inv, 0) | (q8(hv[13], inv, 0) << 8) | (q8(hv[14], inv, 0) << 16) | (q8(hv[15], inv, 0) << 24);
            *(LAS u32x4*)(hqL + j * 1024 + lane * 16) = hq4; if (lane == 0) shL[j] = am * (1.f / 127.f);
            eL[j * 128 + lane] = (unsigned short)es_lo[j]; eL[j * 128 + 64 + lane] = (unsigned short)es_hi[j]; }
        int ncell = 0;
#pragma unroll
        for (int j = 0; j < 8; ++j) { const int v = __shfl(offv[j], (lane >> 3) + 1) - __shfl(offv[j], lane >> 3); if ((lane & 7) == j) ncell = v; }
        int scan = ncell;
#pragma unroll
        for (int o = 1; o < 64; o <<= 1) { const int u = __shfl_up(scan, o); if (lane >= o) scan += u; }
        const int sexc = scan - ncell;
#pragma unroll
        for (int j = 0; j < 8; ++j) {
            const int r0 = es_lo[j] >> 11, r1 = es_hi[j] >> 11;
            const int i0 = __shfl(sexc, r0 * 8 + j) + lane - __shfl(offv[j], r0), i1 = __shfl(sexc, r1 * 8 + j) + 64 + lane - __shfl(offv[j], r1);
            sched[i0] = (unsigned)es_lo[j] | ((unsigned)j << 14) | ((unsigned)lane << 17); sched[i1] = (unsigned)es_hi[j] | ((unsigned)j << 14) | ((unsigned)(64 + lane) << 17);
        }
        u32x4 bufA[16], bufB[16]; unsigned entA, entB, meA, meB; float suA, suB, svA, svB, gwA, gwB;
        const GAS char* gwt = (const GAS char*)gw + (size_t)task * 8 * NSLOT * 4;
#define US_ISSUE(buf, ent, me, sux, svx, gwx, s_) do { ent = sched[(s_) * 16 + (lane & 15)]; unsigned vo = voff; asm("" : "+v"(vo)); _Pragma("unroll") for (int k = 0; k < 16; ++k) { \
            const unsigned e = (unsigned)__builtin_amdgcn_readlane((int)ent, k) & 16383u; const GAS char* row = (const GAS char*)Uq + (size_t)e * DM; asm("" : "+s"(row)); buf[k] = *(const GAS u32x4*)(row + vo); } \
            me = (unsigned)__shfl((int)ent, lane >> 2); const unsigned eo = (me & 16383u) * 4u; sux = *(const GAS float*)((const GAS char*)su + eo); svx = *(const GAS float*)((const GAS char*)sv + eo); \
            gwx = __hip_atomic_load((const GAS float*)(gwt + (((me >> 14) & 7u) * 128u + (me >> 17)) * 4u), __ATOMIC_RELAXED, __HIP_MEMORY_SCOPE_AGENT); } while (0)
#define US_CONS(buf, ent, me, sux, svx, gwx) do { float part[16]; _Pragma("unroll") for (int k = 0; k < 16; ++k) { const unsigned jj = ((unsigned)__builtin_amdgcn_readlane((int)ent, k) >> 14) & 7u; \
                const u32x4 hrow = *(const LAS u32x4*)(hqL + jj * 1024 + lane * 16); part[k] = (float)dot16i(buf[k], hrow); } \
            float r8[8], r4[4], r2[2], r1; \
            _Pragma("unroll") for (int k = 0; k < 8; ++k) { const bool up = lane & 32; const float keep = up ? part[k + 8] : part[k], send = up ? part[k] : part[k + 8]; r8[k] = keep + __shfl_xor(send, 32); } \
            _Pragma("unroll") for (int k = 0; k < 4; ++k) { const bool up = lane & 16; const float keep = up ? r8[k + 4] : r8[k], send = up ? r8[k] : r8[k + 4]; r4[k] = keep + __shfl_xor(send, 16); } \
            _Pragma("unroll") for (int k = 0; k < 2; ++k) { const bool up = lane & 8; const float keep = up ? r4[k + 2] : r4[k], send = up ? r4[k] : r4[k + 2]; r2[k] = keep + __shfl_xor(send, 8); } \
            { const bool up = lane & 4; const float keep = up ? r2[1] : r2[0], send = up ? r2[0] : r2[1]; r1 = keep + __shfl_xor(send, 4); } \
            r1 += __shfl_xor(r1, 2); r1 += __shfl_xor(r1, 1); \
            const unsigned tk = (me >> 14) & 7u; const float cc = gwx * gelu_tanh(r1 * shL[tk] * sux) * svx; \
            if ((lane & 3) == 0) cL[tk * 128u + (me >> 17)] = (_Float16)cc; } while (0)
        US_ISSUE(bufA, entA, meA, suA, svA, gwA, 0); US_ISSUE(bufB, entB, meB, suB, svB, gwB, 1);
#pragma unroll 1
        for (int s = 0; s < 62; s += 2) {
            US_CONS(bufA, entA, meA, suA, svA, gwA); US_ISSUE(bufA, entA, meA, suA, svA, gwA, s + 2);
            US_CONS(bufB, entB, meB, suB, svB, gwB); US_ISSUE(bufB, entB, meB, suB, svB, gwB, s + 3);
        }
        US_CONS(bufA, entA, meA, suA, svA, gwA); US_CONS(bufB, entB, meB, suB, svB, gwB);
#undef US_ISSUE
#undef US_CONS
    }
}

__device__ __forceinline__ void ph_peer_v10(unsigned char* lds_, float* xout, bf16_t* xb, const unsigned char* Vq, const float* gn, bf16_t* hout, int last, const int task) {
    const int tid = opq_tid(), lane = tid & 63, wv = __builtin_amdgcn_readfirstlane(tid >> 6); const unsigned voff = (unsigned)lane * 16u;
    LAS unsigned char* base = (LAS unsigned char*)lds_ + wv * (64 * TK_ROW * 4);
    LAS unsigned char* cwL = base; LAS const _Float16* cL = (LAS const _Float16*)(base + 12320); LAS const unsigned short* eL = (LAS const unsigned short*)(base + 14368); LAS float* tscL = (LAS float*)(base + 16416);
#pragma unroll
    for (int j = 0; j < 8; ++j) {
        const float c0 = (float)cL[j * 128 + lane], c1 = (float)cL[j * 128 + 64 + lane];
        const float am = wave_max(fmaxf(fabsf(c0), fabsf(c1))); const float inv = am > 0.f ? 127.f / am : 0.f;
        cwL[j * 128 + lane] = (unsigned char)((int)__builtin_rintf(c0 * inv) & 255); cwL[j * 128 + 64 + lane] = (unsigned char)((int)__builtin_rintf(c1 * inv) & 255);
        if (lane == 0) tscL[j] = am * (1.f / 127.f); }
#pragma unroll 1
    for (int h = 0; h < 2; ++h) {
        int acc[4][16];
#pragma unroll
        for (int q = 0; q < 4; ++q)
#pragma unroll
            for (int i = 0; i < 16; ++i) acc[q][i] = 0;
        u32x4 bufA[16], bufB[16]; unsigned entA, entB, wqA, wqB;
        LAS const unsigned short* eH = eL + (4 * h + ((lane >> 2) & 3)) * 128 + (lane & 3); LAS const unsigned* wH = (LAS const unsigned*)cwL + (4 * h + (lane & 3)) * 32;
#define VX_ISSUE(buf, ent, wq, s_) do { ent = eH[4 * (s_)]; wq = wH[(s_)]; unsigned vo = voff; asm("" : "+v"(vo)); _Pragma("unroll") for (int k = 0; k < 16; ++k) { \
            const unsigned e = (unsigned)__builtin_amdgcn_readlane((int)ent, k); const GAS char* row = (const GAS char*)Vq + (size_t)e * DM; asm("" : "+s"(row)); buf[k] = *(const GAS u32x4*)(row + vo); } } while (0)
#define VX_CONS(buf, wq) do { _Pragma("unroll") for (int q = 0; q < 4; ++q) { const int wg = __builtin_amdgcn_readlane((int)wq, q); \
            _Pragma("unroll") for (int xi = 0; xi < 4; ++xi) { const unsigned ra = buf[4 * q][xi], rb = buf[4 * q + 1][xi], rc = buf[4 * q + 2][xi], rd = buf[4 * q + 3][xi]; \
                const unsigned t0 = __builtin_amdgcn_perm(rb, ra, 0x05010400u), t1 = __builtin_amdgcn_perm(rb, ra, 0x07030602u), t2 = __builtin_amdgcn_perm(rd, rc, 0x05010400u), t3 = __builtin_amdgcn_perm(rd, rc, 0x07030602u); \
                acc[q][4 * xi] = __builtin_amdgcn_sdot4((int)__builtin_amdgcn_perm(t2, t0, 0x05040100u), wg, acc[q][4 * xi], false); acc[q][4 * xi + 1] = __builtin_amdgcn_sdot4((int)__builtin_amdgcn_perm(t2, t0, 0x07060302u), wg, acc[q][4 * xi + 1], false); \
                acc[q][4 * xi + 2] = __builtin_amdgcn_sdot4((int)__builtin_amdgcn_perm(t3, t1, 0x05040100u), wg, acc[q][4 * xi + 2], false); acc[q][4 * xi + 3] = __builtin_amdgcn_sdot4((int)__builtin_amdgcn_perm(t3, t1, 0x07060302u), wg, acc[q][4 * xi + 3], false); } } } while (0)
        VX_ISSUE(bufA, entA, wqA, 0); VX_ISSUE(bufB, entB, wqB, 1);
#pragma unroll 1
        for (int s = 0; s < 30; s += 2) {
            VX_CONS(bufA, wqA); VX_ISSUE(bufA, entA, wqA, s + 2);
            VX_CONS(bufB, wqB); VX_ISSUE(bufB, entB, wqB, s + 3);
        }
        VX_CONS(bufA, wqA); VX_CONS(bufB, wqB);
#undef VX_ISSUE
#undef VX_CONS
        int task2 = task * 2 + h; asm volatile("" : "+s"(task2)); int lane2 = lane; asm volatile("" : "+v"(lane2));
        f32x4 xv[4][4];
#pragma unroll
        for (int q = 0; q < 4; ++q)
#pragma unroll
            for (int c4 = 0; c4 < 4; ++c4) { const u32x2 w = *(const u32x2*)(xb + ((size_t)task2 * 4 + q) * DM + lane2 * 16 + c4 * 4); xv[q][c4] = (f32x4){lo16(w.x), hi16(w.x), lo16(w.y), hi16(w.y)}; }
        float rstd[4];
#pragma unroll
        for (int q = 0; q < 4; ++q) { float ss = 0.f; const float tsc = tscL[4 * h + q];
#pragma unroll
            for (int c4 = 0; c4 < 4; ++c4) { xv[q][c4].x += tsc * (float)acc[q][c4 * 4 + 0]; xv[q][c4].y += tsc * (float)acc[q][c4 * 4 + 1]; xv[q][c4].z += tsc * (float)acc[q][c4 * 4 + 2]; xv[q][c4].w += tsc * (float)acc[q][c4 * 4 + 3];
                ss += xv[q][c4].x * xv[q][c4].x + xv[q][c4].y * xv[q][c4].y + xv[q][c4].z * xv[q][c4].z + xv[q][c4].w * xv[q][c4].w; }
            rstd[q] = rsqrtf(wave_sum(ss) * (1.f / DM) + EPS); }
#pragma unroll
        for (int q = 0; q < 4; ++q) { const size_t t = (size_t)task2 * 4 + q;
#pragma unroll
            for (int c4 = 0; c4 < 4; ++c4) { const int c = lane2 * 16 + c4 * 4; const f32x4 g = *(const f32x4*)(gn + c); const f32x4 y = xv[q][c4];
                if (last) { *(f32x4*)(xout + t * DM + c) = (f32x4){y.x * rstd[q] * g.x, y.y * rstd[q] * g.y, y.z * rstd[q] * g.z, y.w * rstd[q] * g.w}; }
                else { u32x2 ox; ox.x = pk2(y.x, y.y); ox.y = pk2(y.z, y.w); *(u32x2*)(xb + t * DM + c) = ox;
                    u32x2 ob; ob.x = pk2(y.x * rstd[q] * g.x, y.y * rstd[q] * g.y); ob.y = pk2(y.z * rstd[q] * g.z, y.w * rstd[q] * g.w); *(u32x2*)(hout + t * DM + c) = ob; } } }
    }
}


__device__ __forceinline__ void ph_peer_all(unsigned char* lds_, const short* scores, int* eid, float* gw, int* offs, float* dots, const bf16_t* xg, const float* gf, const float* rowsq, const unsigned char* Uq, const float* su,
                                            const unsigned char* Vq, const float* sv, float* xres, bf16_t* xb, const float* gn, bf16_t* hout, int last, const float* qsrc_u, const float* qsrc_v, unsigned char* qdst, float* qsc) {
    const int wv0 = __builtin_amdgcn_readfirstlane((int)(threadIdx.x >> 6));
    for (int task = blockIdx.x * NWAVE + wv0; task < T / 8; task += gridDim.x * NWAVE) {
        if (qsrc_u && wv0 >= 4) {
            const int widx = blockIdx.x * 4 + (wv0 - 4), nw = gridDim.x * 4;
            ph_quant_rows_w(qsrc_u + (size_t)NEXP * DM, qdst + (size_t)NEXP * DM, qsc, (NL - 1) * NEXP, 0, widx, nw);
            ph_quant_rows_w(qsrc_v + (size_t)NEXP * DM, qdst + (size_t)32 * MiB + (size_t)NEXP * DM, qsc + (1 * MiB / 4), (NL - 1) * NEXP, 0, widx, nw); }
        if (wv0 < 4) __builtin_amdgcn_s_setprio(3);
        ph_topk(lds_, scores, eid, gw, offs, task);
        __builtin_amdgcn_s_setprio(0);
        asm volatile("s_waitcnt vmcnt(0)" ::: "memory");
        ph_peer_u7(lds_, xg, gf, rowsq, Uq, eid, offs, gw, su, sv, task);
        ph_peer_v10(lds_, xres, xb, Vq, gn, hout, last, task);
    }
}

typedef GAS unsigned gu32;
#define XB_TMO      128
#define XB_XCNT(j)  (256  + 64 * (j))
#define XB_XSUB(j)  (1280 + 64 * (j))
#define XB_XGEN(j)  (2304 + 64 * (j))
#define XB_TOP      3328
#define XB_TOPGEN   3392
#define XCD_BAR_WORDS 3456
#define XB_SPIN_CAP (1u << 18)

__device__ __forceinline__ unsigned xb_ld(unsigned* p)              { return __hip_atomic_load(p, __ATOMIC_RELAXED, __HIP_MEMORY_SCOPE_AGENT); }
__device__ __forceinline__ unsigned xb_add(unsigned* p, unsigned v) { return __hip_atomic_fetch_add(p, v, __ATOMIC_RELAXED, __HIP_MEMORY_SCOPE_AGENT); }
__device__ __forceinline__ unsigned xb_xcc_id() { return (unsigned)__builtin_amdgcn_s_getreg((3 << 11) | 20) & 0xFu; }
#define XB_SPIN(cond, bar) do { unsigned _sp = 0; while (cond) { __builtin_amdgcn_s_sleep(1); \
    if ((++_sp & 255u) == 0u) { if (xb_ld(&(bar)[XB_TMO])) break; if (_sp > XB_SPIN_CAP) { atomicAdd(&(bar)[XB_TMO], 1u); break; } } } } while (0)

struct XcdBarrier {
    unsigned* bar; unsigned x;
    volatile LAS unsigned* st;
};

__device__ __forceinline__ XcdBarrier xcd_barrier_post(unsigned* bar, volatile LAS unsigned* st) {
    XcdBarrier b; b.bar = bar; b.x = xb_xcc_id(); b.st = st;
    if (threadIdx.x == 0) (void)xb_add(&bar[XB_XCNT(b.x)], 1u);
    return b;
}
__device__ __forceinline__ void xcd_barrier_complete(unsigned* bar, unsigned x, unsigned& nloc, unsigned& nx) {
    const unsigned G = gridDim.x * gridDim.y * gridDim.z;
    unsigned sum, cnt, mine, sp = 0u;
    for (;;) {
        sum = 0u; cnt = 0u; mine = 0u;
#pragma unroll
        for (unsigned j = 0; j < 16; ++j) { const unsigned c = xb_ld(&bar[XB_XCNT(j)]); sum += c; cnt += (c > 0u) ? 1u : 0u; mine = (j == x) ? c : mine; }
        if (sum == G) break;
        __builtin_amdgcn_s_sleep(1);
        if ((++sp & 255u) == 0u) { if (xb_ld(&bar[XB_TMO])) break; if (sp > XB_SPIN_CAP) { atomicAdd(&bar[XB_TMO], 1u); break; } }
    }
    nloc = mine > 0u ? mine : 1u; nx = cnt > 0u ? cnt : 1u;
}

__device__ __forceinline__ void xcd_barrier(const XcdBarrier& b) {
    asm volatile("s_waitcnt vmcnt(0)" ::: "memory");
    __syncthreads();
    if (threadIdx.x == 0) {
        unsigned* bar = b.bar;
        __builtin_amdgcn_s_waitcnt(0);
        unsigned nloc = b.st[0], nx = b.st[1];
        if (nloc == 0u) { xcd_barrier_complete(bar, b.x, nloc, nx); b.st[0] = nloc; b.st[1] = nx; }
        const unsigned old = xb_add(&bar[XB_XSUB(b.x)], 1u);
        const unsigned gen = old / nloc;
        if (old + 1u == (gen + 1u) * nloc) {
            __builtin_amdgcn_fence(__ATOMIC_RELEASE, "agent");
            asm volatile("s_waitcnt vmcnt(0)" ::: "memory");
            const unsigned og = xb_add(&bar[XB_TOP], 1u);
            const unsigned tg = og / nx;
            if (og + 1u == (tg + 1u) * nx) xb_add(&bar[XB_TOPGEN], 1u);
            else XB_SPIN(xb_ld(&bar[XB_TOPGEN]) == tg, bar);
            __builtin_amdgcn_fence(__ATOMIC_ACQUIRE, "agent");
            xb_add(&bar[XB_XGEN(b.x)], 1u);
            asm volatile("s_waitcnt vmcnt(0)" ::: "memory");
        } else {
            XB_SPIN(xb_ld(&bar[XB_XGEN(b.x)]) == gen, bar);
            __builtin_amdgcn_fence(__ATOMIC_ACQUIRE, "agent");
            asm volatile("s_waitcnt vmcnt(0)" ::: "memory");
        }
    }
    __syncthreads();
}

#define OPQ(p) do { size_t z_ = 0; asm volatile("" : "+s"(z_)); p = (decltype(p))((unsigned char*)(p) + z_); } while (0)
#define WSP(type, name, off) type* name = (type*)(ws + (off))
__global__ void __launch_bounds__(NTHR, 2) mk_fwd(Args a) {
    extern __shared__ __attribute__((aligned(16))) unsigned char lds[];
    float* smem = (float*)lds;
    volatile LAS unsigned* bst = (volatile LAS unsigned*)((LAS unsigned char*)lds + (LDS_BYTES - 64));
    if (threadIdx.x < 2) bst[threadIdx.x] = 0u;
    __syncthreads();
    (void)xcd_barrier_post((unsigned*)(a.ws + WS_CTL), bst);
#ifndef PROBE_I
#define PROBE_I -1
#endif
#define GRID_BAR() do { XcdBarrier b_; b_.bar = (unsigned*)(a.ws + WS_CTL); b_.x = xb_xcc_id(); b_.st = (volatile LAS unsigned*)((LAS unsigned char*)lds + (LDS_BYTES - 64)); xcd_barrier(b_); } while (0)
#define REP(idx) for (int rep_ = 0; rep_ < ((PROBE_I == (idx) && l == 0) ? 2 : 1); ++rep_)
    for (int rep_ = 0; rep_ < (PROBE_I == 0 ? 2 : 1); ++rep_) {
        unsigned char* ws = a.ws; OPQ(ws);
        WSP(bf16_t, Wpool, WS_WPOOL); WSP(bf16_t, Wup, WS_WUP); WSP(bf16_t, Wout, WS_WOUT); WSP(bf16_t, Wpeer, WS_WPEER); WSP(bf16_t, Win, WS_WIN); WSP(bf16_t, Ub, WS_UB); WSP(bf16_t, Vb, WS_VB); WSP(bf16_t, h, WS_H);
#define PRO_WEIGHTS() do { for (int l = 0; l < NL; ++l) { \
            ph_transpose_w(a.w_in + (size_t)l * DM * INW, Win + (size_t)l * INW * DM, DM, INW, lds); \
            ph_wpool_bd(a.w_pool + (size_t)l * 4 * 128 * 256, Wpool + (size_t)l * DM * 256); \
            ph_transpose_w(a.w_up + (size_t)l * AW * DM, Wup + (size_t)l * DM * AW, AW, DM, lds); \
            ph_transpose_w(a.w_out + (size_t)l * DM * DM, Wout + (size_t)l * DM * DM, DM, DM, lds); \
            __syncthreads(); \
            ph_wpeer2(a.peer_wq + (size_t)l * DM * PQW, a.peer_keys + (size_t)l * 2 * NKEY * 128, a.ffn_norm + l * DM, Wpeer + (size_t)l * PQW * DM, smem); } } while (0)
#define PRO_STREAM() do { ph_quant_rows(a.peer_u, ws + WS_UQ, (float*)(ws + WS_SU), NEXP, 0); ph_quant_rows(a.peer_v, ws + WS_VQ, (float*)(ws + WS_SV), NEXP, 0);        ph_rmsnorm(a.x, a.mix_norm, h); } while (0)
        if (blockIdx.x & 8) { PRO_STREAM(); PRO_WEIGHTS(); } else { PRO_WEIGHTS(); PRO_STREAM(); }
#undef PRO_WEIGHTS
#undef PRO_STREAM
        { float* km = (float*)(ws + WS_KM); for (int i = blockIdx.x * NTHR + opq_tid(); i < NB * NBLK * AW; i += gridDim.x * NTHR) km[i] = 0.f; }
    }
    GRID_BAR();
    for (int l = 0; l < NL; ++l) {
        REP(1)
        { unsigned char* ws = a.ws; OPQ(ws); WSP(bf16_t, h, WS_H); WSP(bf16_t, z, WS_Z); WSP(bf16_t, Win, WS_WIN);
          pg8::Gemm g{h, Win + (size_t)l * INW * DM, T, INW, DM, DM, DM, 0}; pg8::StaticOrder S; S.init(T, INW, (int)gridDim.x, (int)blockIdx.x);
          pg8::gemm_phase<EpiZk, pg8::StaticOrder, true, true>((PG8_LAS unsigned char*)lds, g, S, EpiZk{z, (float*)(ws + WS_KM)}); }
        GRID_BAR();
        REP(2)
        { unsigned char* ws = a.ws; OPQ(ws); WSP(bf16_t, z, WS_Z); WSP(bf16_t, m, WS_M);
          ph_poolm2(z, m); }
        REP(3)
        { unsigned char* ws = a.ws; OPQ(ws); WSP(bf16_t, z, WS_Z); WSP(bf16_t, o, WS_O);
          ph_attn(lds, z, (const float*)(ws + WS_KM), o); }
        GRID_BAR();
        { float* km = (float*)(a.ws + WS_KM); for (int i = blockIdx.x * NTHR + opq_tid(); i < NB * NBLK * AW; i += gridDim.x * NTHR) km[i] = 0.f; }
        REP(11)
        { unsigned char* ws = a.ws; OPQ(ws); WSP(bf16_t, z, WS_Z); WSP(bf16_t, m, WS_M); WSP(bf16_t, gaa, WS_GAA); WSP(bf16_t, Wpool, WS_WPOOL);
          { int kpool = 256; asm volatile("" : "+s"(kpool)); pg8::Gemm g{m, Wpool + (size_t)l * DM * 256, T, DM, kpool, PW, 256, 128};        pg8::StaticOrder S; S.init(T, DM, (int)gridDim.x, (int)blockIdx.x);
            pg8::gemm_phase<EpiAdapt8L<EpiPool8L>, pg8::StaticOrder, true, true>((PG8_LAS unsigned char*)lds, g, S, EpiAdapt8L<EpiPool8L>{EpiPool8L{z, a.pool_scale + l * DM, gaa}}); } }
        REP(4)
        { unsigned char* ws = a.ws; OPQ(ws); WSP(bf16_t, z, WS_Z); WSP(bf16_t, o, WS_O); WSP(bf16_t, gaa, WS_GAA); WSP(bf16_t, mrg, WS_MRG); WSP(bf16_t, Wup, WS_WUP);
          { pg8::Gemm g{o, Wup + (size_t)l * DM * AW, T, DM, AW, AW, AW, 0}; pg8::StaticOrder S; S.init(T, DM, (int)gridDim.x, (int)blockIdx.x);
            pg8::gemm_phase<EpiAdapt8L<EpiUp8L>, pg8::StaticOrder, true, true>((PG8_LAS unsigned char*)lds, g, S, EpiAdapt8L<EpiUp8L>{EpiUp8L{z, gaa, mrg}}); } }
        GRID_BAR();
        REP(5)
        { unsigned char* ws = a.ws; OPQ(ws); WSP(bf16_t, mrg, WS_MRG); WSP(bf16_t, Wout, WS_WOUT); WSP(bf16_t, h, WS_H); float* out = a.out; OPQ(out);
          pg8::Gemm g{mrg, Wout + (size_t)l * DM * DM, T, DM, DM, DM, DM, 0}; pg8::StaticOrder S; S.init(T, DM, (int)gridDim.x, (int)blockIdx.x);
          if (l == 0) pg8::gemm_phase<EpiAdapt8L<EpiResNormL<false>, 2>, pg8::StaticOrder, true, true>((PG8_LAS unsigned char*)lds, g, S, EpiAdapt8L<EpiResNormL<false>, 2>{EpiResNormL<false>{a.x, (const bf16_t*)(ws + WS_XB), (bf16_t*)(ws + WS_XB), (float*)(ws + WS_GAA)}});
          else pg8::gemm_phase<EpiAdapt8L<EpiResNormL<true>, 4>, pg8::StaticOrder, true, true>((PG8_LAS unsigned char*)lds, g, S, EpiAdapt8L<EpiResNormL<true>, 4>{EpiResNormL<true>{a.x, (const bf16_t*)(ws + WS_XB), (bf16_t*)(ws + WS_XB), (float*)(ws + WS_GAA)}}); }
        GRID_BAR();
        REP(7)
        { unsigned char* ws = a.ws; OPQ(ws); WSP(bf16_t, h, WS_H); WSP(float, sc, WS_SC); WSP(bf16_t, Wpeer, WS_WPEER);
          pg8::Gemm g{(const bf16_t*)(ws + WS_XB), Wpeer + (size_t)l * PQW * DM, T, PQW, DM, DM, DM, 0}; pg8::StaticOrder S; S.init(T, PQW, (int)gridDim.x, (int)blockIdx.x);
          pg8::Unit u0, u1; u0.pm = 0; u0.pn = 0; u1.pm = 0; u1.pn = 0; const bool h0 = S.next(0, u0), h1 = S.next(1, u1);
          LAS float* rl = (LAS float*)((LAS unsigned char*)lds + 131072);
          { const int t_ = opq_tid(); const int pmx = (t_ < 256) ? u0.pm : u1.pm; if ((t_ < 256) ? h0 : h1) rl[t_] = rstd_of((const float*)(ws + WS_GAA), (size_t)pmx * 256 + (t_ & 255)); }
          { const int t2_ = opq_tid(); if (t2_ < 2) ((LAS int*)((LAS unsigned char*)lds + 133120))[t2_] = (t2_ == 0) ? (h0 ? u0.pm : -1) : (h1 ? u1.pm : -1); }
          __syncthreads();
          pg8::gemm_phase<EpiI16s, pg8::StaticOrder, true, true>((PG8_LAS unsigned char*)lds, g, S, EpiI16s{(short*)sc, (const float*)(ws + WS_GAA)}); }
        GRID_BAR();
        { unsigned char* ws = a.ws; OPQ(ws); WSP(float, sc, WS_SC); WSP(int, eid, WS_EID); WSP(float, gw, WS_GW); WSP(float, wact, WS_WACT); WSP(bf16_t, h, WS_H); float* out = a.out; OPQ(out);
          ph_peer_all(lds, (const short*)sc, eid, gw, (int*)(ws + WS_KMEAN), wact, (const bf16_t*)(ws + WS_XB), a.ffn_norm + l * DM, (const float*)(ws + WS_GAA), ws + WS_UQ + (size_t)l * NEXP * DM, (const float*)(ws + WS_SU) + (size_t)l * NEXP,
                      ws + WS_VQ + (size_t)l * NEXP * DM, (const float*)(ws + WS_SV) + (size_t)l * NEXP, out, (bf16_t*)(ws + WS_XB), l == NL - 1 ? a.final_norm : a.mix_norm + (l + 1) * DM, h, l == NL - 1 ? 1 : 0, l == 0 ? a.peer_u : nullptr, a.peer_v, ws + WS_UQ, (float*)(ws + WS_SU) + NEXP); }
        if (l + 1 < NL) GRID_BAR();
    }
}

extern "C" void kernel_launch(void* const* d_in, const int* in_sizes, int n_in, void* d_out, int out_size, void* d_ws, size_t ws_size, hipStream_t stream) {
    static int grid = 0;
    if (grid == 0) {
        if (n_in != 13 || ws_size < WS_END) { fprintf(stderr, "kernel_launch: unexpected inputs / workspace (%d, %zu)\n", n_in, ws_size); grid = -1; return; }
        int dev = 0, cus = 0, per_cu = 0;
        hipGetDevice(&dev); hipDeviceGetAttribute(&cus, hipDeviceAttributeMultiprocessorCount, dev);
        if (hipFuncSetAttribute((const void*)mk_fwd, hipFuncAttributeMaxDynamicSharedMemorySize, LDS_BYTES) != hipSuccess) { fprintf(stderr, "kernel_launch: hipFuncSetAttribute failed\n"); grid = -1; return; }
        if (hipOccupancyMaxActiveBlocksPerMultiprocessor(&per_cu, (const void*)mk_fwd, NTHR, LDS_BYTES) != hipSuccess || per_cu < 1) { fprintf(stderr, "kernel_launch: occupancy query says %d\n", per_cu); grid = -1; return; }
        grid = cus;
    }
    if (grid < 0) return;
    Args a{};
    a.x = (const float*)d_in[0]; a.mix_norm = (const float*)d_in[1]; a.w_in = (const float*)d_in[2]; a.w_pool = (const float*)d_in[3]; a.pool_scale = (const float*)d_in[4];
    a.w_up = (const float*)d_in[5]; a.w_out = (const float*)d_in[6]; a.ffn_norm = (const float*)d_in[7]; a.peer_wq = (const float*)d_in[8]; a.peer_keys = (const float*)d_in[9];
    a.peer_u = (const float*)d_in[10]; a.peer_v = (const float*)d_in[11]; a.final_norm = (const float*)d_in[12]; a.out = (float*)d_out; a.ws = (unsigned char*)d_ws;
    if (hipMemsetAsync((char*)d_ws + WS_CTL, 0, 65536, stream) != hipSuccess) { fprintf(stderr, "kernel_launch: memset failed\n"); return; }
    void* args[] = {&a};
    hipError_t e = hipLaunchCooperativeKernel((const void*)mk_fwd, dim3(grid), dim3(NTHR), args, LDS_BYTES, stream);
    if (e != hipSuccess) fprintf(stderr, "kernel_launch: cooperative launch failed: %s (grid %d)\n", hipGetErrorString(e), grid);
}
```
